# Optimizing an MI355X kernel written in HIP

```python
import math
import jax, jax.numpy as jnp
from jax import lax
import numpy as np

D_MODEL = 1024
BATCH = 4
SEQ = 4096
DEPTH = 1

MEM_TOKENS = 256
EPS = 1e-6
MLA_HEADS = 8
MLA_NOPE = 64
MLA_ROPE = 32
MLA_V = 64
MLA_Q_RANK = 256
MLA_KV_RANK = 128
ROPE_BASE = 10000.0
Q_BLOCK = 128
HY_WIDTH = D_MODEL - MLA_HEADS * MLA_V
HY_ORDER = 2
HY_DIRS = 2
HY_BANDS = 16
HY_EMB = 1 + 2 * HY_BANDS
HY_FFN = 64
HY_TARGET = 1e-2
HY_FAST_PCT = 0.3
HY_SLOW_PCT = 1.5
OFF_Q = 0
OFF_KV = OFF_Q + MLA_Q_RANK
OFF_KR = OFF_KV + MLA_KV_RANK
OFF_HY = OFF_KR + MLA_ROPE
IN_COLS = OFF_HY + 3 * HY_WIDTH
MEM_HEADS = 4
MEM_HEAD_DIM = D_MODEL // MEM_HEADS
N_GROUPS = 4
EXPERTS_PER_GROUP = 8
TOP_K_IN_GROUP = 2
D_EXPERT = 256

kernel_name = "hybrid_mla_hyena_hmoe_encoder"


def _rms(x, g):
    xf = x.astype(jnp.float32)
    y = xf * lax.rsqrt(jnp.mean(xf * xf, axis=-1, keepdims=True) + EPS)
    return (y * g.astype(jnp.float32)).astype(x.dtype)


def _rope(x, cos, sin):
    x1, x2 = jnp.split(x.astype(jnp.float32), 2, axis=-1)
    return jnp.concatenate([x1 * cos - x2 * sin, x1 * sin + x2 * cos], axis=-1).astype(x.dtype)


def _mla(h_q, h_kv, h_kr, q_norm_g, kv_norm_g, w_uq, w_ukv):
    B, S, _ = h_q.shape
    q = (_rms(h_q, q_norm_g) @ w_uq).reshape(B, S, MLA_HEADS, MLA_NOPE + MLA_ROPE)
    q_nope, q_rot = q[..., :MLA_NOPE], q[..., MLA_NOPE:]
    kv = (_rms(h_kv, kv_norm_g) @ w_ukv).reshape(B, S, MLA_HEADS, MLA_NOPE + MLA_V)
    k_nope, v = kv[..., :MLA_NOPE], kv[..., MLA_NOPE:]
    pos = jnp.arange(S, dtype=jnp.float32)
    half = MLA_ROPE // 2
    inv = ROPE_BASE ** (-jnp.arange(half, dtype=jnp.float32) / half)
    ang = pos[:, None] * inv[None, :]
    cos, sin = jnp.cos(ang), jnp.sin(ang)
    q_rot = _rope(q_rot, cos[:, None, :], sin[:, None, :])
    k_rot = _rope(h_kr, cos, sin)
    scale = (MLA_NOPE + MLA_ROPE) ** -0.5
    nb = S // Q_BLOCK

    def to_blocks(t):
        return jnp.moveaxis(t.reshape(B, nb, Q_BLOCK, *t.shape[2:]), 1, 0)

    def attend(blk):
        qn, qr = blk
        s = (jnp.einsum('bqhd,bkhd->bhqk', qn, k_nope)
             + jnp.einsum('bqhr,bkr->bhqk', qr, k_rot)).astype(jnp.float32) * scale
        p = jax.nn.softmax(s, axis=-1).astype(v.dtype)
        return jnp.einsum('bhqk,bkhd->bqhd', p, v)

    o = lax.map(attend, (to_blocks(q_nope), to_blocks(q_rot)))
    return jnp.moveaxis(o, 0, 1).reshape(B, S, MLA_HEADS * MLA_V)


def _hyena_filters(L, w1, b1, freq, w2, b2, w3, b3, decay):
    f32 = jnp.float32
    t = jnp.arange(L, dtype=f32)
    t01 = t / L
    bands = jnp.linspace(1e-4, HY_BANDS - 1, HY_BANDS, dtype=f32)
    ang = 2.0 * math.pi * t[:, None] * bands[None, :] / L
    z = jnp.concatenate([t01[:, None], jnp.cos(ang), -jnp.sin(ang)], axis=-1)
    fr = freq.astype(f32)
    h = jnp.sin(fr[0] * (z @ w1.astype(f32) + b1.astype(f32)))
    h = jnp.sin(fr[1] * (h @ w2.astype(f32) + b2.astype(f32)))
    h = h @ w3.astype(f32) + b3.astype(f32)
    h = h * jnp.exp(-t01[:, None] * jnp.abs(decay.astype(f32))[None, :])
    h = h.reshape(L, HY_ORDER, HY_DIRS, HY_WIDTH)
    fwd, bwd = h[:, :, 0], h[:, :, 1]
    k = jnp.concatenate([fwd, jnp.zeros((1, HY_ORDER, HY_WIDTH), f32), bwd[:0:-1]], axis=0)
    return jnp.fft.rfft(k, axis=0)


def _hyena(u, conv_w, conv_b, kf, skip):
    B, S, _ = u.shape
    up = jnp.pad(u, ((0, 0), (1, 1), (0, 0)))
    u = up[:, :-2] * conv_w[0] + up[:, 1:-1] * conv_w[1] + up[:, 2:] * conv_w[2] + conv_b
    x1, x2, v = jnp.split(u, 3, axis=-1)
    gates = (x1, x2)
    z = v.astype(jnp.float32)
    for n in range(HY_ORDER):
        zf = jnp.fft.rfft(z, n=2 * S, axis=1)
        conv = jnp.fft.irfft(zf * kf[None, :, n], n=2 * S, axis=1)[:, :S]
        z = gates[n].astype(jnp.float32) * (conv + skip[n].astype(jnp.float32) * z)
    return z.astype(u.dtype)


def _mem_xattn(hx, hm, w_mq, w_mkv, w_mo):
    B, S, _ = hx.shape
    M = hm.shape[1]
    q = (hx @ w_mq).reshape(B, S, MEM_HEADS, MEM_HEAD_DIM)
    k, v = jnp.split(hm @ w_mkv, 2, axis=-1)
    k = k.reshape(B, M, MEM_HEADS, MEM_HEAD_DIM)
    v = v.reshape(B, M, MEM_HEADS, MEM_HEAD_DIM)
    s = jnp.einsum('bshd,bmhd->bhsm', q, k).astype(jnp.float32) * MEM_HEAD_DIM ** -0.5
    p = jax.nn.softmax(s, axis=-1).astype(v.dtype)
    o = jnp.einsum('bhsm,bmhd->bshd', p, v).reshape(B, S, MEM_HEADS * MEM_HEAD_DIM)
    return o @ w_mo


def _hier_moe(h, w_rg, b_rg, w_re, b_re, w_gate, w_up, w_down):
    B, S, D = h.shape
    t = h.reshape(B * S, D)
    g_logits = (t @ w_rg).astype(jnp.float32) + b_rg.astype(jnp.float32)
    g_prob = jax.nn.softmax(g_logits, axis=-1)
    _, g_idx = lax.top_k(g_logits, 1)
    p_group = jnp.take_along_axis(g_prob, g_idx, axis=1)
    e_logits = ((t @ w_re).astype(jnp.float32) + b_re.astype(jnp.float32)).reshape(-1, N_GROUPS, EXPERTS_PER_GROUP)
    e_in = jnp.take_along_axis(e_logits, g_idx[:, :, None], axis=1)[:, 0]
    top_v, top_i = lax.top_k(e_in, TOP_K_IN_GROUP)
    p_exp = jax.nn.softmax(top_v, axis=-1)
    w_e = jnp.sum(jax.nn.one_hot(top_i, EXPERTS_PER_GROUP, dtype=jnp.float32) * p_exp[..., None], axis=1)
    combine = ((p_group * w_e)[:, None, :]
               * jax.nn.one_hot(g_idx[:, 0], N_GROUPS, dtype=jnp.float32)[:, :, None]).astype(t.dtype)
    y = jnp.zeros_like(t)
    for g in range(N_GROUPS):
        a = jnp.einsum('td,edf->tef', t, w_gate[g])
        b = jnp.einsum('td,edf->tef', t, w_up[g])
        m = jax.nn.silu(a) * b * combine[:, g, :, None]
        y = y + jnp.einsum('tef,efd->td', m, w_down[g])
    return y.reshape(B, S, D)


def setup_inputs(seed: int = 0) -> dict:
    key = jax.random.key(seed)
    ks = iter(jax.random.split(key, 40))
    f32 = jnp.float32
    L_ = DEPTH

    def nrm(shape, fan_in, scale=1.0):
        return jax.random.normal(next(ks), shape, f32) * (scale * fan_in ** -0.5)

    def gain(shape):
        return 1.0 + 0.02 * jax.random.normal(next(ks), shape, f32)

    def small(shape, s=0.02):
        return s * jax.random.normal(next(ks), shape, f32)

    G, E, F = N_GROUPS, EXPERTS_PER_GROUP, D_EXPERT
    d_min = math.log(1.0 / HY_TARGET) / HY_SLOW_PCT
    d_max = math.log(1.0 / HY_TARGET) / HY_FAST_PCT
    return {
        "x": jax.random.normal(next(ks), (BATCH, SEQ, D_MODEL), f32),
        "mem": jax.random.normal(next(ks), (BATCH, MEM_TOKENS, D_MODEL), f32),
        "mix_norm_g": gain((L_, D_MODEL)),
        "w_in": nrm((L_, D_MODEL, IN_COLS), D_MODEL),
        "q_norm_g": gain((L_, MLA_Q_RANK)),
        "kv_norm_g": gain((L_, MLA_KV_RANK)),
        "w_uq": nrm((L_, MLA_Q_RANK, MLA_HEADS * (MLA_NOPE + MLA_ROPE)), MLA_Q_RANK),
        "w_ukv": nrm((L_, MLA_KV_RANK, MLA_HEADS * (MLA_NOPE + MLA_V)), MLA_KV_RANK),
        "hy_conv_w": nrm((L_, 3, 3 * HY_WIDTH), 3),
        "hy_conv_b": small((L_, 3 * HY_WIDTH)),
        "hy_w1": nrm((L_, HY_EMB, HY_FFN), HY_EMB),
        "hy_b1": small((L_, HY_FFN), 0.1),
        "hy_freq": gain((L_, 2, HY_FFN)),
        "hy_w2": nrm((L_, HY_FFN, HY_FFN), HY_FFN),
        "hy_b2": small((L_, HY_FFN), 0.1),
        "hy_w3": nrm((L_, HY_FFN, HY_ORDER * HY_DIRS * HY_WIDTH), HY_FFN, 0.1),
        "hy_b3": small((L_, HY_ORDER * HY_DIRS * HY_WIDTH), 0.01),
        "hy_decay": jax.random.uniform(next(ks), (L_, HY_ORDER * HY_DIRS * HY_WIDTH), f32, d_min, d_max),
        "hy_skip": jax.random.normal(next(ks), (L_, HY_ORDER, HY_WIDTH), f32),
        "attn_out_g": gain((L_, MLA_HEADS * MLA_V)),
        "hy_out_g": gain((L_, HY_WIDTH)),
        "w_out": nrm((L_, D_MODEL, D_MODEL), D_MODEL),
        "cross_norm_g": gain((L_, D_MODEL)),
        "mem_norm_g": gain((L_, D_MODEL)),
        "w_mq": nrm((L_, D_MODEL, MEM_HEADS * MEM_HEAD_DIM), D_MODEL),
        "w_mkv": nrm((L_, D_MODEL, 2 * MEM_HEADS * MEM_HEAD_DIM), D_MODEL),
        "w_mo": nrm((L_, MEM_HEADS * MEM_HEAD_DIM, D_MODEL), MEM_HEADS * MEM_HEAD_DIM),
        "ffn_norm_g": gain((L_, D_MODEL)),
        "w_route_group": nrm((L_, D_MODEL, G), D_MODEL),
        "b_route_group": small((L_, G), 0.01),
        "w_route_expert": nrm((L_, D_MODEL, G * E), D_MODEL),
        "b_route_expert": small((L_, G * E), 0.01),
        "w_gate": nrm((L_, G, E, D_MODEL, F), D_MODEL),
        "w_up": nrm((L_, G, E, D_MODEL, F), D_MODEL),
        "w_down": nrm((L_, G, E, F, D_MODEL), F),
        "final_norm_g": gain((D_MODEL,)),
    }


def reference(x, mem, mix_norm_g, w_in, q_norm_g, kv_norm_g, w_uq, w_ukv, hy_conv_w, hy_conv_b,
              hy_w1, hy_b1, hy_freq, hy_w2, hy_b2, hy_w3, hy_b3, hy_decay, hy_skip, attn_out_g, hy_out_g,
              w_out, cross_norm_g, mem_norm_g, w_mq, w_mkv, w_mo, ffn_norm_g, w_route_group, b_route_group,
              w_route_expert, b_route_expert, w_gate, w_up, w_down, final_norm_g):
    S = x.shape[1]
    for l in range(DEPTH):
        h = _rms(x, mix_norm_g[l])
        p = h @ w_in[l]
        a_out = _mla(p[..., OFF_Q:OFF_KV], p[..., OFF_KV:OFF_KR], p[..., OFF_KR:OFF_HY],
                     q_norm_g[l], kv_norm_g[l], w_uq[l], w_ukv[l])
        kf = _hyena_filters(S, hy_w1[l], hy_b1[l], hy_freq[l], hy_w2[l], hy_b2[l], hy_w3[l], hy_b3[l], hy_decay[l])
        h_out = _hyena(p[..., OFF_HY:], hy_conv_w[l], hy_conv_b[l], kf, hy_skip[l])
        mixed = jnp.concatenate([_rms(a_out, attn_out_g[l]), _rms(h_out, hy_out_g[l])], axis=-1)
        x = x + mixed @ w_out[l]
        x = x + _mem_xattn(_rms(x, cross_norm_g[l]), _rms(mem, mem_norm_g[l]), w_mq[l], w_mkv[l], w_mo[l])
        x = x + _hier_moe(_rms(x, ffn_norm_g[l]), w_route_group[l], b_route_group[l], w_route_expert[l],
                          b_route_expert[l], w_gate[l], w_up[l], w_down[l])
    return _rms(x, final_norm_g)
```

```cpp
#include <hip/hip_runtime.h>
#include <cstdint>
#include <cstdio>
typedef _Float16 h16;

constexpr int NB = 4, S = 4096, D = 1024, T = NB * S, MEMT = 256, MROWS = NB * MEMT;
constexpr int NH = 8, HYW = 512;
constexpr int LAT = 416, INC = 1952;
constexpr int MH = 4, MHD = 256;
constexpr int NE = 32, DE = 256;
constexpr float EPS = 1e-6f;
constexpr float LOG2E = 1.4426950408889634f;
constexpr float QSCALE = 0.10206207261596575f * LOG2E;
constexpr float CSCALE = 0.0625f * LOG2E;

constexpr size_t MiB = 1u << 20;
constexpr size_t WS_CTL = 0;
constexpr size_t WS_SSX = 64 * 1024, WS_SSQ = 128 * 1024, WS_SSKV = 192 * 1024, WS_SSA = 256 * 1024, WS_SSH = 320 * 1024,
                 WS_SSX1 = 384 * 1024, WS_SSX2 = 448 * 1024, WS_SSMEM = 512 * 1024, WS_TOKE = 576 * 1024, WS_TOKW = 704 * 1024,
                 WS_TOKP = 832 * 1024;
constexpr size_t WS_WIN = 2 * MiB, WS_WUQ = 6 * MiB, WS_WUKV = 6 * MiB + 512 * 1024, WS_WOUT = 7 * MiB, WS_WMQ = 9 * MiB,
                 WS_WMKV = 11 * MiB, WS_WMO = 15 * MiB, WS_MEMH = 17 * MiB, WS_KC = 19 * MiB, WS_VCT = 21 * MiB, WS_R = 23 * MiB,
                 WS_WGU = 39 * MiB, WS_WDN = 71 * MiB, WS_LAT = 87 * MiB, WS_HYT = 101 * MiB, WS_XH = 149 * MiB, WS_Q = 149 * MiB,
                 WS_K = 173 * MiB, WS_VT = 197 * MiB, WS_AOUT = 213 * MiB, WS_HT = 229 * MiB, WS_LIST = 245 * MiB, WS_H2 = 247 * MiB;
constexpr size_t WS_MIX = 87 * MiB, WS_X1H = 119 * MiB, WS_QC = 151 * MiB, WS_X2H = 87 * MiB, WS_HB = 119 * MiB, WS_YB = 135 * MiB;

__device__ __forceinline__ float wave_sum(float v) {
#pragma unroll
    for (int o = 1; o < 64; o <<= 1) v += __shfl_xor(v, o);
    return v;
}
__device__ __forceinline__ float rstd_of(float ss, int n) { return 1.0f / sqrtf(ss / (float)n + EPS); }

__global__ __launch_bounds__(256) void k_cvt_rows(const float* x, h16* xh, float* ss, int rows, int n) {
    int row = blockIdx.x * 4 + (threadIdx.x >> 6), lane = threadIdx.x & 63;
    if (row >= rows) return;
    float s = 0.f;
    for (int k = lane; k < n; k += 64) { float v = x[(size_t)row * n + k]; s += v * v; xh[(size_t)row * n + k] = (h16)v; }
    s = wave_sum(s);
    if (lane == 0) ss[row] = s;
}
__global__ void k_wt(const float* W, const float* g, const float* g2, int ksplit, h16* Wt, int K, int N, int Npad) {
    size_t i = (size_t)blockIdx.x * 256 + threadIdx.x;
    if (i >= (size_t)K * Npad) return;
    int n = (int)(i % Npad), k = (int)(i / Npad);
    float v = 0.f;
    if (n < N) v = W[(size_t)k * N + n] * (g ? (k < ksplit ? g[k] : g2[k - ksplit]) : 1.f);
    Wt[(size_t)n * K + k] = (h16)v;
}
__global__ void k_wt_gu(const float* wg, const float* wu, const float* g, h16* Wt) {
    size_t i = (size_t)blockIdx.x * 256 + threadIdx.x;
    if (i >= (size_t)NE * D * DE) return;
    int j = (int)(i % DE), k = (int)((i / DE) % D), e = (int)(i / ((size_t)DE * D));
    int np = 32 * (j >> 4) + (j & 15);
    float gg = g[k];
    Wt[((size_t)e * 512 + np) * D + k] = (h16)(wg[i] * gg);
    Wt[((size_t)e * 512 + np + 16) * D + k] = (h16)(wu[i] * gg);
}
__global__ void k_wt_dn(const float* wd, h16* Wt) {
    size_t i = (size_t)blockIdx.x * 256 + threadIdx.x;
    if (i >= (size_t)NE * DE * D) return;
    int n = (int)(i % D), f = (int)((i / D) % DE), e = (int)(i / ((size_t)D * DE));
    Wt[((size_t)e * D + n) * DE + f] = (h16)wd[i];
}
__global__ __launch_bounds__(64) void k_filt12(const float* w1, const float* b1, const float* freq, const float* w2, const float* b2, float* H2) {
    __shared__ float z[33], h1[64];
    int t = blockIdx.x, j = threadIdx.x;
    if (j < 33) {
        float v;
        if (j == 0) v = (float)t / (float)S;
        else {
            int bi = (j - 1) & 15;
            float band = 1e-4f + (float)bi * ((15.0f - 1e-4f) / 15.0f);
            double rev = (double)t * (double)band / (double)S;
            rev -= floor(rev);
            float r2 = (float)(2.0 * rev);
            v = (j <= 16) ? cospif(r2) : -sinpif(r2);
        }
        z[j] = v;
    }
    __syncthreads();
    float a = b1[j];
    for (int i = 0; i < 33; ++i) a += z[i] * w1[i * 64 + j];
    h1[j] = sinf(freq[j] * a);
    __syncthreads();
    float c = b2[j];
    for (int i = 0; i < 64; ++i) c += h1[i] * w2[i * 64 + j];
    H2[t * 64 + j] = sinf(freq[64 + j] * c);
}
__global__ void k_filt3(const float* H2, const float* w3, const float* b3, const float* decay, h16* R) {
    int i = blockIdx.x * 256 + threadIdx.x;
    int col = i & 2047, tau = i >> 11;
    float a = b3[col];
    for (int j = 0; j < 64; ++j) a += H2[tau * 64 + j] * w3[j * 2048 + col];
    a *= expf(-((float)tau / (float)S) * fabsf(decay[col]));
    int o = col >> 10, dir = (col >> 9) & 1, c = col & 511;
    h16* r = R + ((size_t)(o * 512 + c)) * 8192;
    if (dir == 0) r[4096 - tau] = (h16)a;
    else r[tau == 0 ? 0 : 4096 + tau] = (h16)(tau == 0 ? 0.f : a);
}

template <class Epi>
__global__ __launch_bounds__(256) void k_gemm_naive(const h16* A, int lda, const h16* Wt, int ldw, int M, int N, int K, Epi epi) {
    __shared__ float As[16][65], Bs[16][65];
    int tx = threadIdx.x & 15, ty = threadIdx.x >> 4;
    int m0 = blockIdx.y * 64, n0 = blockIdx.x * 64;
    float acc[4][4];
#pragma unroll
    for (int i = 0; i < 4; ++i)
#pragma unroll
        for (int j = 0; j < 4; ++j) acc[i][j] = 0.f;
    for (int k0 = 0; k0 < K; k0 += 16) {
        for (int i = threadIdx.x; i < 1024; i += 256) {
            int r = i >> 4, c = i & 15, m = m0 + r, n = n0 + r;
            As[c][r] = (m < M) ? (float)A[(size_t)m * lda + k0 + c] : 0.f;
            Bs[c][r] = (n < N) ? (float)Wt[(size_t)n * ldw + k0 + c] : 0.f;
        }
        __syncthreads();
#pragma unroll
        for (int kk = 0; kk < 16; ++kk) {
            float a[4], b[4];
#pragma unroll
            for (int i = 0; i < 4; ++i) { a[i] = As[kk][ty * 4 + i]; b[i] = Bs[kk][tx * 4 + i]; }
#pragma unroll
            for (int i = 0; i < 4; ++i)
#pragma unroll
                for (int j = 0; j < 4; ++j) acc[i][j] += a[i] * b[j];
        }
        __syncthreads();
    }
#pragma unroll
    for (int i = 0; i < 4; ++i)
#pragma unroll
        for (int j = 0; j < 4; ++j) { int m = m0 + ty * 4 + i, n = n0 + tx * 4 + j; if (m < M && n < N) epi(m, n, acc[i][j]); }
}
struct EpiIn { const float* ssx; h16* lat; h16* hyT;
    __device__ void operator()(int m, int n, float v) const {
        v *= rstd_of(ssx[m], D);
        if (n < LAT) lat[(size_t)m * LAT + n] = (h16)v;
        else if (n < INC) { int b = m >> 12, t = m & 4095; hyT[((size_t)(b * 1536 + (n - LAT))) * S + t] = (h16)v; }
    } };
struct EpiQ { const float* ssq; h16* Q;
    __device__ void operator()(int m, int n, float v) const {
        v *= rstd_of(ssq[m], 256) * QSCALE; int b = m >> 12, t = m & 4095, h = n / 96, j = n % 96;
        Q[((size_t)((b * NH + h) * S + t)) * 96 + j] = (h16)v;
    } };
struct EpiKV { const float* sskv; h16* K; h16* Vt;
    __device__ void operator()(int m, int n, float v) const {
        v *= rstd_of(sskv[m], 128); int b = m >> 12, t = m & 4095, h = n >> 7, j = n & 127;
        if (j < 64) K[((size_t)((b * NH + h) * S + t)) * 96 + j] = (h16)v;
        else Vt[((size_t)((b * NH + h) * 64 + (j - 64))) * S + t] = (h16)v;
    } };
struct EpiRes { const float* xin; float* X; h16* xh;
    __device__ void operator()(int m, int n, float v) const {
        size_t i = (size_t)m * D + n; float r = xin[i] + v; X[i] = r; xh[i] = (h16)r;
    } };
struct EpiMq { const float* ss; h16* qc;
    __device__ void operator()(int m, int n, float v) const { qc[(size_t)m * D + n] = (h16)(v * rstd_of(ss[m], D) * CSCALE); } };
struct EpiMkv { const float* ss; h16* Kc; h16* VcT;
    __device__ void operator()(int m, int n, float v) const {
        v *= rstd_of(ss[m], D);
        if (n < D) Kc[(size_t)m * D + n] = (h16)v;
        else { int np = n - D, h = np >> 8, d = np & 255, b = m >> 8, mm = m & 255; VcT[((size_t)((b * MH + h) * MHD + d)) * MEMT + mm] = (h16)v; }
    } };

__global__ __launch_bounds__(256) void k_rowss(const h16* A, int lda, int off, int n, float* ss, int rows) {
    int row = blockIdx.x * 4 + (threadIdx.x >> 6), lane = threadIdx.x & 63;
    if (row >= rows) return;
    float s = 0.f;
    for (int k = lane; k < n; k += 64) { float v = (float)A[(size_t)row * lda + off + k]; s += v * v; }
    s = wave_sum(s);
    if (lane == 0) ss[row] = s;
}
__global__ void k_rope(h16* Q, h16* K, const h16* lat) {
    int i = blockIdx.x * 256 + threadIdx.x;
    if (i >= T * 16) return;
    int m = i >> 4, p = i & 15, b = m >> 12, t = m & 4095;
    float inv = exp2f(-(float)p * (13.287712379549449f / 16.0f));
    float ang = (float)t * inv;
    float sn, cs; sincosf(ang, &sn, &cs);
    float k1 = (float)lat[(size_t)m * LAT + 384 + p], k2 = (float)lat[(size_t)m * LAT + 384 + 16 + p];
    h16 o1 = (h16)(k1 * cs - k2 * sn), o2 = (h16)(k1 * sn + k2 * cs);
    for (int h = 0; h < NH; ++h) {
        size_t base = ((size_t)((b * NH + h) * S + t)) * 96 + 64;
        K[base + p] = o1; K[base + 16 + p] = o2;
        float q1 = (float)Q[base + p], q2 = (float)Q[base + 16 + p];
        Q[base + p] = (h16)(q1 * cs - q2 * sn); Q[base + 16 + p] = (h16)(q1 * sn + q2 * cs);
    }
}
__global__ __launch_bounds__(128) void k_attn_naive(const h16* Q, const h16* K, const h16* Vt, h16* aout) {
    __shared__ float Ks[32][96], Vs[32][64];
    int bh = blockIdx.y, q0 = blockIdx.x * 128, tid = threadIdx.x;
    float q[96], o[64];
#pragma unroll
    for (int d = 0; d < 96; ++d) q[d] = (float)Q[((size_t)bh * S + q0 + tid) * 96 + d];
#pragma unroll
    for (int d = 0; d < 64; ++d) o[d] = 0.f;
    float m = -1e30f, l = 0.f;
    for (int k0 = 0; k0 < S; k0 += 32) {
        __syncthreads();
        for (int i = tid; i < 32 * 96; i += 128) { int r = i / 96, c = i % 96; Ks[r][c] = (float)K[((size_t)bh * S + k0 + r) * 96 + c]; }
        for (int i = tid; i < 32 * 64; i += 128) { int d = i >> 5, r = i & 31; Vs[r][d] = (float)Vt[((size_t)bh * 64 + d) * S + k0 + r]; }
        __syncthreads();
        for (int r = 0; r < 32; ++r) {
            float s = 0.f;
#pragma unroll
            for (int d = 0; d < 96; ++d) s += q[d] * Ks[r][d];
            if (s > m) { float al = exp2f(m - s); l *= al;
#pragma unroll
                for (int d = 0; d < 64; ++d) o[d] *= al;
                m = s; }
            float p = exp2f(s - m); l += p;
#pragma unroll
            for (int d = 0; d < 64; ++d) o[d] += p * Vs[r][d];
        }
    }
    int b = bh >> 3, h = bh & 7; float il = 1.f / l;
#pragma unroll
    for (int d = 0; d < 64; ++d) aout[((size_t)(b * S + q0 + tid)) * 512 + h * 64 + d] = (h16)(o[d] * il);
}
__global__ __launch_bounds__(256) void k_hyena_naive(const h16* hyT, const h16* R, const float* convw, const float* convb, const float* skip, h16* hT) {
    __shared__ float z[4096]; __shared__ float Rl[8192];
    int b = blockIdx.x >> 9, c = blockIdx.x & 511, tid = threadIdx.x;
    auto u3 = [&](int ch, int t) -> float {
        const h16* p = hyT + ((size_t)(b * 1536 + ch)) * S;
        float a = t > 0 ? (float)p[t - 1] : 0.f, bb = (float)p[t], cc = t < S - 1 ? (float)p[t + 1] : 0.f;
        return a * convw[ch] + bb * convw[1536 + ch] + cc * convw[3072 + ch] + convb[ch];
    };
    for (int n = 0; n < 2; ++n) {
        for (int u = tid; u < 8192; u += 256) Rl[u] = (float)R[((size_t)(n * 512 + c)) * 8192 + u];
        if (n == 0) for (int t = tid; t < S; t += 256) z[t] = u3(1024 + c, t);
        __syncthreads();
        float acc[16];
#pragma unroll
        for (int i = 0; i < 16; ++i) acc[i] = 0.f;
        for (int s = 0; s < S; ++s) {
            float zs = z[s];
#pragma unroll
            for (int i = 0; i < 16; ++i) acc[i] += zs * Rl[s - (tid + 256 * i) + 4096];
        }
        __syncthreads();
        float sk = skip[n * 512 + c];
#pragma unroll
        for (int i = 0; i < 16; ++i) {
            int t = tid + 256 * i;
            float zn = u3(n == 0 ? c : 512 + c, t) * (acc[i] + sk * z[t]);
            if (n == 0) z[t] = zn; else hT[((size_t)(b * 512 + c)) * S + t] = (h16)zn;
        }
        __syncthreads();
    }
}
__global__ void k_ss_h(const h16* hT, float* ss) {
    int m = blockIdx.x * 256 + threadIdx.x; int b = m >> 12, t = m & 4095; float s = 0.f;
    for (int c = 0; c < 512; ++c) { float v = (float)hT[((size_t)(b * 512 + c)) * S + t]; s += v * v; }
    ss[m] = s;
}
__global__ void k_mixprep(const h16* aout, const h16* hT, const float* ssa, const float* ssh, h16* mix) {
    size_t i = (size_t)blockIdx.x * 256 + threadIdx.x;
    int m = (int)(i & (T - 1)), k = (int)(i >> 14);
    float v;
    if (k < 512) v = (float)aout[(size_t)m * 512 + k] * rstd_of(ssa[m], 512);
    else { int b = m >> 12, t = m & 4095; v = (float)hT[((size_t)(b * 512 + (k - 512))) * S + t] * rstd_of(ssh[m], 512); }
    mix[(size_t)m * D + k] = (h16)v;
}
__global__ __launch_bounds__(256) void k_xattn_naive(h16* qc, const h16* Kc, const h16* VcT) {
    __shared__ float sc[32][257]; __shared__ float il[32]; __shared__ h16 qs[32][256];
    int bh = blockIdx.y, b = bh >> 2, h = bh & 3, t0 = blockIdx.x * 32, tid = threadIdx.x, wv = tid >> 6, lane = tid & 63;
    for (int i = tid; i < 32 * 256; i += 256) { int tok = i >> 8, d = i & 255; qs[tok][d] = qc[((size_t)(b * S + t0 + tok)) * D + h * MHD + d]; }
    __syncthreads();
    for (int mi = 0; mi < 64; ++mi) {
        int mm = wv * 64 + mi;
        const h16* kp = Kc + ((size_t)(b * MEMT + mm)) * D + h * MHD + lane * 4;
        float k0 = (float)kp[0], k1 = (float)kp[1], k2 = (float)kp[2], k3 = (float)kp[3];
        for (int tok = 0; tok < 32; ++tok) {
            float s = (float)qs[tok][lane * 4] * k0 + (float)qs[tok][lane * 4 + 1] * k1 + (float)qs[tok][lane * 4 + 2] * k2 + (float)qs[tok][lane * 4 + 3] * k3;
            s = wave_sum(s);
            if (lane == 0) sc[tok][mm] = s;
        }
    }
    __syncthreads();
    if (tid < 32) { float mx = -1e30f; for (int j = 0; j < 256; ++j) mx = fmaxf(mx, sc[tid][j]); float l = 0.f;
        for (int j = 0; j < 256; ++j) { float p = exp2f(sc[tid][j] - mx); sc[tid][j] = p; l += p; } il[tid] = 1.f / l; }
    __syncthreads();
    for (int di = 0; di < 64; ++di) {
        int d = wv * 64 + di;
        const h16* vp = VcT + ((size_t)((b * MH + h) * MHD + d)) * MEMT + lane * 4;
        float v0 = (float)vp[0], v1 = (float)vp[1], v2 = (float)vp[2], v3 = (float)vp[3];
        for (int tok = 0; tok < 32; ++tok) {
            float o = sc[tok][lane * 4] * v0 + sc[tok][lane * 4 + 1] * v1 + sc[tok][lane * 4 + 2] * v2 + sc[tok][lane * 4 + 3] * v3;
            o = wave_sum(o);
            if (lane == 0) qc[((size_t)(b * S + t0 + tok)) * D + h * MHD + d] = (h16)(o * il[tok]);
        }
    }
}
__global__ __launch_bounds__(256) void k_route(const float* X, const float* g, const float* wrg, const float* brg, const float* wre, const float* bre,
                                               float* ssx2, int* toke, float* tokw, int* tokp, int* cnt, int* list) {
    int m = blockIdx.x * 4 + (threadIdx.x >> 6), lane = threadIdx.x & 63;
    float xs[16]; float ss = 0.f;
#pragma unroll
    for (int i = 0; i < 16; ++i) { xs[i] = X[(size_t)m * D + lane + 64 * i]; ss += xs[i] * xs[i]; }
    ss = wave_sum(ss);
    float rs = rstd_of(ss, D);
    float lg[36];
#pragma unroll
    for (int j = 0; j < 36; ++j) lg[j] = 0.f;
#pragma unroll
    for (int i = 0; i < 16; ++i) { int k = lane + 64 * i; float tv = xs[i] * rs * g[k];
#pragma unroll
        for (int j = 0; j < 4; ++j) lg[j] += tv * wrg[k * 4 + j];
#pragma unroll
        for (int j = 0; j < 32; ++j) lg[4 + j] += tv * wre[k * 32 + j]; }
#pragma unroll
    for (int j = 0; j < 36; ++j) lg[j] = wave_sum(lg[j]);
    if (lane == 0) {
        ssx2[m] = ss;
        float gl[4]; int gi = 0; float gm = -1e30f;
#pragma unroll
        for (int j = 0; j < 4; ++j) { gl[j] = lg[j] + brg[j]; if (gl[j] > gm) { gm = gl[j]; gi = j; } }
        float gs = 0.f;
#pragma unroll
        for (int j = 0; j < 4; ++j) gs += expf(gl[j] - gm);
        float pg = 1.f / gs;
        float e1 = -1e30f, e2 = -1e30f; int i1 = 0, i2 = 0;
#pragma unroll
        for (int g4 = 0; g4 < 4; ++g4) if (g4 == gi) {
#pragma unroll
            for (int j = 0; j < 8; ++j) { float v = lg[4 + g4 * 8 + j] + bre[g4 * 8 + j];
                if (v > e1) { e2 = e1; i2 = i1; e1 = v; i1 = j; } else if (v > e2) { e2 = v; i2 = j; } } }
        float p2 = 1.f / (1.f + expf(e1 - e2)), p1 = 1.f - p2;
        int ea = gi * 8 + i1, eb = gi * 8 + i2;
        toke[m * 2] = ea; toke[m * 2 + 1] = eb; tokw[m * 2] = pg * p1; tokw[m * 2 + 1] = pg * p2;
        int pa = atomicAdd(&cnt[ea], 1), pb = atomicAdd(&cnt[eb], 1);
        tokp[m * 2] = pa; tokp[m * 2 + 1] = pb; list[ea * T + pa] = m * 2; list[eb * T + pb] = m * 2 + 1;
    }
}
__global__ __launch_bounds__(256) void k_moe_naive(const h16* x2h, const float* ssx2, const int* toke, const float* tokw, const h16* Wgu, const h16* Wdn, h16* yb) {
    __shared__ float mh[DE];
    int m = blockIdx.x, tid = threadIdx.x, wv = tid >> 6, lane = tid & 63;
    float xs[16];
#pragma unroll
    for (int i = 0; i < 16; ++i) xs[i] = (float)x2h[(size_t)m * D + lane + 64 * i];
    float rs = rstd_of(ssx2[m], D);
    for (int sl = 0; sl < 2; ++sl) {
        int e = toke[m * 2 + sl]; float w = tokw[m * 2 + sl];
        for (int ji = 0; ji < 64; ++ji) {
            int j = wv * 64 + ji, np = 32 * (j >> 4) + (j & 15);
            const h16* wgp = Wgu + ((size_t)e * 512 + np) * D; const h16* wup = wgp + (size_t)16 * D;
            float a = 0.f, bb = 0.f;
#pragma unroll
            for (int i = 0; i < 16; ++i) { a += xs[i] * (float)wgp[lane + 64 * i]; bb += xs[i] * (float)wup[lane + 64 * i]; }
            a = wave_sum(a) * rs; bb = wave_sum(bb) * rs;
            if (lane == 0) mh[j] = (float)(h16)(a / (1.f + expf(-a)) * bb * w);
        }
        __syncthreads();
        float m4[4];
#pragma unroll
        for (int i = 0; i < 4; ++i) m4[i] = mh[lane + 64 * i];
        for (int ni = 0; ni < 256; ++ni) {
            int n = wv * 256 + ni; const h16* wd = Wdn + ((size_t)e * D + n) * DE; float y = 0.f;
#pragma unroll
            for (int i = 0; i < 4; ++i) y += m4[i] * (float)wd[lane + 64 * i];
            y = wave_sum(y);
            if (lane == 0) yb[((size_t)(m * 2 + sl)) * D + n] = (h16)y;
        }
        __syncthreads();
    }
}
__global__ __launch_bounds__(256) void k_final(const float* X, const h16* yb, const float* g, float* out) {
    int m = blockIdx.x * 4 + (threadIdx.x >> 6), lane = threadIdx.x & 63;
    float v[16]; float ss = 0.f;
#pragma unroll
    for (int i = 0; i < 16; ++i) { int k = lane + 64 * i;
        v[i] = X[(size_t)m * D + k] + (float)yb[((size_t)m * 2) * D + k] + (float)yb[((size_t)m * 2 + 1) * D + k]; ss += v[i] * v[i]; }
    ss = wave_sum(ss); float rs = rstd_of(ss, D);
#pragma unroll
    for (int i = 0; i < 16; ++i) { int k = lane + 64 * i; out[(size_t)m * D + k] = v[i] * rs * g[k]; }
}

template <class Epi>
static void gemm_naive(hipStream_t st, const h16* A, int lda, const h16* Wt, int ldw, int M, int N, int K, Epi e) {
    dim3 g((N + 63) / 64, (M + 63) / 64);
    hipLaunchKernelGGL(k_gemm_naive<Epi>, g, dim3(256), 0, st, A, lda, Wt, ldw, M, N, K, e);
}

extern "C" void kernel_launch(void* const* d_in, const int* in_sizes, int n_in, void* d_out, int out_size, void* d_ws, size_t ws_size, hipStream_t st) {
    const float* x = (const float*)d_in[0]; const float* mem = (const float*)d_in[1];
    const float* mix_g = (const float*)d_in[2]; const float* w_in = (const float*)d_in[3];
    const float* qn_g = (const float*)d_in[4]; const float* kvn_g = (const float*)d_in[5];
    const float* w_uq = (const float*)d_in[6]; const float* w_ukv = (const float*)d_in[7];
    const float* hy_cw = (const float*)d_in[8]; const float* hy_cb = (const float*)d_in[9];
    const float* hy_w1 = (const float*)d_in[10]; const float* hy_b1 = (const float*)d_in[11]; const float* hy_freq = (const float*)d_in[12];
    const float* hy_w2 = (const float*)d_in[13]; const float* hy_b2 = (const float*)d_in[14]; const float* hy_w3 = (const float*)d_in[15];
    const float* hy_b3 = (const float*)d_in[16]; const float* hy_decay = (const float*)d_in[17]; const float* hy_skip = (const float*)d_in[18];
    const float* ao_g = (const float*)d_in[19]; const float* ho_g = (const float*)d_in[20]; const float* w_out = (const float*)d_in[21];
    const float* cross_g = (const float*)d_in[22]; const float* memn_g = (const float*)d_in[23];
    const float* w_mq = (const float*)d_in[24]; const float* w_mkv = (const float*)d_in[25]; const float* w_mo = (const float*)d_in[26];
    const float* ffn_g = (const float*)d_in[27]; const float* w_rg = (const float*)d_in[28]; const float* b_rg = (const float*)d_in[29];
    const float* w_re = (const float*)d_in[30]; const float* b_re = (const float*)d_in[31];
    const float* w_gate = (const float*)d_in[32]; const float* w_up = (const float*)d_in[33]; const float* w_down = (const float*)d_in[34];
    const float* fin_g = (const float*)d_in[35];
    char* ws = (char*)d_ws; float* X = (float*)d_out;
    auto F = [&](size_t off) { return (float*)(ws + off); };
    auto H = [&](size_t off) { return (h16*)(ws + off); };
    auto I = [&](size_t off) { return (int*)(ws + off); };
    hipMemsetAsync(ws + WS_CTL, 0, 4096, st);
    hipLaunchKernelGGL(k_cvt_rows, dim3(T / 4), dim3(256), 0, st, x, H(WS_XH), F(WS_SSX), T, D);
    hipLaunchKernelGGL(k_cvt_rows, dim3(MROWS / 4), dim3(256), 0, st, mem, H(WS_MEMH), F(WS_SSMEM), MROWS, D);
    auto wt = [&](const float* W, const float* g, const float* g2, int ksplit, size_t off, int K, int N, int Npad) {
        size_t n = (size_t)K * Npad; hipLaunchKernelGGL(k_wt, dim3((unsigned)((n + 255) / 256)), dim3(256), 0, st, W, g, g2, ksplit, H(off), K, N, Npad); };
    wt(w_in, mix_g, nullptr, D, WS_WIN, D, INC, 2048);
    wt(w_uq, qn_g, nullptr, 256, WS_WUQ, 256, 768, 768);
    wt(w_ukv, kvn_g, nullptr, 128, WS_WUKV, 128, 1024, 1024);
    wt(w_out, ao_g, ho_g, 512, WS_WOUT, D, D, D);
    wt(w_mq, cross_g, nullptr, D, WS_WMQ, D, D, D);
    wt(w_mkv, memn_g, nullptr, D, WS_WMKV, D, 2048, 2048);
    wt(w_mo, nullptr, nullptr, D, WS_WMO, D, D, D);
    hipLaunchKernelGGL(k_wt_gu, dim3(NE * D * DE / 256), dim3(256), 0, st, w_gate, w_up, ffn_g, H(WS_WGU));
    hipLaunchKernelGGL(k_wt_dn, dim3(NE * D * DE / 256), dim3(256), 0, st, w_down, H(WS_WDN));
    hipLaunchKernelGGL(k_filt12, dim3(S), dim3(64), 0, st, hy_w1, hy_b1, hy_freq, hy_w2, hy_b2, F(WS_H2));
    hipLaunchKernelGGL(k_filt3, dim3(S * 2048 / 256), dim3(256), 0, st, F(WS_H2), hy_w3, hy_b3, hy_decay, H(WS_R));
    gemm_naive(st, H(WS_XH), D, H(WS_WIN), D, T, INC, D, EpiIn{F(WS_SSX), H(WS_LAT), H(WS_HYT)});
    gemm_naive(st, H(WS_MEMH), D, H(WS_WMKV), D, MROWS, 2048, D, EpiMkv{F(WS_SSMEM), H(WS_KC), H(WS_VCT)});
    hipLaunchKernelGGL(k_rowss, dim3(T / 4), dim3(256), 0, st, H(WS_LAT), LAT, 0, 256, F(WS_SSQ), T);
    hipLaunchKernelGGL(k_rowss, dim3(T / 4), dim3(256), 0, st, H(WS_LAT), LAT, 256, 128, F(WS_SSKV), T);
    gemm_naive(st, H(WS_LAT), LAT, H(WS_WUQ), 256, T, 768, 256, EpiQ{F(WS_SSQ), H(WS_Q)});
    gemm_naive(st, H(WS_LAT) + 256, LAT, H(WS_WUKV), 128, T, 1024, 128, EpiKV{F(WS_SSKV), H(WS_K), H(WS_VT)});
    hipLaunchKernelGGL(k_rope, dim3(T * 16 / 256), dim3(256), 0, st, H(WS_Q), H(WS_K), H(WS_LAT));
    hipLaunchKernelGGL(k_attn_naive, dim3(S / 128, NB * NH), dim3(128), 0, st, H(WS_Q), H(WS_K), H(WS_VT), H(WS_AOUT));
    hipLaunchKernelGGL(k_hyena_naive, dim3(NB * HYW), dim3(256), 0, st, H(WS_HYT), H(WS_R), hy_cw, hy_cb, hy_skip, H(WS_HT));
    hipLaunchKernelGGL(k_rowss, dim3(T / 4), dim3(256), 0, st, H(WS_AOUT), 512, 0, 512, F(WS_SSA), T);
    hipLaunchKernelGGL(k_ss_h, dim3(T / 256), dim3(256), 0, st, H(WS_HT), F(WS_SSH));
    hipLaunchKernelGGL(k_mixprep, dim3(T * D / 256), dim3(256), 0, st, H(WS_AOUT), H(WS_HT), F(WS_SSA), F(WS_SSH), H(WS_MIX));
    gemm_naive(st, H(WS_MIX), D, H(WS_WOUT), D, T, D, D, EpiRes{x, X, H(WS_X1H)});
    hipLaunchKernelGGL(k_rowss, dim3(T / 4), dim3(256), 0, st, H(WS_X1H), D, 0, D, F(WS_SSX1), T);
    gemm_naive(st, H(WS_X1H), D, H(WS_WMQ), D, T, D, D, EpiMq{F(WS_SSX1), H(WS_QC)});
    hipLaunchKernelGGL(k_xattn_naive, dim3(S / 32, NB * MH), dim3(256), 0, st, H(WS_QC), H(WS_KC), H(WS_VCT));
    gemm_naive(st, H(WS_QC), D, H(WS_WMO), D, T, D, D, EpiRes{X, X, H(WS_X2H)});
    hipLaunchKernelGGL(k_route, dim3(T / 4), dim3(256), 0, st, X, ffn_g, w_rg, b_rg, w_re, b_re, F(WS_SSX2), I(WS_TOKE), F(WS_TOKW), I(WS_TOKP), I(WS_CTL), I(WS_LIST));
    hipLaunchKernelGGL(k_moe_naive, dim3(T), dim3(256), 0, st, H(WS_X2H), F(WS_SSX2), I(WS_TOKE), F(WS_TOKW), H(WS_WGU), H(WS_WDN), H(WS_YB));
    hipLaunchKernelGGL(k_final, dim3(T / 4), dim3(256), 0, st, X, H(WS_YB), fin_g, X);
    (void)in_sizes; (void)n_in; (void)out_size; (void)ws_size;
}
```

```cpp
#include <hip/hip_runtime.h>
#include <cstdint>
#include <cstdio>
typedef _Float16 h16;

constexpr int NB = 4, S = 4096, D = 1024, T = NB * S, MEMT = 256, MROWS = NB * MEMT;
constexpr int NH = 8, HYW = 512;
constexpr int LAT = 416, INC = 1952;
constexpr int MH = 4, MHD = 256;
constexpr int NE = 32, DE = 256;
constexpr float EPS = 1e-6f;
constexpr float LOG2E = 1.4426950408889634f;
constexpr float QSCALE = 0.10206207261596575f * LOG2E;
constexpr float CSCALE = 0.0625f * LOG2E;

constexpr size_t MiB = 1u << 20;
constexpr size_t WS_CTL = 0;
constexpr size_t WS_SSX = 64 * 1024, WS_SSQ = 128 * 1024, WS_SSKV = 192 * 1024, WS_SSA = 256 * 1024, WS_SSH = 320 * 1024,
                 WS_SSX1 = 384 * 1024, WS_SSX2 = 448 * 1024, WS_SSMEM = 512 * 1024, WS_TOKE = 576 * 1024, WS_TOKW = 704 * 1024,
                 WS_TOKP = 832 * 1024;
constexpr size_t WS_WIN = 2 * MiB, WS_WUQ = 6 * MiB, WS_WUKV = 6 * MiB + 512 * 1024, WS_WOUT = 7 * MiB, WS_WMQ = 9 * MiB,
                 WS_WMKV = 11 * MiB, WS_WMO = 15 * MiB, WS_MEMH = 17 * MiB, WS_KC = 19 * MiB, WS_VCT = 21 * MiB, WS_R = 23 * MiB,
                 WS_WGU = 39 * MiB, WS_WDN = 71 * MiB, WS_LAT = 87 * MiB, WS_HYT = 101 * MiB, WS_XH = 149 * MiB, WS_Q = 149 * MiB,
                 WS_K = 173 * MiB, WS_VT = 197 * MiB, WS_AOUT = 213 * MiB, WS_HT = 229 * MiB, WS_LIST = 245 * MiB, WS_H2 = 247 * MiB;
constexpr size_t WS_MIX = 87 * MiB, WS_X1H = 119 * MiB, WS_QC = 151 * MiB, WS_X2H = 87 * MiB, WS_HB = 119 * MiB, WS_YB = 135 * MiB;

__device__ __forceinline__ float wave_sum(float v) {
#pragma unroll
    for (int o = 1; o < 64; o <<= 1) v += __shfl_xor(v, o);
    return v;
}
__device__ __forceinline__ float rstd_of(float ss, int n) { return 1.0f / sqrtf(ss / (float)n + EPS); }

__global__ __launch_bounds__(256) void k_cvt_rows(const float* x, h16* xh, float* ss, int rows, int n) {
    int row = blockIdx.x * 4 + (threadIdx.x >> 6), lane = threadIdx.x & 63;
    if (row >= rows) return;
    float s = 0.f;
    for (int k = lane; k < n; k += 64) { float v = x[(size_t)row * n + k]; s += v * v; xh[(size_t)row * n + k] = (h16)v; }
    s = wave_sum(s);
    if (lane == 0) ss[row] = s;
}
__global__ void k_wt(const float* W, const float* g, const float* g2, int ksplit, h16* Wt, int K, int N, int Npad) {
    size_t i = (size_t)blockIdx.x * 256 + threadIdx.x;
    if (i >= (size_t)K * Npad) return;
    int n = (int)(i % Npad), k = (int)(i / Npad);
    float v = 0.f;
    if (n < N) v = W[(size_t)k * N + n] * (g ? (k < ksplit ? g[k] : g2[k - ksplit]) : 1.f);
    Wt[(size_t)n * K + k] = (h16)v;
}
__global__ void k_wt_gu(const float* wg, const float* wu, const float* g, h16* Wt) {
    size_t i = (size_t)blockIdx.x * 256 + threadIdx.x;
    if (i >= (size_t)NE * D * DE) return;
    int j = (int)(i % DE), k = (int)((i / DE) % D), e = (int)(i / ((size_t)DE * D));
    int np = 32 * (j >> 4) + (j & 15);
    float gg = g[k];
    Wt[((size_t)e * 512 + np) * D + k] = (h16)(wg[i] * gg);
    Wt[((size_t)e * 512 + np + 16) * D + k] = (h16)(wu[i] * gg);
}
__global__ void k_wt_dn(const float* wd, h16* Wt) {
    size_t i = (size_t)blockIdx.x * 256 + threadIdx.x;
    if (i >= (size_t)NE * DE * D) return;
    int n = (int)(i % D), f = (int)((i / D) % DE), e = (int)(i / ((size_t)D * DE));
    Wt[((size_t)e * D + n) * DE + f] = (h16)wd[i];
}
__global__ __launch_bounds__(64) void k_filt12(const float* w1, const float* b1, const float* freq, const float* w2, const float* b2, float* H2) {
    __shared__ float z[33], h1[64];
    int t = blockIdx.x, j = threadIdx.x;
    if (j < 33) {
        float v;
        if (j == 0) v = (float)t / (float)S;
        else {
            int bi = (j - 1) & 15;
            float band = 1e-4f + (float)bi * ((15.0f - 1e-4f) / 15.0f);
            double rev = (double)t * (double)band / (double)S;
            rev -= floor(rev);
            float r2 = (float)(2.0 * rev);
            v = (j <= 16) ? cospif(r2) : -sinpif(r2);
        }
        z[j] = v;
    }
    __syncthreads();
    float a = b1[j];
    for (int i = 0; i < 33; ++i) a += z[i] * w1[i * 64 + j];
    h1[j] = sinf(freq[j] * a);
    __syncthreads();
    float c = b2[j];
    for (int i = 0; i < 64; ++i) c += h1[i] * w2[i * 64 + j];
    H2[t * 64 + j] = sinf(freq[64 + j] * c);
}
__global__ void k_filt3(const float* H2, const float* w3, const float* b3, const float* decay, h16* R) {
    int i = blockIdx.x * 256 + threadIdx.x;
    int col = i & 2047, tau = i >> 11;
    float a = b3[col];
    for (int j = 0; j < 64; ++j) a += H2[tau * 64 + j] * w3[j * 2048 + col];
    a *= expf(-((float)tau / (float)S) * fabsf(decay[col]));
    int o = col >> 10, dir = (col >> 9) & 1, c = col & 511;
    h16* r = R + ((size_t)(o * 512 + c)) * 8192;
    if (dir == 0) r[4096 - tau] = (h16)a;
    else r[tau == 0 ? 0 : 4096 + tau] = (h16)(tau == 0 ? 0.f : a);
}

template <class Epi>
__global__ __launch_bounds__(256) void k_gemm_naive(const h16* A, int lda, const h16* Wt, int ldw, int M, int N, int K, Epi epi) {
    __shared__ float As[16][65], Bs[16][65];
    int tx = threadIdx.x & 15, ty = threadIdx.x >> 4;
    int m0 = blockIdx.y * 64, n0 = blockIdx.x * 64;
    float acc[4][4];
#pragma unroll
    for (int i = 0; i < 4; ++i)
#pragma unroll
        for (int j = 0; j < 4; ++j) acc[i][j] = 0.f;
    for (int k0 = 0; k0 < K; k0 += 16) {
        for (int i = threadIdx.x; i < 1024; i += 256) {
            int r = i >> 4, c = i & 15, m = m0 + r, n = n0 + r;
            As[c][r] = (m < M) ? (float)A[(size_t)m * lda + k0 + c] : 0.f;
            Bs[c][r] = (n < N) ? (float)Wt[(size_t)n * ldw + k0 + c] : 0.f;
        }
        __syncthreads();
#pragma unroll
        for (int kk = 0; kk < 16; ++kk) {
            float a[4], b[4];
#pragma unroll
            for (int i = 0; i < 4; ++i) { a[i] = As[kk][ty * 4 + i]; b[i] = Bs[kk][tx * 4 + i]; }
#pragma unroll
            for (int i = 0; i < 4; ++i)
#pragma unroll
                for (int j = 0; j < 4; ++j) acc[i][j] += a[i] * b[j];
        }
        __syncthreads();
    }
#pragma unroll
    for (int i = 0; i < 4; ++i)
#pragma unroll
        for (int j = 0; j < 4; ++j) { int m = m0 + ty * 4 + i, n = n0 + tx * 4 + j; if (m < M && n < N) epi(m, n, acc[i][j]); }
}
struct EpiIn { const float* ssx; h16* lat; h16* hyT;
    __device__ void operator()(int m, int n, float v) const {
        v *= rstd_of(ssx[m], D);
        if (n < LAT) lat[(size_t)m * LAT + n] = (h16)v;
        else if (n < INC) { int b = m >> 12, t = m & 4095; hyT[((size_t)(b * 1536 + (n - LAT))) * S + t] = (h16)v; }
    } };
struct EpiQ { const float* ssq; h16* Q;
    __device__ void operator()(int m, int n, float v) const {
        v *= rstd_of(ssq[m], 256) * QSCALE; int b = m >> 12, t = m & 4095, h = n / 96, j = n % 96;
        Q[((size_t)((b * NH + h) * S + t)) * 96 + j] = (h16)v;
    } };
struct EpiKV { const float* sskv; h16* K; h16* Vt;
    __device__ void operator()(int m, int n, float v) const {
        v *= rstd_of(sskv[m], 128); int b = m >> 12, t = m & 4095, h = n >> 7, j = n & 127;
        if (j < 64) K[((size_t)((b * NH + h) * S + t)) * 96 + j] = (h16)v;
        else Vt[((size_t)((b * NH + h) * 64 + (j - 64))) * S + t] = (h16)v;
    } };
struct EpiRes { const float* xin; float* X; h16* xh;
    __device__ void operator()(int m, int n, float v) const {
        size_t i = (size_t)m * D + n; float r = xin[i] + v; X[i] = r; xh[i] = (h16)r;
    } };
struct EpiMq { const float* ss; h16* qc;
    __device__ void operator()(int m, int n, float v) const { qc[(size_t)m * D + n] = (h16)(v * rstd_of(ss[m], D) * CSCALE); } };
struct EpiMkv { const float* ss; h16* Kc; h16* VcT;
    __device__ void operator()(int m, int n, float v) const {
        v *= rstd_of(ss[m], D);
        if (n < D) Kc[(size_t)m * D + n] = (h16)v;
        else { int np = n - D, h = np >> 8, d = np & 255, b = m >> 8, mm = m & 255; VcT[((size_t)((b * MH + h) * MHD + d)) * MEMT + mm] = (h16)v; }
    } };

__global__ __launch_bounds__(256) void k_rowss(const h16* A, int lda, int off, int n, float* ss, int rows) {
    int row = blockIdx.x * 4 + (threadIdx.x >> 6), lane = threadIdx.x & 63;
    if (row >= rows) return;
    float s = 0.f;
    for (int k = lane; k < n; k += 64) { float v = (float)A[(size_t)row * lda + off + k]; s += v * v; }
    s = wave_sum(s);
    if (lane == 0) ss[row] = s;
}
__global__ void k_rope(h16* Q, h16* K, const h16* lat) {
    int i = blockIdx.x * 256 + threadIdx.x;
    if (i >= T * 16) return;
    int m = i >> 4, p = i & 15, b = m >> 12, t = m & 4095;
    float inv = exp2f(-(float)p * (13.287712379549449f / 16.0f));
    float ang = (float)t * inv;
    float sn, cs; sincosf(ang, &sn, &cs);
    float k1 = (float)lat[(size_t)m * LAT + 384 + p], k2 = (float)lat[(size_t)m * LAT + 384 + 16 + p];
    h16 o1 = (h16)(k1 * cs - k2 * sn), o2 = (h16)(k1 * sn + k2 * cs);
    for (int h = 0; h < NH; ++h) {
        size_t base = ((size_t)((b * NH + h) * S + t)) * 96 + 64;
        K[base + p] = o1; K[base + 16 + p] = o2;
        float q1 = (float)Q[base + p], q2 = (float)Q[base + 16 + p];
        Q[base + p] = (h16)(q1 * cs - q2 * sn); Q[base + 16 + p] = (h16)(q1 * sn + q2 * cs);
    }
}
__global__ __launch_bounds__(128) void k_attn_naive(const h16* Q, const h16* K, const h16* Vt, h16* aout) {
    __shared__ float Ks[32][96], Vs[32][64];
    int bh = blockIdx.y, q0 = blockIdx.x * 128, tid = threadIdx.x;
    float q[96], o[64];
#pragma unroll
    for (int d = 0; d < 96; ++d) q[d] = (float)Q[((size_t)bh * S + q0 + tid) * 96 + d];
#pragma unroll
    for (int d = 0; d < 64; ++d) o[d] = 0.f;
    float m = -1e30f, l = 0.f;
    for (int k0 = 0; k0 < S; k0 += 32) {
        __syncthreads();
        for (int i = tid; i < 32 * 96; i += 128) { int r = i / 96, c = i % 96; Ks[r][c] = (float)K[((size_t)bh * S + k0 + r) * 96 + c]; }
        for (int i = tid; i < 32 * 64; i += 128) { int d = i >> 5, r = i & 31; Vs[r][d] = (float)Vt[((size_t)bh * 64 + d) * S + k0 + r]; }
        __syncthreads();
        for (int r = 0; r < 32; ++r) {
            float s = 0.f;
#pragma unroll
            for (int d = 0; d < 96; ++d) s += q[d] * Ks[r][d];
            if (s > m) { float al = exp2f(m - s); l *= al;
#pragma unroll
                for (int d = 0; d < 64; ++d) o[d] *= al;
                m = s; }
            float p = exp2f(s - m); l += p;
#pragma unroll
            for (int d = 0; d < 64; ++d) o[d] += p * Vs[r][d];
        }
    }
    int b = bh >> 3, h = bh & 7; float il = 1.f / l;
#pragma unroll
    for (int d = 0; d < 64; ++d) aout[((size_t)(b * S + q0 + tid)) * 512 + h * 64 + d] = (h16)(o[d] * il);
}
__global__ __launch_bounds__(256) void k_hyena_naive(const h16* hyT, const h16* R, const float* convw, const float* convb, const float* skip, h16* hT) {
    __shared__ float z[4096]; __shared__ float Rl[8192];
    int b = blockIdx.x >> 9, c = blockIdx.x & 511, tid = threadIdx.x;
    auto u3 = [&](int ch, int t) -> float {
        const h16* p = hyT + ((size_t)(b * 1536 + ch)) * S;
        float a = t > 0 ? (float)p[t - 1] : 0.f, bb = (float)p[t], cc = t < S - 1 ? (float)p[t + 1] : 0.f;
        return a * convw[ch] + bb * convw[1536 + ch] + cc * convw[3072 + ch] + convb[ch];
    };
    for (int n = 0; n < 2; ++n) {
        for (int u = tid; u < 8192; u += 256) Rl[u] = (float)R[((size_t)(n * 512 + c)) * 8192 + u];
        if (n == 0) for (int t = tid; t < S; t += 256) z[t] = u3(1024 + c, t);
        __syncthreads();
        float acc[16];
#pragma unroll
        for (int i = 0; i < 16; ++i) acc[i] = 0.f;
        for (int s = 0; s < S; ++s) {
            float zs = z[s];
#pragma unroll
            for (int i = 0; i < 16; ++i) acc[i] += zs * Rl[s - (tid + 256 * i) + 4096];
        }
        __syncthreads();
        float sk = skip[n * 512 + c];
#pragma unroll
        for (int i = 0; i < 16; ++i) {
            int t = tid + 256 * i;
            float zn = u3(n == 0 ? c : 512 + c, t) * (acc[i] + sk * z[t]);
            if (n == 0) z[t] = zn; else hT[((size_t)(b * 512 + c)) * S + t] = (h16)zn;
        }
        __syncthreads();
    }
}
__global__ void k_ss_h(const h16* hT, float* ss) {
    int m = blockIdx.x * 256 + threadIdx.x; int b = m >> 12, t = m & 4095; float s = 0.f;
    for (int c = 0; c < 512; ++c) { float v = (float)hT[((size_t)(b * 512 + c)) * S + t]; s += v * v; }
    ss[m] = s;
}
__global__ void k_mixprep(const h16* aout, const h16* hT, const float* ssa, const float* ssh, h16* mix) {
    size_t i = (size_t)blockIdx.x * 256 + threadIdx.x;
    int m = (int)(i & (T - 1)), k = (int)(i >> 14);
    float v;
    if (k < 512) v = (float)aout[(size_t)m * 512 + k] * rstd_of(ssa[m], 512);
    else { int b = m >> 12, t = m & 4095; v = (float)hT[((size_t)(b * 512 + (k - 512))) * S + t] * rstd_of(ssh[m], 512); }
    mix[(size_t)m * D + k] = (h16)v;
}
__global__ __launch_bounds__(256) void k_xattn_naive(h16* qc, const h16* Kc, const h16* VcT) {
    __shared__ float sc[32][257]; __shared__ float il[32]; __shared__ h16 qs[32][256];
    int bh = blockIdx.y, b = bh >> 2, h = bh & 3, t0 = blockIdx.x * 32, tid = threadIdx.x, wv = tid >> 6, lane = tid & 63;
    for (int i = tid; i < 32 * 256; i += 256) { int tok = i >> 8, d = i & 255; qs[tok][d] = qc[((size_t)(b * S + t0 + tok)) * D + h * MHD + d]; }
    __syncthreads();
    for (int mi = 0; mi < 64; ++mi) {
        int mm = wv * 64 + mi;
        const h16* kp = Kc + ((size_t)(b * MEMT + mm)) * D + h * MHD + lane * 4;
        float k0 = (float)kp[0], k1 = (float)kp[1], k2 = (float)kp[2], k3 = (float)kp[3];
        for (int tok = 0; tok < 32; ++tok) {
            float s = (float)qs[tok][lane * 4] * k0 + (float)qs[tok][lane * 4 + 1] * k1 + (float)qs[tok][lane * 4 + 2] * k2 + (float)qs[tok][lane * 4 + 3] * k3;
            s = wave_sum(s);
            if (lane == 0) sc[tok][mm] = s;
        }
    }
    __syncthreads();
    if (tid < 32) { float mx = -1e30f; for (int j = 0; j < 256; ++j) mx = fmaxf(mx, sc[tid][j]); float l = 0.f;
        for (int j = 0; j < 256; ++j) { float p = exp2f(sc[tid][j] - mx); sc[tid][j] = p; l += p; } il[tid] = 1.f / l; }
    __syncthreads();
    for (int di = 0; di < 64; ++di) {
        int d = wv * 64 + di;
        const h16* vp = VcT + ((size_t)((b * MH + h) * MHD + d)) * MEMT + lane * 4;
        float v0 = (float)vp[0], v1 = (float)vp[1], v2 = (float)vp[2], v3 = (float)vp[3];
        for (int tok = 0; tok < 32; ++tok) {
            float o = sc[tok][lane * 4] * v0 + sc[tok][lane * 4 + 1] * v1 + sc[tok][lane * 4 + 2] * v2 + sc[tok][lane * 4 + 3] * v3;
            o = wave_sum(o);
            if (lane == 0) qc[((size_t)(b * S + t0 + tok)) * D + h * MHD + d] = (h16)(o * il[tok]);
        }
    }
}
__global__ __launch_bounds__(256) void k_route(const float* X, const float* g, const float* wrg, const float* brg, const float* wre, const float* bre,
                                               float* ssx2, int* toke, float* tokw, int* tokp, int* cnt, int* list) {
    int m = blockIdx.x * 4 + (threadIdx.x >> 6), lane = threadIdx.x & 63;
    float xs[16]; float ss = 0.f;
#pragma unroll
    for (int i = 0; i < 16; ++i) { xs[i] = X[(size_t)m * D + lane + 64 * i]; ss += xs[i] * xs[i]; }
    ss = wave_sum(ss);
    float rs = rstd_of(ss, D);
    float lg[36];
#pragma unroll
    for (int j = 0; j < 36; ++j) lg[j] = 0.f;
#pragma unroll
    for (int i = 0; i < 16; ++i) { int k = lane + 64 * i; float tv = xs[i] * rs * g[k];
#pragma unroll
        for (int j = 0; j < 4; ++j) lg[j] += tv * wrg[k * 4 + j];
#pragma unroll
        for (int j = 0; j < 32; ++j) lg[4 + j] += tv * wre[k * 32 + j]; }
#pragma unroll
    for (int j = 0; j < 36; ++j) lg[j] = wave_sum(lg[j]);
    if (lane == 0) {
        ssx2[m] = ss;
        float gl[4]; int gi = 0; float gm = -1e30f;
#pragma unroll
        for (int j = 0; j < 4; ++j) { gl[j] = lg[j] + brg[j]; if (gl[j] > gm) { gm = gl[j]; gi = j; } }
        float gs = 0.f;
#pragma unroll
        for (int j = 0; j < 4; ++j) gs += expf(gl[j] - gm);
        float pg = 1.f / gs;
        float e1 = -1e30f, e2 = -1e30f; int i1 = 0, i2 = 0;
#pragma unroll
        for (int g4 = 0; g4 < 4; ++g4) if (g4 == gi) {
#pragma unroll
            for (int j = 0; j < 8; ++j) { float v = lg[4 + g4 * 8 + j] + bre[g4 * 8 + j];
                if (v > e1) { e2 = e1; i2 = i1; e1 = v; i1 = j; } else if (v > e2) { e2 = v; i2 = j; } } }
        float p2 = 1.f / (1.f + expf(e1 - e2)), p1 = 1.f - p2;
        int ea = gi * 8 + i1, eb = gi * 8 + i2;
        toke[m * 2] = ea; toke[m * 2 + 1] = eb; tokw[m * 2] = pg * p1; tokw[m * 2 + 1] = pg * p2;
        int pa = atomicAdd(&cnt[ea], 1), pb = atomicAdd(&cnt[eb], 1);
        tokp[m * 2] = pa; tokp[m * 2 + 1] = pb; list[ea * T + pa] = m * 2; list[eb * T + pb] = m * 2 + 1;
    }
}
__global__ __launch_bounds__(256) void k_moe_naive(const h16* x2h, const float* ssx2, const int* toke, const float* tokw, const h16* Wgu, const h16* Wdn, h16* yb) {
    __shared__ float mh[DE];
    int m = blockIdx.x, tid = threadIdx.x, wv = tid >> 6, lane = tid & 63;
    float xs[16];
#pragma unroll
    for (int i = 0; i < 16; ++i) xs[i] = (float)x2h[(size_t)m * D + lane + 64 * i];
    float rs = rstd_of(ssx2[m], D);
    for (int sl = 0; sl < 2; ++sl) {
        int e = toke[m * 2 + sl]; float w = tokw[m * 2 + sl];
        for (int ji = 0; ji < 64; ++ji) {
            int j = wv * 64 + ji, np = 32 * (j >> 4) + (j & 15);
            const h16* wgp = Wgu + ((size_t)e * 512 + np) * D; const h16* wup = wgp + (size_t)16 * D;
            float a = 0.f, bb = 0.f;
#pragma unroll
            for (int i = 0; i < 16; ++i) { a += xs[i] * (float)wgp[lane + 64 * i]; bb += xs[i] * (float)wup[lane + 64 * i]; }
            a = wave_sum(a) * rs; bb = wave_sum(bb) * rs;
            if (lane == 0) mh[j] = (float)(h16)(a / (1.f + expf(-a)) * bb * w);
        }
        __syncthreads();
        float m4[4];
#pragma unroll
        for (int i = 0; i < 4; ++i) m4[i] = mh[lane + 64 * i];
        for (int ni = 0; ni < 256; ++ni) {
            int n = wv * 256 + ni; const h16* wd = Wdn + ((size_t)e * D + n) * DE; float y = 0.f;
#pragma unroll
            for (int i = 0; i < 4; ++i) y += m4[i] * (float)wd[lane + 64 * i];
            y = wave_sum(y);
            if (lane == 0) yb[((size_t)(m * 2 + sl)) * D + n] = (h16)y;
        }
        __syncthreads();
    }
}
__global__ __launch_bounds__(256) void k_final(const float* X, const h16* yb, const float* g, float* out) {
    int m = blockIdx.x * 4 + (threadIdx.x >> 6), lane = threadIdx.x & 63;
    float v[16]; float ss = 0.f;
#pragma unroll
    for (int i = 0; i < 16; ++i) { int k = lane + 64 * i;
        v[i] = X[(size_t)m * D + k] + (float)yb[((size_t)m * 2) * D + k] + (float)yb[((size_t)m * 2 + 1) * D + k]; ss += v[i] * v[i]; }
    ss = wave_sum(ss); float rs = rstd_of(ss, D);
#pragma unroll
    for (int i = 0; i < 16; ++i) { int k = lane + 64 * i; out[(size_t)m * D + k] = v[i] * rs * g[k]; }
}


#define LAS __attribute__((address_space(3)))
typedef _Float16 h16x8 __attribute__((ext_vector_type(8)));
typedef _Float16 h16x4 __attribute__((ext_vector_type(4)));
typedef _Float16 h16x2 __attribute__((ext_vector_type(2)));
typedef float f32x4 __attribute__((ext_vector_type(4)));
typedef float f32x16 __attribute__((ext_vector_type(16)));
constexpr int NTHR = 512, NWAVE = 8;
constexpr int LDS_BYTES = 150 * 1024;
constexpr size_t WS_ROPE = 248 * MiB;

struct Params {
    const float* in[36]; float* X; char* ws;
};
#define PF(off) ((float*)(p.ws + (off)))
#define PH(off) ((h16*)(p.ws + (off)))
#define PI(off) ((int*)(p.ws + (off)))

constexpr int G_BM = 256, G_BN = 128, G_BK = 64, G_AB = G_BM * G_BK * 2, G_BB = G_BN * G_BK * 2, G_STAGE = G_AB + G_BB;
static_assert(3 * G_STAGE <= LDS_BYTES, "lds");
__device__ __forceinline__ void glds16(const void* g, LAS char* l) { __builtin_amdgcn_global_load_lds((const unsigned*)g, (LAS unsigned*)l, 16, 0, 0); }

template <bool SWAP, class RowPtr, class Epi>
__device__ __forceinline__ void gemm_tile(LAS char* lds, const RowPtr& rowptr, const h16* __restrict__ Wt, int ldw, int K, int m0, int n0, const Epi& epi) {
    const int tid = threadIdx.x, lane = tid & 63, wid = __builtin_amdgcn_readfirstlane(tid >> 6);
    const int wm = wid >> 1, wn = wid & 1, fr = lane & 15, fq = lane >> 4;
    const h16* asrc[4]; const h16* bsrc[2];
#pragma unroll
    for (int i = 0; i < 4; ++i) { const int r = wid * 32 + i * 8 + (lane >> 3); const int ch = (lane & 7) ^ ((r >> 1) & 7); asrc[i] = rowptr(m0 + r) + ch * 8; }
#pragma unroll
    for (int i = 0; i < 2; ++i) { const int r = wid * 16 + i * 8 + (lane >> 3); const int ch = (lane & 7) ^ ((r >> 1) & 7); bsrc[i] = Wt + (size_t)(n0 + r) * ldw + ch * 8; }
    const int sw = fr >> 1;
    const int aoff = (wm * 64 + fr) * 128 + ((fq ^ sw) * 16);
    const int boff = G_AB + (wn * 64 + fr) * 128 + ((fq ^ sw) * 16);
    f32x4 acc[4][4];
#pragma unroll
    for (int i = 0; i < 4; ++i)
#pragma unroll
        for (int j = 0; j < 4; ++j) acc[i][j] = (f32x4){0.f, 0.f, 0.f, 0.f};
    const int nt = K / G_BK;
    asm volatile("s_waitcnt vmcnt(0)" ::: "memory");
#define G_STAGE_ISSUE(buf, kt) do { LAS char* sa_ = lds + (buf) * G_STAGE + wid * 4096; \
        _Pragma("unroll") for (int i_ = 0; i_ < 4; ++i_) glds16(asrc[i_] + (kt) * G_BK, sa_ + i_ * 1024); \
        LAS char* sb_ = lds + (buf) * G_STAGE + G_AB + wid * 2048; \
        _Pragma("unroll") for (int i_ = 0; i_ < 2; ++i_) glds16(bsrc[i_] + (kt) * G_BK, sb_ + i_ * 1024); } while (0)
    G_STAGE_ISSUE(0, 0);
    if (nt > 1) G_STAGE_ISSUE(1, 1);
    int buf = 0;
    for (int t = 0; t < nt; ++t) {
        if (t + 1 < nt) asm volatile("s_waitcnt vmcnt(6)" ::: "memory"); else asm volatile("s_waitcnt vmcnt(0)" ::: "memory");
        __builtin_amdgcn_s_barrier();
        if (t + 2 < nt) { const int nb_ = buf >= 1 ? buf - 1 : 2; G_STAGE_ISSUE(nb_, t + 2); }
        LAS char* base = lds + buf * G_STAGE;
#pragma unroll
        for (int kk = 0; kk < 2; ++kk) {
            h16x8 a[4], b[4];
#pragma unroll
            for (int i = 0; i < 4; ++i) { a[i] = *(LAS h16x8*)(base + ((aoff ^ (kk * 64)) + i * 2048)); b[i] = *(LAS h16x8*)(base + ((boff ^ (kk * 64)) + i * 2048)); }
#pragma unroll
            for (int i = 0; i < 4; ++i)
#pragma unroll
                for (int j = 0; j < 4; ++j)
                    acc[i][j] = SWAP ? __builtin_amdgcn_mfma_f32_16x16x32_f16(b[j], a[i], acc[i][j], 0, 0, 0)
                                     : __builtin_amdgcn_mfma_f32_16x16x32_f16(a[i], b[j], acc[i][j], 0, 0, 0);
        }
        buf = buf == 2 ? 0 : buf + 1;
    }
#undef G_STAGE_ISSUE
    asm volatile("s_waitcnt lgkmcnt(0)" ::: "memory");
    __builtin_amdgcn_s_barrier();
    if constexpr (SWAP) {
#pragma unroll
        for (int i = 0; i < 4; ++i)
#pragma unroll
            for (int jp = 0; jp < 2; ++jp) epi.row32(m0 + wm * 64 + i * 16 + fr, n0 + wn * 64 + jp * 32 + fq * 4, acc[i][2 * jp], acc[i][2 * jp + 1]);
    } else {
#pragma unroll
        for (int i = 0; i < 4; ++i)
#pragma unroll
            for (int j = 0; j < 4; ++j) epi.col4(m0 + wm * 64 + i * 16 + fq * 4, n0 + wn * 64 + j * 16 + fr, acc[i][j]);
    }
}
struct RowDense { const h16* A; int lda; __device__ __forceinline__ const h16* operator()(int m) const { return A + (size_t)m * lda; } };

__device__ __forceinline__ h16x4 cvt4(f32x4 v) { return (h16x4){(h16)v[0], (h16)v[1], (h16)v[2], (h16)v[3]}; }
__device__ __forceinline__ float rowgrp_sum(float v) { v += __shfl_xor(v, 16); v += __shfl_xor(v, 32); return v; }

struct EHy {
    const float* ssx; h16* hyT;
    __device__ __forceinline__ void col4(int mr, int n, f32x4 v) const {
        const f32x4 ss = *(const f32x4*)(ssx + mr);
        v[0] *= rstd_of(ss[0], D); v[1] *= rstd_of(ss[1], D); v[2] *= rstd_of(ss[2], D); v[3] *= rstd_of(ss[3], D);
        const int b = mr >> 12, t = mr & 4095;
        *(h16x4*)(hyT + ((size_t)(b * 1536 + n)) * S + t) = cvt4(v);
    } };
struct ELat {
    const float* ssx; h16* lat; float* ssq; float* sskv;
    __device__ __forceinline__ void row32(int m, int nb, f32x4 va, f32x4 vb) const {
        const float r = rstd_of(ssx[m], D); va *= r; vb *= r;
        if (nb < LAT) { *(h16x4*)(lat + (size_t)m * LAT + nb) = cvt4(va); *(h16x4*)(lat + (size_t)m * LAT + nb + 16) = cvt4(vb); }
        float s = va[0] * va[0] + va[1] * va[1] + va[2] * va[2] + va[3] * va[3] + vb[0] * vb[0] + vb[1] * vb[1] + vb[2] * vb[2] + vb[3] * vb[3];
        s = rowgrp_sum(s);
        if ((threadIdx.x & 63) < 16 && nb < 384) atomicAdd((nb < 256 ? ssq : sskv) + m, s);
    } };
struct EQ {
    const float* ssq; const float* rope; h16* Q;
    __device__ __forceinline__ void row32(int m, int nb, f32x4 va, f32x4 vb) const {
        const float r = rstd_of(ssq[m], 256) * QSCALE; va *= r; vb *= r;
        const int b = m >> 12, t = m & 4095, blk = nb >> 5, h = blk / 3, part = blk - 3 * h, c = nb & 31;
        if (part == 2) {
            const float* rp = rope + ((size_t)t * 16 + c) * 2;
#pragma unroll
            for (int j = 0; j < 4; ++j) { const float cs = rp[2 * j], sn = rp[2 * j + 1]; const float q1 = va[j], q2 = vb[j]; va[j] = q1 * cs - q2 * sn; vb[j] = q1 * sn + q2 * cs; }
        }
        h16* q = Q + ((size_t)((b * NH + h) * S + t)) * 96 + part * 32 + c;
        *(h16x4*)q = cvt4(va); *(h16x4*)(q + 16) = cvt4(vb);
    } };
struct EK {
    const float* sskv; h16* K;
    __device__ __forceinline__ void row32(int m, int nb, f32x4 va, f32x4 vb) const {
        const float r = rstd_of(sskv[m], 128); va *= r; vb *= r;
        const int b = m >> 12, t = m & 4095, h = nb >> 6, j = nb & 63;
        h16* k = K + ((size_t)((b * NH + h) * S + t)) * 96 + j;
        *(h16x4*)k = cvt4(va); *(h16x4*)(k + 16) = cvt4(vb);
    } };
struct EV {
    const float* sskv; h16* Vt;
    __device__ __forceinline__ void col4(int mr, int n, f32x4 v) const {
        const f32x4 ss = *(const f32x4*)(sskv + mr);
        v[0] *= rstd_of(ss[0], 128); v[1] *= rstd_of(ss[1], 128); v[2] *= rstd_of(ss[2], 128); v[3] *= rstd_of(ss[3], 128);
        const int b = mr >> 12, t = mr & 4095;
        *(h16x4*)(Vt + ((size_t)(b * 512 + n)) * S + t) = cvt4(v);
    } };
struct EKc {
    const float* ss; h16* Kc;
    __device__ __forceinline__ void row32(int m, int nb, f32x4 va, f32x4 vb) const {
        const float r = rstd_of(ss[m], D); va *= r; vb *= r;
        *(h16x4*)(Kc + (size_t)m * D + nb) = cvt4(va); *(h16x4*)(Kc + (size_t)m * D + nb + 16) = cvt4(vb);
    } };
struct EVc {
    const float* ss; h16* VcT;
    __device__ __forceinline__ void col4(int mr, int n, f32x4 v) const {
        const f32x4 s4 = *(const f32x4*)(ss + mr);
        v[0] *= rstd_of(s4[0], D); v[1] *= rstd_of(s4[1], D); v[2] *= rstd_of(s4[2], D); v[3] *= rstd_of(s4[3], D);
        const int b = mr >> 8, mm = mr & 255;
        *(h16x4*)(VcT + ((size_t)(b * 1024 + n)) * MEMT + mm) = cvt4(v);
    } };
struct ERes {
    const float* xin; float* X; h16* xh; float* ss;
    __device__ __forceinline__ void row32(int m, int nb, f32x4 va, f32x4 vb) const {
        const size_t i = (size_t)m * D + nb;
        va += *(const f32x4*)(xin + i); vb += *(const f32x4*)(xin + i + 16);
        *(f32x4*)(X + i) = va; *(f32x4*)(X + i + 16) = vb;
        *(h16x4*)(xh + i) = cvt4(va); *(h16x4*)(xh + i + 16) = cvt4(vb);
        float s = va[0] * va[0] + va[1] * va[1] + va[2] * va[2] + va[3] * va[3] + vb[0] * vb[0] + vb[1] * vb[1] + vb[2] * vb[2] + vb[3] * vb[3];
        s = rowgrp_sum(s);
        if (ss && (threadIdx.x & 63) < 16) atomicAdd(ss + m, s);
    } };
struct EMq {
    const float* ss; h16* qc;
    __device__ __forceinline__ void row32(int m, int nb, f32x4 va, f32x4 vb) const {
        const float r = rstd_of(ss[m], D) * CSCALE; va *= r; vb *= r;
        *(h16x4*)(qc + (size_t)m * D + nb) = cvt4(va); *(h16x4*)(qc + (size_t)m * D + nb + 16) = cvt4(vb);
    } };

template <bool SWAP, class Epi>
__device__ __forceinline__ void gemm_job(LAS char* lds, const h16* A, int lda, const h16* Wt, int ldw, int M, int N, int K, const Epi& epi, int first = 0) {
    const int ntn = N / G_BN, ntiles = (M / G_BM) * ntn;
    const RowDense rp{A, lda};
    const int G = gridDim.x, bx = blockIdx.x, vid = (G % 8 == 0) ? (bx % 8) * (G / 8) + bx / 8 : bx;
    for (int tix = (vid + G - first % G) % G; tix < ntiles; tix += G) {
        const int mt = tix / ntn, nt_ = tix - mt * ntn;
        gemm_tile<SWAP>(lds, rp, Wt, ldw, K, mt * G_BM, nt_ * G_BN, epi);
    }
}

template <class RowMap, class Gain>
__device__ __forceinline__ void wt_item(const float* W, int N, int K, h16* Wt, LAS float* scr, int k0, int n0, int lane, const RowMap& rowmap, const Gain& gain) {
#pragma unroll 8
    for (int i = 0; i < 32; ++i) { const int kk = 2 * i + (lane >> 5); scr[kk * 33 + (lane & 31)] = W[(size_t)(k0 + kk) * N + n0 + (lane & 31)] * gain(k0 + kk); }
    asm volatile("s_waitcnt lgkmcnt(0)" ::: "memory");
    const int c = lane & 7;
#pragma unroll
    for (int j = 0; j < 4; ++j) { const int n = (lane >> 3) + 8 * j; const LAS float* s = scr + (8 * c) * 33 + n;
        h16x8 o = {(h16)s[0], (h16)s[33], (h16)s[66], (h16)s[99], (h16)s[132], (h16)s[165], (h16)s[198], (h16)s[231]};
        *(h16x8*)(Wt + (size_t)rowmap(n0 + n) * K + k0 + 8 * c) = o; }
    asm volatile("s_waitcnt lgkmcnt(0)" ::: "memory");
}
struct GainNone { __device__ __forceinline__ float operator()(int) const { return 1.f; } };
struct Gain1 { const float* g; __device__ __forceinline__ float operator()(int k) const { return g[k]; } };
struct Gain2 { const float* g; const float* g2; __device__ __forceinline__ float operator()(int k) const { return k < 512 ? g[k] : g2[k - 512]; } };
struct MapId { __device__ __forceinline__ int operator()(int n) const { return n; } };
struct MapIn { __device__ __forceinline__ int operator()(int n) const { return n < LAT ? 1536 + n : n - LAT; } };
struct MapKV { __device__ __forceinline__ int operator()(int n) const { const int h = n >> 7, j = n & 127; return j < 64 ? h * 64 + j : 512 + h * 64 + (j - 64); } };
struct MapG { int up; __device__ __forceinline__ int operator()(int j) const { return 32 * (j >> 4) + (j & 15) + up; } };

__device__ __forceinline__ void phase_prep(const Params& p, LAS char* lds) {
    const int tid = threadIdx.x, lane = tid & 63, wid = tid >> 6;
    const int gw = blockIdx.x * NWAVE + wid, NGW = gridDim.x * NWAVE, gt = blockIdx.x * NTHR + tid, NGT = gridDim.x * NTHR;
    LAS float* scr = (LAS float*)(lds + wid * 16384);
    for (int i = gt; i < 5 * 16384; i += NGT) PF(WS_SSQ)[i] = 0.f;
    for (int i = gt; i < 1024; i += NGT) PI(WS_CTL)[i] = 0;
    for (int row = gw; row < T + MROWS; row += NGW) {
        const bool isx = row < T; const int r = isx ? row : row - T;
        const f32x4* src = (const f32x4*)((isx ? p.in[0] : p.in[1]) + (size_t)r * D) + lane;
        h16* dst = (isx ? PH(WS_XH) : PH(WS_MEMH)) + (size_t)r * D;
        float s = 0.f;
#pragma unroll
        for (int j = 0; j < 4; ++j) { const f32x4 v = src[64 * j]; s += v[0] * v[0] + v[1] * v[1] + v[2] * v[2] + v[3] * v[3]; *(h16x4*)(dst + (lane + 64 * j) * 4) = cvt4(v); }
        s = wave_sum(s);
        if (lane == 0) (isx ? PF(WS_SSX) : PF(WS_SSMEM))[r] = s;
    }
    {
        constexpr int I_IN = 16 * 61, I_UQ = 4 * 24, I_UKV = 2 * 32, I_SQ = 16 * 32, I_MKV = 16 * 64, I_EX = 16 * 8, I_DN = 4 * 32;
        constexpr int NIT = I_IN + I_UQ + I_UKV + 3 * I_SQ + I_MKV + NE * (2 * I_EX + I_DN);
        for (int it = gw; it < NIT; it += NGW) {
            int r = it;
            if (r < I_IN) { wt_item(p.in[3], INC, D, PH(WS_WIN), scr, (r / 61) * 64, (r % 61) * 32, lane, MapIn{}, Gain1{p.in[2]}); continue; } r -= I_IN;
            if (r < I_UQ) { wt_item(p.in[6], 768, 256, PH(WS_WUQ), scr, (r / 24) * 64, (r % 24) * 32, lane, MapId{}, Gain1{p.in[4]}); continue; } r -= I_UQ;
            if (r < I_UKV) { wt_item(p.in[7], 1024, 128, PH(WS_WUKV), scr, (r / 32) * 64, (r % 32) * 32, lane, MapKV{}, Gain1{p.in[5]}); continue; } r -= I_UKV;
            if (r < I_SQ) { wt_item(p.in[21], D, D, PH(WS_WOUT), scr, (r / 32) * 64, (r % 32) * 32, lane, MapId{}, Gain2{p.in[19], p.in[20]}); continue; } r -= I_SQ;
            if (r < I_SQ) { wt_item(p.in[24], D, D, PH(WS_WMQ), scr, (r / 32) * 64, (r % 32) * 32, lane, MapId{}, Gain1{p.in[22]}); continue; } r -= I_SQ;
            if (r < I_SQ) { wt_item(p.in[26], D, D, PH(WS_WMO), scr, (r / 32) * 64, (r % 32) * 32, lane, MapId{}, GainNone{}); continue; } r -= I_SQ;
            if (r < I_MKV) { wt_item(p.in[25], 2048, D, PH(WS_WMKV), scr, (r / 64) * 64, (r % 64) * 32, lane, MapId{}, Gain1{p.in[23]}); continue; } r -= I_MKV;
            const int e = r / (2 * I_EX + I_DN); r -= e * (2 * I_EX + I_DN);
            if (r < I_EX) { wt_item(p.in[32] + (size_t)e * D * DE, DE, D, PH(WS_WGU) + (size_t)e * 512 * D, scr, (r / 8) * 64, (r % 8) * 32, lane, MapG{0}, Gain1{p.in[27]}); continue; } r -= I_EX;
            if (r < I_EX) { wt_item(p.in[33] + (size_t)e * D * DE, DE, D, PH(WS_WGU) + (size_t)e * 512 * D, scr, (r / 8) * 64, (r % 8) * 32, lane, MapG{16}, Gain1{p.in[27]}); continue; } r -= I_EX;
            wt_item(p.in[34] + (size_t)e * DE * D, D, DE, PH(WS_WDN) + (size_t)e * D * DE, scr, (r / 32) * 64, (r % 32) * 32, lane, MapId{}, GainNone{});
        }
        for (int i = gt; i < 96 * D / 8; i += NGT) *(h16x8*)(PH(WS_WIN) + (size_t)INC * D + (size_t)i * 8) = (h16x8){0, 0, 0, 0, 0, 0, 0, 0};
    }
    for (int i = gt; i < S * 16; i += NGT) { const int t = i >> 4, pp = i & 15; const float inv = exp2f(-(float)pp * (13.287712379549449f / 16.0f)); float sn, cs; sincosf((float)t * inv, &sn, &cs);
        PF(WS_ROPE)[2 * i] = cs; PF(WS_ROPE)[2 * i + 1] = sn; }
    {
        LAS float* zf = scr; LAS float* h1 = scr + 64;
        const float* w1 = p.in[10]; const float* b1 = p.in[11]; const float* freq = p.in[12]; const float* w2 = p.in[13]; const float* b2 = p.in[14];
        for (int t = gw; t < S; t += NGW) {
            const int j = lane;
            if (j < 33) { float v;
                if (j == 0) v = (float)t / (float)S;
                else { const int bi = (j - 1) & 15; const float band = 1e-4f + (float)bi * ((15.0f - 1e-4f) / 15.0f);
                    double rev = (double)t * (double)band / (double)S; rev -= floor(rev); const float r2 = (float)(2.0 * rev);
                    v = (j <= 16) ? cospif(r2) : -sinpif(r2); }
                zf[j] = v; }
            asm volatile("s_waitcnt lgkmcnt(0)" ::: "memory");
            float a = b1[j];
            for (int i = 0; i < 33; ++i) a += zf[i] * w1[i * 64 + j];
            h1[j] = sinf(freq[j] * a);
            asm volatile("s_waitcnt lgkmcnt(0)" ::: "memory");
            float c = b2[j];
            for (int i = 0; i < 64; ++i) c += h1[i] * w2[i * 64 + j];
            PF(WS_H2)[t * 64 + j] = sinf(freq[64 + j] * c);
            asm volatile("s_waitcnt lgkmcnt(0)" ::: "memory");
        }
    }
}
__device__ __forceinline__ void phase_filt3(const Params& p) {
    const int gt = blockIdx.x * NTHR + threadIdx.x, NGT = gridDim.x * NTHR;
    const float* H2 = PF(WS_H2); const float* w3 = p.in[15]; const float* b3 = p.in[16]; const float* decay = p.in[17]; h16* R = PH(WS_R);
    for (int i = gt; i < S * 2048; i += NGT) {
        const int col = i & 2047, tau = i >> 11;
        float a = b3[col];
#pragma unroll 8
        for (int j = 0; j < 64; ++j) a += H2[tau * 64 + j] * w3[j * 2048 + col];
        a *= expf(-((float)tau / (float)S) * fabsf(decay[col]));
        const int o = col >> 10, dir = (col >> 9) & 1, c = col & 511;
        h16* r = R + ((size_t)(o * 512 + c)) * 8192;
        if (dir == 0) r[4096 - tau] = (h16)a;
        else r[tau == 0 ? 0 : 4096 + tau] = (h16)(tau == 0 ? 0.f : a);
    }
}
__device__ __forceinline__ void phase_krot(const Params& p) {
    const int gt = blockIdx.x * NTHR + threadIdx.x, NGT = gridDim.x * NTHR;
    const h16* lat = PH(WS_LAT); h16* K = PH(WS_K); const float* rope = PF(WS_ROPE);
    for (int i = gt; i < T * 4; i += NGT) {
        const int m = i >> 2, p0 = (i & 3) * 4, b = m >> 12, t = m & 4095;
        const h16x4 k1 = *(const h16x4*)(lat + (size_t)m * LAT + 384 + p0), k2 = *(const h16x4*)(lat + (size_t)m * LAT + 400 + p0);
        h16x4 o1, o2;
#pragma unroll
        for (int j = 0; j < 4; ++j) { const float cs = rope[((size_t)t * 16 + p0 + j) * 2], sn = rope[((size_t)t * 16 + p0 + j) * 2 + 1];
            const float a = (float)k1[j], c = (float)k2[j]; o1[j] = (h16)(a * cs - c * sn); o2[j] = (h16)(a * sn + c * cs); }
#pragma unroll
        for (int h = 0; h < NH; ++h) { h16* kp = K + ((size_t)((b * NH + h) * S + t)) * 96 + 64 + p0; *(h16x4*)kp = o1; *(h16x4*)(kp + 16) = o2; }
    }
}

__global__ void __launch_bounds__(NTHR) mega(Params p, int ph_lo, int ph_hi) {
    extern __shared__ __attribute__((aligned(16))) char lds_raw[];
    LAS char* lds = (LAS char*)lds_raw;
#define PHASE(k) if (ph_lo <= (k) && (k) < ph_hi)
    PHASE(0) { phase_prep(p, lds); }
    PHASE(1) {
        gemm_job<false>(lds, PH(WS_XH), D, PH(WS_WIN), D, T, 1536, D, EHy{PF(WS_SSX), PH(WS_HYT)});
        gemm_job<true>(lds, PH(WS_XH), D, PH(WS_WIN) + (size_t)1536 * D, D, T, 512, D, ELat{PF(WS_SSX), PH(WS_LAT), PF(WS_SSQ), PF(WS_SSKV)});
        gemm_job<true>(lds, PH(WS_MEMH), D, PH(WS_WMKV), D, MROWS, 1024, D, EKc{PF(WS_SSMEM), PH(WS_KC)});
        gemm_job<false>(lds, PH(WS_MEMH), D, PH(WS_WMKV) + (size_t)1024 * D, D, MROWS, 1024, D, EVc{PF(WS_SSMEM), PH(WS_VCT)}, 32);
        phase_filt3(p);
    }
    PHASE(2) {
        gemm_job<true>(lds, PH(WS_LAT), LAT, PH(WS_WUQ), 256, T, 768, 256, EQ{PF(WS_SSQ), PF(WS_ROPE), PH(WS_Q)});
        gemm_job<true>(lds, PH(WS_LAT) + 256, LAT, PH(WS_WUKV), 128, T, 512, 128, EK{PF(WS_SSKV), PH(WS_K)}, 128);
        gemm_job<false>(lds, PH(WS_LAT) + 256, LAT, PH(WS_WUKV) + (size_t)512 * 128, 128, T, 512, 128, EV{PF(WS_SSKV), PH(WS_VT)}, 128);
        phase_krot(p);
    }
    PHASE(5) { gemm_job<true>(lds, PH(WS_MIX), D, PH(WS_WOUT), D, T, D, D, ERes{p.in[0], p.X, PH(WS_X1H), PF(WS_SSX1)}); }
    PHASE(6) { gemm_job<true>(lds, PH(WS_X1H), D, PH(WS_WMQ), D, T, D, D, EMq{PF(WS_SSX1), PH(WS_QC)}); }
    PHASE(8) { gemm_job<true>(lds, PH(WS_QC), D, PH(WS_WMO), D, T, D, D, ERes{p.X, p.X, PH(WS_X2H), nullptr}); }
}

extern "C" void kernel_launch(void* const* d_in, const int* in_sizes, int n_in, void* d_out, int out_size, void* d_ws, size_t ws_size, hipStream_t st) {
    Params p{};
    for (int i = 0; i < 36; ++i) p.in[i] = (const float*)d_in[i];
    p.X = (float*)d_out; p.ws = (char*)d_ws;
    char* ws = (char*)d_ws; float* X = (float*)d_out;
    auto F = [&](size_t off) { return (float*)(ws + off); };
    auto H = [&](size_t off) { return (h16*)(ws + off); };
    auto I = [&](size_t off) { return (int*)(ws + off); };
    static bool attr_done = false;
    if (!attr_done) { (void)hipFuncSetAttribute((const void*)mega, hipFuncAttributeMaxDynamicSharedMemorySize, LDS_BYTES); attr_done = true; }
    auto run = [&](int lo, int hi) { hipLaunchKernelGGL(mega, dim3(256), dim3(NTHR), LDS_BYTES, st, p, lo, hi); };
    run(0, 1); run(1, 2); run(2, 3);
    hipLaunchKernelGGL(k_attn_naive, dim3(S / 128, NB * NH), dim3(128), 0, st, H(WS_Q), H(WS_K), H(WS_VT), H(WS_AOUT));
    hipLaunchKernelGGL(k_hyena_naive, dim3(NB * HYW), dim3(256), 0, st, H(WS_HYT), H(WS_R), p.in[8], p.in[9], p.in[18], H(WS_HT));
    hipLaunchKernelGGL(k_rowss, dim3(T / 4), dim3(256), 0, st, H(WS_AOUT), 512, 0, 512, F(WS_SSA), T);
    hipLaunchKernelGGL(k_ss_h, dim3(T / 256), dim3(256), 0, st, H(WS_HT), F(WS_SSH));
    hipLaunchKernelGGL(k_mixprep, dim3(T * D / 256), dim3(256), 0, st, H(WS_AOUT), H(WS_HT), F(WS_SSA), F(WS_SSH), H(WS_MIX));
    run(5, 6); run(6, 7);
    hipLaunchKernelGGL(k_xattn_naive, dim3(S / 32, NB * MH), dim3(256), 0, st, H(WS_QC), H(WS_KC), H(WS_VCT));
    run(8, 9);
    hipLaunchKernelGGL(k_route, dim3(T / 4), dim3(256), 0, st, X, p.in[27], p.in[28], p.in[29], p.in[30], p.in[31], F(WS_SSX2), I(WS_TOKE), F(WS_TOKW), I(WS_TOKP), I(WS_CTL), I(WS_LIST));
    hipLaunchKernelGGL(k_moe_naive, dim3(T), dim3(256), 0, st, H(WS_X2H), F(WS_SSX2), I(WS_TOKE), F(WS_TOKW), H(WS_WGU), H(WS_WDN), H(WS_YB));
    hipLaunchKernelGGL(k_final, dim3(T / 4), dim3(256), 0, st, X, H(WS_YB), p.in[35], X);
    (void)in_sizes; (void)n_in; (void)out_size; (void)ws_size;
}
```

```cpp
#include <hip/hip_runtime.h>
#include <cstdint>
#include <cstdio>
#include <hip/hip_cooperative_groups.h>
namespace cg = cooperative_groups;
typedef _Float16 h16;

constexpr int NB = 4, S = 4096, D = 1024, T = NB * S, MEMT = 256, MROWS = NB * MEMT;
constexpr int NH = 8, HYW = 512;
constexpr int LAT = 416, INC = 1952;
constexpr int MH = 4, MHD = 256;
constexpr int NE = 32, DE = 256;
constexpr float EPS = 1e-6f;
constexpr float LOG2E = 1.4426950408889634f;
constexpr float QSCALE = 0.10206207261596575f * LOG2E;
constexpr float CSCALE = 0.0625f * LOG2E;

constexpr size_t MiB = 1u << 20;
constexpr size_t WS_CTL = 0;
constexpr size_t WS_SSX = 64 * 1024, WS_SSQ = 128 * 1024, WS_SSKV = 192 * 1024, WS_SSA = 256 * 1024, WS_SSH = 320 * 1024,
                 WS_SSX1 = 384 * 1024, WS_SSX2 = 448 * 1024, WS_SSMEM = 512 * 1024, WS_TOKE = 576 * 1024, WS_TOKW = 704 * 1024,
                 WS_TOKP = 832 * 1024;
constexpr size_t WS_WIN = 2 * MiB, WS_WUQ = 6 * MiB, WS_WUKV = 6 * MiB + 512 * 1024, WS_WOUT = 7 * MiB, WS_WMQ = 9 * MiB,
                 WS_WMKV = 11 * MiB, WS_WMO = 15 * MiB, WS_MEMH = 17 * MiB, WS_KC = 19 * MiB, WS_VCT = 21 * MiB, WS_R = 23 * MiB,
                 WS_WGU = 39 * MiB, WS_WDN = 71 * MiB, WS_LAT = 87 * MiB, WS_HYT = 101 * MiB, WS_XH = 149 * MiB, WS_Q = 149 * MiB,
                 WS_K = 173 * MiB, WS_VT = 197 * MiB, WS_AOUT = 213 * MiB, WS_HT = 229 * MiB, WS_LIST = 245 * MiB, WS_H2 = 247 * MiB;
constexpr size_t WS_MIX = 87 * MiB, WS_X1H = 119 * MiB, WS_QC = 151 * MiB, WS_X2H = 87 * MiB, WS_HB = 119 * MiB, WS_YB = 135 * MiB;

__device__ __forceinline__ float wave_sum(float v) {
#pragma unroll
    for (int o = 1; o < 64; o <<= 1) v += __shfl_xor(v, o);
    return v;
}
__device__ __forceinline__ float rstd_of(float ss, int n) { return 1.0f / sqrtf(ss / (float)n + EPS); }

__global__ __launch_bounds__(256) void k_cvt_rows(const float* x, h16* xh, float* ss, int rows, int n) {
    int row = blockIdx.x * 4 + (threadIdx.x >> 6), lane = threadIdx.x & 63;
    if (row >= rows) return;
    float s = 0.f;
    for (int k = lane; k < n; k += 64) { float v = x[(size_t)row * n + k]; s += v * v; xh[(size_t)row * n + k] = (h16)v; }
    s = wave_sum(s);
    if (lane == 0) ss[row] = s;
}
__global__ void k_wt(const float* W, const float* g, const float* g2, int ksplit, h16* Wt, int K, int N, int Npad) {
    size_t i = (size_t)blockIdx.x * 256 + threadIdx.x;
    if (i >= (size_t)K * Npad) return;
    int n = (int)(i % Npad), k = (int)(i / Npad);
    float v = 0.f;
    if (n < N) v = W[(size_t)k * N + n] * (g ? (k < ksplit ? g[k] : g2[k - ksplit]) : 1.f);
    Wt[(size_t)n * K + k] = (h16)v;
}
__global__ void k_wt_gu(const float* wg, const float* wu, const float* g, h16* Wt) {
    size_t i = (size_t)blockIdx.x * 256 + threadIdx.x;
    if (i >= (size_t)NE * D * DE) return;
    int j = (int)(i % DE), k = (int)((i / DE) % D), e = (int)(i / ((size_t)DE * D));
    int np = 32 * (j >> 4) + (j & 15);
    float gg = g[k];
    Wt[((size_t)e * 512 + np) * D + k] = (h16)(wg[i] * gg);
    Wt[((size_t)e * 512 + np + 16) * D + k] = (h16)(wu[i] * gg);
}
__global__ void k_wt_dn(const float* wd, h16* Wt) {
    size_t i = (size_t)blockIdx.x * 256 + threadIdx.x;
    if (i >= (size_t)NE * DE * D) return;
    int n = (int)(i % D), f = (int)((i / D) % DE), e = (int)(i / ((size_t)D * DE));
    Wt[((size_t)e * D + n) * DE + f] = (h16)wd[i];
}
__global__ __launch_bounds__(64) void k_filt12(const float* w1, const float* b1, const float* freq, const float* w2, const float* b2, float* H2) {
    __shared__ float z[33], h1[64];
    int t = blockIdx.x, j = threadIdx.x;
    if (j < 33) {
        float v;
        if (j == 0) v = (float)t / (float)S;
        else {
            int bi = (j - 1) & 15;
            float band = 1e-4f + (float)bi * ((15.0f - 1e-4f) / 15.0f);
            double rev = (double)t * (double)band / (double)S;
            rev -= floor(rev);
            float r2 = (float)(2.0 * rev);
            v = (j <= 16) ? cospif(r2) : -sinpif(r2);
        }
        z[j] = v;
    }
    __syncthreads();
    float a = b1[j];
    for (int i = 0; i < 33; ++i) a += z[i] * w1[i * 64 + j];
    h1[j] = sinf(freq[j] * a);
    __syncthreads();
    float c = b2[j];
    for (int i = 0; i < 64; ++i) c += h1[i] * w2[i * 64 + j];
    H2[t * 64 + j] = sinf(freq[64 + j] * c);
}
__global__ void k_filt3(const float* H2, const float* w3, const float* b3, const float* decay, h16* R) {
    int i = blockIdx.x * 256 + threadIdx.x;
    int col = i & 2047, tau = i >> 11;
    float a = b3[col];
    for (int j = 0; j < 64; ++j) a += H2[tau * 64 + j] * w3[j * 2048 + col];
    a *= expf(-((float)tau / (float)S) * fabsf(decay[col]));
    int o = col >> 10, dir = (col >> 9) & 1, c = col & 511;
    h16* r = R + ((size_t)(o * 512 + c)) * 8192;
    if (dir == 0) r[4096 - tau] = (h16)a;
    else r[tau == 0 ? 0 : 4096 + tau] = (h16)(tau == 0 ? 0.f : a);
}

template <class Epi>
__global__ __launch_bounds__(256) void k_gemm_naive(const h16* A, int lda, const h16* Wt, int ldw, int M, int N, int K, Epi epi) {
    __shared__ float As[16][65], Bs[16][65];
    int tx = threadIdx.x & 15, ty = threadIdx.x >> 4;
    int m0 = blockIdx.y * 64, n0 = blockIdx.x * 64;
    float acc[4][4];
#pragma unroll
    for (int i = 0; i < 4; ++i)
#pragma unroll
        for (int j = 0; j < 4; ++j) acc[i][j] = 0.f;
    for (int k0 = 0; k0 < K; k0 += 16) {
        for (int i = threadIdx.x; i < 1024; i += 256) {
            int r = i >> 4, c = i & 15, m = m0 + r, n = n0 + r;
            As[c][r] = (m < M) ? (float)A[(size_t)m * lda + k0 + c] : 0.f;
            Bs[c][r] = (n < N) ? (float)Wt[(size_t)n * ldw + k0 + c] : 0.f;
        }
        __syncthreads();
#pragma unroll
        for (int kk = 0; kk < 16; ++kk) {
            float a[4], b[4];
#pragma unroll
            for (int i = 0; i < 4; ++i) { a[i] = As[kk][ty * 4 + i]; b[i] = Bs[kk][tx * 4 + i]; }
#pragma unroll
            for (int i = 0; i < 4; ++i)
#pragma unroll
                for (int j = 0; j < 4; ++j) acc[i][j] += a[i] * b[j];
        }
        __syncthreads();
    }
#pragma unroll
    for (int i = 0; i < 4; ++i)
#pragma unroll
        for (int j = 0; j < 4; ++j) { int m = m0 + ty * 4 + i, n = n0 + tx * 4 + j; if (m < M && n < N) epi(m, n, acc[i][j]); }
}
struct EpiIn { const float* ssx; h16* lat; h16* hyT;
    __device__ void operator()(int m, int n, float v) const {
        v *= rstd_of(ssx[m], D);
        if (n < LAT) lat[(size_t)m * LAT + n] = (h16)v;
        else if (n < INC) { int b = m >> 12, t = m & 4095; hyT[((size_t)(b * 1536 + (n - LAT))) * S + t] = (h16)v; }
    } };
struct EpiQ { const float* ssq; h16* Q;
    __device__ void operator()(int m, int n, float v) const {
        v *= rstd_of(ssq[m], 256) * QSCALE; int b = m >> 12, t = m & 4095, h = n / 96, j = n % 96;
        Q[((size_t)((b * NH + h) * S + t)) * 96 + j] = (h16)v;
    } };
struct EpiKV { const float* sskv; h16* K; h16* Vt;
    __device__ void operator()(int m, int n, float v) const {
        v *= rstd_of(sskv[m], 128); int b = m >> 12, t = m & 4095, h = n >> 7, j = n & 127;
        if (j < 64) K[((size_t)((b * NH + h) * S + t)) * 96 + j] = (h16)v;
        else Vt[((size_t)((b * NH + h) * 64 + (j - 64))) * S + t] = (h16)v;
    } };
struct EpiRes { const float* xin; float* X; h16* xh;
    __device__ void operator()(int m, int n, float v) const {
        size_t i = (size_t)m * D + n; float r = xin[i] + v; X[i] = r; xh[i] = (h16)r;
    } };
struct EpiMq { const float* ss; h16* qc;
    __device__ void operator()(int m, int n, float v) const { qc[(size_t)m * D + n] = (h16)(v * rstd_of(ss[m], D) * CSCALE); } };
struct EpiMkv { const float* ss; h16* Kc; h16* VcT;
    __device__ void operator()(int m, int n, float v) const {
        v *= rstd_of(ss[m], D);
        if (n < D) Kc[(size_t)m * D + n] = (h16)v;
        else { int np = n - D, h = np >> 8, d = np & 255, b = m >> 8, mm = m & 255; VcT[((size_t)((b * MH + h) * MHD + d)) * MEMT + mm] = (h16)v; }
    } };

__global__ __launch_bounds__(256) void k_rowss(const h16* A, int lda, int off, int n, float* ss, int rows) {
    int row = blockIdx.x * 4 + (threadIdx.x >> 6), lane = threadIdx.x & 63;
    if (row >= rows) return;
    float s = 0.f;
    for (int k = lane; k < n; k += 64) { float v = (float)A[(size_t)row * lda + off + k]; s += v * v; }
    s = wave_sum(s);
    if (lane == 0) ss[row] = s;
}
__global__ void k_rope(h16* Q, h16* K, const h16* lat) {
    int i = blockIdx.x * 256 + threadIdx.x;
    if (i >= T * 16) return;
    int m = i >> 4, p = i & 15, b = m >> 12, t = m & 4095;
    float inv = exp2f(-(float)p * (13.287712379549449f / 16.0f));
    float ang = (float)t * inv;
    float sn, cs; sincosf(ang, &sn, &cs);
    float k1 = (float)lat[(size_t)m * LAT + 384 + p], k2 = (float)lat[(size_t)m * LAT + 384 + 16 + p];
    h16 o1 = (h16)(k1 * cs - k2 * sn), o2 = (h16)(k1 * sn + k2 * cs);
    for (int h = 0; h < NH; ++h) {
        size_t base = ((size_t)((b * NH + h) * S + t)) * 96 + 64;
        K[base + p] = o1; K[base + 16 + p] = o2;
        float q1 = (float)Q[base + p], q2 = (float)Q[base + 16 + p];
        Q[base + p] = (h16)(q1 * cs - q2 * sn); Q[base + 16 + p] = (h16)(q1 * sn + q2 * cs);
    }
}
__global__ __launch_bounds__(128) void k_attn_naive(const h16* Q, const h16* K, const h16* Vt, h16* aout) {
    __shared__ float Ks[32][96], Vs[32][64];
    int bh = blockIdx.y, q0 = blockIdx.x * 128, tid = threadIdx.x;
    float q[96], o[64];
#pragma unroll
    for (int d = 0; d < 96; ++d) q[d] = (float)Q[((size_t)bh * S + q0 + tid) * 96 + d];
#pragma unroll
    for (int d = 0; d < 64; ++d) o[d] = 0.f;
    float m = -1e30f, l = 0.f;
    for (int k0 = 0; k0 < S; k0 += 32) {
        __syncthreads();
        for (int i = tid; i < 32 * 96; i += 128) { int r = i / 96, c = i % 96; Ks[r][c] = (float)K[((size_t)bh * S + k0 + r) * 96 + c]; }
        for (int i = tid; i < 32 * 64; i += 128) { int d = i >> 5, r = i & 31; Vs[r][d] = (float)Vt[((size_t)bh * 64 + d) * S + k0 + r]; }
        __syncthreads();
        for (int r = 0; r < 32; ++r) {
            float s = 0.f;
#pragma unroll
            for (int d = 0; d < 96; ++d) s += q[d] * Ks[r][d];
            if (s > m) { float al = exp2f(m - s); l *= al;
#pragma unroll
                for (int d = 0; d < 64; ++d) o[d] *= al;
                m = s; }
            float p = exp2f(s - m); l += p;
#pragma unroll
            for (int d = 0; d < 64; ++d) o[d] += p * Vs[r][d];
        }
    }
    int b = bh >> 3, h = bh & 7; float il = 1.f / l;
#pragma unroll
    for (int d = 0; d < 64; ++d) aout[((size_t)(b * S + q0 + tid)) * 512 + h * 64 + d] = (h16)(o[d] * il);
}
__global__ __launch_bounds__(256) void k_hyena_naive(const h16* hyT, const h16* R, const float* convw, const float* convb, const float* skip, h16* hT) {
    __shared__ float z[4096]; __shared__ float Rl[8192];
    int b = blockIdx.x >> 9, c = blockIdx.x & 511, tid = threadIdx.x;
    auto u3 = [&](int ch, int t) -> float {
        const h16* p = hyT + ((size_t)(b * 1536 + ch)) * S;
        float a = t > 0 ? (float)p[t - 1] : 0.f, bb = (float)p[t], cc = t < S - 1 ? (float)p[t + 1] : 0.f;
        return a * convw[ch] + bb * convw[1536 + ch] + cc * convw[3072 + ch] + convb[ch];
    };
    for (int n = 0; n < 2; ++n) {
        for (int u = tid; u < 8192; u += 256) Rl[u] = (float)R[((size_t)(n * 512 + c)) * 8192 + u];
        if (n == 0) for (int t = tid; t < S; t += 256) z[t] = u3(1024 + c, t);
        __syncthreads();
        float acc[16];
#pragma unroll
        for (int i = 0; i < 16; ++i) acc[i] = 0.f;
        for (int s = 0; s < S; ++s) {
            float zs = z[s];
#pragma unroll
            for (int i = 0; i < 16; ++i) acc[i] += zs * Rl[s - (tid + 256 * i) + 4096];
        }
        __syncthreads();
        float sk = skip[n * 512 + c];
#pragma unroll
        for (int i = 0; i < 16; ++i) {
            int t = tid + 256 * i;
            float zn = u3(n == 0 ? c : 512 + c, t) * (acc[i] + sk * z[t]);
            if (n == 0) z[t] = zn; else hT[((size_t)(b * 512 + c)) * S + t] = (h16)zn;
        }
        __syncthreads();
    }
}
__global__ void k_ss_h(const h16* hT, float* ss) {
    int m = blockIdx.x * 256 + threadIdx.x; int b = m >> 12, t = m & 4095; float s = 0.f;
    for (int c = 0; c < 512; ++c) { float v = (float)hT[((size_t)(b * 512 + c)) * S + t]; s += v * v; }
    ss[m] = s;
}
__global__ void k_mixprep(const h16* aout, const h16* hT, const float* ssa, const float* ssh, h16* mix) {
    size_t i = (size_t)blockIdx.x * 256 + threadIdx.x;
    int m = (int)(i & (T - 1)), k = (int)(i >> 14);
    float v;
    if (k < 512) v = (float)aout[(size_t)m * 512 + k] * rstd_of(ssa[m], 512);
    else { int b = m >> 12, t = m & 4095; v = (float)hT[((size_t)(b * 512 + (k - 512))) * S + t] * rstd_of(ssh[m], 512); }
    mix[(size_t)m * D + k] = (h16)v;
}
__global__ __launch_bounds__(256) void k_xattn_naive(h16* qc, const h16* Kc, const h16* VcT) {
    __shared__ float sc[32][257]; __shared__ float il[32]; __shared__ h16 qs[32][256];
    int bh = blockIdx.y, b = bh >> 2, h = bh & 3, t0 = blockIdx.x * 32, tid = threadIdx.x, wv = tid >> 6, lane = tid & 63;
    for (int i = tid; i < 32 * 256; i += 256) { int tok = i >> 8, d = i & 255; qs[tok][d] = qc[((size_t)(b * S + t0 + tok)) * D + h * MHD + d]; }
    __syncthreads();
    for (int mi = 0; mi < 64; ++mi) {
        int mm = wv * 64 + mi;
        const h16* kp = Kc + ((size_t)(b * MEMT + mm)) * D + h * MHD + lane * 4;
        float k0 = (float)kp[0], k1 = (float)kp[1], k2 = (float)kp[2], k3 = (float)kp[3];
        for (int tok = 0; tok < 32; ++tok) {
            float s = (float)qs[tok][lane * 4] * k0 + (float)qs[tok][lane * 4 + 1] * k1 + (float)qs[tok][lane * 4 + 2] * k2 + (float)qs[tok][lane * 4 + 3] * k3;
            s = wave_sum(s);
            if (lane == 0) sc[tok][mm] = s;
        }
    }
    __syncthreads();
    if (tid < 32) { float mx = -1e30f; for (int j = 0; j < 256; ++j) mx = fmaxf(mx, sc[tid][j]); float l = 0.f;
        for (int j = 0; j < 256; ++j) { float p = exp2f(sc[tid][j] - mx); sc[tid][j] = p; l += p; } il[tid] = 1.f / l; }
    __syncthreads();
    for (int di = 0; di < 64; ++di) {
        int d = wv * 64 + di;
        const h16* vp = VcT + ((size_t)((b * MH + h) * MHD + d)) * MEMT + lane * 4;
        float v0 = (float)vp[0], v1 = (float)vp[1], v2 = (float)vp[2], v3 = (float)vp[3];
        for (int tok = 0; tok < 32; ++tok) {
            float o = sc[tok][lane * 4] * v0 + sc[tok][lane * 4 + 1] * v1 + sc[tok][lane * 4 + 2] * v2 + sc[tok][lane * 4 + 3] * v3;
            o = wave_sum(o);
            if (lane == 0) qc[((size_t)(b * S + t0 + tok)) * D + h * MHD + d] = (h16)(o * il[tok]);
        }
    }
}
__global__ __launch_bounds__(256) void k_route(const float* X, const float* g, const float* wrg, const float* brg, const float* wre, const float* bre,
                                               float* ssx2, int* toke, float* tokw, int* tokp, int* cnt, int* list) {
    int m = blockIdx.x * 4 + (threadIdx.x >> 6), lane = threadIdx.x & 63;
    float xs[16]; float ss = 0.f;
#pragma unroll
    for (int i = 0; i < 16; ++i) { xs[i] = X[(size_t)m * D + lane + 64 * i]; ss += xs[i] * xs[i]; }
    ss = wave_sum(ss);
    float rs = rstd_of(ss, D);
    float lg[36];
#pragma unroll
    for (int j = 0; j < 36; ++j) lg[j] = 0.f;
#pragma unroll
    for (int i = 0; i < 16; ++i) { int k = lane + 64 * i; float tv = xs[i] * rs * g[k];
#pragma unroll
        for (int j = 0; j < 4; ++j) lg[j] += tv * wrg[k * 4 + j];
#pragma unroll
        for (int j = 0; j < 32; ++j) lg[4 + j] += tv * wre[k * 32 + j]; }
#pragma unroll
    for (int j = 0; j < 36; ++j) lg[j] = wave_sum(lg[j]);
    if (lane == 0) {
        ssx2[m] = ss;
        float gl[4]; int gi = 0; float gm = -1e30f;
#pragma unroll
        for (int j = 0; j < 4; ++j) { gl[j] = lg[j] + brg[j]; if (gl[j] > gm) { gm = gl[j]; gi = j; } }
        float gs = 0.f;
#pragma unroll
        for (int j = 0; j < 4; ++j) gs += expf(gl[j] - gm);
        float pg = 1.f / gs;
        float e1 = -1e30f, e2 = -1e30f; int i1 = 0, i2 = 0;
#pragma unroll
        for (int g4 = 0; g4 < 4; ++g4) if (g4 == gi) {
#pragma unroll
            for (int j = 0; j < 8; ++j) { float v = lg[4 + g4 * 8 + j] + bre[g4 * 8 + j];
                if (v > e1) { e2 = e1; i2 = i1; e1 = v; i1 = j; } else if (v > e2) { e2 = v; i2 = j; } } }
        float p2 = 1.f / (1.f + expf(e1 - e2)), p1 = 1.f - p2;
        int ea = gi * 8 + i1, eb = gi * 8 + i2;
        toke[m * 2] = ea; toke[m * 2 + 1] = eb; tokw[m * 2] = pg * p1; tokw[m * 2 + 1] = pg * p2;
        int pa = atomicAdd(&cnt[ea], 1), pb = atomicAdd(&cnt[eb], 1);
        tokp[m * 2] = pa; tokp[m * 2 + 1] = pb; list[ea * T + pa] = m * 2; list[eb * T + pb] = m * 2 + 1;
    }
}
__global__ __launch_bounds__(256) void k_moe_naive(const h16* x2h, const float* ssx2, const int* toke, const float* tokw, const h16* Wgu, const h16* Wdn, h16* yb) {
    __shared__ float mh[DE];
    int m = blockIdx.x, tid = threadIdx.x, wv = tid >> 6, lane = tid & 63;
    float xs[16];
#pragma unroll
    for (int i = 0; i < 16; ++i) xs[i] = (float)x2h[(size_t)m * D + lane + 64 * i];
    float rs = rstd_of(ssx2[m], D);
    for (int sl = 0; sl < 2; ++sl) {
        int e = toke[m * 2 + sl]; float w = tokw[m * 2 + sl];
        for (int ji = 0; ji < 64; ++ji) {
            int j = wv * 64 + ji, np = 32 * (j >> 4) + (j & 15);
            const h16* wgp = Wgu + ((size_t)e * 512 + np) * D; const h16* wup = wgp + (size_t)16 * D;
            float a = 0.f, bb = 0.f;
#pragma unroll
            for (int i = 0; i < 16; ++i) { a += xs[i] * (float)wgp[lane + 64 * i]; bb += xs[i] * (float)wup[lane + 64 * i]; }
            a = wave_sum(a) * rs; bb = wave_sum(bb) * rs;
            if (lane == 0) mh[j] = (float)(h16)(a / (1.f + expf(-a)) * bb * w);
        }
        __syncthreads();
        float m4[4];
#pragma unroll
        for (int i = 0; i < 4; ++i) m4[i] = mh[lane + 64 * i];
        for (int ni = 0; ni < 256; ++ni) {
            int n = wv * 256 + ni; const h16* wd = Wdn + ((size_t)e * D + n) * DE; float y = 0.f;
#pragma unroll
            for (int i = 0; i < 4; ++i) y += m4[i] * (float)wd[lane + 64 * i];
            y = wave_sum(y);
            if (lane == 0) yb[((size_t)(m * 2 + sl)) * D + n] = (h16)y;
        }
        __syncthreads();
    }
}
__global__ __launch_bounds__(256) void k_final(const float* X, const h16* yb, const float* g, float* out) {
    int m = blockIdx.x * 4 + (threadIdx.x >> 6), lane = threadIdx.x & 63;
    float v[16]; float ss = 0.f;
#pragma unroll
    for (int i = 0; i < 16; ++i) { int k = lane + 64 * i;
        v[i] = X[(size_t)m * D + k] + (float)yb[((size_t)m * 2) * D + k] + (float)yb[((size_t)m * 2 + 1) * D + k]; ss += v[i] * v[i]; }
    ss = wave_sum(ss); float rs = rstd_of(ss, D);
#pragma unroll
    for (int i = 0; i < 16; ++i) { int k = lane + 64 * i; out[(size_t)m * D + k] = v[i] * rs * g[k]; }
}


#define LAS __attribute__((address_space(3)))
typedef _Float16 h16x8 __attribute__((ext_vector_type(8)));
typedef _Float16 h16x4 __attribute__((ext_vector_type(4)));
typedef _Float16 h16x2 __attribute__((ext_vector_type(2)));
typedef float f32x4 __attribute__((ext_vector_type(4)));
typedef float f32x16 __attribute__((ext_vector_type(16)));
constexpr int NTHR = 512, NWAVE = 8;
constexpr int LDS_BYTES = 150 * 1024;
constexpr size_t WS_ROPE = 248 * MiB;

struct Params {
    const float* in[36]; float* X; char* ws;
};
#define PF(off) ((float*)(p.ws + (off)))
#define PH(off) ((h16*)(p.ws + (off)))
#define PI(off) ((int*)(p.ws + (off)))

constexpr int G_BM = 256, G_BN = 128, G_BK = 64, G_AB = G_BM * G_BK * 2, G_BB = G_BN * G_BK * 2, G_STAGE = G_AB + G_BB;
static_assert(3 * G_STAGE <= LDS_BYTES, "lds");
__device__ __forceinline__ void glds16(const void* g, LAS char* l) { __builtin_amdgcn_global_load_lds((const unsigned*)g, (LAS unsigned*)l, 16, 0, 0); }

template <bool SWAP, class RowPtr, class Epi>
__device__ __forceinline__ void gemm_tile(LAS char* lds, const RowPtr& rowptr, const h16* __restrict__ Wt, int ldw, int K, int m0, int n0, const Epi& epi) {
    const int tid = threadIdx.x, lane = tid & 63, wid = __builtin_amdgcn_readfirstlane(tid >> 6);
    const int wm = wid >> 1, wn = wid & 1, fr = lane & 15, fq = lane >> 4;
    const h16* asrc[4]; const h16* bsrc[2];
#pragma unroll
    for (int i = 0; i < 4; ++i) { const int r = wid * 32 + i * 8 + (lane >> 3); const int ch = (lane & 7) ^ ((r >> 1) & 7); asrc[i] = rowptr(m0 + r) + ch * 8; }
#pragma unroll
    for (int i = 0; i < 2; ++i) { const int r = wid * 16 + i * 8 + (lane >> 3); const int ch = (lane & 7) ^ ((r >> 1) & 7); bsrc[i] = Wt + (size_t)(n0 + r) * ldw + ch * 8; }
    const int sw = fr >> 1;
    const int aoff = (wm * 64 + fr) * 128 + ((fq ^ sw) * 16);
    const int boff = G_AB + (wn * 64 + fr) * 128 + ((fq ^ sw) * 16);
    f32x4 acc[4][4];
#pragma unroll
    for (int i = 0; i < 4; ++i)
#pragma unroll
        for (int j = 0; j < 4; ++j) acc[i][j] = (f32x4){0.f, 0.f, 0.f, 0.f};
    const int nt = K / G_BK;
    asm volatile("s_waitcnt vmcnt(0)" ::: "memory");
#define G_STAGE_ISSUE(buf, kt) do { LAS char* sa_ = lds + (buf) * G_STAGE + wid * 4096; \
        _Pragma("unroll") for (int i_ = 0; i_ < 4; ++i_) glds16(asrc[i_] + (kt) * G_BK, sa_ + i_ * 1024); \
        LAS char* sb_ = lds + (buf) * G_STAGE + G_AB + wid * 2048; \
        _Pragma("unroll") for (int i_ = 0; i_ < 2; ++i_) glds16(bsrc[i_] + (kt) * G_BK, sb_ + i_ * 1024); } while (0)
    G_STAGE_ISSUE(0, 0);
    if (nt > 1) G_STAGE_ISSUE(1, 1);
    int buf = 0;
    for (int t = 0; t < nt; ++t) {
        if (t + 1 < nt) asm volatile("s_waitcnt vmcnt(6)" ::: "memory"); else asm volatile("s_waitcnt vmcnt(0)" ::: "memory");
        __builtin_amdgcn_s_barrier();
        if (t + 2 < nt) { const int nb_ = buf >= 1 ? buf - 1 : 2; G_STAGE_ISSUE(nb_, t + 2); }
        LAS char* base = lds + buf * G_STAGE;
#pragma unroll
        for (int kk = 0; kk < 2; ++kk) {
            h16x8 a[4], b[4];
#pragma unroll
            for (int i = 0; i < 4; ++i) { a[i] = *(LAS h16x8*)(base + ((aoff ^ (kk * 64)) + i * 2048)); b[i] = *(LAS h16x8*)(base + ((boff ^ (kk * 64)) + i * 2048)); }
#pragma unroll
            for (int i = 0; i < 4; ++i)
#pragma unroll
                for (int j = 0; j < 4; ++j)
                    acc[i][j] = SWAP ? __builtin_amdgcn_mfma_f32_16x16x32_f16(b[j], a[i], acc[i][j], 0, 0, 0)
                                     : __builtin_amdgcn_mfma_f32_16x16x32_f16(a[i], b[j], acc[i][j], 0, 0, 0);
        }
        buf = buf == 2 ? 0 : buf + 1;
    }
#undef G_STAGE_ISSUE
    asm volatile("s_waitcnt lgkmcnt(0)" ::: "memory");
    __builtin_amdgcn_s_barrier();
    if constexpr (SWAP) {
#pragma unroll
        for (int i = 0; i < 4; ++i)
#pragma unroll
            for (int jp = 0; jp < 2; ++jp) epi.row32(m0 + wm * 64 + i * 16 + fr, n0 + wn * 64 + jp * 32 + fq * 4, acc[i][2 * jp], acc[i][2 * jp + 1]);
    } else {
#pragma unroll
        for (int i = 0; i < 4; ++i)
#pragma unroll
            for (int j = 0; j < 4; ++j) epi.col4(m0 + wm * 64 + i * 16 + fq * 4, n0 + wn * 64 + j * 16 + fr, acc[i][j]);
    }
}
struct RowDense { const h16* A; int lda; __device__ __forceinline__ const h16* operator()(int m) const { return A + (size_t)m * lda; } };

__device__ __forceinline__ h16x4 cvt4(f32x4 v) { return (h16x4){(h16)v[0], (h16)v[1], (h16)v[2], (h16)v[3]}; }
__device__ __forceinline__ float rowgrp_sum(float v) { v += __shfl_xor(v, 16); v += __shfl_xor(v, 32); return v; }

struct EHy {
    const float* ssx; h16* hyT;
    __device__ __forceinline__ void col4(int mr, int n, f32x4 v) const {
        const f32x4 ss = *(const f32x4*)(ssx + mr);
        v[0] *= rstd_of(ss[0], D); v[1] *= rstd_of(ss[1], D); v[2] *= rstd_of(ss[2], D); v[3] *= rstd_of(ss[3], D);
        const int b = mr >> 12, t = mr & 4095;
        *(h16x4*)(hyT + ((size_t)(b * 1536 + n)) * S + t) = cvt4(v);
    } };
struct ELat {
    const float* ssx; h16* lat; float* ssq; float* sskv;
    __device__ __forceinline__ void row32(int m, int nb, f32x4 va, f32x4 vb) const {
        const float r = rstd_of(ssx[m], D); va *= r; vb *= r;
        if (nb < LAT) { *(h16x4*)(lat + (size_t)m * LAT + nb) = cvt4(va); *(h16x4*)(lat + (size_t)m * LAT + nb + 16) = cvt4(vb); }
        float s = va[0] * va[0] + va[1] * va[1] + va[2] * va[2] + va[3] * va[3] + vb[0] * vb[0] + vb[1] * vb[1] + vb[2] * vb[2] + vb[3] * vb[3];
        s = rowgrp_sum(s);
        if ((threadIdx.x & 63) < 16 && nb < 384) atomicAdd((nb < 256 ? ssq : sskv) + m, s);
    } };
struct EQ {
    const float* ssq; const float* rope; h16* Q;
    __device__ __forceinline__ void row32(int m, int nb, f32x4 va, f32x4 vb) const {
        const float r = rstd_of(ssq[m], 256) * QSCALE; va *= r; vb *= r;
        const int b = m >> 12, t = m & 4095, blk = nb >> 5, h = blk / 3, part = blk - 3 * h, c = nb & 31;
        if (part == 2) {
            const float* rp = rope + ((size_t)t * 16 + c) * 2;
#pragma unroll
            for (int j = 0; j < 4; ++j) { const float cs = rp[2 * j], sn = rp[2 * j + 1]; const float q1 = va[j], q2 = vb[j]; va[j] = q1 * cs - q2 * sn; vb[j] = q1 * sn + q2 * cs; }
        }
        h16* q = Q + ((size_t)((b * NH + h) * S + t)) * 96 + part * 32 + c;
        *(h16x4*)q = cvt4(va); *(h16x4*)(q + 16) = cvt4(vb);
    } };
struct EK {
    const float* sskv; h16* K;
    __device__ __forceinline__ void row32(int m, int nb, f32x4 va, f32x4 vb) const {
        const float r = rstd_of(sskv[m], 128); va *= r; vb *= r;
        const int b = m >> 12, t = m & 4095, h = nb >> 6, j = nb & 63;
        h16* k = K + ((size_t)((b * NH + h) * S + t)) * 96 + j;
        *(h16x4*)k = cvt4(va); *(h16x4*)(k + 16) = cvt4(vb);
    } };
struct EV {
    const float* sskv; h16* Vt;
    __device__ __forceinline__ void col4(int mr, int n, f32x4 v) const {
        const f32x4 ss = *(const f32x4*)(sskv + mr);
        v[0] *= rstd_of(ss[0], 128); v[1] *= rstd_of(ss[1], 128); v[2] *= rstd_of(ss[2], 128); v[3] *= rstd_of(ss[3], 128);
        const int b = mr >> 12, t = mr & 4095;
        *(h16x4*)(Vt + ((size_t)(b * 512 + n)) * S + t) = cvt4(v);
    } };
struct EKc {
    const float* ss; h16* Kc;
    __device__ __forceinline__ void row32(int m, int nb, f32x4 va, f32x4 vb) const {
        const float r = rstd_of(ss[m], D); va *= r; vb *= r;
        *(h16x4*)(Kc + (size_t)m * D + nb) = cvt4(va); *(h16x4*)(Kc + (size_t)m * D + nb + 16) = cvt4(vb);
    } };
struct EVc {
    const float* ss; h16* VcT;
    __device__ __forceinline__ void col4(int mr, int n, f32x4 v) const {
        const f32x4 s4 = *(const f32x4*)(ss + mr);
        v[0] *= rstd_of(s4[0], D); v[1] *= rstd_of(s4[1], D); v[2] *= rstd_of(s4[2], D); v[3] *= rstd_of(s4[3], D);
        const int b = mr >> 8, mm = mr & 255;
        *(h16x4*)(VcT + ((size_t)(b * 1024 + n)) * MEMT + mm) = cvt4(v);
    } };
struct ERes {
    const float* xin; float* X; h16* xh; float* ss;
    __device__ __forceinline__ void row32(int m, int nb, f32x4 va, f32x4 vb) const {
        const size_t i = (size_t)m * D + nb;
        va += *(const f32x4*)(xin + i); vb += *(const f32x4*)(xin + i + 16);
        *(f32x4*)(X + i) = va; *(f32x4*)(X + i + 16) = vb;
        *(h16x4*)(xh + i) = cvt4(va); *(h16x4*)(xh + i + 16) = cvt4(vb);
        float s = va[0] * va[0] + va[1] * va[1] + va[2] * va[2] + va[3] * va[3] + vb[0] * vb[0] + vb[1] * vb[1] + vb[2] * vb[2] + vb[3] * vb[3];
        s = rowgrp_sum(s);
        if (ss && (threadIdx.x & 63) < 16) atomicAdd(ss + m, s);
    } };
struct EMq {
    const float* ss; h16* qc;
    __device__ __forceinline__ void row32(int m, int nb, f32x4 va, f32x4 vb) const {
        const float r = rstd_of(ss[m], D) * CSCALE; va *= r; vb *= r;
        *(h16x4*)(qc + (size_t)m * D + nb) = cvt4(va); *(h16x4*)(qc + (size_t)m * D + nb + 16) = cvt4(vb);
    } };

template <bool SWAP, class Epi>
__device__ __forceinline__ void gemm_job(LAS char* lds, const h16* A, int lda, const h16* Wt, int ldw, int M, int N, int K, const Epi& epi, int first = 0) {
    const int ntn = N / G_BN, ntiles = (M / G_BM) * ntn;
    const RowDense rp{A, lda};
    const int G = gridDim.x, bx = blockIdx.x, vid = (G % 8 == 0) ? (bx % 8) * (G / 8) + bx / 8 : bx;
    for (int tix = (vid + G - first % G) % G; tix < ntiles; tix += G) {
        const int mt = tix / ntn, nt_ = tix - mt * ntn;
        gemm_tile<SWAP>(lds, rp, Wt, ldw, K, mt * G_BM, nt_ * G_BN, epi);
    }
}

template <class RowMap, class Gain>
__device__ __forceinline__ void wt_item(const float* W, int N, int K, h16* Wt, LAS float* scr, int k0, int n0, int lane, const RowMap& rowmap, const Gain& gain) {
#pragma unroll 8
    for (int i = 0; i < 32; ++i) { const int kk = 2 * i + (lane >> 5); scr[kk * 33 + (lane & 31)] = W[(size_t)(k0 + kk) * N + n0 + (lane & 31)] * gain(k0 + kk); }
    asm volatile("s_waitcnt lgkmcnt(0)" ::: "memory");
    const int c = lane & 7;
#pragma unroll
    for (int j = 0; j < 4; ++j) { const int n = (lane >> 3) + 8 * j; const LAS float* s = scr + (8 * c) * 33 + n;
        h16x8 o = {(h16)s[0], (h16)s[33], (h16)s[66], (h16)s[99], (h16)s[132], (h16)s[165], (h16)s[198], (h16)s[231]};
        *(h16x8*)(Wt + (size_t)rowmap(n0 + n) * K + k0 + 8 * c) = o; }
    asm volatile("s_waitcnt lgkmcnt(0)" ::: "memory");
}
struct GainNone { __device__ __forceinline__ float operator()(int) const { return 1.f; } };
struct Gain1 { const float* g; __device__ __forceinline__ float operator()(int k) const { return g[k]; } };
struct Gain2 { const float* g; const float* g2; __device__ __forceinline__ float operator()(int k) const { return k < 512 ? g[k] : g2[k - 512]; } };
struct MapId { __device__ __forceinline__ int operator()(int n) const { return n; } };
struct MapIn { __device__ __forceinline__ int operator()(int n) const { return n < LAT ? 1536 + n : n - LAT; } };
struct MapKV { __device__ __forceinline__ int operator()(int n) const { const int h = n >> 7, j = n & 127; return j < 64 ? h * 64 + j : 512 + h * 64 + (j - 64); } };
struct MapG { int up; __device__ __forceinline__ int operator()(int j) const { return 32 * (j >> 4) + (j & 15) + up; } };

__device__ __forceinline__ void phase_prep(const Params& p, LAS char* lds) {
    const int tid = threadIdx.x, lane = tid & 63, wid = tid >> 6;
    const int gw = blockIdx.x * NWAVE + wid, NGW = gridDim.x * NWAVE, gt = blockIdx.x * NTHR + tid, NGT = gridDim.x * NTHR;
    LAS float* scr = (LAS float*)(lds + wid * 16384);
    for (int i = gt; i < 5 * 16384; i += NGT) PF(WS_SSQ)[i] = 0.f;
    for (int i = gt; i < 1024; i += NGT) PI(WS_CTL)[i] = 0;
    for (int row = gw; row < T + MROWS; row += NGW) {
        const bool isx = row < T; const int r = isx ? row : row - T;
        const f32x4* src = (const f32x4*)((isx ? p.in[0] : p.in[1]) + (size_t)r * D) + lane;
        h16* dst = (isx ? PH(WS_XH) : PH(WS_MEMH)) + (size_t)r * D;
        float s = 0.f;
#pragma unroll
        for (int j = 0; j < 4; ++j) { const f32x4 v = src[64 * j]; s += v[0] * v[0] + v[1] * v[1] + v[2] * v[2] + v[3] * v[3]; *(h16x4*)(dst + (lane + 64 * j) * 4) = cvt4(v); }
        s = wave_sum(s);
        if (lane == 0) (isx ? PF(WS_SSX) : PF(WS_SSMEM))[r] = s;
    }
    {
        constexpr int I_IN = 16 * 61, I_UQ = 4 * 24, I_UKV = 2 * 32, I_SQ = 16 * 32, I_MKV = 16 * 64, I_EX = 16 * 8, I_DN = 4 * 32;
        constexpr int NIT = I_IN + I_UQ + I_UKV + 3 * I_SQ + I_MKV + NE * (2 * I_EX + I_DN);
        for (int it = gw; it < NIT; it += NGW) {
            int r = it;
            if (r < I_IN) { wt_item(p.in[3], INC, D, PH(WS_WIN), scr, (r / 61) * 64, (r % 61) * 32, lane, MapIn{}, Gain1{p.in[2]}); continue; } r -= I_IN;
            if (r < I_UQ) { wt_item(p.in[6], 768, 256, PH(WS_WUQ), scr, (r / 24) * 64, (r % 24) * 32, lane, MapId{}, Gain1{p.in[4]}); continue; } r -= I_UQ;
            if (r < I_UKV) { wt_item(p.in[7], 1024, 128, PH(WS_WUKV), scr, (r / 32) * 64, (r % 32) * 32, lane, MapKV{}, Gain1{p.in[5]}); continue; } r -= I_UKV;
            if (r < I_SQ) { wt_item(p.in[21], D, D, PH(WS_WOUT), scr, (r / 32) * 64, (r % 32) * 32, lane, MapId{}, Gain2{p.in[19], p.in[20]}); continue; } r -= I_SQ;
            if (r < I_SQ) { wt_item(p.in[24], D, D, PH(WS_WMQ), scr, (r / 32) * 64, (r % 32) * 32, lane, MapId{}, Gain1{p.in[22]}); continue; } r -= I_SQ;
            if (r < I_SQ) { wt_item(p.in[26], D, D, PH(WS_WMO), scr, (r / 32) * 64, (r % 32) * 32, lane, MapId{}, GainNone{}); continue; } r -= I_SQ;
            if (r < I_MKV) { wt_item(p.in[25], 2048, D, PH(WS_WMKV), scr, (r / 64) * 64, (r % 64) * 32, lane, MapId{}, Gain1{p.in[23]}); continue; } r -= I_MKV;
            const int e = r / (2 * I_EX + I_DN); r -= e * (2 * I_EX + I_DN);
            if (r < I_EX) { wt_item(p.in[32] + (size_t)e * D * DE, DE, D, PH(WS_WGU) + (size_t)e * 512 * D, scr, (r / 8) * 64, (r % 8) * 32, lane, MapG{0}, Gain1{p.in[27]}); continue; } r -= I_EX;
            if (r < I_EX) { wt_item(p.in[33] + (size_t)e * D * DE, DE, D, PH(WS_WGU) + (size_t)e * 512 * D, scr, (r / 8) * 64, (r % 8) * 32, lane, MapG{16}, Gain1{p.in[27]}); continue; } r -= I_EX;
            wt_item(p.in[34] + (size_t)e * DE * D, D, DE, PH(WS_WDN) + (size_t)e * D * DE, scr, (r / 32) * 64, (r % 32) * 32, lane, MapId{}, GainNone{});
        }
        for (int i = gt; i < 96 * D / 8; i += NGT) *(h16x8*)(PH(WS_WIN) + (size_t)INC * D + (size_t)i * 8) = (h16x8){0, 0, 0, 0, 0, 0, 0, 0};
    }
    for (int i = gt; i < S * 16; i += NGT) { const int t = i >> 4, pp = i & 15; const float inv = exp2f(-(float)pp * (13.287712379549449f / 16.0f)); float sn, cs; sincosf((float)t * inv, &sn, &cs);
        PF(WS_ROPE)[2 * i] = cs; PF(WS_ROPE)[2 * i + 1] = sn; }
    {
        LAS float* zf = scr; LAS float* h1 = scr + 64;
        const float* w1 = p.in[10]; const float* b1 = p.in[11]; const float* freq = p.in[12]; const float* w2 = p.in[13]; const float* b2 = p.in[14];
        for (int t = gw; t < S; t += NGW) {
            const int j = lane;
            if (j < 33) { float v;
                if (j == 0) v = (float)t / (float)S;
                else { const int bi = (j - 1) & 15; const float band = 1e-4f + (float)bi * ((15.0f - 1e-4f) / 15.0f);
                    double rev = (double)t * (double)band / (double)S; rev -= floor(rev); const float r2 = (float)(2.0 * rev);
                    v = (j <= 16) ? cospif(r2) : -sinpif(r2); }
                zf[j] = v; }
            asm volatile("s_waitcnt lgkmcnt(0)" ::: "memory");
            float a = b1[j];
            for (int i = 0; i < 33; ++i) a += zf[i] * w1[i * 64 + j];
            h1[j] = sinf(freq[j] * a);
            asm volatile("s_waitcnt lgkmcnt(0)" ::: "memory");
            float c = b2[j];
            for (int i = 0; i < 64; ++i) c += h1[i] * w2[i * 64 + j];
            PF(WS_H2)[t * 64 + j] = sinf(freq[64 + j] * c);
            asm volatile("s_waitcnt lgkmcnt(0)" ::: "memory");
        }
    }
}
__device__ __forceinline__ void phase_filt3(const Params& p) {
    const int gt = blockIdx.x * NTHR + threadIdx.x, NGT = gridDim.x * NTHR;
    const float* H2 = PF(WS_H2); const float* w3 = p.in[15]; const float* b3 = p.in[16]; const float* decay = p.in[17]; h16* R = PH(WS_R);
    for (int i = gt; i < S * 2048; i += NGT) {
        const int col = i & 2047, tau = i >> 11;
        float a = b3[col];
#pragma unroll 8
        for (int j = 0; j < 64; ++j) a += H2[tau * 64 + j] * w3[j * 2048 + col];
        a *= expf(-((float)tau / (float)S) * fabsf(decay[col]));
        const int o = col >> 10, dir = (col >> 9) & 1, c = col & 511;
        h16* r = R + ((size_t)(o * 512 + c)) * 8192;
        if (dir == 0) r[4096 - tau] = (h16)a;
        else r[tau == 0 ? 0 : 4096 + tau] = (h16)(tau == 0 ? 0.f : a);
    }
}
__device__ __forceinline__ void phase_krot(const Params& p) {
    const int gt = blockIdx.x * NTHR + threadIdx.x, NGT = gridDim.x * NTHR;
    const h16* lat = PH(WS_LAT); h16* K = PH(WS_K); const float* rope = PF(WS_ROPE);
    for (int i = gt; i < T * 4; i += NGT) {
        const int m = i >> 2, p0 = (i & 3) * 4, b = m >> 12, t = m & 4095;
        const h16x4 k1 = *(const h16x4*)(lat + (size_t)m * LAT + 384 + p0), k2 = *(const h16x4*)(lat + (size_t)m * LAT + 400 + p0);
        h16x4 o1, o2;
#pragma unroll
        for (int j = 0; j < 4; ++j) { const float cs = rope[((size_t)t * 16 + p0 + j) * 2], sn = rope[((size_t)t * 16 + p0 + j) * 2 + 1];
            const float a = (float)k1[j], c = (float)k2[j]; o1[j] = (h16)(a * cs - c * sn); o2[j] = (h16)(a * sn + c * cs); }
#pragma unroll
        for (int h = 0; h < NH; ++h) { h16* kp = K + ((size_t)((b * NH + h) * S + t)) * 96 + 64 + p0; *(h16x4*)kp = o1; *(h16x4*)(kp + 16) = o2; }
    }
}


__device__ __forceinline__ void phase_attn_naive(const Params& p, LAS char* lds) {
    LAS float* Ks = (LAS float*)lds; LAS float* Vs = Ks + 32 * 96;
    const h16* Q = PH(WS_Q); const h16* K = PH(WS_K); const h16* Vt = PH(WS_VT); h16* aout = PH(WS_AOUT);
    const int tid = threadIdx.x;
    for (int u = blockIdx.x; u < NB * NH * (S / 512); u += gridDim.x) {
        const int bh = u >> 3, q0 = (u & 7) * 512;
        float q[96], o[64];
#pragma unroll
        for (int d = 0; d < 96; ++d) q[d] = (float)Q[((size_t)bh * S + q0 + tid) * 96 + d];
#pragma unroll
        for (int d = 0; d < 64; ++d) o[d] = 0.f;
        float m = -1e30f, l = 0.f;
        for (int k0 = 0; k0 < S; k0 += 32) {
            __syncthreads();
            for (int i = tid; i < 32 * 96; i += NTHR) Ks[i] = (float)K[((size_t)bh * S + k0) * 96 + i];
            for (int i = tid; i < 32 * 64; i += NTHR) { const int d = i >> 5, r = i & 31; Vs[r * 64 + d] = (float)Vt[((size_t)bh * 64 + d) * S + k0 + r]; }
            __syncthreads();
            for (int r = 0; r < 32; ++r) {
                float sc = 0.f;
#pragma unroll
                for (int d = 0; d < 96; ++d) sc += q[d] * Ks[r * 96 + d];
                if (sc > m) { const float al = exp2f(m - sc); l *= al;
#pragma unroll
                    for (int d = 0; d < 64; ++d) o[d] *= al;
                    m = sc; }
                const float pp = exp2f(sc - m); l += pp;
#pragma unroll
                for (int d = 0; d < 64; ++d) o[d] += pp * Vs[r * 64 + d];
            }
        }
        const int b = bh >> 3, h = bh & 7; const float il = 1.f / l;
#pragma unroll
        for (int d = 0; d < 64; ++d) aout[((size_t)(b * S + q0 + tid)) * 512 + h * 64 + d] = (h16)(o[d] * il);
    }
    __syncthreads();
}
__device__ __forceinline__ void phase_hyena_naive(const Params& p, LAS char* lds) {
    LAS float* z = (LAS float*)lds; LAS float* Rl = z + 4096;
    const h16* hyT = PH(WS_HYT); const h16* R = PH(WS_R); const float* convw = p.in[8]; const float* convb = p.in[9]; const float* skip = p.in[18]; h16* hT = PH(WS_HT);
    const int tid = threadIdx.x;
    for (int u = blockIdx.x; u < NB * HYW; u += gridDim.x) {
        const int b = u >> 9, c = u & 511;
        auto u3 = [&](int ch, int t) -> float {
            const h16* pp = hyT + ((size_t)(b * 1536 + ch)) * S;
            const float a = t > 0 ? (float)pp[t - 1] : 0.f, bb = (float)pp[t], cc = t < S - 1 ? (float)pp[t + 1] : 0.f;
            return a * convw[ch] + bb * convw[1536 + ch] + cc * convw[3072 + ch] + convb[ch];
        };
        for (int n = 0; n < 2; ++n) {
            for (int uu = tid; uu < 8192; uu += NTHR) Rl[uu] = (float)R[((size_t)(n * 512 + c)) * 8192 + uu];
            if (n == 0) for (int t = tid; t < S; t += NTHR) z[t] = u3(1024 + c, t);
            __syncthreads();
            float acc[8];
#pragma unroll
            for (int i = 0; i < 8; ++i) acc[i] = 0.f;
            for (int s_ = 0; s_ < S; ++s_) {
                const float zs = z[s_];
#pragma unroll
                for (int i = 0; i < 8; ++i) acc[i] += zs * Rl[s_ - (tid + 512 * i) + 4096];
            }
            __syncthreads();
            const float sk = skip[n * 512 + c];
#pragma unroll
            for (int i = 0; i < 8; ++i) {
                const int t = tid + 512 * i;
                const float zn = u3(n == 0 ? c : 512 + c, t) * (acc[i] + sk * z[t]);
                if (n == 0) z[t] = zn; else hT[((size_t)(b * 512 + c)) * S + t] = (h16)zn;
            }
            __syncthreads();
        }
    }
}
__device__ __forceinline__ void phase_mixprep(const Params& p, LAS char* lds) {
    constexpr int LDT = 520;
    LAS h16* tile = (LAS h16*)lds;
    const h16* aout = PH(WS_AOUT); const h16* hT = PH(WS_HT); h16* mix = PH(WS_MIX);
    const int tid = threadIdx.x, lane = tid & 63, wid = tid >> 6;
    for (int u = blockIdx.x; u < T / 64; u += gridDim.x) {
        const int m0 = u * 64, b = m0 >> 12, t0 = m0 & 4095;
        __syncthreads();
        for (int i = tid; i < 512 * 8; i += NTHR) { const int c = i >> 3, j = i & 7;
            const h16x8 v = *(const h16x8*)(hT + ((size_t)(b * 512 + c)) * S + t0 + j * 8);
#pragma unroll
            for (int e = 0; e < 8; ++e) tile[(j * 8 + e) * LDT + c] = v[e]; }
        __syncthreads();
        for (int rr = 0; rr < 8; ++rr) {
            const int r = wid * 8 + rr; const size_t m = (size_t)(m0 + r);
            const h16x8 hv = *(LAS h16x8*)(tile + r * LDT + lane * 8);
            const h16x8 av = *(const h16x8*)(aout + m * 512 + lane * 8);
            float sh = 0.f, sa = 0.f;
#pragma unroll
            for (int e = 0; e < 8; ++e) { const float x = (float)hv[e], y = (float)av[e]; sh += x * x; sa += y * y; }
            sh = wave_sum(sh); sa = wave_sum(sa);
            const float rh = rstd_of(sh, 512), ra = rstd_of(sa, 512);
            h16x8 oh, oa;
#pragma unroll
            for (int e = 0; e < 8; ++e) { oh[e] = (h16)((float)hv[e] * rh); oa[e] = (h16)((float)av[e] * ra); }
            *(h16x8*)(mix + m * D + lane * 8) = oa; *(h16x8*)(mix + m * D + 512 + lane * 8) = oh;
        }
    }
    __syncthreads();
}
__device__ __forceinline__ void phase_xattn_naive(const Params& p, LAS char* lds) {
    LAS float* sc = (LAS float*)lds;
    LAS float* il = sc + 32 * 257;
    LAS h16* qs = (LAS h16*)(il + 32);
    h16* qc = PH(WS_QC); const h16* Kc = PH(WS_KC); const h16* VcT = PH(WS_VCT);
    const int tid = threadIdx.x, wv = tid >> 6, lane = tid & 63;
    for (int u = blockIdx.x; u < (S / 32) * NB * MH; u += gridDim.x) {
        const int bh = u >> 7, b = bh >> 2, h = bh & 3, t0 = (u & 127) * 32;
        __syncthreads();
        for (int i = tid; i < 32 * 256; i += NTHR) { const int tok = i >> 8, d = i & 255; qs[tok * 256 + d] = qc[((size_t)(b * S + t0 + tok)) * D + h * MHD + d]; }
        __syncthreads();
        for (int mi = 0; mi < 32; ++mi) {
            const int mm = wv * 32 + mi;
            const h16x4 kv = *(const h16x4*)(Kc + ((size_t)(b * MEMT + mm)) * D + h * MHD + lane * 4);
            for (int tok = 0; tok < 32; ++tok) {
                const h16x4 qv = *(LAS h16x4*)(qs + tok * 256 + lane * 4);
                float s_ = (float)qv[0] * (float)kv[0] + (float)qv[1] * (float)kv[1] + (float)qv[2] * (float)kv[2] + (float)qv[3] * (float)kv[3];
                s_ = wave_sum(s_);
                if (lane == 0) sc[tok * 257 + mm] = s_;
            }
        }
        __syncthreads();
        if (tid < 32) { float mx = -1e30f; for (int j = 0; j < 256; ++j) mx = fmaxf(mx, sc[tid * 257 + j]); float l = 0.f;
            for (int j = 0; j < 256; ++j) { const float pp = exp2f(sc[tid * 257 + j] - mx); sc[tid * 257 + j] = pp; l += pp; } il[tid] = 1.f / l; }
        __syncthreads();
        for (int di = 0; di < 32; ++di) {
            const int d = wv * 32 + di;
            const h16x4 vv = *(const h16x4*)(VcT + ((size_t)((b * MH + h) * MHD + d)) * MEMT + lane * 4);
            for (int tok = 0; tok < 32; ++tok) {
                float o = sc[tok * 257 + lane * 4] * (float)vv[0] + sc[tok * 257 + lane * 4 + 1] * (float)vv[1] + sc[tok * 257 + lane * 4 + 2] * (float)vv[2] + sc[tok * 257 + lane * 4 + 3] * (float)vv[3];
                o = wave_sum(o);
                if (lane == 0) qc[((size_t)(b * S + t0 + tok)) * D + h * MHD + d] = (h16)(o * il[tok]);
            }
        }
    }
    __syncthreads();
}
__device__ __forceinline__ void phase_route(const Params& p) {
    const float* X = p.X; const float* g = p.in[27]; const float* wrg = p.in[28]; const float* brg = p.in[29]; const float* wre = p.in[30]; const float* bre = p.in[31];
    float* ssx2 = PF(WS_SSX2); float* tokw = PF(WS_TOKW); int* cnt = PI(WS_CTL); int* list = PI(WS_LIST);
    const int lane = threadIdx.x & 63, gw = blockIdx.x * NWAVE + (threadIdx.x >> 6), NGW = gridDim.x * NWAVE;
    for (int m = gw; m < T; m += NGW) {
        float ss = 0.f;
#pragma unroll 4
        for (int i = 0; i < 16; ++i) { const float xv = X[(size_t)m * D + lane + 64 * i]; ss += xv * xv; }
        ss = wave_sum(ss);
        const float rs = rstd_of(ss, D);
        float lg[36];
#pragma unroll
        for (int j = 0; j < 36; ++j) lg[j] = 0.f;
#pragma unroll 1
        for (int i = 0; i < 16; ++i) { const int k = lane + 64 * i; const float tv = X[(size_t)m * D + k] * rs * g[k];
            const f32x4 wg4 = *(const f32x4*)(wrg + k * 4);
#pragma unroll
            for (int j = 0; j < 4; ++j) lg[j] += tv * wg4[j];
#pragma unroll
            for (int j4 = 0; j4 < 8; ++j4) { const f32x4 we4 = *(const f32x4*)(wre + k * 32 + j4 * 4);
#pragma unroll
                for (int j = 0; j < 4; ++j) lg[4 + j4 * 4 + j] += tv * we4[j]; } }
#pragma unroll
        for (int j = 0; j < 36; ++j) lg[j] = wave_sum(lg[j]);
        if (lane == 0) {
            ssx2[m] = ss;
            float gl[4]; int gi = 0; float gm = -1e30f;
#pragma unroll
            for (int j = 0; j < 4; ++j) { gl[j] = lg[j] + brg[j]; if (gl[j] > gm) { gm = gl[j]; gi = j; } }
            float gs = 0.f;
#pragma unroll
            for (int j = 0; j < 4; ++j) gs += expf(gl[j] - gm);
            const float pg = 1.f / gs;
            float e1 = -1e30f, e2 = -1e30f; int i1 = 0, i2 = 0;
#pragma unroll
            for (int g4 = 0; g4 < 4; ++g4) if (g4 == gi) {
#pragma unroll
                for (int j = 0; j < 8; ++j) { const float v = lg[4 + g4 * 8 + j] + bre[g4 * 8 + j];
                    if (v > e1) { e2 = e1; i2 = i1; e1 = v; i1 = j; } else if (v > e2) { e2 = v; i2 = j; } } }
            const float p2 = 1.f / (1.f + expf(e1 - e2)), p1 = 1.f - p2;
            const int ea = gi * 8 + i1, eb = gi * 8 + i2;
            tokw[m * 2] = pg * p1; tokw[m * 2 + 1] = pg * p2;
            const int pa = atomicAdd(&cnt[ea], 1), pb = atomicAdd(&cnt[eb], 1);
            list[ea * T + pa] = m * 2; list[eb * T + pb] = m * 2 + 1;
        }
    }
}
struct RowGather { const h16* A; const int* lst; int Me; __device__ __forceinline__ const h16* operator()(int m) const { const int pr = m < Me ? lst[m] : lst[0]; return A + (size_t)(pr >> 1) * D; } };
struct RowClamp { const h16* A; int Me; __device__ __forceinline__ const h16* operator()(int m) const { return A + (size_t)(m < Me ? m : 0) * DE; } };
struct EGu { const int* lst; int Me; const float* ssx2; const float* tokw; h16* hb;
    __device__ __forceinline__ void row32(int m, int nb, f32x4 va, f32x4 vb) const {
        if (m >= Me) return;
        const int pr = lst[m]; const float rs = rstd_of(ssx2[pr >> 1], D), w = tokw[pr];
        h16x4 o;
#pragma unroll
        for (int j = 0; j < 4; ++j) { const float a = va[j] * rs, bb = vb[j] * rs; o[j] = (h16)(a / (1.f + __expf(-a)) * bb * w); }
        *(h16x4*)(hb + (size_t)m * DE + (nb >> 5) * 16 + (nb & 31)) = o;
    } };
struct EDn { const int* lst; int Me; h16* yb;
    __device__ __forceinline__ void row32(int m, int nb, f32x4 va, f32x4 vb) const {
        if (m >= Me) return;
        h16* y = yb + (size_t)lst[m] * D + nb;
        *(h16x4*)y = cvt4(va); *(h16x4*)(y + 16) = cvt4(vb);
    } };
template <bool DOWN>
__device__ __forceinline__ void phase_moe(const Params& p, LAS char* lds) {
    const int* cnt = PI(WS_CTL);
    const int G = gridDim.x, bx = blockIdx.x, vid = (G % 8 == 0) ? (bx % 8) * (G / 8) + bx / 8 : bx;
    constexpr int NTN = DOWN ? D / G_BN : 512 / G_BN;
    int tbase = 0, off = 0;
    int tix = vid;
    for (int e = 0; e < NE; ++e) {
        const int Me = cnt[e], nmt = (Me + G_BM - 1) / G_BM, nte = nmt * NTN;
        const int* lst = PI(WS_LIST) + (size_t)e * T;
        for (; tix < tbase + nte; tix += G) {
            const int lt = tix - tbase, mt = lt / NTN, nt_ = lt - mt * NTN;
            if (!DOWN) gemm_tile<true>(lds, RowGather{PH(WS_X2H), lst, Me}, PH(WS_WGU) + (size_t)e * 512 * D, D, D, mt * G_BM, nt_ * G_BN,
                                       EGu{lst, Me, PF(WS_SSX2), PF(WS_TOKW), PH(WS_HB) + (size_t)off * DE});
            else gemm_tile<true>(lds, RowClamp{PH(WS_HB) + (size_t)off * DE, Me}, PH(WS_WDN) + (size_t)e * D * DE, DE, DE, mt * G_BM, nt_ * G_BN,
                                 EDn{lst, Me, PH(WS_YB)});
        }
        tbase += nte; off += Me;
    }
}
__device__ __forceinline__ void phase_final(const Params& p) {
    const float* X = p.X; const h16* yb = PH(WS_YB); const float* g = p.in[35]; float* out = p.X;
    const int lane = threadIdx.x & 63, gw = blockIdx.x * NWAVE + (threadIdx.x >> 6), NGW = gridDim.x * NWAVE;
    for (int m = gw; m < T; m += NGW) {
        f32x4 v[4]; float ss = 0.f;
#pragma unroll
        for (int i = 0; i < 4; ++i) { const int k = (lane + 64 * i) * 4;
            const f32x4 xv = *(const f32x4*)(X + (size_t)m * D + k); const h16x4 y0 = *(const h16x4*)(yb + ((size_t)m * 2) * D + k), y1 = *(const h16x4*)(yb + ((size_t)m * 2 + 1) * D + k);
#pragma unroll
            for (int j = 0; j < 4; ++j) { v[i][j] = xv[j] + (float)y0[j] + (float)y1[j]; ss += v[i][j] * v[i][j]; } }
        ss = wave_sum(ss); const float rs = rstd_of(ss, D);
#pragma unroll
        for (int i = 0; i < 4; ++i) { const int k = (lane + 64 * i) * 4; const f32x4 gv = *(const f32x4*)(g + k); *(f32x4*)(out + (size_t)m * D + k) = v[i] * rs * gv; }
    }
}

__global__ void __launch_bounds__(NTHR) mega(Params p, int ph_lo, int ph_hi) {
    extern __shared__ __attribute__((aligned(16))) char lds_raw[];
    LAS char* lds = (LAS char*)lds_raw;
    cg::grid_group grid = cg::this_grid();
#define PHASE(k) if (ph_lo <= (k) && (k) < ph_hi)
#define SEAM(k) if (ph_lo <= (k) && (k) + 1 < ph_hi) grid.sync()
    PHASE(0) { phase_prep(p, lds); }
    SEAM(0);
    PHASE(1) {
        gemm_job<false>(lds, PH(WS_XH), D, PH(WS_WIN), D, T, 1536, D, EHy{PF(WS_SSX), PH(WS_HYT)});
        gemm_job<true>(lds, PH(WS_XH), D, PH(WS_WIN) + (size_t)1536 * D, D, T, 512, D, ELat{PF(WS_SSX), PH(WS_LAT), PF(WS_SSQ), PF(WS_SSKV)});
        gemm_job<true>(lds, PH(WS_MEMH), D, PH(WS_WMKV), D, MROWS, 1024, D, EKc{PF(WS_SSMEM), PH(WS_KC)});
        gemm_job<false>(lds, PH(WS_MEMH), D, PH(WS_WMKV) + (size_t)1024 * D, D, MROWS, 1024, D, EVc{PF(WS_SSMEM), PH(WS_VCT)}, 32);
        phase_filt3(p);
    }
    SEAM(1);
    PHASE(2) {
        gemm_job<true>(lds, PH(WS_LAT), LAT, PH(WS_WUQ), 256, T, 768, 256, EQ{PF(WS_SSQ), PF(WS_ROPE), PH(WS_Q)});
        gemm_job<true>(lds, PH(WS_LAT) + 256, LAT, PH(WS_WUKV), 128, T, 512, 128, EK{PF(WS_SSKV), PH(WS_K)}, 128);
        gemm_job<false>(lds, PH(WS_LAT) + 256, LAT, PH(WS_WUKV) + (size_t)512 * 128, 128, T, 512, 128, EV{PF(WS_SSKV), PH(WS_VT)}, 128);
        phase_krot(p);
    }
    SEAM(2);
    PHASE(3) { phase_attn_naive(p, lds); phase_hyena_naive(p, lds); }
    SEAM(3);
    PHASE(4) { phase_mixprep(p, lds); }
    SEAM(4);
    PHASE(5) { gemm_job<true>(lds, PH(WS_MIX), D, PH(WS_WOUT), D, T, D, D, ERes{p.in[0], p.X, PH(WS_X1H), PF(WS_SSX1)}); }
    SEAM(5);
    PHASE(6) { gemm_job<true>(lds, PH(WS_X1H), D, PH(WS_WMQ), D, T, D, D, EMq{PF(WS_SSX1), PH(WS_QC)}); }
    SEAM(6);
    PHASE(7) { phase_xattn_naive(p, lds); }
    SEAM(7);
    PHASE(8) { gemm_job<true>(lds, PH(WS_QC), D, PH(WS_WMO), D, T, D, D, ERes{p.X, p.X, PH(WS_X2H), nullptr}); }
    SEAM(8);
    PHASE(9) { phase_route(p); }
    SEAM(9);
    PHASE(10) { phase_moe<false>(p, lds); }
    SEAM(10);
    PHASE(11) { phase_moe<true>(p, lds); }
    SEAM(11);
    PHASE(12) { phase_final(p); }
}

extern "C" void kernel_launch(void* const* d_in, const int* in_sizes, int n_in, void* d_out, int out_size, void* d_ws, size_t ws_size, hipStream_t st) {
    Params p{};
    for (int i = 0; i < 36; ++i) p.in[i] = (const float*)d_in[i];
    p.X = (float*)d_out; p.ws = (char*)d_ws;
    static int grid = 0;
    if (!grid) {
        (void)hipFuncSetAttribute((const void*)mega, hipFuncAttributeMaxDynamicSharedMemorySize, LDS_BYTES);
        int dev = 0, cus = 0, per_cu = 0;
        (void)hipGetDevice(&dev);
        (void)hipDeviceGetAttribute(&cus, hipDeviceAttributeMultiprocessorCount, dev);
        (void)hipOccupancyMaxActiveBlocksPerMultiprocessor(&per_cu, (const void*)mega, NTHR, LDS_BYTES);
        if (per_cu < 1) { fprintf(stderr, "kernel_launch: occupancy query says %d blocks/CU\n", per_cu); per_cu = 1; }
        grid = cus;
    }
    int lo = 0, hi = 13;
    void* args[] = {&p, &lo, &hi};
    hipError_t e = hipLaunchCooperativeKernel((const void*)mega, dim3(grid), dim3(NTHR), args, LDS_BYTES, st);
    if (e != hipSuccess) fprintf(stderr, "cooperative launch failed: %s (grid %d)\n", hipGetErrorString(e), grid);
    (void)in_sizes; (void)n_in; (void)out_size; (void)ws_size;
}
```

```cpp
#include <hip/hip_runtime.h>
#include <cstdint>
#include <cstdio>
#include <hip/hip_cooperative_groups.h>
namespace cg = cooperative_groups;
typedef _Float16 h16;

constexpr int NB = 4, S = 4096, D = 1024, T = NB * S, MEMT = 256, MROWS = NB * MEMT;
constexpr int NH = 8, HYW = 512;
constexpr int LAT = 416, INC = 1952;
constexpr int MH = 4, MHD = 256;
constexpr int NE = 32, DE = 256;
constexpr float EPS = 1e-6f;
constexpr float LOG2E = 1.4426950408889634f;
constexpr float QSCALE = 0.10206207261596575f * LOG2E;
constexpr float CSCALE = 0.0625f * LOG2E;

constexpr size_t MiB = 1u << 20;
constexpr size_t WS_CTL = 0;
constexpr size_t WS_SSX = 64 * 1024, WS_SSQ = 128 * 1024, WS_SSKV = 192 * 1024, WS_SSA = 256 * 1024, WS_SSH = 320 * 1024,
                 WS_SSX1 = 384 * 1024, WS_SSX2 = 448 * 1024, WS_SSMEM = 512 * 1024, WS_TOKE = 576 * 1024, WS_TOKW = 704 * 1024,
                 WS_TOKP = 832 * 1024;
constexpr size_t WS_WIN = 2 * MiB, WS_WUQ = 6 * MiB, WS_WUKV = 6 * MiB + 512 * 1024, WS_WOUT = 7 * MiB, WS_WMQ = 9 * MiB,
                 WS_WMKV = 11 * MiB, WS_WMO = 15 * MiB, WS_MEMH = 17 * MiB, WS_KC = 19 * MiB, WS_VCT = 21 * MiB, WS_R = 23 * MiB,
                 WS_WGU = 39 * MiB, WS_WDN = 71 * MiB, WS_LAT = 87 * MiB, WS_HYT = 101 * MiB, WS_XH = 149 * MiB, WS_Q = 149 * MiB,
                 WS_K = 173 * MiB, WS_VT = 197 * MiB, WS_AOUT = 213 * MiB, WS_HT = 229 * MiB, WS_LIST = 245 * MiB, WS_H2 = 247 * MiB;
constexpr size_t WS_MIX = 87 * MiB, WS_X1H = 119 * MiB, WS_QC = 151 * MiB, WS_X2H = 87 * MiB, WS_HB = 119 * MiB, WS_YB = 135 * MiB;

__device__ __forceinline__ float wave_sum(float v) {
#pragma unroll
    for (int o = 1; o < 64; o <<= 1) v += __shfl_xor(v, o);
    return v;
}
__device__ __forceinline__ float rstd_of(float ss, int n) { return 1.0f / sqrtf(ss / (float)n + EPS); }

__global__ __launch_bounds__(256) void k_cvt_rows(const float* x, h16* xh, float* ss, int rows, int n) {
    int row = blockIdx.x * 4 + (threadIdx.x >> 6), lane = threadIdx.x & 63;
    if (row >= rows) return;
    float s = 0.f;
    for (int k = lane; k < n; k += 64) { float v = x[(size_t)row * n + k]; s += v * v; xh[(size_t)row * n + k] = (h16)v; }
    s = wave_sum(s);
    if (lane == 0) ss[row] = s;
}
__global__ void k_wt(const float* W, const float* g, const float* g2, int ksplit, h16* Wt, int K, int N, int Npad) {
    size_t i = (size_t)blockIdx.x * 256 + threadIdx.x;
    if (i >= (size_t)K * Npad) return;
    int n = (int)(i % Npad), k = (int)(i / Npad);
    float v = 0.f;
    if (n < N) v = W[(size_t)k * N + n] * (g ? (k < ksplit ? g[k] : g2[k - ksplit]) : 1.f);
    Wt[(size_t)n * K + k] = (h16)v;
}
__global__ void k_wt_gu(const float* wg, const float* wu, const float* g, h16* Wt) {
    size_t i = (size_t)blockIdx.x * 256 + threadIdx.x;
    if (i >= (size_t)NE * D * DE) return;
    int j = (int)(i % DE), k = (int)((i / DE) % D), e = (int)(i / ((size_t)DE * D));
    int np = 32 * (j >> 4) + (j & 15);
    float gg = g[k];
    Wt[((size_t)e * 512 + np) * D + k] = (h16)(wg[i] * gg);
    Wt[((size_t)e * 512 + np + 16) * D + k] = (h16)(wu[i] * gg);
}
__global__ void k_wt_dn(const float* wd, h16* Wt) {
    size_t i = (size_t)blockIdx.x * 256 + threadIdx.x;
    if (i >= (size_t)NE * DE * D) return;
    int n = (int)(i % D), f = (int)((i / D) % DE), e = (int)(i / ((size_t)D * DE));
    Wt[((size_t)e * D + n) * DE + f] = (h16)wd[i];
}
__global__ __launch_bounds__(64) void k_filt12(const float* w1, const float* b1, const float* freq, const float* w2, const float* b2, float* H2) {
    __shared__ float z[33], h1[64];
    int t = blockIdx.x, j = threadIdx.x;
    if (j < 33) {
        float v;
        if (j == 0) v = (float)t / (float)S;
        else {
            int bi = (j - 1) & 15;
            float band = 1e-4f + (float)bi * ((15.0f - 1e-4f) / 15.0f);
            double rev = (double)t * (double)band / (double)S;
            rev -= floor(rev);
            float r2 = (float)(2.0 * rev);
            v = (j <= 16) ? cospif(r2) : -sinpif(r2);
        }
        z[j] = v;
    }
    __syncthreads();
    float a = b1[j];
    for (int i = 0; i < 33; ++i) a += z[i] * w1[i * 64 + j];
    h1[j] = sinf(freq[j] * a);
    __syncthreads();
    float c = b2[j];
    for (int i = 0; i < 64; ++i) c += h1[i] * w2[i * 64 + j];
    H2[t * 64 + j] = sinf(freq[64 + j] * c);
}
__global__ void k_filt3(const float* H2, const float* w3, const float* b3, const float* decay, h16* R) {
    int i = blockIdx.x * 256 + threadIdx.x;
    int col = i & 2047, tau = i >> 11;
    float a = b3[col];
    for (int j = 0; j < 64; ++j) a += H2[tau * 64 + j] * w3[j * 2048 + col];
    a *= expf(-((float)tau / (float)S) * fabsf(decay[col]));
    int o = col >> 10, dir = (col >> 9) & 1, c = col & 511;
    h16* r = R + ((size_t)(o * 512 + c)) * 8192;
    if (dir == 0) r[4096 - tau] = (h16)a;
    else r[tau == 0 ? 0 : 4096 + tau] = (h16)(tau == 0 ? 0.f : a);
}

template <class Epi>
__global__ __launch_bounds__(256) void k_gemm_naive(const h16* A, int lda, const h16* Wt, int ldw, int M, int N, int K, Epi epi) {
    __shared__ float As[16][65], Bs[16][65];
    int tx = threadIdx.x & 15, ty = threadIdx.x >> 4;
    int m0 = blockIdx.y * 64, n0 = blockIdx.x * 64;
    float acc[4][4];
#pragma unroll
    for (int i = 0; i < 4; ++i)
#pragma unroll
        for (int j = 0; j < 4; ++j) acc[i][j] = 0.f;
    for (int k0 = 0; k0 < K; k0 += 16) {
        for (int i = threadIdx.x; i < 1024; i += 256) {
            int r = i >> 4, c = i & 15, m = m0 + r, n = n0 + r;
            As[c][r] = (m < M) ? (float)A[(size_t)m * lda + k0 + c] : 0.f;
            Bs[c][r] = (n < N) ? (float)Wt[(size_t)n * ldw + k0 + c] : 0.f;
        }
        __syncthreads();
#pragma unroll
        for (int kk = 0; kk < 16; ++kk) {
            float a[4], b[4];
#pragma unroll
            for (int i = 0; i < 4; ++i) { a[i] = As[kk][ty * 4 + i]; b[i] = Bs[kk][tx * 4 + i]; }
#pragma unroll
            for (int i = 0; i < 4; ++i)
#pragma unroll
                for (int j = 0; j < 4; ++j) acc[i][j] += a[i] * b[j];
        }
        __syncthreads();
    }
#pragma unroll
    for (int i = 0; i < 4; ++i)
#pragma unroll
        for (int j = 0; j < 4; ++j) { int m = m0 + ty * 4 + i, n = n0 + tx * 4 + j; if (m < M && n < N) epi(m, n, acc[i][j]); }
}
struct EpiIn { const float* ssx; h16* lat; h16* hyT;
    __device__ void operator()(int m, int n, float v) const {
        v *= rstd_of(ssx[m], D);
        if (n < LAT) lat[(size_t)m * LAT + n] = (h16)v;
        else if (n < INC) { int b = m >> 12, t = m & 4095; hyT[((size_t)(b * 1536 + (n - LAT))) * S + t] = (h16)v; }
    } };
struct EpiQ { const float* ssq; h16* Q;
    __device__ void operator()(int m, int n, float v) const {
        v *= rstd_of(ssq[m], 256) * QSCALE; int b = m >> 12, t = m & 4095, h = n / 96, j = n % 96;
        Q[((size_t)((b * NH + h) * S + t)) * 96 + j] = (h16)v;
    } };
struct EpiKV { const float* sskv; h16* K; h16* Vt;
    __device__ void operator()(int m, int n, float v) const {
        v *= rstd_of(sskv[m], 128); int b = m >> 12, t = m & 4095, h = n >> 7, j = n & 127;
        if (j < 64) K[((size_t)((b * NH + h) * S + t)) * 96 + j] = (h16)v;
        else Vt[((size_t)((b * NH + h) * 64 + (j - 64))) * S + t] = (h16)v;
    } };
struct EpiRes { const float* xin; float* X; h16* xh;
    __device__ void operator()(int m, int n, float v) const {
        size_t i = (size_t)m * D + n; float r = xin[i] + v; X[i] = r; xh[i] = (h16)r;
    } };
struct EpiMq { const float* ss; h16* qc;
    __device__ void operator()(int m, int n, float v) const { qc[(size_t)m * D + n] = (h16)(v * rstd_of(ss[m], D) * CSCALE); } };
struct EpiMkv { const float* ss; h16* Kc; h16* VcT;
    __device__ void operator()(int m, int n, float v) const {
        v *= rstd_of(ss[m], D);
        if (n < D) Kc[(size_t)m * D + n] = (h16)v;
        else { int np = n - D, h = np >> 8, d = np & 255, b = m >> 8, mm = m & 255; VcT[((size_t)((b * MH + h) * MHD + d)) * MEMT + mm] = (h16)v; }
    } };

__global__ __launch_bounds__(256) void k_rowss(const h16* A, int lda, int off, int n, float* ss, int rows) {
    int row = blockIdx.x * 4 + (threadIdx.x >> 6), lane = threadIdx.x & 63;
    if (row >= rows) return;
    float s = 0.f;
    for (int k = lane; k < n; k += 64) { float v = (float)A[(size_t)row * lda + off + k]; s += v * v; }
    s = wave_sum(s);
    if (lane == 0) ss[row] = s;
}
__global__ void k_rope(h16* Q, h16* K, const h16* lat) {
    int i = blockIdx.x * 256 + threadIdx.x;
    if (i >= T * 16) return;
    int m = i >> 4, p = i & 15, b = m >> 12, t = m & 4095;
    float inv = exp2f(-(float)p * (13.287712379549449f / 16.0f));
    float ang = (float)t * inv;
    float sn, cs; sincosf(ang, &sn, &cs);
    float k1 = (float)lat[(size_t)m * LAT + 384 + p], k2 = (float)lat[(size_t)m * LAT + 384 + 16 + p];
    h16 o1 = (h16)(k1 * cs - k2 * sn), o2 = (h16)(k1 * sn + k2 * cs);
    for (int h = 0; h < NH; ++h) {
        size_t base = ((size_t)((b * NH + h) * S + t)) * 96 + 64;
        K[base + p] = o1; K[base + 16 + p] = o2;
        float q1 = (float)Q[base + p], q2 = (float)Q[base + 16 + p];
        Q[base + p] = (h16)(q1 * cs - q2 * sn); Q[base + 16 + p] = (h16)(q1 * sn + q2 * cs);
    }
}
__global__ __launch_bounds__(128) void k_attn_naive(const h16* Q, const h16* K, const h16* Vt, h16* aout) {
    __shared__ float Ks[32][96], Vs[32][64];
    int bh = blockIdx.y, q0 = blockIdx.x * 128, tid = threadIdx.x;
    float q[96], o[64];
#pragma unroll
    for (int d = 0; d < 96; ++d) q[d] = (float)Q[((size_t)bh * S + q0 + tid) * 96 + d];
#pragma unroll
    for (int d = 0; d < 64; ++d) o[d] = 0.f;
    float m = -1e30f, l = 0.f;
    for (int k0 = 0; k0 < S; k0 += 32) {
        __syncthreads();
        for (int i = tid; i < 32 * 96; i += 128) { int r = i / 96, c = i % 96; Ks[r][c] = (float)K[((size_t)bh * S + k0 + r) * 96 + c]; }
        for (int i = tid; i < 32 * 64; i += 128) { int d = i >> 5, r = i & 31; Vs[r][d] = (float)Vt[((size_t)bh * 64 + d) * S + k0 + r]; }
        __syncthreads();
        for (int r = 0; r < 32; ++r) {
            float s = 0.f;
#pragma unroll
            for (int d = 0; d < 96; ++d) s += q[d] * Ks[r][d];
            if (s > m) { float al = exp2f(m - s); l *= al;
#pragma unroll
                for (int d = 0; d < 64; ++d) o[d] *= al;
                m = s; }
            float p = exp2f(s - m); l += p;
#pragma unroll
            for (int d = 0; d < 64; ++d) o[d] += p * Vs[r][d];
        }
    }
    int b = bh >> 3, h = bh & 7; float il = 1.f / l;
#pragma unroll
    for (int d = 0; d < 64; ++d) aout[((size_t)(b * S + q0 + tid)) * 512 + h * 64 + d] = (h16)(o[d] * il);
}
__global__ __launch_bounds__(256) void k_hyena_naive(const h16* hyT, const h16* R, const float* convw, const float* convb, const float* skip, h16* hT) {
    __shared__ float z[4096]; __shared__ float Rl[8192];
    int b = blockIdx.x >> 9, c = blockIdx.x & 511, tid = threadIdx.x;
    auto u3 = [&](int ch, int t) -> float {
        const h16* p = hyT + ((size_t)(b * 1536 + ch)) * S;
        float a = t > 0 ? (float)p[t - 1] : 0.f, bb = (float)p[t], cc = t < S - 1 ? (float)p[t + 1] : 0.f;
        return a * convw[ch] + bb * convw[1536 + ch] + cc * convw[3072 + ch] + convb[ch];
    };
    for (int n = 0; n < 2; ++n) {
        for (int u = tid; u < 8192; u += 256) Rl[u] = (float)R[((size_t)(n * 512 + c)) * 8192 + u];
        if (n == 0) for (int t = tid; t < S; t += 256) z[t] = u3(1024 + c, t);
        __syncthreads();
        float acc[16];
#pragma unroll
        for (int i = 0; i < 16; ++i) acc[i] = 0.f;
        for (int s = 0; s < S; ++s) {
            float zs = z[s];
#pragma unroll
            for (int i = 0; i < 16; ++i) acc[i] += zs * Rl[s - (tid + 256 * i) + 4096];
        }
        __syncthreads();
        float sk = skip[n * 512 + c];
#pragma unroll
        for (int i = 0; i < 16; ++i) {
            int t = tid + 256 * i;
            float zn = u3(n == 0 ? c : 512 + c, t) * (acc[i] + sk * z[t]);
            if (n == 0) z[t] = zn; else hT[((size_t)(b * 512 + c)) * S + t] = (h16)zn;
        }
        __syncthreads();
    }
}
__global__ void k_ss_h(const h16* hT, float* ss) {
    int m = blockIdx.x * 256 + threadIdx.x; int b = m >> 12, t = m & 4095; float s = 0.f;
    for (int c = 0; c < 512; ++c) { float v = (float)hT[((size_t)(b * 512 + c)) * S + t]; s += v * v; }
    ss[m] = s;
}
__global__ void k_mixprep(const h16* aout, const h16* hT, const float* ssa, const float* ssh, h16* mix) {
    size_t i = (size_t)blockIdx.x * 256 + threadIdx.x;
    int m = (int)(i & (T - 1)), k = (int)(i >> 14);
    float v;
    if (k < 512) v = (float)aout[(size_t)m * 512 + k] * rstd_of(ssa[m], 512);
    else { int b = m >> 12, t = m & 4095; v = (float)hT[((size_t)(b * 512 + (k - 512))) * S + t] * rstd_of(ssh[m], 512); }
    mix[(size_t)m * D + k] = (h16)v;
}
__global__ __launch_bounds__(256) void k_xattn_naive(h16* qc, const h16* Kc, const h16* VcT) {
    __shared__ float sc[32][257]; __shared__ float il[32]; __shared__ h16 qs[32][256];
    int bh = blockIdx.y, b = bh >> 2, h = bh & 3, t0 = blockIdx.x * 32, tid = threadIdx.x, wv = tid >> 6, lane = tid & 63;
    for (int i = tid; i < 32 * 256; i += 256) { int tok = i >> 8, d = i & 255; qs[tok][d] = qc[((size_t)(b * S + t0 + tok)) * D + h * MHD + d]; }
    __syncthreads();
    for (int mi = 0; mi < 64; ++mi) {
        int mm = wv * 64 + mi;
        const h16* kp = Kc + ((size_t)(b * MEMT + mm)) * D + h * MHD + lane * 4;
        float k0 = (float)kp[0], k1 = (float)kp[1], k2 = (float)kp[2], k3 = (float)kp[3];
        for (int tok = 0; tok < 32; ++tok) {
            float s = (float)qs[tok][lane * 4] * k0 + (float)qs[tok][lane * 4 + 1] * k1 + (float)qs[tok][lane * 4 + 2] * k2 + (float)qs[tok][lane * 4 + 3] * k3;
            s = wave_sum(s);
            if (lane == 0) sc[tok][mm] = s;
        }
    }
    __syncthreads();
    if (tid < 32) { float mx = -1e30f; for (int j = 0; j < 256; ++j) mx = fmaxf(mx, sc[tid][j]); float l = 0.f;
        for (int j = 0; j < 256; ++j) { float p = exp2f(sc[tid][j] - mx); sc[tid][j] = p; l += p; } il[tid] = 1.f / l; }
    __syncthreads();
    for (int di = 0; di < 64; ++di) {
        int d = wv * 64 + di;
        const h16* vp = VcT + ((size_t)((b * MH + h) * MHD + d)) * MEMT + lane * 4;
        float v0 = (float)vp[0], v1 = (float)vp[1], v2 = (float)vp[2], v3 = (float)vp[3];
        for (int tok = 0; tok < 32; ++tok) {
            float o = sc[tok][lane * 4] * v0 + sc[tok][lane * 4 + 1] * v1 + sc[tok][lane * 4 + 2] * v2 + sc[tok][lane * 4 + 3] * v3;
            o = wave_sum(o);
            if (lane == 0) qc[((size_t)(b * S + t0 + tok)) * D + h * MHD + d] = (h16)(o * il[tok]);
        }
    }
}
__global__ __launch_bounds__(256) void k_route(const float* X, const float* g, const float* wrg, const float* brg, const float* wre, const float* bre,
                                               float* ssx2, int* toke, float* tokw, int* tokp, int* cnt, int* list) {
    int m = blockIdx.x * 4 + (threadIdx.x >> 6), lane = threadIdx.x & 63;
    float xs[16]; float ss = 0.f;
#pragma unroll
    for (int i = 0; i < 16; ++i) { xs[i] = X[(size_t)m * D + lane + 64 * i]; ss += xs[i] * xs[i]; }
    ss = wave_sum(ss);
    float rs = rstd_of(ss, D);
    float lg[36];
#pragma unroll
    for (int j = 0; j < 36; ++j) lg[j] = 0.f;
#pragma unroll
    for (int i = 0; i < 16; ++i) { int k = lane + 64 * i; float tv = xs[i] * rs * g[k];
#pragma unroll
        for (int j = 0; j < 4; ++j) lg[j] += tv * wrg[k * 4 + j];
#pragma unroll
        for (int j = 0; j < 32; ++j) lg[4 + j] += tv * wre[k * 32 + j]; }
#pragma unroll
    for (int j = 0; j < 36; ++j) lg[j] = wave_sum(lg[j]);
    if (lane == 0) {
        ssx2[m] = ss;
        float gl[4]; int gi = 0; float gm = -1e30f;
#pragma unroll
        for (int j = 0; j < 4; ++j) { gl[j] = lg[j] + brg[j]; if (gl[j] > gm) { gm = gl[j]; gi = j; } }
        float gs = 0.f;
#pragma unroll
        for (int j = 0; j < 4; ++j) gs += expf(gl[j] - gm);
        float pg = 1.f / gs;
        float e1 = -1e30f, e2 = -1e30f; int i1 = 0, i2 = 0;
#pragma unroll
        for (int g4 = 0; g4 < 4; ++g4) if (g4 == gi) {
#pragma unroll
            for (int j = 0; j < 8; ++j) { float v = lg[4 + g4 * 8 + j] + bre[g4 * 8 + j];
                if (v > e1) { e2 = e1; i2 = i1; e1 = v; i1 = j; } else if (v > e2) { e2 = v; i2 = j; } } }
        float p2 = 1.f / (1.f + expf(e1 - e2)), p1 = 1.f - p2;
        int ea = gi * 8 + i1, eb = gi * 8 + i2;
        toke[m * 2] = ea; toke[m * 2 + 1] = eb; tokw[m * 2] = pg * p1; tokw[m * 2 + 1] = pg * p2;
        int pa = atomicAdd(&cnt[ea], 1), pb = atomicAdd(&cnt[eb], 1);
        tokp[m * 2] = pa; tokp[m * 2 + 1] = pb; list[ea * T + pa] = m * 2; list[eb * T + pb] = m * 2 + 1;
    }
}
__global__ __launch_bounds__(256) void k_moe_naive(const h16* x2h, const float* ssx2, const int* toke, const float* tokw, const h16* Wgu, const h16* Wdn, h16* yb) {
    __shared__ float mh[DE];
    int m = blockIdx.x, tid = threadIdx.x, wv = tid >> 6, lane = tid & 63;
    float xs[16];
#pragma unroll
    for (int i = 0; i < 16; ++i) xs[i] = (float)x2h[(size_t)m * D + lane + 64 * i];
    float rs = rstd_of(ssx2[m], D);
    for (int sl = 0; sl < 2; ++sl) {
        int e = toke[m * 2 + sl]; float w = tokw[m * 2 + sl];
        for (int ji = 0; ji < 64; ++ji) {
            int j = wv * 64 + ji, np = 32 * (j >> 4) + (j & 15);
            const h16* wgp = Wgu + ((size_t)e * 512 + np) * D; const h16* wup = wgp + (size_t)16 * D;
            float a = 0.f, bb = 0.f;
#pragma unroll
            for (int i = 0; i < 16; ++i) { a += xs[i] * (float)wgp[lane + 64 * i]; bb += xs[i] * (float)wup[lane + 64 * i]; }
            a = wave_sum(a) * rs; bb = wave_sum(bb) * rs;
            if (lane == 0) mh[j] = (float)(h16)(a / (1.f + expf(-a)) * bb * w);
        }
        __syncthreads();
        float m4[4];
#pragma unroll
        for (int i = 0; i < 4; ++i) m4[i] = mh[lane + 64 * i];
        for (int ni = 0; ni < 256; ++ni) {
            int n = wv * 256 + ni; const h16* wd = Wdn + ((size_t)e * D + n) * DE; float y = 0.f;
#pragma unroll
            for (int i = 0; i < 4; ++i) y += m4[i] * (float)wd[lane + 64 * i];
            y = wave_sum(y);
            if (lane == 0) yb[((size_t)(m * 2 + sl)) * D + n] = (h16)y;
        }
        __syncthreads();
    }
}
__global__ __launch_bounds__(256) void k_final(const float* X, const h16* yb, const float* g, float* out) {
    int m = blockIdx.x * 4 + (threadIdx.x >> 6), lane = threadIdx.x & 63;
    float v[16]; float ss = 0.f;
#pragma unroll
    for (int i = 0; i < 16; ++i) { int k = lane + 64 * i;
        v[i] = X[(size_t)m * D + k] + (float)yb[((size_t)m * 2) * D + k] + (float)yb[((size_t)m * 2 + 1) * D + k]; ss += v[i] * v[i]; }
    ss = wave_sum(ss); float rs = rstd_of(ss, D);
#pragma unroll
    for (int i = 0; i < 16; ++i) { int k = lane + 64 * i; out[(size_t)m * D + k] = v[i] * rs * g[k]; }
}


#define LAS __attribute__((address_space(3)))
typedef _Float16 h16x8 __attribute__((ext_vector_type(8)));
typedef _Float16 h16x4 __attribute__((ext_vector_type(4)));
typedef _Float16 h16x2 __attribute__((ext_vector_type(2)));
typedef float f32x4 __attribute__((ext_vector_type(4)));
typedef float f32x16 __attribute__((ext_vector_type(16)));
constexpr int NTHR = 512, NWAVE = 8;
constexpr int LDS_BYTES = 150 * 1024;
constexpr size_t WS_ROPE = 248 * MiB;

struct Params {
    const float* in[36]; float* X; char* ws;
};
#define PF(off) ((float*)(p.ws + (off)))
#define PH(off) ((h16*)(p.ws + (off)))
#define PI(off) ((int*)(p.ws + (off)))

constexpr int G_BM = 256, G_BN = 128, G_BK = 64, G_AB = G_BM * G_BK * 2, G_BB = G_BN * G_BK * 2, G_STAGE = G_AB + G_BB;
static_assert(3 * G_STAGE <= LDS_BYTES, "lds");
__device__ __forceinline__ void glds16(const void* g, LAS char* l) { __builtin_amdgcn_global_load_lds((const unsigned*)g, (LAS unsigned*)l, 16, 0, 0); }

template <bool SWAP, class RowPtr, class Epi>
__device__ __forceinline__ void gemm_tile(LAS char* lds, const RowPtr& rowptr, const h16* __restrict__ Wt, int ldw, int K, int m0, int n0, const Epi& epi) {
    const int tid = threadIdx.x, lane = tid & 63, wid = __builtin_amdgcn_readfirstlane(tid >> 6);
    const int wm = wid >> 1, wn = wid & 1, fr = lane & 15, fq = lane >> 4;
    const h16* asrc[4]; const h16* bsrc[2];
#pragma unroll
    for (int i = 0; i < 4; ++i) { const int r = wid * 32 + i * 8 + (lane >> 3); const int ch = (lane & 7) ^ ((r >> 1) & 7); asrc[i] = rowptr(m0 + r) + ch * 8; }
#pragma unroll
    for (int i = 0; i < 2; ++i) { const int r = wid * 16 + i * 8 + (lane >> 3); const int ch = (lane & 7) ^ ((r >> 1) & 7); bsrc[i] = Wt + (size_t)(n0 + r) * ldw + ch * 8; }
    const int sw = fr >> 1;
    const int aoff = (wm * 64 + fr) * 128 + ((fq ^ sw) * 16);
    const int boff = G_AB + (wn * 64 + fr) * 128 + ((fq ^ sw) * 16);
    f32x4 acc[4][4];
#pragma unroll
    for (int i = 0; i < 4; ++i)
#pragma unroll
        for (int j = 0; j < 4; ++j) acc[i][j] = (f32x4){0.f, 0.f, 0.f, 0.f};
    const int nt = K / G_BK;
    asm volatile("s_waitcnt vmcnt(0)" ::: "memory");
#define G_STAGE_ISSUE(buf, kt) do { LAS char* sa_ = lds + (buf) * G_STAGE + wid * 4096; \
        _Pragma("unroll") for (int i_ = 0; i_ < 4; ++i_) glds16(asrc[i_] + (kt) * G_BK, sa_ + i_ * 1024); \
        LAS char* sb_ = lds + (buf) * G_STAGE + G_AB + wid * 2048; \
        _Pragma("unroll") for (int i_ = 0; i_ < 2; ++i_) glds16(bsrc[i_] + (kt) * G_BK, sb_ + i_ * 1024); } while (0)
    G_STAGE_ISSUE(0, 0);
    if (nt > 1) G_STAGE_ISSUE(1, 1);
    int buf = 0;
    for (int t = 0; t < nt; ++t) {
        if (t + 1 < nt) asm volatile("s_waitcnt vmcnt(6)" ::: "memory"); else asm volatile("s_waitcnt vmcnt(0)" ::: "memory");
        __builtin_amdgcn_s_barrier();
        if (t + 2 < nt) { const int nb_ = buf >= 1 ? buf - 1 : 2; G_STAGE_ISSUE(nb_, t + 2); }
        LAS char* base = lds + buf * G_STAGE;
#pragma unroll
        for (int kk = 0; kk < 2; ++kk) {
            h16x8 a[4], b[4];
#pragma unroll
            for (int i = 0; i < 4; ++i) { a[i] = *(LAS h16x8*)(base + ((aoff ^ (kk * 64)) + i * 2048)); b[i] = *(LAS h16x8*)(base + ((boff ^ (kk * 64)) + i * 2048)); }
#pragma unroll
            for (int i = 0; i < 4; ++i)
#pragma unroll
                for (int j = 0; j < 4; ++j)
                    acc[i][j] = SWAP ? __builtin_amdgcn_mfma_f32_16x16x32_f16(b[j], a[i], acc[i][j], 0, 0, 0)
                                     : __builtin_amdgcn_mfma_f32_16x16x32_f16(a[i], b[j], acc[i][j], 0, 0, 0);
        }
        buf = buf == 2 ? 0 : buf + 1;
    }
#undef G_STAGE_ISSUE
    asm volatile("s_waitcnt lgkmcnt(0)" ::: "memory");
    __builtin_amdgcn_s_barrier();
    if constexpr (SWAP) {
#pragma unroll
        for (int i = 0; i < 4; ++i)
#pragma unroll
            for (int jp = 0; jp < 2; ++jp) epi.row32(m0 + wm * 64 + i * 16 + fr, n0 + wn * 64 + jp * 32 + fq * 4, acc[i][2 * jp], acc[i][2 * jp + 1]);
    } else {
#pragma unroll
        for (int i = 0; i < 4; ++i)
#pragma unroll
            for (int j = 0; j < 4; ++j) epi.col4(m0 + wm * 64 + i * 16 + fq * 4, n0 + wn * 64 + j * 16 + fr, acc[i][j]);
    }
}
struct RowDense { const h16* A; int lda; __device__ __forceinline__ const h16* operator()(int m) const { return A + (size_t)m * lda; } };

__device__ __forceinline__ h16x4 cvt4(f32x4 v) { return (h16x4){(h16)v[0], (h16)v[1], (h16)v[2], (h16)v[3]}; }
__device__ __forceinline__ float rowgrp_sum(float v) { v += __shfl_xor(v, 16); v += __shfl_xor(v, 32); return v; }

struct EHy {
    const float* ssx; h16* hyT;
    __device__ __forceinline__ void col4(int mr, int n, f32x4 v) const {
        const f32x4 ss = *(const f32x4*)(ssx + mr);
        v[0] *= rstd_of(ss[0], D); v[1] *= rstd_of(ss[1], D); v[2] *= rstd_of(ss[2], D); v[3] *= rstd_of(ss[3], D);
        const int b = mr >> 12, t = mr & 4095;
        *(h16x4*)(hyT + ((size_t)(b * 1536 + n)) * S + t) = cvt4(v);
    } };
struct ELat {
    const float* ssx; h16* lat; float* ssq; float* sskv;
    __device__ __forceinline__ void row32(int m, int nb, f32x4 va, f32x4 vb) const {
        const float r = rstd_of(ssx[m], D); va *= r; vb *= r;
        if (nb < LAT) { *(h16x4*)(lat + (size_t)m * LAT + nb) = cvt4(va); *(h16x4*)(lat + (size_t)m * LAT + nb + 16) = cvt4(vb); }
        float s = va[0] * va[0] + va[1] * va[1] + va[2] * va[2] + va[3] * va[3] + vb[0] * vb[0] + vb[1] * vb[1] + vb[2] * vb[2] + vb[3] * vb[3];
        s = rowgrp_sum(s);
        if ((threadIdx.x & 63) < 16 && nb < 384) atomicAdd((nb < 256 ? ssq : sskv) + m, s);
    } };
struct EQ {
    const float* ssq; const float* rope; h16* Q;
    __device__ __forceinline__ void row32(int m, int nb, f32x4 va, f32x4 vb) const {
        const float r = rstd_of(ssq[m], 256) * QSCALE; va *= r; vb *= r;
        const int b = m >> 12, t = m & 4095, blk = nb >> 5, h = blk / 3, part = blk - 3 * h, c = nb & 31;
        if (part == 2) {
            const float* rp = rope + ((size_t)t * 16 + c) * 2;
#pragma unroll
            for (int j = 0; j < 4; ++j) { const float cs = rp[2 * j], sn = rp[2 * j + 1]; const float q1 = va[j], q2 = vb[j]; va[j] = q1 * cs - q2 * sn; vb[j] = q1 * sn + q2 * cs; }
        }
        h16* q = Q + ((size_t)((b * NH + h) * S + t)) * 96 + part * 32 + c;
        *(h16x4*)q = cvt4(va); *(h16x4*)(q + 16) = cvt4(vb);
    } };
struct EK {
    const float* sskv; h16* K;
    __device__ __forceinline__ void row32(int m, int nb, f32x4 va, f32x4 vb) const {
        const float r = rstd_of(sskv[m], 128); va *= r; vb *= r;
        const int b = m >> 12, t = m & 4095, h = nb >> 6, j = nb & 63;
        h16* k = K + ((size_t)((b * NH + h) * S + t)) * 96 + j;
        *(h16x4*)k = cvt4(va); *(h16x4*)(k + 16) = cvt4(vb);
    } };
struct EV {
    const float* sskv; h16* Vt;
    __device__ __forceinline__ void col4(int mr, int n, f32x4 v) const {
        const f32x4 ss = *(const f32x4*)(sskv + mr);
        v[0] *= rstd_of(ss[0], 128); v[1] *= rstd_of(ss[1], 128); v[2] *= rstd_of(ss[2], 128); v[3] *= rstd_of(ss[3], 128);
        const int b = mr >> 12, t = mr & 4095;
        *(h16x4*)(Vt + ((size_t)(b * 512 + n)) * S + t) = cvt4(v);
    } };
struct EKc {
    const float* ss; h16* Kc;
    __device__ __forceinline__ void row32(int m, int nb, f32x4 va, f32x4 vb) const {
        const float r = rstd_of(ss[m], D); va *= r; vb *= r;
        *(h16x4*)(Kc + (size_t)m * D + nb) = cvt4(va); *(h16x4*)(Kc + (size_t)m * D + nb + 16) = cvt4(vb);
    } };
struct EVc {
    const float* ss; h16* VcT;
    __device__ __forceinline__ void col4(int mr, int n, f32x4 v) const {
        const f32x4 s4 = *(const f32x4*)(ss + mr);
        v[0] *= rstd_of(s4[0], D); v[1] *= rstd_of(s4[1], D); v[2] *= rstd_of(s4[2], D); v[3] *= rstd_of(s4[3], D);
        const int b = mr >> 8, mm = mr & 255;
        *(h16x4*)(VcT + ((size_t)(b * 1024 + n)) * MEMT + mm) = cvt4(v);
    } };
struct ERes {
    const float* xin; float* X; h16* xh; float* ss;
    __device__ __forceinline__ void row32(int m, int nb, f32x4 va, f32x4 vb) const {
        const size_t i = (size_t)m * D + nb;
        va += *(const f32x4*)(xin + i); vb += *(const f32x4*)(xin + i + 16);
        *(f32x4*)(X + i) = va; *(f32x4*)(X + i + 16) = vb;
        *(h16x4*)(xh + i) = cvt4(va); *(h16x4*)(xh + i + 16) = cvt4(vb);
        float s = va[0] * va[0] + va[1] * va[1] + va[2] * va[2] + va[3] * va[3] + vb[0] * vb[0] + vb[1] * vb[1] + vb[2] * vb[2] + vb[3] * vb[3];
        s = rowgrp_sum(s);
        if (ss && (threadIdx.x & 63) < 16) atomicAdd(ss + m, s);
    } };
struct EMq {
    const float* ss; h16* qc;
    __device__ __forceinline__ void row32(int m, int nb, f32x4 va, f32x4 vb) const {
        const float r = rstd_of(ss[m], D) * CSCALE; va *= r; vb *= r;
        *(h16x4*)(qc + (size_t)m * D + nb) = cvt4(va); *(h16x4*)(qc + (size_t)m * D + nb + 16) = cvt4(vb);
    } };

template <bool SWAP, class Epi>
__device__ __forceinline__ void gemm_job(LAS char* lds, const h16* A, int lda, const h16* Wt, int ldw, int M, int N, int K, const Epi& epi, int first = 0) {
    const int ntn = N / G_BN, ntiles = (M / G_BM) * ntn;
    const RowDense rp{A, lda};
    const int G = gridDim.x, bx = blockIdx.x, vid = (G % 8 == 0) ? (bx % 8) * (G / 8) + bx / 8 : bx;
    for (int tix = (vid + G - first % G) % G; tix < ntiles; tix += G) {
        const int mt = tix / ntn, nt_ = tix - mt * ntn;
        gemm_tile<SWAP>(lds, rp, Wt, ldw, K, mt * G_BM, nt_ * G_BN, epi);
    }
}

template <class RowMap, class Gain>
__device__ __forceinline__ void wt_item(const float* W, int N, int K, h16* Wt, LAS float* scr, int k0, int n0, int lane, const RowMap& rowmap, const Gain& gain) {
#pragma unroll 8
    for (int i = 0; i < 32; ++i) { const int kk = 2 * i + (lane >> 5); scr[kk * 33 + (lane & 31)] = W[(size_t)(k0 + kk) * N + n0 + (lane & 31)] * gain(k0 + kk); }
    asm volatile("s_waitcnt lgkmcnt(0)" ::: "memory");
    const int c = lane & 7;
#pragma unroll
    for (int j = 0; j < 4; ++j) { const int n = (lane >> 3) + 8 * j; const LAS float* s = scr + (8 * c) * 33 + n;
        h16x8 o = {(h16)s[0], (h16)s[33], (h16)s[66], (h16)s[99], (h16)s[132], (h16)s[165], (h16)s[198], (h16)s[231]};
        *(h16x8*)(Wt + (size_t)rowmap(n0 + n) * K + k0 + 8 * c) = o; }
    asm volatile("s_waitcnt lgkmcnt(0)" ::: "memory");
}
struct GainNone { __device__ __forceinline__ float operator()(int) const { return 1.f; } };
struct Gain1 { const float* g; __device__ __forceinline__ float operator()(int k) const { return g[k]; } };
struct Gain2 { const float* g; const float* g2; __device__ __forceinline__ float operator()(int k) const { return k < 512 ? g[k] : g2[k - 512]; } };
struct MapId { __device__ __forceinline__ int operator()(int n) const { return n; } };
struct MapIn { __device__ __forceinline__ int operator()(int n) const { return n < LAT ? 1536 + n : n - LAT; } };
struct MapKV { __device__ __forceinline__ int operator()(int n) const { const int h = n >> 7, j = n & 127; return j < 64 ? h * 64 + j : 512 + h * 64 + (j - 64); } };
struct MapG { int up; __device__ __forceinline__ int operator()(int j) const { return 32 * (j >> 4) + (j & 15) + up; } };

__device__ __forceinline__ void phase_prep(const Params& p, LAS char* lds) {
    const int tid = threadIdx.x, lane = tid & 63, wid = tid >> 6;
    const int gw = blockIdx.x * NWAVE + wid, NGW = gridDim.x * NWAVE, gt = blockIdx.x * NTHR + tid, NGT = gridDim.x * NTHR;
    LAS float* scr = (LAS float*)(lds + wid * 16384);
    for (int i = gt; i < 5 * 16384; i += NGT) PF(WS_SSQ)[i] = 0.f;
    for (int i = gt; i < 1024; i += NGT) PI(WS_CTL)[i] = 0;
    for (int row = gw; row < T + MROWS; row += NGW) {
        const bool isx = row < T; const int r = isx ? row : row - T;
        const f32x4* src = (const f32x4*)((isx ? p.in[0] : p.in[1]) + (size_t)r * D) + lane;
        h16* dst = (isx ? PH(WS_XH) : PH(WS_MEMH)) + (size_t)r * D;
        float s = 0.f;
#pragma unroll
        for (int j = 0; j < 4; ++j) { const f32x4 v = src[64 * j]; s += v[0] * v[0] + v[1] * v[1] + v[2] * v[2] + v[3] * v[3]; *(h16x4*)(dst + (lane + 64 * j) * 4) = cvt4(v); }
        s = wave_sum(s);
        if (lane == 0) (isx ? PF(WS_SSX) : PF(WS_SSMEM))[r] = s;
    }
    {
        constexpr int I_IN = 16 * 61, I_UQ = 4 * 24, I_UKV = 2 * 32, I_SQ = 16 * 32, I_MKV = 16 * 64, I_EX = 16 * 8, I_DN = 4 * 32;
        constexpr int NIT = I_IN + I_UQ + I_UKV + 3 * I_SQ + I_MKV + NE * (2 * I_EX + I_DN);
        for (int it = gw; it < NIT; it += NGW) {
            int r = it;
            if (r < I_IN) { wt_item(p.in[3], INC, D, PH(WS_WIN), scr, (r / 61) * 64, (r % 61) * 32, lane, MapIn{}, Gain1{p.in[2]}); continue; } r -= I_IN;
            if (r < I_UQ) { wt_item(p.in[6], 768, 256, PH(WS_WUQ), scr, (r / 24) * 64, (r % 24) * 32, lane, MapId{}, Gain1{p.in[4]}); continue; } r -= I_UQ;
            if (r < I_UKV) { wt_item(p.in[7], 1024, 128, PH(WS_WUKV), scr, (r / 32) * 64, (r % 32) * 32, lane, MapKV{}, Gain1{p.in[5]}); continue; } r -= I_UKV;
            if (r < I_SQ) { wt_item(p.in[21], D, D, PH(WS_WOUT), scr, (r / 32) * 64, (r % 32) * 32, lane, MapId{}, Gain2{p.in[19], p.in[20]}); continue; } r -= I_SQ;
            if (r < I_SQ) { wt_item(p.in[24], D, D, PH(WS_WMQ), scr, (r / 32) * 64, (r % 32) * 32, lane, MapId{}, Gain1{p.in[22]}); continue; } r -= I_SQ;
            if (r < I_SQ) { wt_item(p.in[26], D, D, PH(WS_WMO), scr, (r / 32) * 64, (r % 32) * 32, lane, MapId{}, GainNone{}); continue; } r -= I_SQ;
            if (r < I_MKV) { wt_item(p.in[25], 2048, D, PH(WS_WMKV), scr, (r / 64) * 64, (r % 64) * 32, lane, MapId{}, Gain1{p.in[23]}); continue; } r -= I_MKV;
            const int e = r / (2 * I_EX + I_DN); r -= e * (2 * I_EX + I_DN);
            if (r < I_EX) { wt_item(p.in[32] + (size_t)e * D * DE, DE, D, PH(WS_WGU) + (size_t)e * 512 * D, scr, (r / 8) * 64, (r % 8) * 32, lane, MapG{0}, Gain1{p.in[27]}); continue; } r -= I_EX;
            if (r < I_EX) { wt_item(p.in[33] + (size_t)e * D * DE, DE, D, PH(WS_WGU) + (size_t)e * 512 * D, scr, (r / 8) * 64, (r % 8) * 32, lane, MapG{16}, Gain1{p.in[27]}); continue; } r -= I_EX;
            wt_item(p.in[34] + (size_t)e * DE * D, D, DE, PH(WS_WDN) + (size_t)e * D * DE, scr, (r / 32) * 64, (r % 32) * 32, lane, MapId{}, GainNone{});
        }
        for (int i = gt; i < 96 * D / 8; i += NGT) *(h16x8*)(PH(WS_WIN) + (size_t)INC * D + (size_t)i * 8) = (h16x8){0, 0, 0, 0, 0, 0, 0, 0};
    }
    for (int i = gt; i < S * 16; i += NGT) { const int t = i >> 4, pp = i & 15; const float inv = exp2f(-(float)pp * (13.287712379549449f / 16.0f)); float sn, cs; sincosf((float)t * inv, &sn, &cs);
        PF(WS_ROPE)[2 * i] = cs; PF(WS_ROPE)[2 * i + 1] = sn; }
    {
        LAS float* zf = scr; LAS float* h1 = scr + 64;
        const float* w1 = p.in[10]; const float* b1 = p.in[11]; const float* freq = p.in[12]; const float* w2 = p.in[13]; const float* b2 = p.in[14];
        for (int t = gw; t < S; t += NGW) {
            const int j = lane;
            if (j < 33) { float v;
                if (j == 0) v = (float)t / (float)S;
                else { const int bi = (j - 1) & 15; const float band = 1e-4f + (float)bi * ((15.0f - 1e-4f) / 15.0f);
                    double rev = (double)t * (double)band / (double)S; rev -= floor(rev); const float r2 = (float)(2.0 * rev);
                    v = (j <= 16) ? cospif(r2) : -sinpif(r2); }
                zf[j] = v; }
            asm volatile("s_waitcnt lgkmcnt(0)" ::: "memory");
            float a = b1[j];
            for (int i = 0; i < 33; ++i) a += zf[i] * w1[i * 64 + j];
            h1[j] = sinf(freq[j] * a);
            asm volatile("s_waitcnt lgkmcnt(0)" ::: "memory");
            float c = b2[j];
            for (int i = 0; i < 64; ++i) c += h1[i] * w2[i * 64 + j];
            PF(WS_H2)[t * 64 + j] = sinf(freq[64 + j] * c);
            asm volatile("s_waitcnt lgkmcnt(0)" ::: "memory");
        }
    }
}
__device__ __forceinline__ void phase_filt3(const Params& p) {
    const int gt = blockIdx.x * NTHR + threadIdx.x, NGT = gridDim.x * NTHR;
    const float* H2 = PF(WS_H2); const float* w3 = p.in[15]; const float* b3 = p.in[16]; const float* decay = p.in[17]; h16* R = PH(WS_R);
    for (int i = gt; i < S * 2048; i += NGT) {
        const int col = i & 2047, tau = i >> 11;
        float a = b3[col];
#pragma unroll 8
        for (int j = 0; j < 64; ++j) a += H2[tau * 64 + j] * w3[j * 2048 + col];
        a *= expf(-((float)tau / (float)S) * fabsf(decay[col]));
        const int o = col >> 10, dir = (col >> 9) & 1, c = col & 511;
        h16* r = R + ((size_t)(o * 512 + c)) * 8192;
        if (dir == 0) r[4096 - tau] = (h16)a;
        else r[tau == 0 ? 0 : 4096 + tau] = (h16)(tau == 0 ? 0.f : a);
    }
}
__device__ __forceinline__ void phase_krot(const Params& p) {
    const int gt = blockIdx.x * NTHR + threadIdx.x, NGT = gridDim.x * NTHR;
    const h16* lat = PH(WS_LAT); h16* K = PH(WS_K); const float* rope = PF(WS_ROPE);
    for (int i = gt; i < T * 4; i += NGT) {
        const int m = i >> 2, p0 = (i & 3) * 4, b = m >> 12, t = m & 4095;
        const h16x4 k1 = *(const h16x4*)(lat + (size_t)m * LAT + 384 + p0), k2 = *(const h16x4*)(lat + (size_t)m * LAT + 400 + p0);
        h16x4 o1, o2;
#pragma unroll
        for (int j = 0; j < 4; ++j) { const float cs = rope[((size_t)t * 16 + p0 + j) * 2], sn = rope[((size_t)t * 16 + p0 + j) * 2 + 1];
            const float a = (float)k1[j], c = (float)k2[j]; o1[j] = (h16)(a * cs - c * sn); o2[j] = (h16)(a * sn + c * cs); }
#pragma unroll
        for (int h = 0; h < NH; ++h) { h16* kp = K + ((size_t)((b * NH + h) * S + t)) * 96 + 64 + p0; *(h16x4*)kp = o1; *(h16x4*)(kp + 16) = o2; }
    }
}


__device__ __forceinline__ void phase_attn_naive(const Params& p, LAS char* lds) {
    LAS float* Ks = (LAS float*)lds; LAS float* Vs = Ks + 32 * 96;
    const h16* Q = PH(WS_Q); const h16* K = PH(WS_K); const h16* Vt = PH(WS_VT); h16* aout = PH(WS_AOUT);
    const int tid = threadIdx.x;
    for (int u = blockIdx.x; u < NB * NH * (S / 512); u += gridDim.x) {
        const int bh = u >> 3, q0 = (u & 7) * 512;
        float q[96], o[64];
#pragma unroll
        for (int d = 0; d < 96; ++d) q[d] = (float)Q[((size_t)bh * S + q0 + tid) * 96 + d];
#pragma unroll
        for (int d = 0; d < 64; ++d) o[d] = 0.f;
        float m = -1e30f, l = 0.f;
        for (int k0 = 0; k0 < S; k0 += 32) {
            __syncthreads();
            for (int i = tid; i < 32 * 96; i += NTHR) Ks[i] = (float)K[((size_t)bh * S + k0) * 96 + i];
            for (int i = tid; i < 32 * 64; i += NTHR) { const int d = i >> 5, r = i & 31; Vs[r * 64 + d] = (float)Vt[((size_t)bh * 64 + d) * S + k0 + r]; }
            __syncthreads();
            for (int r = 0; r < 32; ++r) {
                float sc = 0.f;
#pragma unroll
                for (int d = 0; d < 96; ++d) sc += q[d] * Ks[r * 96 + d];
                if (sc > m) { const float al = exp2f(m - sc); l *= al;
#pragma unroll
                    for (int d = 0; d < 64; ++d) o[d] *= al;
                    m = sc; }
                const float pp = exp2f(sc - m); l += pp;
#pragma unroll
                for (int d = 0; d < 64; ++d) o[d] += pp * Vs[r * 64 + d];
            }
        }
        const int b = bh >> 3, h = bh & 7; const float il = 1.f / l;
#pragma unroll
        for (int d = 0; d < 64; ++d) aout[((size_t)(b * S + q0 + tid)) * 512 + h * 64 + d] = (h16)(o[d] * il);
    }
    __syncthreads();
}
constexpr int AT_KROW = 208, AT_VROW = 136, AT_KB = 64 * AT_KROW, AT_VB = 64 * AT_VROW, AT_BUF = AT_KB + AT_VB;
__device__ __forceinline__ void phase_attn(const Params& p, LAS char* lds) {
    const int tid = threadIdx.x, lane = tid & 63, wid = __builtin_amdgcn_readfirstlane(tid >> 6), r32 = lane & 31, hi = lane >> 5;
    const h16* Qg = PH(WS_Q); const h16* Kg = PH(WS_K); const h16* Vtg = PH(WS_VT); h16* aout = PH(WS_AOUT);
    const int k0r = tid / 12, k0c = tid - 12 * k0r, c1 = tid + 512, k1r = c1 / 12, k1c = c1 - 12 * k1r;
    const int vdv = tid >> 3, vc = tid & 7;
    const int G = gridDim.x, bx = blockIdx.x, vid = (G % 8 == 0) ? (bx % 8) * (G / 8) + bx / 8 : bx;
    for (int u = vid; u < NB * NH * 16; u += G) {
        const int bh = u >> 4, q0 = (u & 15) * 256 + wid * 32;
        h16x8 qf[6];
        { const h16* qp = Qg + ((size_t)bh * S + q0 + r32) * 96 + 8 * hi;
#pragma unroll
          for (int s_ = 0; s_ < 6; ++s_) qf[s_] = *(const h16x8*)(qp + 16 * s_); }
        const h16* Kb = Kg + (size_t)bh * S * 96; const h16* Vb = Vtg + (size_t)bh * 64 * S + (size_t)vdv * S + vc * 8;
        h16x8 kr0, kr1, vr;
        kr0 = *(const h16x8*)(Kb + tid * 8); kr1 = kr0; if (tid < 256) kr1 = *(const h16x8*)(Kb + c1 * 8); vr = *(const h16x8*)(Vb);
        __syncthreads();
        { *(LAS h16x8*)(lds + k0r * AT_KROW + k0c * 16) = kr0; if (tid < 256) *(LAS h16x8*)(lds + k1r * AT_KROW + k1c * 16) = kr1;
          LAS char* vn = lds + AT_KB + vdv * AT_VROW + vc * 16; *(LAS h16x4*)vn = (h16x4){vr[0], vr[1], vr[2], vr[3]}; *(LAS h16x4*)(vn + 8) = (h16x4){vr[4], vr[5], vr[6], vr[7]}; }
        __syncthreads();
        f32x16 o0, o1;
#pragma unroll
        for (int r = 0; r < 16; ++r) { o0[r] = 0.f; o1[r] = 0.f; }
        float m = -1e30f, l = 0.f;
        for (int t = 0; t < S / 64; ++t) {
            if (t + 1 < S / 64) {
                const h16* kn = Kb + (size_t)(t + 1) * 64 * 96;
                kr0 = *(const h16x8*)(kn + tid * 8); if (tid < 256) kr1 = *(const h16x8*)(kn + c1 * 8); vr = *(const h16x8*)(Vb + (t + 1) * 64);
            }
            LAS char* kb = lds + (t & 1) * AT_BUF; LAS char* vb = kb + AT_KB;
            f32x16 p0, p1;
#pragma unroll
            for (int r = 0; r < 16; ++r) { p0[r] = 0.f; p1[r] = 0.f; }
#pragma unroll
            for (int s_ = 0; s_ < 6; ++s_) {
                const h16x8 a0 = *(LAS h16x8*)(kb + r32 * AT_KROW + s_ * 32 + hi * 16);
                const h16x8 a1 = *(LAS h16x8*)(kb + (32 + r32) * AT_KROW + s_ * 32 + hi * 16);
                p0 = __builtin_amdgcn_mfma_f32_32x32x16_f16(a0, qf[s_], p0, 0, 0, 0);
                p1 = __builtin_amdgcn_mfma_f32_32x32x16_f16(a1, qf[s_], p1, 0, 0, 0);
            }
            float mx = fmaxf(p0[0], p1[0]);
#pragma unroll
            for (int r = 1; r < 16; ++r) mx = fmaxf(mx, fmaxf(p0[r], p1[r]));
            mx = fmaxf(mx, __shfl_xor(mx, 32));
            const float mn = fmaxf(m, mx), al = __builtin_amdgcn_exp2f(m - mn); m = mn;
            float rs = 0.f;
#pragma unroll
            for (int r = 0; r < 16; ++r) { p0[r] = __builtin_amdgcn_exp2f(p0[r] - mn); p1[r] = __builtin_amdgcn_exp2f(p1[r] - mn); rs += p0[r] + p1[r]; }
            l = l * al + rs;
#pragma unroll
            for (int r = 0; r < 16; ++r) { o0[r] *= al; o1[r] *= al; }
            h16x8 pf[2][2];
#pragma unroll
            for (int j = 0; j < 8; ++j) { pf[0][0][j] = (h16)p0[j]; pf[0][1][j] = (h16)p0[8 + j]; pf[1][0][j] = (h16)p1[j]; pf[1][1][j] = (h16)p1[8 + j]; }
#pragma unroll
            for (int kh = 0; kh < 2; ++kh)
#pragma unroll
                for (int s_ = 0; s_ < 2; ++s_) {
                    LAS char* v0 = vb + r32 * AT_VROW + (kh * 32 + 16 * s_ + 4 * hi) * 2;
                    const h16x4 a = *(LAS h16x4*)v0, b = *(LAS h16x4*)(v0 + 16);
                    const h16x4 c = *(LAS h16x4*)(v0 + 32 * AT_VROW), d = *(LAS h16x4*)(v0 + 32 * AT_VROW + 16);
                    const h16x8 vf0 = {a[0], a[1], a[2], a[3], b[0], b[1], b[2], b[3]}, vf1 = {c[0], c[1], c[2], c[3], d[0], d[1], d[2], d[3]};
                    o0 = __builtin_amdgcn_mfma_f32_32x32x16_f16(vf0, pf[kh][s_], o0, 0, 0, 0);
                    o1 = __builtin_amdgcn_mfma_f32_32x32x16_f16(vf1, pf[kh][s_], o1, 0, 0, 0);
                }
            if (t + 1 < S / 64) {
                LAS char* kn = lds + ((t + 1) & 1) * AT_BUF;
                *(LAS h16x8*)(kn + k0r * AT_KROW + k0c * 16) = kr0; if (tid < 256) *(LAS h16x8*)(kn + k1r * AT_KROW + k1c * 16) = kr1;
                LAS char* vn = kn + AT_KB + vdv * AT_VROW + vc * 16; *(LAS h16x4*)vn = (h16x4){vr[0], vr[1], vr[2], vr[3]}; *(LAS h16x4*)(vn + 8) = (h16x4){vr[4], vr[5], vr[6], vr[7]};
            }
            __syncthreads();
        }
        const float il = 1.f / (l + __shfl_xor(l, 32));
        const int b = bh >> 3, h = bh & 7;
        h16* ap = aout + ((size_t)(b * S + q0 + r32)) * 512 + h * 64 + 4 * hi;
#pragma unroll
        for (int g = 0; g < 4; ++g) {
            *(h16x4*)(ap + 8 * g) = (h16x4){(h16)(o0[4 * g] * il), (h16)(o0[4 * g + 1] * il), (h16)(o0[4 * g + 2] * il), (h16)(o0[4 * g + 3] * il)};
            *(h16x4*)(ap + 32 + 8 * g) = (h16x4){(h16)(o1[4 * g] * il), (h16)(o1[4 * g + 1] * il), (h16)(o1[4 * g + 2] * il), (h16)(o1[4 * g + 3] * il)};
        }
    }
    __syncthreads();
}
__device__ __forceinline__ void phase_hyena_naive(const Params& p, LAS char* lds) {
    LAS float* z = (LAS float*)lds; LAS float* Rl = z + 4096;
    const h16* hyT = PH(WS_HYT); const h16* R = PH(WS_R); const float* convw = p.in[8]; const float* convb = p.in[9]; const float* skip = p.in[18]; h16* hT = PH(WS_HT);
    const int tid = threadIdx.x;
    for (int u = blockIdx.x; u < NB * HYW; u += gridDim.x) {
        const int b = u >> 9, c = u & 511;
        auto u3 = [&](int ch, int t) -> float {
            const h16* pp = hyT + ((size_t)(b * 1536 + ch)) * S;
            const float a = t > 0 ? (float)pp[t - 1] : 0.f, bb = (float)pp[t], cc = t < S - 1 ? (float)pp[t + 1] : 0.f;
            return a * convw[ch] + bb * convw[1536 + ch] + cc * convw[3072 + ch] + convb[ch];
        };
        for (int n = 0; n < 2; ++n) {
            for (int uu = tid; uu < 8192; uu += NTHR) Rl[uu] = (float)R[((size_t)(n * 512 + c)) * 8192 + uu];
            if (n == 0) for (int t = tid; t < S; t += NTHR) z[t] = u3(1024 + c, t);
            __syncthreads();
            float acc[8];
#pragma unroll
            for (int i = 0; i < 8; ++i) acc[i] = 0.f;
            for (int s_ = 0; s_ < S; ++s_) {
                const float zs = z[s_];
#pragma unroll
                for (int i = 0; i < 8; ++i) acc[i] += zs * Rl[s_ - (tid + 512 * i) + 4096];
            }
            __syncthreads();
            const float sk = skip[n * 512 + c];
#pragma unroll
            for (int i = 0; i < 8; ++i) {
                const int t = tid + 512 * i;
                const float zn = u3(n == 0 ? c : 512 + c, t) * (acc[i] + sk * z[t]);
                if (n == 0) z[t] = zn; else hT[((size_t)(b * 512 + c)) * S + t] = (h16)zn;
            }
            __syncthreads();
        }
    }
}
__device__ __forceinline__ void phase_mixprep(const Params& p, LAS char* lds) {
    constexpr int LDT = 520;
    LAS h16* tile = (LAS h16*)lds;
    const h16* aout = PH(WS_AOUT); const h16* hT = PH(WS_HT); h16* mix = PH(WS_MIX);
    const int tid = threadIdx.x, lane = tid & 63, wid = tid >> 6;
    for (int u = blockIdx.x; u < T / 64; u += gridDim.x) {
        const int m0 = u * 64, b = m0 >> 12, t0 = m0 & 4095;
        __syncthreads();
        for (int i = tid; i < 512 * 8; i += NTHR) { const int c = i >> 3, j = i & 7;
            const h16x8 v = *(const h16x8*)(hT + ((size_t)(b * 512 + c)) * S + t0 + j * 8);
#pragma unroll
            for (int e = 0; e < 8; ++e) tile[(j * 8 + e) * LDT + c] = v[e]; }
        __syncthreads();
        for (int rr = 0; rr < 8; ++rr) {
            const int r = wid * 8 + rr; const size_t m = (size_t)(m0 + r);
            const h16x8 hv = *(LAS h16x8*)(tile + r * LDT + lane * 8);
            const h16x8 av = *(const h16x8*)(aout + m * 512 + lane * 8);
            float sh = 0.f, sa = 0.f;
#pragma unroll
            for (int e = 0; e < 8; ++e) { const float x = (float)hv[e], y = (float)av[e]; sh += x * x; sa += y * y; }
            sh = wave_sum(sh); sa = wave_sum(sa);
            const float rh = rstd_of(sh, 512), ra = rstd_of(sa, 512);
            h16x8 oh, oa;
#pragma unroll
            for (int e = 0; e < 8; ++e) { oh[e] = (h16)((float)hv[e] * rh); oa[e] = (h16)((float)av[e] * ra); }
            *(h16x8*)(mix + m * D + lane * 8) = oa; *(h16x8*)(mix + m * D + 512 + lane * 8) = oh;
        }
    }
    __syncthreads();
}
__device__ __forceinline__ void phase_xattn_naive(const Params& p, LAS char* lds) {
    LAS float* sc = (LAS float*)lds;
    LAS float* il = sc + 32 * 257;
    LAS h16* qs = (LAS h16*)(il + 32);
    h16* qc = PH(WS_QC); const h16* Kc = PH(WS_KC); const h16* VcT = PH(WS_VCT);
    const int tid = threadIdx.x, wv = tid >> 6, lane = tid & 63;
    for (int u = blockIdx.x; u < (S / 32) * NB * MH; u += gridDim.x) {
        const int bh = u >> 7, b = bh >> 2, h = bh & 3, t0 = (u & 127) * 32;
        __syncthreads();
        for (int i = tid; i < 32 * 256; i += NTHR) { const int tok = i >> 8, d = i & 255; qs[tok * 256 + d] = qc[((size_t)(b * S + t0 + tok)) * D + h * MHD + d]; }
        __syncthreads();
        for (int mi = 0; mi < 32; ++mi) {
            const int mm = wv * 32 + mi;
            const h16x4 kv = *(const h16x4*)(Kc + ((size_t)(b * MEMT + mm)) * D + h * MHD + lane * 4);
            for (int tok = 0; tok < 32; ++tok) {
                const h16x4 qv = *(LAS h16x4*)(qs + tok * 256 + lane * 4);
                float s_ = (float)qv[0] * (float)kv[0] + (float)qv[1] * (float)kv[1] + (float)qv[2] * (float)kv[2] + (float)qv[3] * (float)kv[3];
                s_ = wave_sum(s_);
                if (lane == 0) sc[tok * 257 + mm] = s_;
            }
        }
        __syncthreads();
        if (tid < 32) { float mx = -1e30f; for (int j = 0; j < 256; ++j) mx = fmaxf(mx, sc[tid * 257 + j]); float l = 0.f;
            for (int j = 0; j < 256; ++j) { const float pp = exp2f(sc[tid * 257 + j] - mx); sc[tid * 257 + j] = pp; l += pp; } il[tid] = 1.f / l; }
        __syncthreads();
        for (int di = 0; di < 32; ++di) {
            const int d = wv * 32 + di;
            const h16x4 vv = *(const h16x4*)(VcT + ((size_t)((b * MH + h) * MHD + d)) * MEMT + lane * 4);
            for (int tok = 0; tok < 32; ++tok) {
                float o = sc[tok * 257 + lane * 4] * (float)vv[0] + sc[tok * 257 + lane * 4 + 1] * (float)vv[1] + sc[tok * 257 + lane * 4 + 2] * (float)vv[2] + sc[tok * 257 + lane * 4 + 3] * (float)vv[3];
                o = wave_sum(o);
                if (lane == 0) qc[((size_t)(b * S + t0 + tok)) * D + h * MHD + d] = (h16)(o * il[tok]);
            }
        }
    }
    __syncthreads();
}
__device__ __forceinline__ void phase_route(const Params& p) {
    const float* X = p.X; const float* g = p.in[27]; const float* wrg = p.in[28]; const float* brg = p.in[29]; const float* wre = p.in[30]; const float* bre = p.in[31];
    float* ssx2 = PF(WS_SSX2); float* tokw = PF(WS_TOKW); int* cnt = PI(WS_CTL); int* list = PI(WS_LIST);
    const int lane = threadIdx.x & 63, gw = blockIdx.x * NWAVE + (threadIdx.x >> 6), NGW = gridDim.x * NWAVE;
    for (int m = gw; m < T; m += NGW) {
        float ss = 0.f;
#pragma unroll 4
        for (int i = 0; i < 16; ++i) { const float xv = X[(size_t)m * D + lane + 64 * i]; ss += xv * xv; }
        ss = wave_sum(ss);
        const float rs = rstd_of(ss, D);
        float lg[36];
#pragma unroll
        for (int j = 0; j < 36; ++j) lg[j] = 0.f;
#pragma unroll 1
        for (int i = 0; i < 16; ++i) { const int k = lane + 64 * i; const float tv = X[(size_t)m * D + k] * rs * g[k];
            const f32x4 wg4 = *(const f32x4*)(wrg + k * 4);
#pragma unroll
            for (int j = 0; j < 4; ++j) lg[j] += tv * wg4[j];
#pragma unroll
            for (int j4 = 0; j4 < 8; ++j4) { const f32x4 we4 = *(const f32x4*)(wre + k * 32 + j4 * 4);
#pragma unroll
                for (int j = 0; j < 4; ++j) lg[4 + j4 * 4 + j] += tv * we4[j]; } }
#pragma unroll
        for (int j = 0; j < 36; ++j) lg[j] = wave_sum(lg[j]);
        if (lane == 0) {
            ssx2[m] = ss;
            float gl[4]; int gi = 0; float gm = -1e30f;
#pragma unroll
            for (int j = 0; j < 4; ++j) { gl[j] = lg[j] + brg[j]; if (gl[j] > gm) { gm = gl[j]; gi = j; } }
            float gs = 0.f;
#pragma unroll
            for (int j = 0; j < 4; ++j) gs += expf(gl[j] - gm);
            const float pg = 1.f / gs;
            float e1 = -1e30f, e2 = -1e30f; int i1 = 0, i2 = 0;
#pragma unroll
            for (int g4 = 0; g4 < 4; ++g4) if (g4 == gi) {
#pragma unroll
                for (int j = 0; j < 8; ++j) { const float v = lg[4 + g4 * 8 + j] + bre[g4 * 8 + j];
                    if (v > e1) { e2 = e1; i2 = i1; e1 = v; i1 = j; } else if (v > e2) { e2 = v; i2 = j; } } }
            const float p2 = 1.f / (1.f + expf(e1 - e2)), p1 = 1.f - p2;
            const int ea = gi * 8 + i1, eb = gi * 8 + i2;
            tokw[m * 2] = pg * p1; tokw[m * 2 + 1] = pg * p2;
            const int pa = atomicAdd(&cnt[ea], 1), pb = atomicAdd(&cnt[eb], 1);
            list[ea * T + pa] = m * 2; list[eb * T + pb] = m * 2 + 1;
        }
    }
}
struct RowGather { const h16* A; const int* lst; int Me; __device__ __forceinline__ const h16* operator()(int m) const { const int pr = m < Me ? lst[m] : lst[0]; return A + (size_t)(pr >> 1) * D; } };
struct RowClamp { const h16* A; int Me; __device__ __forceinline__ const h16* operator()(int m) const { return A + (size_t)(m < Me ? m : 0) * DE; } };
struct EGu { const int* lst; int Me; const float* ssx2; const float* tokw; h16* hb;
    __device__ __forceinline__ void row32(int m, int nb, f32x4 va, f32x4 vb) const {
        if (m >= Me) return;
        const int pr = lst[m]; const float rs = rstd_of(ssx2[pr >> 1], D), w = tokw[pr];
        h16x4 o;
#pragma unroll
        for (int j = 0; j < 4; ++j) { const float a = va[j] * rs, bb = vb[j] * rs; o[j] = (h16)(a / (1.f + __expf(-a)) * bb * w); }
        *(h16x4*)(hb + (size_t)m * DE + (nb >> 5) * 16 + (nb & 31)) = o;
    } };
struct EDn { const int* lst; int Me; h16* yb;
    __device__ __forceinline__ void row32(int m, int nb, f32x4 va, f32x4 vb) const {
        if (m >= Me) return;
        h16* y = yb + (size_t)lst[m] * D + nb;
        *(h16x4*)y = cvt4(va); *(h16x4*)(y + 16) = cvt4(vb);
    } };
template <bool DOWN>
__device__ __forceinline__ void phase_moe(const Params& p, LAS char* lds) {
    const int* cnt = PI(WS_CTL);
    const int G = gridDim.x, bx = blockIdx.x, vid = (G % 8 == 0) ? (bx % 8) * (G / 8) + bx / 8 : bx;
    constexpr int NTN = DOWN ? D / G_BN : 512 / G_BN;
    int tbase = 0, off = 0;
    int tix = vid;
    for (int e = 0; e < NE; ++e) {
        const int Me = cnt[e], nmt = (Me + G_BM - 1) / G_BM, nte = nmt * NTN;
        const int* lst = PI(WS_LIST) + (size_t)e * T;
        for (; tix < tbase + nte; tix += G) {
            const int lt = tix - tbase, mt = lt / NTN, nt_ = lt - mt * NTN;
            if (!DOWN) gemm_tile<true>(lds, RowGather{PH(WS_X2H), lst, Me}, PH(WS_WGU) + (size_t)e * 512 * D, D, D, mt * G_BM, nt_ * G_BN,
                                       EGu{lst, Me, PF(WS_SSX2), PF(WS_TOKW), PH(WS_HB) + (size_t)off * DE});
            else gemm_tile<true>(lds, RowClamp{PH(WS_HB) + (size_t)off * DE, Me}, PH(WS_WDN) + (size_t)e * D * DE, DE, DE, mt * G_BM, nt_ * G_BN,
                                 EDn{lst, Me, PH(WS_YB)});
        }
        tbase += nte; off += Me;
    }
}
__device__ __forceinline__ void phase_final(const Params& p) {
    const float* X = p.X; const h16* yb = PH(WS_YB); const float* g = p.in[35]; float* out = p.X;
    const int lane = threadIdx.x & 63, gw = blockIdx.x * NWAVE + (threadIdx.x >> 6), NGW = gridDim.x * NWAVE;
    for (int m = gw; m < T; m += NGW) {
        f32x4 v[4]; float ss = 0.f;
#pragma unroll
        for (int i = 0; i < 4; ++i) { const int k = (lane + 64 * i) * 4;
            const f32x4 xv = *(const f32x4*)(X + (size_t)m * D + k); const h16x4 y0 = *(const h16x4*)(yb + ((size_t)m * 2) * D + k), y1 = *(const h16x4*)(yb + ((size_t)m * 2 + 1) * D + k);
#pragma unroll
            for (int j = 0; j < 4; ++j) { v[i][j] = xv[j] + (float)y0[j] + (float)y1[j]; ss += v[i][j] * v[i][j]; } }
        ss = wave_sum(ss); const float rs = rstd_of(ss, D);
#pragma unroll
        for (int i = 0; i < 4; ++i) { const int k = (lane + 64 * i) * 4; const f32x4 gv = *(const f32x4*)(g + k); *(f32x4*)(out + (size_t)m * D + k) = v[i] * rs * gv; }
    }
}

__global__ void __launch_bounds__(NTHR) mega(Params p, int ph_lo, int ph_hi) {
    extern __shared__ __attribute__((aligned(16))) char lds_raw[];
    LAS char* lds = (LAS char*)lds_raw;
    cg::grid_group grid = cg::this_grid();
#define PHASE(k) if (ph_lo <= (k) && (k) < ph_hi)
#define SEAM(k) if (ph_lo <= (k) && (k) + 1 < ph_hi) grid.sync()
    PHASE(0) { phase_prep(p, lds); }
    SEAM(0);
    PHASE(1) {
        gemm_job<false>(lds, PH(WS_XH), D, PH(WS_WIN), D, T, 1536, D, EHy{PF(WS_SSX), PH(WS_HYT)});
        gemm_job<true>(lds, PH(WS_XH), D, PH(WS_WIN) + (size_t)1536 * D, D, T, 512, D, ELat{PF(WS_SSX), PH(WS_LAT), PF(WS_SSQ), PF(WS_SSKV)});
        gemm_job<true>(lds, PH(WS_MEMH), D, PH(WS_WMKV), D, MROWS, 1024, D, EKc{PF(WS_SSMEM), PH(WS_KC)});
        gemm_job<false>(lds, PH(WS_MEMH), D, PH(WS_WMKV) + (size_t)1024 * D, D, MROWS, 1024, D, EVc{PF(WS_SSMEM), PH(WS_VCT)}, 32);
        phase_filt3(p);
    }
    SEAM(1);
    PHASE(2) {
        gemm_job<true>(lds, PH(WS_LAT), LAT, PH(WS_WUQ), 256, T, 768, 256, EQ{PF(WS_SSQ), PF(WS_ROPE), PH(WS_Q)});
        gemm_job<true>(lds, PH(WS_LAT) + 256, LAT, PH(WS_WUKV), 128, T, 512, 128, EK{PF(WS_SSKV), PH(WS_K)}, 128);
        gemm_job<false>(lds, PH(WS_LAT) + 256, LAT, PH(WS_WUKV) + (size_t)512 * 128, 128, T, 512, 128, EV{PF(WS_SSKV), PH(WS_VT)}, 128);
        phase_krot(p);
    }
    SEAM(2);
    PHASE(3) { phase_attn(p, lds); phase_hyena_naive(p, lds); }
    SEAM(3);
    PHASE(4) { phase_mixprep(p, lds); }
    SEAM(4);
    PHASE(5) { gemm_job<true>(lds, PH(WS_MIX), D, PH(WS_WOUT), D, T, D, D, ERes{p.in[0], p.X, PH(WS_X1H), PF(WS_SSX1)}); }
    SEAM(5);
    PHASE(6) { gemm_job<true>(lds, PH(WS_X1H), D, PH(WS_WMQ), D, T, D, D, EMq{PF(WS_SSX1), PH(WS_QC)}); }
    SEAM(6);
    PHASE(7) { phase_xattn_naive(p, lds); }
    SEAM(7);
    PHASE(8) { gemm_job<true>(lds, PH(WS_QC), D, PH(WS_WMO), D, T, D, D, ERes{p.X, p.X, PH(WS_X2H), nullptr}); }
    SEAM(8);
    PHASE(9) { phase_route(p); }
    SEAM(9);
    PHASE(10) { phase_moe<false>(p, lds); }
    SEAM(10);
    PHASE(11) { phase_moe<true>(p, lds); }
    SEAM(11);
    PHASE(12) { phase_final(p); }
}

extern "C" void kernel_launch(void* const* d_in, const int* in_sizes, int n_in, void* d_out, int out_size, void* d_ws, size_t ws_size, hipStream_t st) {
    Params p{};
    for (int i = 0; i < 36; ++i) p.in[i] = (const float*)d_in[i];
    p.X = (float*)d_out; p.ws = (char*)d_ws;
    static int grid = 0;
    if (!grid) {
        (void)hipFuncSetAttribute((const void*)mega, hipFuncAttributeMaxDynamicSharedMemorySize, LDS_BYTES);
        int dev = 0, cus = 0, per_cu = 0;
        (void)hipGetDevice(&dev);
        (void)hipDeviceGetAttribute(&cus, hipDeviceAttributeMultiprocessorCount, dev);
        (void)hipOccupancyMaxActiveBlocksPerMultiprocessor(&per_cu, (const void*)mega, NTHR, LDS_BYTES);
        if (per_cu < 1) { fprintf(stderr, "kernel_launch: occupancy query says %d blocks/CU\n", per_cu); per_cu = 1; }
        grid = cus;
    }
    int lo = 0, hi = 13;
    void* args[] = {&p, &lo, &hi};
    hipError_t e = hipLaunchCooperativeKernel((const void*)mega, dim3(grid), dim3(NTHR), args, LDS_BYTES, st);
    if (e != hipSuccess) fprintf(stderr, "cooperative launch failed: %s (grid %d)\n", hipGetErrorString(e), grid);
    (void)in_sizes; (void)n_in; (void)out_size; (void)ws_size;
}
```

```cpp
#include <hip/hip_runtime.h>
#include <cstdint>
#include <cstdio>
#include <hip/hip_cooperative_groups.h>
namespace cg = cooperative_groups;
typedef _Float16 h16;

constexpr int NB = 4, S = 4096, D = 1024, T = NB * S, MEMT = 256, MROWS = NB * MEMT;
constexpr int NH = 8, HYW = 512;
constexpr int LAT = 416, INC = 1952;
constexpr int MH = 4, MHD = 256;
constexpr int NE = 32, DE = 256;
constexpr float EPS = 1e-6f;
constexpr float LOG2E = 1.4426950408889634f;
constexpr float QSCALE = 0.10206207261596575f * LOG2E;
constexpr float CSCALE = 0.0625f * LOG2E;

constexpr size_t MiB = 1u << 20;
constexpr size_t WS_CTL = 0;
constexpr size_t WS_SSX = 64 * 1024, WS_SSQ = 128 * 1024, WS_SSKV = 192 * 1024, WS_SSA = 256 * 1024, WS_SSH = 320 * 1024,
                 WS_SSX1 = 384 * 1024, WS_SSX2 = 448 * 1024, WS_SSMEM = 512 * 1024, WS_TOKE = 576 * 1024, WS_TOKW = 704 * 1024,
                 WS_TOKP = 832 * 1024;
constexpr size_t WS_WIN = 2 * MiB, WS_WUQ = 6 * MiB, WS_WUKV = 6 * MiB + 512 * 1024, WS_WOUT = 7 * MiB, WS_WMQ = 9 * MiB,
                 WS_WMKV = 11 * MiB, WS_WMO = 15 * MiB, WS_MEMH = 17 * MiB, WS_KC = 19 * MiB, WS_VCT = 21 * MiB, WS_R = 23 * MiB,
                 WS_WGU = 39 * MiB, WS_WDN = 71 * MiB, WS_LAT = 87 * MiB, WS_HYT = 101 * MiB, WS_XH = 149 * MiB, WS_Q = 149 * MiB,
                 WS_K = 173 * MiB, WS_VT = 197 * MiB, WS_AOUT = 213 * MiB, WS_HT = 229 * MiB, WS_LIST = 245 * MiB, WS_H2 = 247 * MiB;
constexpr size_t WS_MIX = 87 * MiB, WS_X1H = 119 * MiB, WS_QC = 151 * MiB, WS_X2H = 87 * MiB, WS_HB = 119 * MiB, WS_YB = 135 * MiB;

__device__ __forceinline__ float wave_sum(float v) {
#pragma unroll
    for (int o = 1; o < 64; o <<= 1) v += __shfl_xor(v, o);
    return v;
}
__device__ __forceinline__ float rstd_of(float ss, int n) { return 1.0f / sqrtf(ss / (float)n + EPS); }

__global__ __launch_bounds__(256) void k_cvt_rows(const float* x, h16* xh, float* ss, int rows, int n) {
    int row = blockIdx.x * 4 + (threadIdx.x >> 6), lane = threadIdx.x & 63;
    if (row >= rows) return;
    float s = 0.f;
    for (int k = lane; k < n; k += 64) { float v = x[(size_t)row * n + k]; s += v * v; xh[(size_t)row * n + k] = (h16)v; }
    s = wave_sum(s);
    if (lane == 0) ss[row] = s;
}
__global__ void k_wt(const float* W, const float* g, const float* g2, int ksplit, h16* Wt, int K, int N, int Npad) {
    size_t i = (size_t)blockIdx.x * 256 + threadIdx.x;
    if (i >= (size_t)K * Npad) return;
    int n = (int)(i % Npad), k = (int)(i / Npad);
    float v = 0.f;
    if (n < N) v = W[(size_t)k * N + n] * (g ? (k < ksplit ? g[k] : g2[k - ksplit]) : 1.f);
    Wt[(size_t)n * K + k] = (h16)v;
}
__global__ void k_wt_gu(const float* wg, const float* wu, const float* g, h16* Wt) {
    size_t i = (size_t)blockIdx.x * 256 + threadIdx.x;
    if (i >= (size_t)NE * D * DE) return;
    int j = (int)(i % DE), k = (int)((i / DE) % D), e = (int)(i / ((size_t)DE * D));
    int np = 32 * (j >> 4) + (j & 15);
    float gg = g[k];
    Wt[((size_t)e * 512 + np) * D + k] = (h16)(wg[i] * gg);
    Wt[((size_t)e * 512 + np + 16) * D + k] = (h16)(wu[i] * gg);
}
__global__ void k_wt_dn(const float* wd, h16* Wt) {
    size_t i = (size_t)blockIdx.x * 256 + threadIdx.x;
    if (i >= (size_t)NE * DE * D) return;
    int n = (int)(i % D), f = (int)((i / D) % DE), e = (int)(i / ((size_t)D * DE));
    Wt[((size_t)e * D + n) * DE + f] = (h16)wd[i];
}
__global__ __launch_bounds__(64) void k_filt12(const float* w1, const float* b1, const float* freq, const float* w2, const float* b2, float* H2) {
    __shared__ float z[33], h1[64];
    int t = blockIdx.x, j = threadIdx.x;
    if (j < 33) {
        float v;
        if (j == 0) v = (float)t / (float)S;
        else {
            int bi = (j - 1) & 15;
            float band = 1e-4f + (float)bi * ((15.0f - 1e-4f) / 15.0f);
            double rev = (double)t * (double)band / (double)S;
            rev -= floor(rev);
            float r2 = (float)(2.0 * rev);
            v = (j <= 16) ? cospif(r2) : -sinpif(r2);
        }
        z[j] = v;
    }
    __syncthreads();
    float a = b1[j];
    for (int i = 0; i < 33; ++i) a += z[i] * w1[i * 64 + j];
    h1[j] = sinf(freq[j] * a);
    __syncthreads();
    float c = b2[j];
    for (int i = 0; i < 64; ++i) c += h1[i] * w2[i * 64 + j];
    H2[t * 64 + j] = sinf(freq[64 + j] * c);
}
__global__ void k_filt3(const float* H2, const float* w3, const float* b3, const float* decay, h16* R) {
    int i = blockIdx.x * 256 + threadIdx.x;
    int col = i & 2047, tau = i >> 11;
    float a = b3[col];
    for (int j = 0; j < 64; ++j) a += H2[tau * 64 + j] * w3[j * 2048 + col];
    a *= expf(-((float)tau / (float)S) * fabsf(decay[col]));
    int o = col >> 10, dir = (col >> 9) & 1, c = col & 511;
    h16* r = R + ((size_t)(o * 512 + c)) * 8192;
    if (dir == 0) r[4096 - tau] = (h16)a;
    else r[tau == 0 ? 0 : 4096 + tau] = (h16)(tau == 0 ? 0.f : a);
}

template <class Epi>
__global__ __launch_bounds__(256) void k_gemm_naive(const h16* A, int lda, const h16* Wt, int ldw, int M, int N, int K, Epi epi) {
    __shared__ float As[16][65], Bs[16][65];
    int tx = threadIdx.x & 15, ty = threadIdx.x >> 4;
    int m0 = blockIdx.y * 64, n0 = blockIdx.x * 64;
    float acc[4][4];
#pragma unroll
    for (int i = 0; i < 4; ++i)
#pragma unroll
        for (int j = 0; j < 4; ++j) acc[i][j] = 0.f;
    for (int k0 = 0; k0 < K; k0 += 16) {
        for (int i = threadIdx.x; i < 1024; i += 256) {
            int r = i >> 4, c = i & 15, m = m0 + r, n = n0 + r;
            As[c][r] = (m < M) ? (float)A[(size_t)m * lda + k0 + c] : 0.f;
            Bs[c][r] = (n < N) ? (float)Wt[(size_t)n * ldw + k0 + c] : 0.f;
        }
        __syncthreads();
#pragma unroll
        for (int kk = 0; kk < 16; ++kk) {
            float a[4], b[4];
#pragma unroll
            for (int i = 0; i < 4; ++i) { a[i] = As[kk][ty * 4 + i]; b[i] = Bs[kk][tx * 4 + i]; }
#pragma unroll
            for (int i = 0; i < 4; ++i)
#pragma unroll
                for (int j = 0; j < 4; ++j) acc[i][j] += a[i] * b[j];
        }
        __syncthreads();
    }
#pragma unroll
    for (int i = 0; i < 4; ++i)
#pragma unroll
        for (int j = 0; j < 4; ++j) { int m = m0 + ty * 4 + i, n = n0 + tx * 4 + j; if (m < M && n < N) epi(m, n, acc[i][j]); }
}
struct EpiIn { const float* ssx; h16* lat; h16* hyT;
    __device__ void operator()(int m, int n, float v) const {
        v *= rstd_of(ssx[m], D);
        if (n < LAT) lat[(size_t)m * LAT + n] = (h16)v;
        else if (n < INC) { int b = m >> 12, t = m & 4095; hyT[((size_t)(b * 1536 + (n - LAT))) * S + t] = (h16)v; }
    } };
struct EpiQ { const float* ssq; h16* Q;
    __device__ void operator()(int m, int n, float v) const {
        v *= rstd_of(ssq[m], 256) * QSCALE; int b = m >> 12, t = m & 4095, h = n / 96, j = n % 96;
        Q[((size_t)((b * NH + h) * S + t)) * 96 + j] = (h16)v;
    } };
struct EpiKV { const float* sskv; h16* K; h16* Vt;
    __device__ void operator()(int m, int n, float v) const {
        v *= rstd_of(sskv[m], 128); int b = m >> 12, t = m & 4095, h = n >> 7, j = n & 127;
        if (j < 64) K[((size_t)((b * NH + h) * S + t)) * 96 + j] = (h16)v;
        else Vt[((size_t)((b * NH + h) * 64 + (j - 64))) * S + t] = (h16)v;
    } };
struct EpiRes { const float* xin; float* X; h16* xh;
    __device__ void operator()(int m, int n, float v) const {
        size_t i = (size_t)m * D + n; float r = xin[i] + v; X[i] = r; xh[i] = (h16)r;
    } };
struct EpiMq { const float* ss; h16* qc;
    __device__ void operator()(int m, int n, float v) const { qc[(size_t)m * D + n] = (h16)(v * rstd_of(ss[m], D) * CSCALE); } };
struct EpiMkv { const float* ss; h16* Kc; h16* VcT;
    __device__ void operator()(int m, int n, float v) const {
        v *= rstd_of(ss[m], D);
        if (n < D) Kc[(size_t)m * D + n] = (h16)v;
        else { int np = n - D, h = np >> 8, d = np & 255, b = m >> 8, mm = m & 255; VcT[((size_t)((b * MH + h) * MHD + d)) * MEMT + mm] = (h16)v; }
    } };

__global__ __launch_bounds__(256) void k_rowss(const h16* A, int lda, int off, int n, float* ss, int rows) {
    int row = blockIdx.x * 4 + (threadIdx.x >> 6), lane = threadIdx.x & 63;
    if (row >= rows) return;
    float s = 0.f;
    for (int k = lane; k < n; k += 64) { float v = (float)A[(size_t)row * lda + off + k]; s += v * v; }
    s = wave_sum(s);
    if (lane == 0) ss[row] = s;
}
__global__ void k_rope(h16* Q, h16* K, const h16* lat) {
    int i = blockIdx.x * 256 + threadIdx.x;
    if (i >= T * 16) return;
    int m = i >> 4, p = i & 15, b = m >> 12, t = m & 4095;
    float inv = exp2f(-(float)p * (13.287712379549449f / 16.0f));
    float ang = (float)t * inv;
    float sn, cs; sincosf(ang, &sn, &cs);
    float k1 = (float)lat[(size_t)m * LAT + 384 + p], k2 = (float)lat[(size_t)m * LAT + 384 + 16 + p];
    h16 o1 = (h16)(k1 * cs - k2 * sn), o2 = (h16)(k1 * sn + k2 * cs);
    for (int h = 0; h < NH; ++h) {
        size_t base = ((size_t)((b * NH + h) * S + t)) * 96 + 64;
        K[base + p] = o1; K[base + 16 + p] = o2;
        float q1 = (float)Q[base + p], q2 = (float)Q[base + 16 + p];
        Q[base + p] = (h16)(q1 * cs - q2 * sn); Q[base + 16 + p] = (h16)(q1 * sn + q2 * cs);
    }
}
__global__ __launch_bounds__(128) void k_attn_naive(const h16* Q, const h16* K, const h16* Vt, h16* aout) {
    __shared__ float Ks[32][96], Vs[32][64];
    int bh = blockIdx.y, q0 = blockIdx.x * 128, tid = threadIdx.x;
    float q[96], o[64];
#pragma unroll
    for (int d = 0; d < 96; ++d) q[d] = (float)Q[((size_t)bh * S + q0 + tid) * 96 + d];
#pragma unroll
    for (int d = 0; d < 64; ++d) o[d] = 0.f;
    float m = -1e30f, l = 0.f;
    for (int k0 = 0; k0 < S; k0 += 32) {
        __syncthreads();
        for (int i = tid; i < 32 * 96; i += 128) { int r = i / 96, c = i % 96; Ks[r][c] = (float)K[((size_t)bh * S + k0 + r) * 96 + c]; }
        for (int i = tid; i < 32 * 64; i += 128) { int d = i >> 5, r = i & 31; Vs[r][d] = (float)Vt[((size_t)bh * 64 + d) * S + k0 + r]; }
        __syncthreads();
        for (int r = 0; r < 32; ++r) {
            float s = 0.f;
#pragma unroll
            for (int d = 0; d < 96; ++d) s += q[d] * Ks[r][d];
            if (s > m) { float al = exp2f(m - s); l *= al;
#pragma unroll
                for (int d = 0; d < 64; ++d) o[d] *= al;
                m = s; }
            float p = exp2f(s - m); l += p;
#pragma unroll
            for (int d = 0; d < 64; ++d) o[d] += p * Vs[r][d];
        }
    }
    int b = bh >> 3, h = bh & 7; float il = 1.f / l;
#pragma unroll
    for (int d = 0; d < 64; ++d) aout[((size_t)(b * S + q0 + tid)) * 512 + h * 64 + d] = (h16)(o[d] * il);
}
__global__ __launch_bounds__(256) void k_hyena_naive(const h16* hyT, const h16* R, const float* convw, const float* convb, const float* skip, h16* hT) {
    __shared__ float z[4096]; __shared__ float Rl[8192];
    int b = blockIdx.x >> 9, c = blockIdx.x & 511, tid = threadIdx.x;
    auto u3 = [&](int ch, int t) -> float {
        const h16* p = hyT + ((size_t)(b * 1536 + ch)) * S;
        float a = t > 0 ? (float)p[t - 1] : 0.f, bb = (float)p[t], cc = t < S - 1 ? (float)p[t + 1] : 0.f;
        return a * convw[ch] + bb * convw[1536 + ch] + cc * convw[3072 + ch] + convb[ch];
    };
    for (int n = 0; n < 2; ++n) {
        for (int u = tid; u < 8192; u += 256) Rl[u] = (float)R[((size_t)(n * 512 + c)) * 8192 + u];
        if (n == 0) for (int t = tid; t < S; t += 256) z[t] = u3(1024 + c, t);
        __syncthreads();
        float acc[16];
#pragma unroll
        for (int i = 0; i < 16; ++i) acc[i] = 0.f;
        for (int s = 0; s < S; ++s) {
            float zs = z[s];
#pragma unroll
            for (int i = 0; i < 16; ++i) acc[i] += zs * Rl[s - (tid + 256 * i) + 4096];
        }
        __syncthreads();
        float sk = skip[n * 512 + c];
#pragma unroll
        for (int i = 0; i < 16; ++i) {
            int t = tid + 256 * i;
            float zn = u3(n == 0 ? c : 512 + c, t) * (acc[i] + sk * z[t]);
            if (n == 0) z[t] = zn; else hT[((size_t)(b * 512 + c)) * S + t] = (h16)zn;
        }
        __syncthreads();
    }
}
__global__ void k_ss_h(const h16* hT, float* ss) {
    int m = blockIdx.x * 256 + threadIdx.x; int b = m >> 12, t = m & 4095; float s = 0.f;
    for (int c = 0; c < 512; ++c) { float v = (float)hT[((size_t)(b * 512 + c)) * S + t]; s += v * v; }
    ss[m] = s;
}
__global__ void k_mixprep(const h16* aout, const h16* hT, const float* ssa, const float* ssh, h16* mix) {
    size_t i = (size_t)blockIdx.x * 256 + threadIdx.x;
    int m = (int)(i & (T - 1)), k = (int)(i >> 14);
    float v;
    if (k < 512) v = (float)aout[(size_t)m * 512 + k] * rstd_of(ssa[m], 512);
    else { int b = m >> 12, t = m & 4095; v = (float)hT[((size_t)(b * 512 + (k - 512))) * S + t] * rstd_of(ssh[m], 512); }
    mix[(size_t)m * D + k] = (h16)v;
}
__global__ __launch_bounds__(256) void k_xattn_naive(h16* qc, const h16* Kc, const h16* VcT) {
    __shared__ float sc[32][257]; __shared__ float il[32]; __shared__ h16 qs[32][256];
    int bh = blockIdx.y, b = bh >> 2, h = bh & 3, t0 = blockIdx.x * 32, tid = threadIdx.x, wv = tid >> 6, lane = tid & 63;
    for (int i = tid; i < 32 * 256; i += 256) { int tok = i >> 8, d = i & 255; qs[tok][d] = qc[((size_t)(b * S + t0 + tok)) * D + h * MHD + d]; }
    __syncthreads();
    for (int mi = 0; mi < 64; ++mi) {
        int mm = wv * 64 + mi;
        const h16* kp = Kc + ((size_t)(b * MEMT + mm)) * D + h * MHD + lane * 4;
        float k0 = (float)kp[0], k1 = (float)kp[1], k2 = (float)kp[2], k3 = (float)kp[3];
        for (int tok = 0; tok < 32; ++tok) {
            float s = (float)qs[tok][lane * 4] * k0 + (float)qs[tok][lane * 4 + 1] * k1 + (float)qs[tok][lane * 4 + 2] * k2 + (float)qs[tok][lane * 4 + 3] * k3;
            s = wave_sum(s);
            if (lane == 0) sc[tok][mm] = s;
        }
    }
    __syncthreads();
    if (tid < 32) { float mx = -1e30f; for (int j = 0; j < 256; ++j) mx = fmaxf(mx, sc[tid][j]); float l = 0.f;
        for (int j = 0; j < 256; ++j) { float p = exp2f(sc[tid][j] - mx); sc[tid][j] = p; l += p; } il[tid] = 1.f / l; }
    __syncthreads();
    for (int di = 0; di < 64; ++di) {
        int d = wv * 64 + di;
        const h16* vp = VcT + ((size_t)((b * MH + h) * MHD + d)) * MEMT + lane * 4;
        float v0 = (float)vp[0], v1 = (float)vp[1], v2 = (float)vp[2], v3 = (float)vp[3];
        for (int tok = 0; tok < 32; ++tok) {
            float o = sc[tok][lane * 4] * v0 + sc[tok][lane * 4 + 1] * v1 + sc[tok][lane * 4 + 2] * v2 + sc[tok][lane * 4 + 3] * v3;
            o = wave_sum(o);
            if (lane == 0) qc[((size_t)(b * S + t0 + tok)) * D + h * MHD + d] = (h16)(o * il[tok]);
        }
    }
}
__global__ __launch_bounds__(256) void k_route(const float* X, const float* g, const float* wrg, const float* brg, const float* wre, const float* bre,
                                               float* ssx2, int* toke, float* tokw, int* tokp, int* cnt, int* list) {
    int m = blockIdx.x * 4 + (threadIdx.x >> 6), lane = threadIdx.x & 63;
    float xs[16]; float ss = 0.f;
#pragma unroll
    for (int i = 0; i < 16; ++i) { xs[i] = X[(size_t)m * D + lane + 64 * i]; ss += xs[i] * xs[i]; }
    ss = wave_sum(ss);
    float rs = rstd_of(ss, D);
    float lg[36];
#pragma unroll
    for (int j = 0; j < 36; ++j) lg[j] = 0.f;
#pragma unroll
    for (int i = 0; i < 16; ++i) { int k = lane + 64 * i; float tv = xs[i] * rs * g[k];
#pragma unroll
        for (int j = 0; j < 4; ++j) lg[j] += tv * wrg[k * 4 + j];
#pragma unroll
        for (int j = 0; j < 32; ++j) lg[4 + j] += tv * wre[k * 32 + j]; }
#pragma unroll
    for (int j = 0; j < 36; ++j) lg[j] = wave_sum(lg[j]);
    if (lane == 0) {
        ssx2[m] = ss;
        float gl[4]; int gi = 0; float gm = -1e30f;
#pragma unroll
        for (int j = 0; j < 4; ++j) { gl[j] = lg[j] + brg[j]; if (gl[j] > gm) { gm = gl[j]; gi = j; } }
        float gs = 0.f;
#pragma unroll
        for (int j = 0; j < 4; ++j) gs += expf(gl[j] - gm);
        float pg = 1.f / gs;
        float e1 = -1e30f, e2 = -1e30f; int i1 = 0, i2 = 0;
#pragma unroll
        for (int g4 = 0; g4 < 4; ++g4) if (g4 == gi) {
#pragma unroll
            for (int j = 0; j < 8; ++j) { float v = lg[4 + g4 * 8 + j] + bre[g4 * 8 + j];
                if (v > e1) { e2 = e1; i2 = i1; e1 = v; i1 = j; } else if (v > e2) { e2 = v; i2 = j; } } }
        float p2 = 1.f / (1.f + expf(e1 - e2)), p1 = 1.f - p2;
        int ea = gi * 8 + i1, eb = gi * 8 + i2;
        toke[m * 2] = ea; toke[m * 2 + 1] = eb; tokw[m * 2] = pg * p1; tokw[m * 2 + 1] = pg * p2;
        int pa = atomicAdd(&cnt[ea], 1), pb = atomicAdd(&cnt[eb], 1);
        tokp[m * 2] = pa; tokp[m * 2 + 1] = pb; list[ea * T + pa] = m * 2; list[eb * T + pb] = m * 2 + 1;
    }
}
__global__ __launch_bounds__(256) void k_moe_naive(const h16* x2h, const float* ssx2, const int* toke, const float* tokw, const h16* Wgu, const h16* Wdn, h16* yb) {
    __shared__ float mh[DE];
    int m = blockIdx.x, tid = threadIdx.x, wv = tid >> 6, lane = tid & 63;
    float xs[16];
#pragma unroll
    for (int i = 0; i < 16; ++i) xs[i] = (float)x2h[(size_t)m * D + lane + 64 * i];
    float rs = rstd_of(ssx2[m], D);
    for (int sl = 0; sl < 2; ++sl) {
        int e = toke[m * 2 + sl]; float w = tokw[m * 2 + sl];
        for (int ji = 0; ji < 64; ++ji) {
            int j = wv * 64 + ji, np = 32 * (j >> 4) + (j & 15);
            const h16* wgp = Wgu + ((size_t)e * 512 + np) * D; const h16* wup = wgp + (size_t)16 * D;
            float a = 0.f, bb = 0.f;
#pragma unroll
            for (int i = 0; i < 16; ++i) { a += xs[i] * (float)wgp[lane + 64 * i]; bb += xs[i] * (float)wup[lane + 64 * i]; }
            a = wave_sum(a) * rs; bb = wave_sum(bb) * rs;
            if (lane == 0) mh[j] = (float)(h16)(a / (1.f + expf(-a)) * bb * w);
        }
        __syncthreads();
        float m4[4];
#pragma unroll
        for (int i = 0; i < 4; ++i) m4[i] = mh[lane + 64 * i];
        for (int ni = 0; ni < 256; ++ni) {
            int n = wv * 256 + ni; const h16* wd = Wdn + ((size_t)e * D + n) * DE; float y = 0.f;
#pragma unroll
            for (int i = 0; i < 4; ++i) y += m4[i] * (float)wd[lane + 64 * i];
            y = wave_sum(y);
            if (lane == 0) yb[((size_t)(m * 2 + sl)) * D + n] = (h16)y;
        }
        __syncthreads();
    }
}
__global__ __launch_bounds__(256) void k_final(const float* X, const h16* yb, const float* g, float* out) {
    int m = blockIdx.x * 4 + (threadIdx.x >> 6), lane = threadIdx.x & 63;
    float v[16]; float ss = 0.f;
#pragma unroll
    for (int i = 0; i < 16; ++i) { int k = lane + 64 * i;
        v[i] = X[(size_t)m * D + k] + (float)yb[((size_t)m * 2) * D + k] + (float)yb[((size_t)m * 2 + 1) * D + k]; ss += v[i] * v[i]; }
    ss = wave_sum(ss); float rs = rstd_of(ss, D);
#pragma unroll
    for (int i = 0; i < 16; ++i) { int k = lane + 64 * i; out[(size_t)m * D + k] = v[i] * rs * g[k]; }
}


#define LAS __attribute__((address_space(3)))
typedef _Float16 h16x8 __attribute__((ext_vector_type(8)));
typedef _Float16 h16x4 __attribute__((ext_vector_type(4)));
typedef _Float16 h16x2 __attribute__((ext_vector_type(2)));
typedef float f32x4 __attribute__((ext_vector_type(4)));
typedef float f32x16 __attribute__((ext_vector_type(16)));
constexpr int NTHR = 512, NWAVE = 8;
constexpr int LDS_BYTES = 150 * 1024;
constexpr size_t WS_ROPE = 248 * MiB;
constexpr float HY_FSCALE = 256.f, HY_FINV = 1.f / 256.f;

struct Params {
    const float* in[36]; float* X; char* ws;
};
#define PF(off) ((float*)(p.ws + (off)))
#define PH(off) ((h16*)(p.ws + (off)))
#define PI(off) ((int*)(p.ws + (off)))

constexpr int G_BM = 256, G_BN = 128, G_BK = 64, G_AB = G_BM * G_BK * 2, G_BB = G_BN * G_BK * 2, G_STAGE = G_AB + G_BB;
static_assert(3 * G_STAGE <= LDS_BYTES, "lds");
__device__ __forceinline__ void glds16(const void* g, LAS char* l) { __builtin_amdgcn_global_load_lds((const unsigned*)g, (LAS unsigned*)l, 16, 0, 0); }

template <bool SWAP, class RowPtr, class Epi>
__device__ __forceinline__ void gemm_tile(LAS char* lds, const RowPtr& rowptr, const h16* __restrict__ Wt, int ldw, int K, int m0, int n0, const Epi& epi) {
    const int tid = threadIdx.x, lane = tid & 63, wid = __builtin_amdgcn_readfirstlane(tid >> 6);
    const int wm = wid >> 1, wn = wid & 1, fr = lane & 15, fq = lane >> 4;
    const h16* asrc[4]; const h16* bsrc[2];
#pragma unroll
    for (int i = 0; i < 4; ++i) { const int r = wid * 32 + i * 8 + (lane >> 3); const int ch = (lane & 7) ^ ((r >> 1) & 7); asrc[i] = rowptr(m0 + r) + ch * 8; }
#pragma unroll
    for (int i = 0; i < 2; ++i) { const int r = wid * 16 + i * 8 + (lane >> 3); const int ch = (lane & 7) ^ ((r >> 1) & 7); bsrc[i] = Wt + (size_t)(n0 + r) * ldw + ch * 8; }
    const int sw = fr >> 1;
    const int aoff = (wm * 64 + fr) * 128 + ((fq ^ sw) * 16);
    const int boff = G_AB + (wn * 64 + fr) * 128 + ((fq ^ sw) * 16);
    f32x4 acc[4][4];
#pragma unroll
    for (int i = 0; i < 4; ++i)
#pragma unroll
        for (int j = 0; j < 4; ++j) acc[i][j] = (f32x4){0.f, 0.f, 0.f, 0.f};
    const int nt = K / G_BK;
    asm volatile("s_waitcnt vmcnt(0)" ::: "memory");
#define G_STAGE_ISSUE(buf, kt) do { LAS char* sa_ = lds + (buf) * G_STAGE + wid * 4096; \
        _Pragma("unroll") for (int i_ = 0; i_ < 4; ++i_) glds16(asrc[i_] + (kt) * G_BK, sa_ + i_ * 1024); \
        LAS char* sb_ = lds + (buf) * G_STAGE + G_AB + wid * 2048; \
        _Pragma("unroll") for (int i_ = 0; i_ < 2; ++i_) glds16(bsrc[i_] + (kt) * G_BK, sb_ + i_ * 1024); } while (0)
    G_STAGE_ISSUE(0, 0);
    if (nt > 1) G_STAGE_ISSUE(1, 1);
    int buf = 0;
    for (int t = 0; t < nt; ++t) {
        if (t + 1 < nt) asm volatile("s_waitcnt vmcnt(6)" ::: "memory"); else asm volatile("s_waitcnt vmcnt(0)" ::: "memory");
        __builtin_amdgcn_s_barrier();
        if (t + 2 < nt) { const int nb_ = buf >= 1 ? buf - 1 : 2; G_STAGE_ISSUE(nb_, t + 2); }
        LAS char* base = lds + buf * G_STAGE;
#pragma unroll
        for (int kk = 0; kk < 2; ++kk) {
            h16x8 a[4], b[4];
#pragma unroll
            for (int i = 0; i < 4; ++i) { a[i] = *(LAS h16x8*)(base + ((aoff ^ (kk * 64)) + i * 2048)); b[i] = *(LAS h16x8*)(base + ((boff ^ (kk * 64)) + i * 2048)); }
#pragma unroll
            for (int i = 0; i < 4; ++i)
#pragma unroll
                for (int j = 0; j < 4; ++j)
                    acc[i][j] = SWAP ? __builtin_amdgcn_mfma_f32_16x16x32_f16(b[j], a[i], acc[i][j], 0, 0, 0)
                                     : __builtin_amdgcn_mfma_f32_16x16x32_f16(a[i], b[j], acc[i][j], 0, 0, 0);
        }
        buf = buf == 2 ? 0 : buf + 1;
    }
#undef G_STAGE_ISSUE
    asm volatile("s_waitcnt lgkmcnt(0)" ::: "memory");
    __builtin_amdgcn_s_barrier();
    if constexpr (SWAP) {
#pragma unroll
        for (int i = 0; i < 4; ++i)
#pragma unroll
            for (int jp = 0; jp < 2; ++jp) epi.row32(m0 + wm * 64 + i * 16 + fr, n0 + wn * 64 + jp * 32 + fq * 4, acc[i][2 * jp], acc[i][2 * jp + 1]);
    } else {
#pragma unroll
        for (int i = 0; i < 4; ++i)
#pragma unroll
            for (int j = 0; j < 4; ++j) epi.col4(m0 + wm * 64 + i * 16 + fq * 4, n0 + wn * 64 + j * 16 + fr, acc[i][j]);
    }
}
struct RowDense { const h16* A; int lda; __device__ __forceinline__ const h16* operator()(int m) const { return A + (size_t)m * lda; } };

__device__ __forceinline__ h16x4 cvt4(f32x4 v) { return (h16x4){(h16)v[0], (h16)v[1], (h16)v[2], (h16)v[3]}; }
__device__ __forceinline__ float rowgrp_sum(float v) { v += __shfl_xor(v, 16); v += __shfl_xor(v, 32); return v; }

struct EHy {
    const float* ssx; h16* hyT;
    __device__ __forceinline__ void col4(int mr, int n, f32x4 v) const {
        const f32x4 ss = *(const f32x4*)(ssx + mr);
        v[0] *= rstd_of(ss[0], D); v[1] *= rstd_of(ss[1], D); v[2] *= rstd_of(ss[2], D); v[3] *= rstd_of(ss[3], D);
        const int b = mr >> 12, t = mr & 4095;
        *(h16x4*)(hyT + ((size_t)(b * 1536 + n)) * S + t) = cvt4(v);
    } };
struct ELat {
    const float* ssx; h16* lat; float* ssq; float* sskv;
    __device__ __forceinline__ void row32(int m, int nb, f32x4 va, f32x4 vb) const {
        const float r = rstd_of(ssx[m], D); va *= r; vb *= r;
        if (nb < LAT) { *(h16x4*)(lat + (size_t)m * LAT + nb) = cvt4(va); *(h16x4*)(lat + (size_t)m * LAT + nb + 16) = cvt4(vb); }
        float s = va[0] * va[0] + va[1] * va[1] + va[2] * va[2] + va[3] * va[3] + vb[0] * vb[0] + vb[1] * vb[1] + vb[2] * vb[2] + vb[3] * vb[3];
        s = rowgrp_sum(s);
        if ((threadIdx.x & 63) < 16 && nb < 384) atomicAdd((nb < 256 ? ssq : sskv) + m, s);
    } };
struct EQ {
    const float* ssq; const float* rope; h16* Q;
    __device__ __forceinline__ void row32(int m, int nb, f32x4 va, f32x4 vb) const {
        const float r = rstd_of(ssq[m], 256) * QSCALE; va *= r; vb *= r;
        const int b = m >> 12, t = m & 4095, blk = nb >> 5, h = blk / 3, part = blk - 3 * h, c = nb & 31;
        if (part == 2) {
            const float* rp = rope + ((size_t)t * 16 + c) * 2;
#pragma unroll
            for (int j = 0; j < 4; ++j) { const float cs = rp[2 * j], sn = rp[2 * j + 1]; const float q1 = va[j], q2 = vb[j]; va[j] = q1 * cs - q2 * sn; vb[j] = q1 * sn + q2 * cs; }
        }
        h16* q = Q + ((size_t)((b * NH + h) * S + t)) * 96 + part * 32 + c;
        *(h16x4*)q = cvt4(va); *(h16x4*)(q + 16) = cvt4(vb);
    } };
struct EK {
    const float* sskv; h16* K;
    __device__ __forceinline__ void row32(int m, int nb, f32x4 va, f32x4 vb) const {
        const float r = rstd_of(sskv[m], 128); va *= r; vb *= r;
        const int b = m >> 12, t = m & 4095, h = nb >> 6, j = nb & 63;
        h16* k = K + ((size_t)((b * NH + h) * S + t)) * 96 + j;
        *(h16x4*)k = cvt4(va); *(h16x4*)(k + 16) = cvt4(vb);
    } };
struct EV {
    const float* sskv; h16* Vt;
    __device__ __forceinline__ void col4(int mr, int n, f32x4 v) const {
        const f32x4 ss = *(const f32x4*)(sskv + mr);
        v[0] *= rstd_of(ss[0], 128); v[1] *= rstd_of(ss[1], 128); v[2] *= rstd_of(ss[2], 128); v[3] *= rstd_of(ss[3], 128);
        const int b = mr >> 12, t = mr & 4095;
        *(h16x4*)(Vt + ((size_t)(b * 512 + n)) * S + t) = cvt4(v);
    } };
struct EKc {
    const float* ss; h16* Kc;
    __device__ __forceinline__ void row32(int m, int nb, f32x4 va, f32x4 vb) const {
        const float r = rstd_of(ss[m], D); va *= r; vb *= r;
        *(h16x4*)(Kc + (size_t)m * D + nb) = cvt4(va); *(h16x4*)(Kc + (size_t)m * D + nb + 16) = cvt4(vb);
    } };
struct EVc {
    const float* ss; h16* VcT;
    __device__ __forceinline__ void col4(int mr, int n, f32x4 v) const {
        const f32x4 s4 = *(const f32x4*)(ss + mr);
        v[0] *= rstd_of(s4[0], D); v[1] *= rstd_of(s4[1], D); v[2] *= rstd_of(s4[2], D); v[3] *= rstd_of(s4[3], D);
        const int b = mr >> 8, mm = mr & 255;
        *(h16x4*)(VcT + ((size_t)(b * 1024 + n)) * MEMT + mm) = cvt4(v);
    } };
struct ERes {
    const float* xin; float* X; h16* xh; float* ss;
    __device__ __forceinline__ void row32(int m, int nb, f32x4 va, f32x4 vb) const {
        const size_t i = (size_t)m * D + nb;
        va += *(const f32x4*)(xin + i); vb += *(const f32x4*)(xin + i + 16);
        *(f32x4*)(X + i) = va; *(f32x4*)(X + i + 16) = vb;
        *(h16x4*)(xh + i) = cvt4(va); *(h16x4*)(xh + i + 16) = cvt4(vb);
        float s = va[0] * va[0] + va[1] * va[1] + va[2] * va[2] + va[3] * va[3] + vb[0] * vb[0] + vb[1] * vb[1] + vb[2] * vb[2] + vb[3] * vb[3];
        s = rowgrp_sum(s);
        if (ss && (threadIdx.x & 63) < 16) atomicAdd(ss + m, s);
    } };
struct EMq {
    const float* ss; h16* qc;
    __device__ __forceinline__ void row32(int m, int nb, f32x4 va, f32x4 vb) const {
        const float r = rstd_of(ss[m], D) * CSCALE; va *= r; vb *= r;
        *(h16x4*)(qc + (size_t)m * D + nb) = cvt4(va); *(h16x4*)(qc + (size_t)m * D + nb + 16) = cvt4(vb);
    } };

template <bool SWAP, class Epi>
__device__ __forceinline__ void gemm_job(LAS char* lds, const h16* A, int lda, const h16* Wt, int ldw, int M, int N, int K, const Epi& epi, int first = 0) {
    const int ntn = N / G_BN, ntiles = (M / G_BM) * ntn;
    const RowDense rp{A, lda};
    const int G = gridDim.x, bx = blockIdx.x, vid = (G % 8 == 0) ? (bx % 8) * (G / 8) + bx / 8 : bx;
    for (int tix = (vid + G - first % G) % G; tix < ntiles; tix += G) {
        const int mt = tix / ntn, nt_ = tix - mt * ntn;
        gemm_tile<SWAP>(lds, rp, Wt, ldw, K, mt * G_BM, nt_ * G_BN, epi);
    }
}

template <class RowMap, class Gain>
__device__ __forceinline__ void wt_item(const float* W, int N, int K, h16* Wt, LAS float* scr, int k0, int n0, int lane, const RowMap& rowmap, const Gain& gain) {
#pragma unroll 8
    for (int i = 0; i < 32; ++i) { const int kk = 2 * i + (lane >> 5); scr[kk * 33 + (lane & 31)] = W[(size_t)(k0 + kk) * N + n0 + (lane & 31)] * gain(k0 + kk); }
    asm volatile("s_waitcnt lgkmcnt(0)" ::: "memory");
    const int c = lane & 7;
#pragma unroll
    for (int j = 0; j < 4; ++j) { const int n = (lane >> 3) + 8 * j; const LAS float* s = scr + (8 * c) * 33 + n;
        h16x8 o = {(h16)s[0], (h16)s[33], (h16)s[66], (h16)s[99], (h16)s[132], (h16)s[165], (h16)s[198], (h16)s[231]};
        *(h16x8*)(Wt + (size_t)rowmap(n0 + n) * K + k0 + 8 * c) = o; }
    asm volatile("s_waitcnt lgkmcnt(0)" ::: "memory");
}
struct GainNone { __device__ __forceinline__ float operator()(int) const { return 1.f; } };
struct Gain1 { const float* g; __device__ __forceinline__ float operator()(int k) const { return g[k]; } };
struct Gain2 { const float* g; const float* g2; __device__ __forceinline__ float operator()(int k) const { return k < 512 ? g[k] : g2[k - 512]; } };
struct MapId { __device__ __forceinline__ int operator()(int n) const { return n; } };
struct MapIn { __device__ __forceinline__ int operator()(int n) const { return n < LAT ? 1536 + n : n - LAT; } };
struct MapKV { __device__ __forceinline__ int operator()(int n) const { const int h = n >> 7, j = n & 127; return j < 64 ? h * 64 + j : 512 + h * 64 + (j - 64); } };
struct MapG { int up; __device__ __forceinline__ int operator()(int j) const { return 32 * (j >> 4) + (j & 15) + up; } };

__device__ __forceinline__ void phase_prep(const Params& p, LAS char* lds) {
    const int tid = threadIdx.x, lane = tid & 63, wid = tid >> 6;
    const int gw = blockIdx.x * NWAVE + wid, NGW = gridDim.x * NWAVE, gt = blockIdx.x * NTHR + tid, NGT = gridDim.x * NTHR;
    LAS float* scr = (LAS float*)(lds + wid * 16384);
    for (int i = gt; i < 5 * 16384; i += NGT) PF(WS_SSQ)[i] = 0.f;
    for (int i = gt; i < 1024; i += NGT) PI(WS_CTL)[i] = 0;
    for (int row = gw; row < T + MROWS; row += NGW) {
        const bool isx = row < T; const int r = isx ? row : row - T;
        const f32x4* src = (const f32x4*)((isx ? p.in[0] : p.in[1]) + (size_t)r * D) + lane;
        h16* dst = (isx ? PH(WS_XH) : PH(WS_MEMH)) + (size_t)r * D;
        float s = 0.f;
#pragma unroll
        for (int j = 0; j < 4; ++j) { const f32x4 v = src[64 * j]; s += v[0] * v[0] + v[1] * v[1] + v[2] * v[2] + v[3] * v[3]; *(h16x4*)(dst + (lane + 64 * j) * 4) = cvt4(v); }
        s = wave_sum(s);
        if (lane == 0) (isx ? PF(WS_SSX) : PF(WS_SSMEM))[r] = s;
    }
    {
        constexpr int I_IN = 16 * 61, I_UQ = 4 * 24, I_UKV = 2 * 32, I_SQ = 16 * 32, I_MKV = 16 * 64, I_EX = 16 * 8, I_DN = 4 * 32;
        constexpr int NIT = I_IN + I_UQ + I_UKV + 3 * I_SQ + I_MKV + NE * (2 * I_EX + I_DN);
        for (int it = gw; it < NIT; it += NGW) {
            int r = it;
            if (r < I_IN) { wt_item(p.in[3], INC, D, PH(WS_WIN), scr, (r / 61) * 64, (r % 61) * 32, lane, MapIn{}, Gain1{p.in[2]}); continue; } r -= I_IN;
            if (r < I_UQ) { wt_item(p.in[6], 768, 256, PH(WS_WUQ), scr, (r / 24) * 64, (r % 24) * 32, lane, MapId{}, Gain1{p.in[4]}); continue; } r -= I_UQ;
            if (r < I_UKV) { wt_item(p.in[7], 1024, 128, PH(WS_WUKV), scr, (r / 32) * 64, (r % 32) * 32, lane, MapKV{}, Gain1{p.in[5]}); continue; } r -= I_UKV;
            if (r < I_SQ) { wt_item(p.in[21], D, D, PH(WS_WOUT), scr, (r / 32) * 64, (r % 32) * 32, lane, MapId{}, Gain2{p.in[19], p.in[20]}); continue; } r -= I_SQ;
            if (r < I_SQ) { wt_item(p.in[24], D, D, PH(WS_WMQ), scr, (r / 32) * 64, (r % 32) * 32, lane, MapId{}, Gain1{p.in[22]}); continue; } r -= I_SQ;
            if (r < I_SQ) { wt_item(p.in[26], D, D, PH(WS_WMO), scr, (r / 32) * 64, (r % 32) * 32, lane, MapId{}, GainNone{}); continue; } r -= I_SQ;
            if (r < I_MKV) { wt_item(p.in[25], 2048, D, PH(WS_WMKV), scr, (r / 64) * 64, (r % 64) * 32, lane, MapId{}, Gain1{p.in[23]}); continue; } r -= I_MKV;
            const int e = r / (2 * I_EX + I_DN); r -= e * (2 * I_EX + I_DN);
            if (r < I_EX) { wt_item(p.in[32] + (size_t)e * D * DE, DE, D, PH(WS_WGU) + (size_t)e * 512 * D, scr, (r / 8) * 64, (r % 8) * 32, lane, MapG{0}, Gain1{p.in[27]}); continue; } r -= I_EX;
            if (r < I_EX) { wt_item(p.in[33] + (size_t)e * D * DE, DE, D, PH(WS_WGU) + (size_t)e * 512 * D, scr, (r / 8) * 64, (r % 8) * 32, lane, MapG{16}, Gain1{p.in[27]}); continue; } r -= I_EX;
            wt_item(p.in[34] + (size_t)e * DE * D, D, DE, PH(WS_WDN) + (size_t)e * D * DE, scr, (r / 32) * 64, (r % 32) * 32, lane, MapId{}, GainNone{});
        }
        for (int i = gt; i < 96 * D / 8; i += NGT) *(h16x8*)(PH(WS_WIN) + (size_t)INC * D + (size_t)i * 8) = (h16x8){0, 0, 0, 0, 0, 0, 0, 0};
    }
    for (int i = gt; i < S * 16; i += NGT) { const int t = i >> 4, pp = i & 15; const float inv = exp2f(-(float)pp * (13.287712379549449f / 16.0f)); float sn, cs; sincosf((float)t * inv, &sn, &cs);
        PF(WS_ROPE)[2 * i] = cs; PF(WS_ROPE)[2 * i + 1] = sn; }
    {
        LAS float* zf = scr; LAS float* h1 = scr + 64;
        const float* w1 = p.in[10]; const float* b1 = p.in[11]; const float* freq = p.in[12]; const float* w2 = p.in[13]; const float* b2 = p.in[14];
        for (int t = gw; t < S; t += NGW) {
            const int j = lane;
            if (j < 33) { float v;
                if (j == 0) v = (float)t / (float)S;
                else { const int bi = (j - 1) & 15; const float band = 1e-4f + (float)bi * ((15.0f - 1e-4f) / 15.0f);
                    double rev = (double)t * (double)band / (double)S; rev -= floor(rev); const float r2 = (float)(2.0 * rev);
                    v = (j <= 16) ? cospif(r2) : -sinpif(r2); }
                zf[j] = v; }
            asm volatile("s_waitcnt lgkmcnt(0)" ::: "memory");
            float a = b1[j];
            for (int i = 0; i < 33; ++i) a += zf[i] * w1[i * 64 + j];
            h1[j] = sinf(freq[j] * a);
            asm volatile("s_waitcnt lgkmcnt(0)" ::: "memory");
            float c = b2[j];
            for (int i = 0; i < 64; ++i) c += h1[i] * w2[i * 64 + j];
            PF(WS_H2)[t * 64 + j] = sinf(freq[64 + j] * c);
            asm volatile("s_waitcnt lgkmcnt(0)" ::: "memory");
        }
    }
}
__device__ __forceinline__ void phase_filt3(const Params& p) {
    const int gt = blockIdx.x * NTHR + threadIdx.x, NGT = gridDim.x * NTHR;
    const float* H2 = PF(WS_H2); const float* w3 = p.in[15]; const float* b3 = p.in[16]; const float* decay = p.in[17]; h16* R = PH(WS_R);
    for (int i = gt; i < S * 2048; i += NGT) {
        const int col = i & 2047, tau = i >> 11;
        float a = b3[col];
#pragma unroll 8
        for (int j = 0; j < 64; ++j) a += H2[tau * 64 + j] * w3[j * 2048 + col];
        a *= HY_FSCALE * expf(-((float)tau / (float)S) * fabsf(decay[col]));
        const int o = col >> 10, dir = (col >> 9) & 1, c = col & 511;
        h16* r = R + ((size_t)(o * 512 + c)) * 8192;
        if (dir == 0) r[4096 - tau] = (h16)a;
        else r[tau == 0 ? 0 : 4096 + tau] = (h16)(tau == 0 ? 0.f : a);
    }
}
__device__ __forceinline__ void phase_krot(const Params& p) {
    const int gt = blockIdx.x * NTHR + threadIdx.x, NGT = gridDim.x * NTHR;
    const h16* lat = PH(WS_LAT); h16* K = PH(WS_K); const float* rope = PF(WS_ROPE);
    for (int i = gt; i < T * 4; i += NGT) {
        const int m = i >> 2, p0 = (i & 3) * 4, b = m >> 12, t = m & 4095;
        const h16x4 k1 = *(const h16x4*)(lat + (size_t)m * LAT + 384 + p0), k2 = *(const h16x4*)(lat + (size_t)m * LAT + 400 + p0);
        h16x4 o1, o2;
#pragma unroll
        for (int j = 0; j < 4; ++j) { const float cs = rope[((size_t)t * 16 + p0 + j) * 2], sn = rope[((size_t)t * 16 + p0 + j) * 2 + 1];
            const float a = (float)k1[j], c = (float)k2[j]; o1[j] = (h16)(a * cs - c * sn); o2[j] = (h16)(a * sn + c * cs); }
#pragma unroll
        for (int h = 0; h < NH; ++h) { h16* kp = K + ((size_t)((b * NH + h) * S + t)) * 96 + 64 + p0; *(h16x4*)kp = o1; *(h16x4*)(kp + 16) = o2; }
    }
}


__device__ __forceinline__ void phase_attn_naive(const Params& p, LAS char* lds) {
    LAS float* Ks = (LAS float*)lds; LAS float* Vs = Ks + 32 * 96;
    const h16* Q = PH(WS_Q); const h16* K = PH(WS_K); const h16* Vt = PH(WS_VT); h16* aout = PH(WS_AOUT);
    const int tid = threadIdx.x;
    for (int u = blockIdx.x; u < NB * NH * (S / 512); u += gridDim.x) {
        const int bh = u >> 3, q0 = (u & 7) * 512;
        float q[96], o[64];
#pragma unroll
        for (int d = 0; d < 96; ++d) q[d] = (float)Q[((size_t)bh * S + q0 + tid) * 96 + d];
#pragma unroll
        for (int d = 0; d < 64; ++d) o[d] = 0.f;
        float m = -1e30f, l = 0.f;
        for (int k0 = 0; k0 < S; k0 += 32) {
            __syncthreads();
            for (int i = tid; i < 32 * 96; i += NTHR) Ks[i] = (float)K[((size_t)bh * S + k0) * 96 + i];
            for (int i = tid; i < 32 * 64; i += NTHR) { const int d = i >> 5, r = i & 31; Vs[r * 64 + d] = (float)Vt[((size_t)bh * 64 + d) * S + k0 + r]; }
            __syncthreads();
            for (int r = 0; r < 32; ++r) {
                float sc = 0.f;
#pragma unroll
                for (int d = 0; d < 96; ++d) sc += q[d] * Ks[r * 96 + d];
                if (sc > m) { const float al = exp2f(m - sc); l *= al;
#pragma unroll
                    for (int d = 0; d < 64; ++d) o[d] *= al;
                    m = sc; }
                const float pp = exp2f(sc - m); l += pp;
#pragma unroll
                for (int d = 0; d < 64; ++d) o[d] += pp * Vs[r * 64 + d];
            }
        }
        const int b = bh >> 3, h = bh & 7; const float il = 1.f / l;
#pragma unroll
        for (int d = 0; d < 64; ++d) aout[((size_t)(b * S + q0 + tid)) * 512 + h * 64 + d] = (h16)(o[d] * il);
    }
    __syncthreads();
}
constexpr int AT_KROW = 208, AT_VROW = 136, AT_KB = 64 * AT_KROW, AT_VB = 64 * AT_VROW, AT_BUF = AT_KB + AT_VB;
__device__ __forceinline__ void phase_attn(const Params& p, LAS char* lds) {
    const int tid = threadIdx.x, lane = tid & 63, wid = __builtin_amdgcn_readfirstlane(tid >> 6), r32 = lane & 31, hi = lane >> 5;
    const h16* Qg = PH(WS_Q); const h16* Kg = PH(WS_K); const h16* Vtg = PH(WS_VT); h16* aout = PH(WS_AOUT);
    const int k0r = tid / 12, k0c = tid - 12 * k0r, c1 = tid + 512, k1r = c1 / 12, k1c = c1 - 12 * k1r;
    const int vdv = tid >> 3, vc = tid & 7;
    const int G = gridDim.x, bx = blockIdx.x, vid = (G % 8 == 0) ? (bx % 8) * (G / 8) + bx / 8 : bx;
    for (int u = vid; u < NB * NH * 16; u += G) {
        const int bh = u >> 4, q0 = (u & 15) * 256 + wid * 32;
        h16x8 qf[6];
        { const h16* qp = Qg + ((size_t)bh * S + q0 + r32) * 96 + 8 * hi;
#pragma unroll
          for (int s_ = 0; s_ < 6; ++s_) qf[s_] = *(const h16x8*)(qp + 16 * s_); }
        const h16* Kb = Kg + (size_t)bh * S * 96; const h16* Vb = Vtg + (size_t)bh * 64 * S + (size_t)vdv * S + vc * 8;
        h16x8 kr0, kr1, vr;
        kr0 = *(const h16x8*)(Kb + tid * 8); kr1 = kr0; if (tid < 256) kr1 = *(const h16x8*)(Kb + c1 * 8); vr = *(const h16x8*)(Vb);
        __syncthreads();
        { *(LAS h16x8*)(lds + k0r * AT_KROW + k0c * 16) = kr0; if (tid < 256) *(LAS h16x8*)(lds + k1r * AT_KROW + k1c * 16) = kr1;
          LAS char* vn = lds + AT_KB + vdv * AT_VROW + vc * 16; *(LAS h16x4*)vn = (h16x4){vr[0], vr[1], vr[2], vr[3]}; *(LAS h16x4*)(vn + 8) = (h16x4){vr[4], vr[5], vr[6], vr[7]}; }
        __syncthreads();
        f32x16 o0, o1;
#pragma unroll
        for (int r = 0; r < 16; ++r) { o0[r] = 0.f; o1[r] = 0.f; }
        float m = -1e30f, l = 0.f;
        for (int t = 0; t < S / 64; ++t) {
            if (t + 1 < S / 64) {
                const h16* kn = Kb + (size_t)(t + 1) * 64 * 96;
                kr0 = *(const h16x8*)(kn + tid * 8); if (tid < 256) kr1 = *(const h16x8*)(kn + c1 * 8); vr = *(const h16x8*)(Vb + (t + 1) * 64);
            }
            LAS char* kb = lds + (t & 1) * AT_BUF; LAS char* vb = kb + AT_KB;
            f32x16 p0, p1;
#pragma unroll
            for (int r = 0; r < 16; ++r) { p0[r] = 0.f; p1[r] = 0.f; }
#pragma unroll
            for (int s_ = 0; s_ < 6; ++s_) {
                const h16x8 a0 = *(LAS h16x8*)(kb + r32 * AT_KROW + s_ * 32 + hi * 16);
                const h16x8 a1 = *(LAS h16x8*)(kb + (32 + r32) * AT_KROW + s_ * 32 + hi * 16);
                p0 = __builtin_amdgcn_mfma_f32_32x32x16_f16(a0, qf[s_], p0, 0, 0, 0);
                p1 = __builtin_amdgcn_mfma_f32_32x32x16_f16(a1, qf[s_], p1, 0, 0, 0);
            }
            float mx = fmaxf(p0[0], p1[0]);
#pragma unroll
            for (int r = 1; r < 16; ++r) mx = fmaxf(mx, fmaxf(p0[r], p1[r]));
            mx = fmaxf(mx, __shfl_xor(mx, 32));
            const float mn = fmaxf(m, mx), al = __builtin_amdgcn_exp2f(m - mn); m = mn;
            float rs = 0.f;
#pragma unroll
            for (int r = 0; r < 16; ++r) { p0[r] = __builtin_amdgcn_exp2f(p0[r] - mn); p1[r] = __builtin_amdgcn_exp2f(p1[r] - mn); rs += p0[r] + p1[r]; }
            l = l * al + rs;
#pragma unroll
            for (int r = 0; r < 16; ++r) { o0[r] *= al; o1[r] *= al; }
            h16x8 pf[2][2];
#pragma unroll
            for (int j = 0; j < 8; ++j) { pf[0][0][j] = (h16)p0[j]; pf[0][1][j] = (h16)p0[8 + j]; pf[1][0][j] = (h16)p1[j]; pf[1][1][j] = (h16)p1[8 + j]; }
#pragma unroll
            for (int kh = 0; kh < 2; ++kh)
#pragma unroll
                for (int s_ = 0; s_ < 2; ++s_) {
                    LAS char* v0 = vb + r32 * AT_VROW + (kh * 32 + 16 * s_ + 4 * hi) * 2;
                    const h16x4 a = *(LAS h16x4*)v0, b = *(LAS h16x4*)(v0 + 16);
                    const h16x4 c = *(LAS h16x4*)(v0 + 32 * AT_VROW), d = *(LAS h16x4*)(v0 + 32 * AT_VROW + 16);
                    const h16x8 vf0 = {a[0], a[1], a[2], a[3], b[0], b[1], b[2], b[3]}, vf1 = {c[0], c[1], c[2], c[3], d[0], d[1], d[2], d[3]};
                    o0 = __builtin_amdgcn_mfma_f32_32x32x16_f16(vf0, pf[kh][s_], o0, 0, 0, 0);
                    o1 = __builtin_amdgcn_mfma_f32_32x32x16_f16(vf1, pf[kh][s_], o1, 0, 0, 0);
                }
            if (t + 1 < S / 64) {
                LAS char* kn = lds + ((t + 1) & 1) * AT_BUF;
                *(LAS h16x8*)(kn + k0r * AT_KROW + k0c * 16) = kr0; if (tid < 256) *(LAS h16x8*)(kn + k1r * AT_KROW + k1c * 16) = kr1;
                LAS char* vn = kn + AT_KB + vdv * AT_VROW + vc * 16; *(LAS h16x4*)vn = (h16x4){vr[0], vr[1], vr[2], vr[3]}; *(LAS h16x4*)(vn + 8) = (h16x4){vr[4], vr[5], vr[6], vr[7]};
            }
            __syncthreads();
        }
        const float il = 1.f / (l + __shfl_xor(l, 32));
        const int b = bh >> 3, h = bh & 7;
        h16* ap = aout + ((size_t)(b * S + q0 + r32)) * 512 + h * 64 + 4 * hi;
#pragma unroll
        for (int g = 0; g < 4; ++g) {
            *(h16x4*)(ap + 8 * g) = (h16x4){(h16)(o0[4 * g] * il), (h16)(o0[4 * g + 1] * il), (h16)(o0[4 * g + 2] * il), (h16)(o0[4 * g + 3] * il)};
            *(h16x4*)(ap + 32 + 8 * g) = (h16x4){(h16)(o1[4 * g] * il), (h16)(o1[4 * g + 1] * il), (h16)(o1[4 * g + 2] * il), (h16)(o1[4 * g + 3] * il)};
        }
    }
    __syncthreads();
}
__device__ __forceinline__ void phase_hyena_naive(const Params& p, LAS char* lds) {
    LAS float* z = (LAS float*)lds; LAS float* Rl = z + 4096;
    const h16* hyT = PH(WS_HYT); const h16* R = PH(WS_R); const float* convw = p.in[8]; const float* convb = p.in[9]; const float* skip = p.in[18]; h16* hT = PH(WS_HT);
    const int tid = threadIdx.x;
    for (int u = blockIdx.x; u < NB * HYW; u += gridDim.x) {
        const int b = u >> 9, c = u & 511;
        auto u3 = [&](int ch, int t) -> float {
            const h16* pp = hyT + ((size_t)(b * 1536 + ch)) * S;
            const float a = t > 0 ? (float)pp[t - 1] : 0.f, bb = (float)pp[t], cc = t < S - 1 ? (float)pp[t + 1] : 0.f;
            return a * convw[ch] + bb * convw[1536 + ch] + cc * convw[3072 + ch] + convb[ch];
        };
        for (int n = 0; n < 2; ++n) {
            for (int uu = tid; uu < 8192; uu += NTHR) Rl[uu] = (float)R[((size_t)(n * 512 + c)) * 8192 + uu];
            if (n == 0) for (int t = tid; t < S; t += NTHR) z[t] = u3(1024 + c, t);
            __syncthreads();
            float acc[8];
#pragma unroll
            for (int i = 0; i < 8; ++i) acc[i] = 0.f;
            for (int s_ = 0; s_ < S; ++s_) {
                const float zs = z[s_];
#pragma unroll
                for (int i = 0; i < 8; ++i) acc[i] += zs * Rl[s_ - (tid + 512 * i) + 4096];
            }
            __syncthreads();
            const float sk = skip[n * 512 + c];
#pragma unroll
            for (int i = 0; i < 8; ++i) {
                const int t = tid + 512 * i;
                const float zn = u3(n == 0 ? c : 512 + c, t) * (acc[i] * HY_FINV + sk * z[t]);
                if (n == 0) z[t] = zn; else hT[((size_t)(b * 512 + c)) * S + t] = (h16)zn;
            }
            __syncthreads();
        }
    }
}
constexpr int HY_CS = 16448, HY_ZOFF = 4 * HY_CS, HY_ZB = 11584, HY_LDS = HY_ZOFF + 4 * HY_ZB;
static_assert(HY_LDS <= LDS_BYTES, "hyena lds");
__device__ __forceinline__ void phase_hyena(const Params& p, LAS char* lds) {
    const int tid = threadIdx.x, lane = tid & 63, wid = __builtin_amdgcn_readfirstlane(tid >> 6), r32 = lane & 31, hi = lane >> 5;
    const h16* hyT = PH(WS_HYT); const h16* Rg = PH(WS_R); const float* convw = p.in[8]; const float* convb = p.in[9]; const float* skip = p.in[18]; h16* hT = PH(WS_HT);
    const int G = gridDim.x, bx = blockIdx.x, vid = (G % 8 == 0) ? (bx % 8) * (G / 8) + bx / 8 : bx;
    __syncthreads();
    for (int i = tid; i < 4 * 16 * 36; i += NTHR) { const int batch = i / 576, rem = i - batch * 576, blk = rem / 36, w = rem - blk * 36, bi = blk < 8 ? blk : 64 + blk;
        *(LAS unsigned*)(lds + HY_ZOFF + batch * HY_ZB + bi * 144 + w * 4) = 0u; }
    const int i0 = wid * 8, q = r32 & 3, ii = r32 >> 2, batch = r32 & 3;
    const int abase = q * HY_CS + 2 * (4096 + 8 * hi - (r32 - q));
    const int bbase = HY_ZOFF + batch * HY_ZB + ((i0 + ii + 8) * 72 + 8 * hi) * 2;
    for (int c = vid; c < HYW; c += G) {
        for (int n = 0; n < 2; ++n) {
            __syncthreads();
            { const h16* Rc = Rg + ((size_t)(n * 512 + c)) * 8192;
              for (int k = tid; k < 1024; k += NTHR) { const h16x8 v = *(const h16x8*)(Rc + k * 8);
                  *(LAS h16x8*)(lds + k * 16) = v;
#pragma unroll
                  for (int qq = 1; qq < 4; ++qq)
#pragma unroll
                      for (int e = 0; e < 8; ++e) *(LAS h16*)(lds + qq * HY_CS + (k * 8 + e + qq) * 2) = v[e]; } }
            if (n == 0) {
                const int ch = 1024 + c; const float w0 = convw[ch], w1 = convw[1536 + ch], w2 = convw[3072 + ch], bb = convb[ch];
                for (int i = tid; i < 4 * 512; i += NTHR) { const int bt = i >> 9, t0 = (i & 511) * 8; const h16* raw = hyT + ((size_t)(bt * 1536 + ch)) * S + t0;
                    const h16x8 v = *(const h16x8*)raw; float x[10]; x[0] = t0 > 0 ? (float)raw[-1] : 0.f; x[9] = t0 + 8 < S ? (float)raw[8] : 0.f;
#pragma unroll
                    for (int e = 0; e < 8; ++e) x[e + 1] = (float)v[e];
                    h16x8 o;
#pragma unroll
                    for (int e = 0; e < 8; ++e) o[e] = (h16)(w0 * x[e] + w1 * x[e + 1] + w2 * x[e + 2] + bb);
                    *(LAS h16x8*)(lds + HY_ZOFF + bt * HY_ZB + (((t0 >> 6) + 8) * 72 + (t0 & 63)) * 2) = o; }
            }
            __syncthreads();
            f32x16 acc0, acc1;
#pragma unroll
            for (int r = 0; r < 16; ++r) { acc0[r] = 0.f; acc1[r] = 0.f; }
            for (int d = i0 - 63; d <= i0 + 7; ++d) {
                LAS char* ap = lds + abase - 128 * d; LAS char* bp = lds + bbase - 144 * d;
#pragma unroll
                for (int kc = 0; kc < 4; ++kc) {
                    const h16x8 bf = *(LAS h16x8*)(bp + 32 * kc);
                    const h16x4 a0l = *(LAS h16x4*)(ap + 32 * kc), a0h = *(LAS h16x4*)(ap + 32 * kc + 8);
                    const h16x4 a1l = *(LAS h16x4*)(ap + 32 * kc - 64), a1h = *(LAS h16x4*)(ap + 32 * kc - 56);
                    const h16x8 af0 = {a0l[0], a0l[1], a0l[2], a0l[3], a0h[0], a0h[1], a0h[2], a0h[3]}, af1 = {a1l[0], a1l[1], a1l[2], a1l[3], a1h[0], a1h[1], a1h[2], a1h[3]};
                    acc0 = __builtin_amdgcn_mfma_f32_32x32x16_f16(af0, bf, acc0, 0, 0, 0);
                    acc1 = __builtin_amdgcn_mfma_f32_32x32x16_f16(af1, bf, acc1, 0, 0, 0);
                }
            }
            __syncthreads();
            {
                const int gch = n == 0 ? c : 512 + c; const float w0 = convw[gch], w1 = convw[1536 + gch], w2 = convw[3072 + gch], bb = convb[gch], sk = skip[n * 512 + c];
                const h16* graw = hyT + ((size_t)(batch * 1536 + gch)) * S;
#pragma unroll
                for (int rt = 0; rt < 2; ++rt)
#pragma unroll
                    for (int g = 0; g < 4; ++g) {
                        const int a4 = 32 * rt + 8 * g + 4 * hi, t4 = 64 * (i0 + ii) + a4;
                        LAS char* zp = lds + HY_ZOFF + batch * HY_ZB + ((i0 + ii + 8) * 72 + a4) * 2;
                        const h16x4 zo = *(LAS h16x4*)zp;
                        const h16x4 gv = *(const h16x4*)(graw + t4);
                        float x[6]; x[0] = t4 > 0 ? (float)graw[t4 - 1] : 0.f; x[5] = t4 + 4 < S ? (float)graw[t4 + 4] : 0.f;
#pragma unroll
                        for (int e = 0; e < 4; ++e) x[e + 1] = (float)gv[e];
                        h16x4 zn;
#pragma unroll
                        for (int e = 0; e < 4; ++e) { const float gc = w0 * x[e] + w1 * x[e + 1] + w2 * x[e + 2] + bb; const float y = (rt == 0 ? acc0[4 * g + e] : acc1[4 * g + e]) * HY_FINV;
                            zn[e] = (h16)(gc * (y + sk * (float)zo[e])); }
                        if (n == 0) *(LAS h16x4*)zp = zn; else *(h16x4*)(hT + ((size_t)(batch * 512 + c)) * S + t4) = zn;
                    }
            }
        }
    }
    __syncthreads();
}
__device__ __forceinline__ void phase_mixprep(const Params& p, LAS char* lds) {
    constexpr int LDT = 520;
    LAS h16* tile = (LAS h16*)lds;
    const h16* aout = PH(WS_AOUT); const h16* hT = PH(WS_HT); h16* mix = PH(WS_MIX);
    const int tid = threadIdx.x, lane = tid & 63, wid = tid >> 6;
    for (int u = blockIdx.x; u < T / 64; u += gridDim.x) {
        const int m0 = u * 64, b = m0 >> 12, t0 = m0 & 4095;
        __syncthreads();
        for (int i = tid; i < 512 * 8; i += NTHR) { const int c = i >> 3, j = i & 7;
            const h16x8 v = *(const h16x8*)(hT + ((size_t)(b * 512 + c)) * S + t0 + j * 8);
#pragma unroll
            for (int e = 0; e < 8; ++e) tile[(j * 8 + e) * LDT + c] = v[e]; }
        __syncthreads();
        for (int rr = 0; rr < 8; ++rr) {
            const int r = wid * 8 + rr; const size_t m = (size_t)(m0 + r);
            const h16x8 hv = *(LAS h16x8*)(tile + r * LDT + lane * 8);
            const h16x8 av = *(const h16x8*)(aout + m * 512 + lane * 8);
            float sh = 0.f, sa = 0.f;
#pragma unroll
            for (int e = 0; e < 8; ++e) { const float x = (float)hv[e], y = (float)av[e]; sh += x * x; sa += y * y; }
            sh = wave_sum(sh); sa = wave_sum(sa);
            const float rh = rstd_of(sh, 512), ra = rstd_of(sa, 512);
            h16x8 oh, oa;
#pragma unroll
            for (int e = 0; e < 8; ++e) { oh[e] = (h16)((float)hv[e] * rh); oa[e] = (h16)((float)av[e] * ra); }
            *(h16x8*)(mix + m * D + lane * 8) = oa; *(h16x8*)(mix + m * D + 512 + lane * 8) = oh;
        }
    }
    __syncthreads();
}
__device__ __forceinline__ void phase_xattn_naive(const Params& p, LAS char* lds) {
    LAS float* sc = (LAS float*)lds;
    LAS float* il = sc + 32 * 257;
    LAS h16* qs = (LAS h16*)(il + 32);
    h16* qc = PH(WS_QC); const h16* Kc = PH(WS_KC); const h16* VcT = PH(WS_VCT);
    const int tid = threadIdx.x, wv = tid >> 6, lane = tid & 63;
    for (int u = blockIdx.x; u < (S / 32) * NB * MH; u += gridDim.x) {
        const int bh = u >> 7, b = bh >> 2, h = bh & 3, t0 = (u & 127) * 32;
        __syncthreads();
        for (int i = tid; i < 32 * 256; i += NTHR) { const int tok = i >> 8, d = i & 255; qs[tok * 256 + d] = qc[((size_t)(b * S + t0 + tok)) * D + h * MHD + d]; }
        __syncthreads();
        for (int mi = 0; mi < 32; ++mi) {
            const int mm = wv * 32 + mi;
            const h16x4 kv = *(const h16x4*)(Kc + ((size_t)(b * MEMT + mm)) * D + h * MHD + lane * 4);
            for (int tok = 0; tok < 32; ++tok) {
                const h16x4 qv = *(LAS h16x4*)(qs + tok * 256 + lane * 4);
                float s_ = (float)qv[0] * (float)kv[0] + (float)qv[1] * (float)kv[1] + (float)qv[2] * (float)kv[2] + (float)qv[3] * (float)kv[3];
                s_ = wave_sum(s_);
                if (lane == 0) sc[tok * 257 + mm] = s_;
            }
        }
        __syncthreads();
        if (tid < 32) { float mx = -1e30f; for (int j = 0; j < 256; ++j) mx = fmaxf(mx, sc[tid * 257 + j]); float l = 0.f;
            for (int j = 0; j < 256; ++j) { const float pp = exp2f(sc[tid * 257 + j] - mx); sc[tid * 257 + j] = pp; l += pp; } il[tid] = 1.f / l; }
        __syncthreads();
        for (int di = 0; di < 32; ++di) {
            const int d = wv * 32 + di;
            const h16x4 vv = *(const h16x4*)(VcT + ((size_t)((b * MH + h) * MHD + d)) * MEMT + lane * 4);
            for (int tok = 0; tok < 32; ++tok) {
                float o = sc[tok * 257 + lane * 4] * (float)vv[0] + sc[tok * 257 + lane * 4 + 1] * (float)vv[1] + sc[tok * 257 + lane * 4 + 2] * (float)vv[2] + sc[tok * 257 + lane * 4 + 3] * (float)vv[3];
                o = wave_sum(o);
                if (lane == 0) qc[((size_t)(b * S + t0 + tok)) * D + h * MHD + d] = (h16)(o * il[tok]);
            }
        }
    }
    __syncthreads();
}
constexpr int XA_KROW = 528, XA_VROW = 136, XA_KB = 64 * XA_KROW, XA_VB = 128 * XA_VROW, XA_BUF = XA_KB + XA_VB;
static_assert(2 * XA_BUF <= LDS_BYTES, "xattn lds");
__device__ __forceinline__ void phase_xattn(const Params& p, LAS char* lds) {
    const int tid = threadIdx.x, lane = tid & 63, wid = __builtin_amdgcn_readfirstlane(tid >> 6), r32 = lane & 31, hi = lane >> 5;
    h16* qc = PH(WS_QC); const h16* Kc = PH(WS_KC); const h16* VcT = PH(WS_VCT);
    const int G = gridDim.x, bx = blockIdx.x, vid = (G % 8 == 0) ? (bx % 8) * (G / 8) + bx / 8 : bx;
    for (int u = vid; u < NB * MH * 16; u += G) {
        const int bh = u >> 4, b = bh >> 2, h = bh & 3, q0 = (u & 15) * 256 + wid * 32;
        h16* qrow = qc + ((size_t)(b * S + q0 + r32)) * D + h * MHD;
        h16x8 qf[16];
#pragma unroll
        for (int s_ = 0; s_ < 16; ++s_) qf[s_] = *(const h16x8*)(qrow + 16 * s_ + 8 * hi);
        const h16* Ksrc = Kc + ((size_t)(b * MEMT + (tid >> 5))) * D + h * MHD + (tid & 31) * 8;
        const h16* Vsrc = VcT + ((size_t)(bh * MHD + (tid >> 3))) * MEMT + (tid & 7) * 8;
        const int kdst = (tid >> 5) * XA_KROW + (tid & 31) * 16, vdst = XA_KB + (tid >> 3) * XA_VROW + (tid & 7) * 16;
        h16x8 kr[4], vr[2];
#pragma unroll
        for (int j = 0; j < 4; ++j) kr[j] = *(const h16x8*)(Ksrc + (size_t)(16 * j) * D);
#pragma unroll
        for (int j = 0; j < 2; ++j) vr[j] = *(const h16x8*)(Vsrc + (size_t)(64 * j) * MEMT);
        __syncthreads();
#pragma unroll
        for (int j = 0; j < 4; ++j) *(LAS h16x8*)(lds + kdst + 16 * j * XA_KROW) = kr[j];
#pragma unroll
        for (int j = 0; j < 2; ++j) { LAS char* vn = lds + vdst + 64 * j * XA_VROW; *(LAS h16x4*)vn = (h16x4){vr[j][0], vr[j][1], vr[j][2], vr[j][3]}; *(LAS h16x4*)(vn + 8) = (h16x4){vr[j][4], vr[j][5], vr[j][6], vr[j][7]}; }
        __syncthreads();
        f32x16 o[4]; float m = -1e30f, l = 0.f;
#pragma unroll
        for (int dt = 0; dt < 4; ++dt)
#pragma unroll
            for (int r = 0; r < 16; ++r) o[dt][r] = 0.f;
        for (int st = 0; st < 8; ++st) {
            const int t = st & 3, pass = st >> 2;
            if (st + 1 < 8) { const int t1 = (st + 1) & 3, p1 = (st + 1) >> 2;
#pragma unroll
                for (int j = 0; j < 4; ++j) kr[j] = *(const h16x8*)(Ksrc + (size_t)(64 * t1 + 16 * j) * D);
#pragma unroll
                for (int j = 0; j < 2; ++j) vr[j] = *(const h16x8*)(Vsrc + (size_t)(128 * p1 + 64 * j) * MEMT + 64 * t1); }
            LAS char* kb = lds + (st & 1) * XA_BUF; LAS char* vb = kb + XA_KB;
            f32x16 p0, p1_;
#pragma unroll
            for (int r = 0; r < 16; ++r) { p0[r] = 0.f; p1_[r] = 0.f; }
#pragma unroll
            for (int s_ = 0; s_ < 16; ++s_) {
                const h16x8 a0 = *(LAS h16x8*)(kb + r32 * XA_KROW + s_ * 32 + hi * 16);
                const h16x8 a1 = *(LAS h16x8*)(kb + (32 + r32) * XA_KROW + s_ * 32 + hi * 16);
                p0 = __builtin_amdgcn_mfma_f32_32x32x16_f16(a0, qf[s_], p0, 0, 0, 0);
                p1_ = __builtin_amdgcn_mfma_f32_32x32x16_f16(a1, qf[s_], p1_, 0, 0, 0);
            }
            float mx = fmaxf(p0[0], p1_[0]);
#pragma unroll
            for (int r = 1; r < 16; ++r) mx = fmaxf(mx, fmaxf(p0[r], p1_[r]));
            mx = fmaxf(mx, __shfl_xor(mx, 32));
            const float mn = fmaxf(m, mx), al = __builtin_amdgcn_exp2f(m - mn); m = mn;
            float rs = 0.f;
#pragma unroll
            for (int r = 0; r < 16; ++r) { p0[r] = __builtin_amdgcn_exp2f(p0[r] - mn); p1_[r] = __builtin_amdgcn_exp2f(p1_[r] - mn); rs += p0[r] + p1_[r]; }
            l = l * al + rs;
#pragma unroll
            for (int dt = 0; dt < 4; ++dt)
#pragma unroll
                for (int r = 0; r < 16; ++r) o[dt][r] *= al;
            h16x8 pf[2][2];
#pragma unroll
            for (int j = 0; j < 8; ++j) { pf[0][0][j] = (h16)p0[j]; pf[0][1][j] = (h16)p0[8 + j]; pf[1][0][j] = (h16)p1_[j]; pf[1][1][j] = (h16)p1_[8 + j]; }
#pragma unroll
            for (int kh = 0; kh < 2; ++kh)
#pragma unroll
                for (int s_ = 0; s_ < 2; ++s_)
#pragma unroll
                    for (int dt = 0; dt < 4; ++dt) {
                        LAS char* v0 = vb + (dt * 32 + r32) * XA_VROW + (kh * 32 + 16 * s_ + 4 * hi) * 2;
                        const h16x4 a = *(LAS h16x4*)v0, c = *(LAS h16x4*)(v0 + 16);
                        const h16x8 vf = {a[0], a[1], a[2], a[3], c[0], c[1], c[2], c[3]};
                        o[dt] = __builtin_amdgcn_mfma_f32_32x32x16_f16(vf, pf[kh][s_], o[dt], 0, 0, 0);
                    }
            if (st + 1 < 8) {
                LAS char* nb = lds + ((st + 1) & 1) * XA_BUF;
#pragma unroll
                for (int j = 0; j < 4; ++j) *(LAS h16x8*)(nb + kdst + 16 * j * XA_KROW) = kr[j];
#pragma unroll
                for (int j = 0; j < 2; ++j) { LAS char* vn = nb + vdst + 64 * j * XA_VROW; *(LAS h16x4*)vn = (h16x4){vr[j][0], vr[j][1], vr[j][2], vr[j][3]}; *(LAS h16x4*)(vn + 8) = (h16x4){vr[j][4], vr[j][5], vr[j][6], vr[j][7]}; }
            }
            if (t == 3) {
                const float il = 1.f / (l + __shfl_xor(l, 32));
                h16* op = qrow + pass * 128 + 4 * hi;
#pragma unroll
                for (int dt = 0; dt < 4; ++dt)
#pragma unroll
                    for (int g = 0; g < 4; ++g) {
                        *(h16x4*)(op + dt * 32 + 8 * g) = (h16x4){(h16)(o[dt][4 * g] * il), (h16)(o[dt][4 * g + 1] * il), (h16)(o[dt][4 * g + 2] * il), (h16)(o[dt][4 * g + 3] * il)};
                        o[dt][4 * g] = 0.f; o[dt][4 * g + 1] = 0.f; o[dt][4 * g + 2] = 0.f; o[dt][4 * g + 3] = 0.f; }
                m = -1e30f; l = 0.f;
            }
            __syncthreads();
        }
    }
    __syncthreads();
}
__device__ __forceinline__ void phase_route(const Params& p) {
    const float* X = p.X; const float* g = p.in[27]; const float* wrg = p.in[28]; const float* brg = p.in[29]; const float* wre = p.in[30]; const float* bre = p.in[31];
    float* ssx2 = PF(WS_SSX2); float* tokw = PF(WS_TOKW); int* cnt = PI(WS_CTL); int* list = PI(WS_LIST);
    const int lane = threadIdx.x & 63, gw = blockIdx.x * NWAVE + (threadIdx.x >> 6), NGW = gridDim.x * NWAVE;
    for (int m = gw; m < T; m += NGW) {
        float ss = 0.f;
#pragma unroll 4
        for (int i = 0; i < 16; ++i) { const float xv = X[(size_t)m * D + lane + 64 * i]; ss += xv * xv; }
        ss = wave_sum(ss);
        const float rs = rstd_of(ss, D);
        float lg[36];
#pragma unroll
        for (int j = 0; j < 36; ++j) lg[j] = 0.f;
#pragma unroll 1
        for (int i = 0; i < 16; ++i) { const int k = lane + 64 * i; const float tv = X[(size_t)m * D + k] * rs * g[k];
            const f32x4 wg4 = *(const f32x4*)(wrg + k * 4);
#pragma unroll
            for (int j = 0; j < 4; ++j) lg[j] += tv * wg4[j];
#pragma unroll
            for (int j4 = 0; j4 < 8; ++j4) { const f32x4 we4 = *(const f32x4*)(wre + k * 32 + j4 * 4);
#pragma unroll
                for (int j = 0; j < 4; ++j) lg[4 + j4 * 4 + j] += tv * we4[j]; } }
#pragma unroll
        for (int j = 0; j < 36; ++j) lg[j] = wave_sum(lg[j]);
        if (lane == 0) {
            ssx2[m] = ss;
            float gl[4]; int gi = 0; float gm = -1e30f;
#pragma unroll
            for (int j = 0; j < 4; ++j) { gl[j] = lg[j] + brg[j]; if (gl[j] > gm) { gm = gl[j]; gi = j; } }
            float gs = 0.f;
#pragma unroll
            for (int j = 0; j < 4; ++j) gs += expf(gl[j] - gm);
            const float pg = 1.f / gs;
            float e1 = -1e30f, e2 = -1e30f; int i1 = 0, i2 = 0;
#pragma unroll
            for (int g4 = 0; g4 < 4; ++g4) if (g4 == gi) {
#pragma unroll
                for (int j = 0; j < 8; ++j) { const float v = lg[4 + g4 * 8 + j] + bre[g4 * 8 + j];
                    if (v > e1) { e2 = e1; i2 = i1; e1 = v; i1 = j; } else if (v > e2) { e2 = v; i2 = j; } } }
            const float p2 = 1.f / (1.f + expf(e1 - e2)), p1 = 1.f - p2;
            const int ea = gi * 8 + i1, eb = gi * 8 + i2;
            tokw[m * 2] = pg * p1; tokw[m * 2 + 1] = pg * p2;
            const int pa = atomicAdd(&cnt[ea], 1), pb = atomicAdd(&cnt[eb], 1);
            list[ea * T + pa] = m * 2; list[eb * T + pb] = m * 2 + 1;
        }
    }
}
struct RowGather { const h16* A; const int* lst; int Me; __device__ __forceinline__ const h16* operator()(int m) const { const int pr = m < Me ? lst[m] : lst[0]; return A + (size_t)(pr >> 1) * D; } };
struct RowClamp { const h16* A; int Me; __device__ __forceinline__ const h16* operator()(int m) const { return A + (size_t)(m < Me ? m : 0) * DE; } };
struct EGu { const int* lst; int Me; const float* ssx2; const float* tokw; h16* hb;
    __device__ __forceinline__ void row32(int m, int nb, f32x4 va, f32x4 vb) const {
        if (m >= Me) return;
        const int pr = lst[m]; const float rs = rstd_of(ssx2[pr >> 1], D), w = tokw[pr];
        h16x4 o;
#pragma unroll
        for (int j = 0; j < 4; ++j) { const float a = va[j] * rs, bb = vb[j] * rs; o[j] = (h16)(a / (1.f + __expf(-a)) * bb * w); }
        *(h16x4*)(hb + (size_t)m * DE + (nb >> 5) * 16 + (nb & 31)) = o;
    } };
struct EDn { const int* lst; int Me; h16* yb;
    __device__ __forceinline__ void row32(int m, int nb, f32x4 va, f32x4 vb) const {
        if (m >= Me) return;
        h16* y = yb + (size_t)lst[m] * D + nb;
        *(h16x4*)y = cvt4(va); *(h16x4*)(y + 16) = cvt4(vb);
    } };
template <bool DOWN>
__device__ __forceinline__ void phase_moe(const Params& p, LAS char* lds) {
    const int* cnt = PI(WS_CTL);
    const int G = gridDim.x, bx = blockIdx.x, vid = (G % 8 == 0) ? (bx % 8) * (G / 8) + bx / 8 : bx;
    constexpr int NTN = DOWN ? D / G_BN : 512 / G_BN;
    int tbase = 0, off = 0;
    int tix = vid;
    for (int e = 0; e < NE; ++e) {
        const int Me = cnt[e], nmt = (Me + G_BM - 1) / G_BM, nte = nmt * NTN;
        const int* lst = PI(WS_LIST) + (size_t)e * T;
        for (; tix < tbase + nte; tix += G) {
            const int lt = tix - tbase, mt = lt / NTN, nt_ = lt - mt * NTN;
            if (!DOWN) gemm_tile<true>(lds, RowGather{PH(WS_X2H), lst, Me}, PH(WS_WGU) + (size_t)e * 512 * D, D, D, mt * G_BM, nt_ * G_BN,
                                       EGu{lst, Me, PF(WS_SSX2), PF(WS_TOKW), PH(WS_HB) + (size_t)off * DE});
            else gemm_tile<true>(lds, RowClamp{PH(WS_HB) + (size_t)off * DE, Me}, PH(WS_WDN) + (size_t)e * D * DE, DE, DE, mt * G_BM, nt_ * G_BN,
                                 EDn{lst, Me, PH(WS_YB)});
        }
        tbase += nte; off += Me;
    }
}
__device__ __forceinline__ void phase_final(const Params& p) {
    const float* X = p.X; const h16* yb = PH(WS_YB); const float* g = p.in[35]; float* out = p.X;
    const int lane = threadIdx.x & 63, gw = blockIdx.x * NWAVE + (threadIdx.x >> 6), NGW = gridDim.x * NWAVE;
    for (int m = gw; m < T; m += NGW) {
        f32x4 v[4]; float ss = 0.f;
#pragma unroll
        for (int i = 0; i < 4; ++i) { const int k = (lane + 64 * i) * 4;
            const f32x4 xv = *(const f32x4*)(X + (size_t)m * D + k); const h16x4 y0 = *(const h16x4*)(yb + ((size_t)m * 2) * D + k), y1 = *(const h16x4*)(yb + ((size_t)m * 2 + 1) * D + k);
#pragma unroll
            for (int j = 0; j < 4; ++j) { v[i][j] = xv[j] + (float)y0[j] + (float)y1[j]; ss += v[i][j] * v[i][j]; } }
        ss = wave_sum(ss); const float rs = rstd_of(ss, D);
#pragma unroll
        for (int i = 0; i < 4; ++i) { const int k = (lane + 64 * i) * 4; const f32x4 gv = *(const f32x4*)(g + k); *(f32x4*)(out + (size_t)m * D + k) = v[i] * rs * gv; }
    }
}

__global__ void __launch_bounds__(NTHR) mega(Params p, int ph_lo, int ph_hi) {
    extern __shared__ __attribute__((aligned(16))) char lds_raw[];
    LAS char* lds = (LAS char*)lds_raw;
    cg::grid_group grid = cg::this_grid();
#define PHASE(k) if (ph_lo <= (k) && (k) < ph_hi)
#define SEAM(k) if (ph_lo <= (k) && (k) + 1 < ph_hi) grid.sync()
    PHASE(0) { phase_prep(p, lds); }
    SEAM(0);
    PHASE(1) {
        gemm_job<false>(lds, PH(WS_XH), D, PH(WS_WIN), D, T, 1536, D, EHy{PF(WS_SSX), PH(WS_HYT)});
        gemm_job<true>(lds, PH(WS_XH), D, PH(WS_WIN) + (size_t)1536 * D, D, T, 512, D, ELat{PF(WS_SSX), PH(WS_LAT), PF(WS_SSQ), PF(WS_SSKV)});
        gemm_job<true>(lds, PH(WS_MEMH), D, PH(WS_WMKV), D, MROWS, 1024, D, EKc{PF(WS_SSMEM), PH(WS_KC)});
        gemm_job<false>(lds, PH(WS_MEMH), D, PH(WS_WMKV) + (size_t)1024 * D, D, MROWS, 1024, D, EVc{PF(WS_SSMEM), PH(WS_VCT)}, 32);
        phase_filt3(p);
    }
    SEAM(1);
    PHASE(2) {
        gemm_job<true>(lds, PH(WS_LAT), LAT, PH(WS_WUQ), 256, T, 768, 256, EQ{PF(WS_SSQ), PF(WS_ROPE), PH(WS_Q)});
        gemm_job<true>(lds, PH(WS_LAT) + 256, LAT, PH(WS_WUKV), 128, T, 512, 128, EK{PF(WS_SSKV), PH(WS_K)}, 128);
        gemm_job<false>(lds, PH(WS_LAT) + 256, LAT, PH(WS_WUKV) + (size_t)512 * 128, 128, T, 512, 128, EV{PF(WS_SSKV), PH(WS_VT)}, 128);
        phase_krot(p);
    }
    SEAM(2);
    PHASE(3) { phase_attn(p, lds); phase_hyena(p, lds); }
    SEAM(3);
    PHASE(4) { phase_mixprep(p, lds); }
    SEAM(4);
    PHASE(5) { gemm_job<true>(lds, PH(WS_MIX), D, PH(WS_WOUT), D, T, D, D, ERes{p.in[0], p.X, PH(WS_X1H), PF(WS_SSX1)}); }
    SEAM(5);
    PHASE(6) { gemm_job<true>(lds, PH(WS_X1H), D, PH(WS_WMQ), D, T, D, D, EMq{PF(WS_SSX1), PH(WS_QC)}); }
    SEAM(6);
    PHASE(7) { phase_xattn(p, lds); }
    SEAM(7);
    PHASE(8) { gemm_job<true>(lds, PH(WS_QC), D, PH(WS_WMO), D, T, D, D, ERes{p.X, p.X, PH(WS_X2H), nullptr}); }
    SEAM(8);
    PHASE(9) { phase_route(p); }
    SEAM(9);
    PHASE(10) { phase_moe<false>(p, lds); }
    SEAM(10);
    PHASE(11) { phase_moe<true>(p, lds); }
    SEAM(11);
    PHASE(12) { phase_final(p); }
}

extern "C" void kernel_launch(void* const* d_in, const int* in_sizes, int n_in, void* d_out, int out_size, void* d_ws, size_t ws_size, hipStream_t st) {
    Params p{};
    for (int i = 0; i < 36; ++i) p.in[i] = (const float*)d_in[i];
    p.X = (float*)d_out; p.ws = (char*)d_ws;
    static int grid = 0;
    if (!grid) {
        (void)hipFuncSetAttribute((const void*)mega, hipFuncAttributeMaxDynamicSharedMemorySize, LDS_BYTES);
        int dev = 0, cus = 0, per_cu = 0;
        (void)hipGetDevice(&dev);
        (void)hipDeviceGetAttribute(&cus, hipDeviceAttributeMultiprocessorCount, dev);
        (void)hipOccupancyMaxActiveBlocksPerMultiprocessor(&per_cu, (const void*)mega, NTHR, LDS_BYTES);
        if (per_cu < 1) { fprintf(stderr, "kernel_launch: occupancy query says %d blocks/CU\n", per_cu); per_cu = 1; }
        grid = cus;
    }
    int lo = 0, hi = 13;
    void* args[] = {&p, &lo, &hi};
    hipError_t e = hipLaunchCooperativeKernel((const void*)mega, dim3(grid), dim3(NTHR), args, LDS_BYTES, st);
    if (e != hipSuccess) fprintf(stderr, "cooperative launch failed: %s (grid %d)\n", hipGetErrorString(e), grid);
    (void)in_sizes; (void)n_in; (void)out_size; (void)ws_size;
}
```

```cpp
#include <hip/hip_runtime.h>
#include <cstdint>
#include <cstdio>
#include <hip/hip_cooperative_groups.h>
namespace cg = cooperative_groups;
typedef _Float16 h16;

constexpr int NB = 4, S = 4096, D = 1024, T = NB * S, MEMT = 256, MROWS = NB * MEMT;
constexpr int NH = 8, HYW = 512;
constexpr int LAT = 416, INC = 1952;
constexpr int MH = 4, MHD = 256;
constexpr int NE = 32, DE = 256;
constexpr float EPS = 1e-6f;
constexpr float LOG2E = 1.4426950408889634f;
constexpr float QSCALE = 0.10206207261596575f * LOG2E;
constexpr float CSCALE = 0.0625f * LOG2E;

constexpr size_t MiB = 1u << 20;
constexpr size_t WS_CTL = 0;
constexpr size_t WS_SSX = 64 * 1024, WS_SSQ = 128 * 1024, WS_SSKV = 192 * 1024, WS_SSA = 256 * 1024, WS_SSH = 320 * 1024,
                 WS_SSX1 = 384 * 1024, WS_SSX2 = 448 * 1024, WS_SSMEM = 512 * 1024, WS_TOKE = 576 * 1024, WS_TOKW = 704 * 1024,
                 WS_TOKP = 832 * 1024;
constexpr size_t WS_WIN = 2 * MiB, WS_WUQ = 6 * MiB, WS_WUKV = 6 * MiB + 512 * 1024, WS_WOUT = 7 * MiB, WS_WMQ = 9 * MiB,
                 WS_WMKV = 11 * MiB, WS_WMO = 15 * MiB, WS_MEMH = 17 * MiB, WS_KC = 19 * MiB, WS_VCT = 21 * MiB, WS_R = 23 * MiB,
                 WS_WGU = 39 * MiB, WS_WDN = 71 * MiB, WS_LAT = 87 * MiB, WS_HYT = 101 * MiB, WS_XH = 149 * MiB, WS_Q = 149 * MiB,
                 WS_K = 173 * MiB, WS_VT = 197 * MiB, WS_AOUT = 213 * MiB, WS_HT = 229 * MiB, WS_LIST = 245 * MiB, WS_H2 = 247 * MiB;
constexpr size_t WS_OC = 183 * MiB, WS_BAR = 16 * 1024;
constexpr size_t WS_MIX = 87 * MiB, WS_X1H = 119 * MiB, WS_QC = 151 * MiB, WS_X2H = 87 * MiB, WS_HB = 119 * MiB, WS_YB = 135 * MiB;

__device__ __forceinline__ float wave_sum(float v) {
#pragma unroll
    for (int o = 1; o < 64; o <<= 1) v += __shfl_xor(v, o);
    return v;
}
__device__ __forceinline__ float rstd_of(float ss, int n) { return 1.0f / sqrtf(ss / (float)n + EPS); }

#define LAS __attribute__((address_space(3)))
typedef _Float16 h16x8 __attribute__((ext_vector_type(8)));
typedef _Float16 h16x4 __attribute__((ext_vector_type(4)));
typedef _Float16 h16x2 __attribute__((ext_vector_type(2)));
typedef float f32x4 __attribute__((ext_vector_type(4)));
typedef float f32x16 __attribute__((ext_vector_type(16)));
constexpr int NTHR = 512, NWAVE = 8;
constexpr int LDS_BYTES = 150 * 1024;
constexpr size_t WS_ROPE = 248 * MiB;
constexpr float HY_FSCALE = 256.f, HY_FINV = 1.f / 256.f;

struct Params {
    const float* in[36]; float* X; char* ws;
};
#define PF(off) ((float*)(p.ws + (off)))
#define PH(off) ((h16*)(p.ws + (off)))
#define PI(off) ((int*)(p.ws + (off)))

constexpr int G_BM = 256, G_BN = 128, G_BK = 64, G_AB = G_BM * G_BK * 2, G_BB = G_BN * G_BK * 2, G_STAGE = G_AB + G_BB;
static_assert(3 * G_STAGE <= LDS_BYTES, "lds");
__device__ __forceinline__ void glds16(const void* g, LAS char* l) { __builtin_amdgcn_global_load_lds((const unsigned*)g, (LAS unsigned*)l, 16, 0, 0); }

template <bool SWAP, class RowPtr, class Epi>
__device__ __forceinline__ void gemm_tile(LAS char* lds, const RowPtr& rowptr, const h16* __restrict__ Wt, int ldw, int K, int m0, int n0, const Epi& epi) {
    const int tid = threadIdx.x, lane = tid & 63, wid = __builtin_amdgcn_readfirstlane(tid >> 6);
    const int wm = wid >> 1, wn = wid & 1, fr = lane & 15, fq = lane >> 4;
    const h16* asrc[4]; const h16* bsrc[2];
#pragma unroll
    for (int i = 0; i < 4; ++i) { const int r = wid * 32 + i * 8 + (lane >> 3); const int ch = (lane & 7) ^ ((r >> 1) & 7); asrc[i] = rowptr(m0 + r) + ch * 8; }
#pragma unroll
    for (int i = 0; i < 2; ++i) { const int r = wid * 16 + i * 8 + (lane >> 3); const int ch = (lane & 7) ^ ((r >> 1) & 7); bsrc[i] = Wt + (size_t)(n0 + r) * ldw + ch * 8; }
    const int sw = fr >> 1;
    const int aoff = (wm * 64 + fr) * 128 + ((fq ^ sw) * 16);
    const int boff = G_AB + (wn * 64 + fr) * 128 + ((fq ^ sw) * 16);
    f32x4 acc[4][4];
#pragma unroll
    for (int i = 0; i < 4; ++i)
#pragma unroll
        for (int j = 0; j < 4; ++j) acc[i][j] = (f32x4){0.f, 0.f, 0.f, 0.f};
    const int nt = K / G_BK;
    asm volatile("s_waitcnt vmcnt(0)" ::: "memory");
#define G_STAGE_ISSUE(buf, kt) do { LAS char* sa_ = lds + (buf) * G_STAGE + wid * 4096; \
        _Pragma("unroll") for (int i_ = 0; i_ < 4; ++i_) glds16(asrc[i_] + (kt) * G_BK, sa_ + i_ * 1024); \
        LAS char* sb_ = lds + (buf) * G_STAGE + G_AB + wid * 2048; \
        _Pragma("unroll") for (int i_ = 0; i_ < 2; ++i_) glds16(bsrc[i_] + (kt) * G_BK, sb_ + i_ * 1024); } while (0)
    G_STAGE_ISSUE(0, 0);
    if (nt > 1) G_STAGE_ISSUE(1, 1);
    int buf = 0;
    for (int t = 0; t < nt; ++t) {
        if (t + 1 < nt) asm volatile("s_waitcnt vmcnt(6)" ::: "memory"); else asm volatile("s_waitcnt vmcnt(0)" ::: "memory");
        __builtin_amdgcn_s_barrier();
        if (t + 2 < nt) { const int nb_ = buf >= 1 ? buf - 1 : 2; G_STAGE_ISSUE(nb_, t + 2); }
        LAS char* base = lds + buf * G_STAGE;
#pragma unroll
        for (int kk = 0; kk < 2; ++kk) {
            h16x8 a[4], b[4];
#pragma unroll
            for (int i = 0; i < 4; ++i) { a[i] = *(LAS h16x8*)(base + ((aoff ^ (kk * 64)) + i * 2048)); b[i] = *(LAS h16x8*)(base + ((boff ^ (kk * 64)) + i * 2048)); }
#pragma unroll
            for (int i = 0; i < 4; ++i)
#pragma unroll
                for (int j = 0; j < 4; ++j)
                    acc[i][j] = SWAP ? __builtin_amdgcn_mfma_f32_16x16x32_f16(b[j], a[i], acc[i][j], 0, 0, 0)
                                     : __builtin_amdgcn_mfma_f32_16x16x32_f16(a[i], b[j], acc[i][j], 0, 0, 0);
        }
        buf = buf == 2 ? 0 : buf + 1;
    }
#undef G_STAGE_ISSUE
    asm volatile("s_waitcnt lgkmcnt(0)" ::: "memory");
    __builtin_amdgcn_s_barrier();
    if constexpr (SWAP) {
#pragma unroll
        for (int i = 0; i < 4; ++i)
#pragma unroll
            for (int jp = 0; jp < 2; ++jp) epi.row32(m0 + wm * 64 + i * 16 + fr, n0 + wn * 64 + jp * 32 + fq * 4, acc[i][2 * jp], acc[i][2 * jp + 1]);
    } else {
#pragma unroll
        for (int i = 0; i < 4; ++i)
#pragma unroll
            for (int j = 0; j < 4; ++j) epi.col4(m0 + wm * 64 + i * 16 + fq * 4, n0 + wn * 64 + j * 16 + fr, acc[i][j]);
    }
}
struct RowDense { const h16* A; int lda; __device__ __forceinline__ const h16* operator()(int m) const { return A + (size_t)m * lda; } };

__device__ __forceinline__ h16x4 cvt4(f32x4 v) { return (h16x4){(h16)v[0], (h16)v[1], (h16)v[2], (h16)v[3]}; }
__device__ __forceinline__ float rowgrp_sum(float v) { v += __shfl_xor(v, 16); v += __shfl_xor(v, 32); return v; }

struct EHy {
    const float* ssx; h16* hyT;
    __device__ __forceinline__ void col4(int mr, int n, f32x4 v) const {
        const f32x4 ss = *(const f32x4*)(ssx + mr);
        v[0] *= rstd_of(ss[0], D); v[1] *= rstd_of(ss[1], D); v[2] *= rstd_of(ss[2], D); v[3] *= rstd_of(ss[3], D);
        const int b = mr >> 12, t = mr & 4095;
        *(h16x4*)(hyT + ((size_t)(b * 1536 + n)) * S + t) = cvt4(v);
    } };
struct ELat {
    const float* ssx; h16* lat; float* ssq; float* sskv;
    __device__ __forceinline__ void row32(int m, int nb, f32x4 va, f32x4 vb) const {
        const float r = rstd_of(ssx[m], D); va *= r; vb *= r;
        if (nb < LAT) { *(h16x4*)(lat + (size_t)m * LAT + nb) = cvt4(va); *(h16x4*)(lat + (size_t)m * LAT + nb + 16) = cvt4(vb); }
        float s = va[0] * va[0] + va[1] * va[1] + va[2] * va[2] + va[3] * va[3] + vb[0] * vb[0] + vb[1] * vb[1] + vb[2] * vb[2] + vb[3] * vb[3];
        s = rowgrp_sum(s);
        if (ssq && (threadIdx.x & 63) < 16 && nb < 384) atomicAdd((nb < 256 ? ssq : sskv) + m, s);
    } };
struct EQ {
    const float* ssq; const float* rope; h16* Q;
    __device__ __forceinline__ void row32(int m, int nb, f32x4 va, f32x4 vb) const {
        const float r = rstd_of(ssq[m], 256) * QSCALE; va *= r; vb *= r;
        const int b = m >> 12, t = m & 4095, blk = nb >> 5, h = blk / 3, part = blk - 3 * h, c = nb & 31;
        if (part == 2) {
            const float* rp = rope + ((size_t)t * 16 + c) * 2;
#pragma unroll
            for (int j = 0; j < 4; ++j) { const float cs = rp[2 * j], sn = rp[2 * j + 1]; const float q1 = va[j], q2 = vb[j]; va[j] = q1 * cs - q2 * sn; vb[j] = q1 * sn + q2 * cs; }
        }
        h16* q = Q + ((size_t)((b * NH + h) * S + t)) * 96 + part * 32 + c;
        *(h16x4*)q = cvt4(va); *(h16x4*)(q + 16) = cvt4(vb);
    } };
struct EK {
    const float* sskv; h16* K;
    __device__ __forceinline__ void row32(int m, int nb, f32x4 va, f32x4 vb) const {
        const float r = rstd_of(sskv[m], 128); va *= r; vb *= r;
        const int b = m >> 12, t = m & 4095, h = nb >> 6, j = nb & 63;
        h16* k = K + ((size_t)((b * NH + h) * S + t)) * 96 + j;
        *(h16x4*)k = cvt4(va); *(h16x4*)(k + 16) = cvt4(vb);
    } };
struct EV {
    const float* sskv; h16* Vt;
    __device__ __forceinline__ void col4(int mr, int n, f32x4 v) const {
        const f32x4 ss = *(const f32x4*)(sskv + mr);
        v[0] *= rstd_of(ss[0], 128); v[1] *= rstd_of(ss[1], 128); v[2] *= rstd_of(ss[2], 128); v[3] *= rstd_of(ss[3], 128);
        const int b = mr >> 12, t = mr & 4095;
        *(h16x4*)(Vt + ((size_t)(b * 512 + n)) * S + t) = cvt4(v);
    } };
struct EKc {
    const float* ss; h16* Kc;
    __device__ __forceinline__ void row32(int m, int nb, f32x4 va, f32x4 vb) const {
        const float r = rstd_of(ss[m], D); va *= r; vb *= r;
        *(h16x4*)(Kc + (size_t)m * D + nb) = cvt4(va); *(h16x4*)(Kc + (size_t)m * D + nb + 16) = cvt4(vb);
    } };
struct EVc {
    const float* ss; h16* VcT;
    __device__ __forceinline__ void col4(int mr, int n, f32x4 v) const {
        const f32x4 s4 = *(const f32x4*)(ss + mr);
        v[0] *= rstd_of(s4[0], D); v[1] *= rstd_of(s4[1], D); v[2] *= rstd_of(s4[2], D); v[3] *= rstd_of(s4[3], D);
        const int b = mr >> 8, mm = mr & 255;
        *(h16x4*)(VcT + ((size_t)(b * 1024 + n)) * MEMT + mm) = cvt4(v);
    } };
struct ERes {
    const float* xin; float* X; h16* xh; float* ss;
    __device__ __forceinline__ void row32(int m, int nb, f32x4 va, f32x4 vb) const {
        const size_t i = (size_t)m * D + nb;
        va += *(const f32x4*)(xin + i); vb += *(const f32x4*)(xin + i + 16);
        *(f32x4*)(X + i) = va; *(f32x4*)(X + i + 16) = vb;
        *(h16x4*)(xh + i) = cvt4(va); *(h16x4*)(xh + i + 16) = cvt4(vb);
        float s = va[0] * va[0] + va[1] * va[1] + va[2] * va[2] + va[3] * va[3] + vb[0] * vb[0] + vb[1] * vb[1] + vb[2] * vb[2] + vb[3] * vb[3];
        s = rowgrp_sum(s);
        if (ss && (threadIdx.x & 63) < 16) atomicAdd(ss + m, s);
    } };
struct EMq {
    const float* ss; h16* qc;
    __device__ __forceinline__ void row32(int m, int nb, f32x4 va, f32x4 vb) const {
        const float r = rstd_of(ss[m], D) * CSCALE; va *= r; vb *= r;
        *(h16x4*)(qc + (size_t)m * D + nb) = cvt4(va); *(h16x4*)(qc + (size_t)m * D + nb + 16) = cvt4(vb);
    } };

template <bool SWAP, class Epi>
__device__ __forceinline__ void gemm_job(LAS char* lds, const h16* A, int lda, const h16* Wt, int ldw, int M, int N, int K, const Epi& epi, int first = 0) {
    const int ntn = N / G_BN, ntiles = (M / G_BM) * ntn;
    const RowDense rp{A, lda};
    const int G = gridDim.x, bx = blockIdx.x, vid = (G % 8 == 0) ? (bx % 8) * (G / 8) + bx / 8 : bx;
    for (int tix = (vid + G - first % G) % G; tix < ntiles; tix += G) {
        const int mt = tix / ntn, nt_ = tix - mt * ntn;
        gemm_tile<SWAP>(lds, rp, Wt, ldw, K, mt * G_BM, nt_ * G_BN, epi);
    }
}

template <class RowMap, class Gain>
__device__ __forceinline__ void wt_item(const float* W, int N, int K, h16* Wt, LAS float* scr, int k0, int n0, int lane, const RowMap& rowmap, const Gain& gain) {
#pragma unroll 8
    for (int i = 0; i < 32; ++i) { const int kk = 2 * i + (lane >> 5); scr[kk * 33 + (lane & 31)] = W[(size_t)(k0 + kk) * N + n0 + (lane & 31)] * gain(k0 + kk); }
    asm volatile("s_waitcnt lgkmcnt(0)" ::: "memory");
    const int c = lane & 7;
#pragma unroll
    for (int j = 0; j < 4; ++j) { const int n = (lane >> 3) + 8 * j; const LAS float* s = scr + (8 * c) * 33 + n;
        h16x8 o = {(h16)s[0], (h16)s[33], (h16)s[66], (h16)s[99], (h16)s[132], (h16)s[165], (h16)s[198], (h16)s[231]};
        *(h16x8*)(Wt + (size_t)rowmap(n0 + n) * K + k0 + 8 * c) = o; }
    asm volatile("s_waitcnt lgkmcnt(0)" ::: "memory");
}
struct GainNone { __device__ __forceinline__ float operator()(int) const { return 1.f; } };
struct Gain1 { const float* g; __device__ __forceinline__ float operator()(int k) const { return g[k]; } };
struct Gain2 { const float* g; const float* g2; __device__ __forceinline__ float operator()(int k) const { return k < 512 ? g[k] : g2[k - 512]; } };
struct MapId { __device__ __forceinline__ int operator()(int n) const { return n; } };
struct MapIn { __device__ __forceinline__ int operator()(int n) const { return n < LAT ? 1536 + n : n - LAT; } };
struct MapKV { __device__ __forceinline__ int operator()(int n) const { const int h = n >> 7, j = n & 127; return j < 64 ? h * 64 + j : 512 + h * 64 + (j - 64); } };
struct MapG { int up; __device__ __forceinline__ int operator()(int j) const { return 32 * (j >> 4) + (j & 15) + up; } };

__device__ __forceinline__ void phase_prep(const Params& p, LAS char* lds) {
    const int tid = threadIdx.x, lane = tid & 63, wid = tid >> 6;
    const int gw = blockIdx.x * NWAVE + wid, NGW = gridDim.x * NWAVE, gt = blockIdx.x * NTHR + tid, NGT = gridDim.x * NTHR;
    LAS float* scr = (LAS float*)(lds + wid * 16384);
    for (int i = gt; i < 5 * 16384; i += NGT) PF(WS_SSQ)[i] = 0.f;
    for (int row = gw; row < T + MROWS; row += NGW) {
        const bool isx = row < T; const int r = isx ? row : row - T;
        const f32x4* src = (const f32x4*)((isx ? p.in[0] : p.in[1]) + (size_t)r * D) + lane;
        h16* dst = (isx ? PH(WS_XH) : PH(WS_MEMH)) + (size_t)r * D;
        float s = 0.f;
#pragma unroll
        for (int j = 0; j < 4; ++j) { const f32x4 v = src[64 * j]; s += v[0] * v[0] + v[1] * v[1] + v[2] * v[2] + v[3] * v[3]; *(h16x4*)(dst + (lane + 64 * j) * 4) = cvt4(v); }
        s = wave_sum(s);
        if (lane == 0) (isx ? PF(WS_SSX) : PF(WS_SSMEM))[r] = s;
    }
    {
        constexpr int I_IN = 16 * 61, I_UQ = 4 * 24, I_UKV = 2 * 32, I_SQ = 16 * 32, I_MKV = 16 * 64, I_EX = 16 * 8, I_DN = 4 * 32;
        constexpr int NIT = I_IN + I_UQ + I_UKV + 3 * I_SQ + I_MKV + NE * (2 * I_EX + I_DN);
        for (int it = gw; it < NIT; it += NGW) {
            int r = it;
            if (r < I_IN) { wt_item(p.in[3], INC, D, PH(WS_WIN), scr, (r / 61) * 64, (r % 61) * 32, lane, MapIn{}, Gain1{p.in[2]}); continue; } r -= I_IN;
            if (r < I_UQ) { wt_item(p.in[6], 768, 256, PH(WS_WUQ), scr, (r / 24) * 64, (r % 24) * 32, lane, MapId{}, Gain1{p.in[4]}); continue; } r -= I_UQ;
            if (r < I_UKV) { wt_item(p.in[7], 1024, 128, PH(WS_WUKV), scr, (r / 32) * 64, (r % 32) * 32, lane, MapKV{}, Gain1{p.in[5]}); continue; } r -= I_UKV;
            if (r < I_SQ) { wt_item(p.in[21], D, D, PH(WS_WOUT), scr, (r / 32) * 64, (r % 32) * 32, lane, MapId{}, Gain2{p.in[19], p.in[20]}); continue; } r -= I_SQ;
            if (r < I_SQ) { wt_item(p.in[24], D, D, PH(WS_WMQ), scr, (r / 32) * 64, (r % 32) * 32, lane, MapId{}, Gain1{p.in[22]}); continue; } r -= I_SQ;
            if (r < I_SQ) { wt_item(p.in[26], D, D, PH(WS_WMO), scr, (r / 32) * 64, (r % 32) * 32, lane, MapId{}, GainNone{}); continue; } r -= I_SQ;
            if (r < I_MKV) { wt_item(p.in[25], 2048, D, PH(WS_WMKV), scr, (r / 64) * 64, (r % 64) * 32, lane, MapId{}, Gain1{p.in[23]}); continue; } r -= I_MKV;
            const int e = r / (2 * I_EX + I_DN); r -= e * (2 * I_EX + I_DN);
            if (r < I_EX) { wt_item(p.in[32] + (size_t)e * D * DE, DE, D, PH(WS_WGU) + (size_t)e * 512 * D, scr, (r / 8) * 64, (r % 8) * 32, lane, MapG{0}, Gain1{p.in[27]}); continue; } r -= I_EX;
            if (r < I_EX) { wt_item(p.in[33] + (size_t)e * D * DE, DE, D, PH(WS_WGU) + (size_t)e * 512 * D, scr, (r / 8) * 64, (r % 8) * 32, lane, MapG{16}, Gain1{p.in[27]}); continue; } r -= I_EX;
            wt_item(p.in[34] + (size_t)e * DE * D, D, DE, PH(WS_WDN) + (size_t)e * D * DE, scr, (r / 32) * 64, (r % 32) * 32, lane, MapId{}, GainNone{});
        }
        for (int i = gt; i < 96 * D / 8; i += NGT) *(h16x8*)(PH(WS_WIN) + (size_t)INC * D + (size_t)i * 8) = (h16x8){0, 0, 0, 0, 0, 0, 0, 0};
    }
    for (int i = gt; i < S * 16; i += NGT) { const int t = i >> 4, pp = i & 15; const float inv = exp2f(-(float)pp * (13.287712379549449f / 16.0f)); float sn, cs; sincosf((float)t * inv, &sn, &cs);
        PF(WS_ROPE)[2 * i] = cs; PF(WS_ROPE)[2 * i + 1] = sn; }
    {
        LAS float* zf = scr; LAS float* h1 = scr + 64;
        const float* w1 = p.in[10]; const float* b1 = p.in[11]; const float* freq = p.in[12]; const float* w2 = p.in[13]; const float* b2 = p.in[14];
        for (int t = gw; t < S; t += NGW) {
            const int j = lane;
            if (j < 33) { float v;
                if (j == 0) v = (float)t / (float)S;
                else { const int bi = (j - 1) & 15; const float band = 1e-4f + (float)bi * ((15.0f - 1e-4f) / 15.0f);
                    double rev = (double)t * (double)band / (double)S; rev -= floor(rev); const float r2 = (float)(2.0 * rev);
                    v = (j <= 16) ? cospif(r2) : -sinpif(r2); }
                zf[j] = v; }
            asm volatile("s_waitcnt lgkmcnt(0)" ::: "memory");
            float a = b1[j];
            for (int i = 0; i < 33; ++i) a += zf[i] * w1[i * 64 + j];
            h1[j] = sinf(freq[j] * a);
            asm volatile("s_waitcnt lgkmcnt(0)" ::: "memory");
            float c = b2[j];
            for (int i = 0; i < 64; ++i) c += h1[i] * w2[i * 64 + j];
            PF(WS_H2)[t * 64 + j] = sinf(freq[64 + j] * c);
            asm volatile("s_waitcnt lgkmcnt(0)" ::: "memory");
        }
    }
}
__device__ __forceinline__ void phase_filt3(const Params& p) {
    const int gt = blockIdx.x * NTHR + threadIdx.x, NGT = gridDim.x * NTHR;
    const float* H2 = PF(WS_H2); const float* w3 = p.in[15]; const float* b3 = p.in[16]; const float* decay = p.in[17]; h16* R = PH(WS_R);
    for (int i = gt; i < S * 2048; i += NGT) {
        const int col = i & 2047, tau = i >> 11;
        float a = b3[col];
#pragma unroll 8
        for (int j = 0; j < 64; ++j) a += H2[tau * 64 + j] * w3[j * 2048 + col];
        a *= HY_FSCALE * expf(-((float)tau / (float)S) * fabsf(decay[col]));
        const int o = col >> 10, dir = (col >> 9) & 1, c = col & 511;
        h16* r = R + ((size_t)(o * 512 + c)) * 8192;
        if (dir == 0) r[4096 - tau] = (h16)a;
        else r[tau == 0 ? 0 : 4096 + tau] = (h16)(tau == 0 ? 0.f : a);
    }
}
__device__ __forceinline__ void phase_krot(const Params& p) {
    const int gt = blockIdx.x * NTHR + threadIdx.x, NGT = gridDim.x * NTHR;
    const h16* lat = PH(WS_LAT); h16* K = PH(WS_K); const float* rope = PF(WS_ROPE);
    for (int i = gt; i < T * 4; i += NGT) {
        const int m = i >> 2, p0 = (i & 3) * 4, b = m >> 12, t = m & 4095;
        const h16x4 k1 = *(const h16x4*)(lat + (size_t)m * LAT + 384 + p0), k2 = *(const h16x4*)(lat + (size_t)m * LAT + 400 + p0);
        h16x4 o1, o2;
#pragma unroll
        for (int j = 0; j < 4; ++j) { const float cs = rope[((size_t)t * 16 + p0 + j) * 2], sn = rope[((size_t)t * 16 + p0 + j) * 2 + 1];
            const float a = (float)k1[j], c = (float)k2[j]; o1[j] = (h16)(a * cs - c * sn); o2[j] = (h16)(a * sn + c * cs); }
#pragma unroll
        for (int h = 0; h < NH; ++h) { h16* kp = K + ((size_t)((b * NH + h) * S + t)) * 96 + 64 + p0; *(h16x4*)kp = o1; *(h16x4*)(kp + 16) = o2; }
    }
}


constexpr int AT_KROW = 208, AT_VROW = 136, AT_KB = 64 * AT_KROW, AT_VB = 64 * AT_VROW, AT_BUF = AT_KB + AT_VB;
__device__ __forceinline__ void phase_attn(const Params& p, LAS char* lds) {
    const int tid = threadIdx.x, lane = tid & 63, wid = __builtin_amdgcn_readfirstlane(tid >> 6), r32 = lane & 31, hi = lane >> 5;
    const h16* Qg = PH(WS_Q); const h16* Kg = PH(WS_K); const h16* Vtg = PH(WS_VT); h16* aout = PH(WS_AOUT);
    const int k0r = tid / 12, k0c = tid - 12 * k0r, c1 = tid + 512, k1r = c1 / 12, k1c = c1 - 12 * k1r;
    const int vdv = tid >> 3, vc = tid & 7;
    const int G = gridDim.x, bx = blockIdx.x, vid = (G % 8 == 0) ? (bx % 8) * (G / 8) + bx / 8 : bx;
    for (int u = vid; u < NB * NH * 16; u += G) {
        const int bh = u >> 4, q0 = (u & 15) * 256 + wid * 32;
        h16x8 qf[6];
        { const h16* qp = Qg + ((size_t)bh * S + q0 + r32) * 96 + 8 * hi;
#pragma unroll
          for (int s_ = 0; s_ < 6; ++s_) qf[s_] = *(const h16x8*)(qp + 16 * s_); }
        const h16* Kb = Kg + (size_t)bh * S * 96; const h16* Vb = Vtg + (size_t)bh * 64 * S + (size_t)vdv * S + vc * 8;
        h16x8 kr0, kr1, vr;
        kr0 = *(const h16x8*)(Kb + tid * 8); kr1 = kr0; if (tid < 256) kr1 = *(const h16x8*)(Kb + c1 * 8); vr = *(const h16x8*)(Vb);
        __syncthreads();
        { *(LAS h16x8*)(lds + k0r * AT_KROW + k0c * 16) = kr0; if (tid < 256) *(LAS h16x8*)(lds + k1r * AT_KROW + k1c * 16) = kr1;
          LAS char* vn = lds + AT_KB + vdv * AT_VROW + vc * 16; *(LAS h16x4*)vn = (h16x4){vr[0], vr[1], vr[2], vr[3]}; *(LAS h16x4*)(vn + 8) = (h16x4){vr[4], vr[5], vr[6], vr[7]}; }
        __syncthreads();
        f32x16 o0, o1;
#pragma unroll
        for (int r = 0; r < 16; ++r) { o0[r] = 0.f; o1[r] = 0.f; }
        float m = -1e30f, l = 0.f;
        for (int t = 0; t < S / 64; ++t) {
            if (t + 1 < S / 64) {
                const h16* kn = Kb + (size_t)(t + 1) * 64 * 96;
                kr0 = *(const h16x8*)(kn + tid * 8); if (tid < 256) kr1 = *(const h16x8*)(kn + c1 * 8); vr = *(const h16x8*)(Vb + (t + 1) * 64);
            }
            LAS char* kb = lds + (t & 1) * AT_BUF; LAS char* vb = kb + AT_KB;
            f32x16 p0, p1;
#pragma unroll
            for (int r = 0; r < 16; ++r) { p0[r] = 0.f; p1[r] = 0.f; }
#pragma unroll
            for (int s_ = 0; s_ < 6; ++s_) {
                const h16x8 a0 = *(LAS h16x8*)(kb + r32 * AT_KROW + s_ * 32 + hi * 16);
                const h16x8 a1 = *(LAS h16x8*)(kb + (32 + r32) * AT_KROW + s_ * 32 + hi * 16);
                p0 = __builtin_amdgcn_mfma_f32_32x32x16_f16(a0, qf[s_], p0, 0, 0, 0);
                p1 = __builtin_amdgcn_mfma_f32_32x32x16_f16(a1, qf[s_], p1, 0, 0, 0);
            }
            float mx = fmaxf(p0[0], p1[0]);
#pragma unroll
            for (int r = 1; r < 16; ++r) mx = fmaxf(mx, fmaxf(p0[r], p1[r]));
            mx = fmaxf(mx, __shfl_xor(mx, 32));
            const float mn = fmaxf(m, mx), al = __builtin_amdgcn_exp2f(m - mn); m = mn;
            float rs = 0.f;
#pragma unroll
            for (int r = 0; r < 16; ++r) { p0[r] = __builtin_amdgcn_exp2f(p0[r] - mn); p1[r] = __builtin_amdgcn_exp2f(p1[r] - mn); rs += p0[r] + p1[r]; }
            l = l * al + rs;
#pragma unroll
            for (int r = 0; r < 16; ++r) { o0[r] *= al; o1[r] *= al; }
            h16x8 pf[2][2];
#pragma unroll
            for (int j = 0; j < 8; ++j) { pf[0][0][j] = (h16)p0[j]; pf[0][1][j] = (h16)p0[8 + j]; pf[1][0][j] = (h16)p1[j]; pf[1][1][j] = (h16)p1[8 + j]; }
#pragma unroll
            for (int kh = 0; kh < 2; ++kh)
#pragma unroll
                for (int s_ = 0; s_ < 2; ++s_) {
                    LAS char* v0 = vb + r32 * AT_VROW + (kh * 32 + 16 * s_ + 4 * hi) * 2;
                    const h16x4 a = *(LAS h16x4*)v0, b = *(LAS h16x4*)(v0 + 16);
                    const h16x4 c = *(LAS h16x4*)(v0 + 32 * AT_VROW), d = *(LAS h16x4*)(v0 + 32 * AT_VROW + 16);
                    const h16x8 vf0 = {a[0], a[1], a[2], a[3], b[0], b[1], b[2], b[3]}, vf1 = {c[0], c[1], c[2], c[3], d[0], d[1], d[2], d[3]};
                    o0 = __builtin_amdgcn_mfma_f32_32x32x16_f16(vf0, pf[kh][s_], o0, 0, 0, 0);
                    o1 = __builtin_amdgcn_mfma_f32_32x32x16_f16(vf1, pf[kh][s_], o1, 0, 0, 0);
                }
            if (t + 1 < S / 64) {
                LAS char* kn = lds + ((t + 1) & 1) * AT_BUF;
                *(LAS h16x8*)(kn + k0r * AT_KROW + k0c * 16) = kr0; if (tid < 256) *(LAS h16x8*)(kn + k1r * AT_KROW + k1c * 16) = kr1;
                LAS char* vn = kn + AT_KB + vdv * AT_VROW + vc * 16; *(LAS h16x4*)vn = (h16x4){vr[0], vr[1], vr[2], vr[3]}; *(LAS h16x4*)(vn + 8) = (h16x4){vr[4], vr[5], vr[6], vr[7]};
            }
            __syncthreads();
        }
        const float il = 1.f / (l + __shfl_xor(l, 32));
        const int b = bh >> 3, h = bh & 7;
        h16* ap = aout + ((size_t)(b * S + q0 + r32)) * 512 + h * 64 + 4 * hi;
#pragma unroll
        for (int g = 0; g < 4; ++g) {
            *(h16x4*)(ap + 8 * g) = (h16x4){(h16)(o0[4 * g] * il), (h16)(o0[4 * g + 1] * il), (h16)(o0[4 * g + 2] * il), (h16)(o0[4 * g + 3] * il)};
            *(h16x4*)(ap + 32 + 8 * g) = (h16x4){(h16)(o1[4 * g] * il), (h16)(o1[4 * g + 1] * il), (h16)(o1[4 * g + 2] * il), (h16)(o1[4 * g + 3] * il)};
        }
    }
    __syncthreads();
}
constexpr int HY_CS = 16448, HY_ZOFF = 4 * HY_CS, HY_ZB = 11584, HY_LDS = HY_ZOFF + 4 * HY_ZB;
static_assert(HY_LDS <= LDS_BYTES, "hyena lds");
__device__ __forceinline__ void phase_hyena(const Params& p, LAS char* lds) {
    const int tid = threadIdx.x, lane = tid & 63, wid = __builtin_amdgcn_readfirstlane(tid >> 6), r32 = lane & 31, hi = lane >> 5;
    const h16* hyT = PH(WS_HYT); const h16* Rg = PH(WS_R); const float* convw = p.in[8]; const float* convb = p.in[9]; const float* skip = p.in[18]; h16* hT = PH(WS_HT);
    const int G = gridDim.x, bx = blockIdx.x, vid = (G % 8 == 0) ? (bx % 8) * (G / 8) + bx / 8 : bx;
    __syncthreads();
    for (int i = tid; i < 4 * 16 * 36; i += NTHR) { const int batch = i / 576, rem = i - batch * 576, blk = rem / 36, w = rem - blk * 36, bi = blk < 8 ? blk : 64 + blk;
        *(LAS unsigned*)(lds + HY_ZOFF + batch * HY_ZB + bi * 144 + w * 4) = 0u; }
    const int i0 = wid * 8, q = r32 & 3, ii = r32 >> 2, batch = r32 & 3;
    const int abase = q * HY_CS + 2 * (4096 + 8 * hi - (r32 - q));
    const int bbase = HY_ZOFF + batch * HY_ZB + ((i0 + ii + 8) * 72 + 8 * hi) * 2;
    for (int c = vid; c < HYW; c += G) {
        for (int n = 0; n < 2; ++n) {
            __syncthreads();
            { const h16* Rc = Rg + ((size_t)(n * 512 + c)) * 8192;
              for (int k = tid; k < 1024; k += NTHR) { const h16x8 v = *(const h16x8*)(Rc + k * 8);
                  *(LAS h16x8*)(lds + k * 16) = v;
#pragma unroll
                  for (int qq = 1; qq < 4; ++qq)
#pragma unroll
                      for (int e = 0; e < 8; ++e) *(LAS h16*)(lds + qq * HY_CS + (k * 8 + e + qq) * 2) = v[e]; } }
            if (n == 0) {
                const int ch = 1024 + c; const float w0 = convw[ch], w1 = convw[1536 + ch], w2 = convw[3072 + ch], bb = convb[ch];
                for (int i = tid; i < 4 * 512; i += NTHR) { const int bt = i >> 9, t0 = (i & 511) * 8; const h16* raw = hyT + ((size_t)(bt * 1536 + ch)) * S + t0;
                    const h16x8 v = *(const h16x8*)raw; float x[10]; x[0] = t0 > 0 ? (float)raw[-1] : 0.f; x[9] = t0 + 8 < S ? (float)raw[8] : 0.f;
#pragma unroll
                    for (int e = 0; e < 8; ++e) x[e + 1] = (float)v[e];
                    h16x8 o;
#pragma unroll
                    for (int e = 0; e < 8; ++e) o[e] = (h16)(w0 * x[e] + w1 * x[e + 1] + w2 * x[e + 2] + bb);
                    *(LAS h16x8*)(lds + HY_ZOFF + bt * HY_ZB + (((t0 >> 6) + 8) * 72 + (t0 & 63)) * 2) = o; }
            }
            __syncthreads();
            f32x16 acc0, acc1;
#pragma unroll
            for (int r = 0; r < 16; ++r) { acc0[r] = 0.f; acc1[r] = 0.f; }
            for (int d = i0 - 63; d <= i0 + 7; ++d) {
                LAS char* ap = lds + abase - 128 * d; LAS char* bp = lds + bbase - 144 * d;
#pragma unroll
                for (int kc = 0; kc < 4; ++kc) {
                    const h16x8 bf = *(LAS h16x8*)(bp + 32 * kc);
                    const h16x4 a0l = *(LAS h16x4*)(ap + 32 * kc), a0h = *(LAS h16x4*)(ap + 32 * kc + 8);
                    const h16x4 a1l = *(LAS h16x4*)(ap + 32 * kc - 64), a1h = *(LAS h16x4*)(ap + 32 * kc - 56);
                    const h16x8 af0 = {a0l[0], a0l[1], a0l[2], a0l[3], a0h[0], a0h[1], a0h[2], a0h[3]}, af1 = {a1l[0], a1l[1], a1l[2], a1l[3], a1h[0], a1h[1], a1h[2], a1h[3]};
                    acc0 = __builtin_amdgcn_mfma_f32_32x32x16_f16(af0, bf, acc0, 0, 0, 0);
                    acc1 = __builtin_amdgcn_mfma_f32_32x32x16_f16(af1, bf, acc1, 0, 0, 0);
                }
            }
            __syncthreads();
            {
                const int gch = n == 0 ? c : 512 + c; const float w0 = convw[gch], w1 = convw[1536 + gch], w2 = convw[3072 + gch], bb = convb[gch], sk = skip[n * 512 + c];
                const h16* graw = hyT + ((size_t)(batch * 1536 + gch)) * S;
#pragma unroll
                for (int rt = 0; rt < 2; ++rt)
#pragma unroll
                    for (int g = 0; g < 4; ++g) {
                        const int a4 = 32 * rt + 8 * g + 4 * hi, t4 = 64 * (i0 + ii) + a4;
                        LAS char* zp = lds + HY_ZOFF + batch * HY_ZB + ((i0 + ii + 8) * 72 + a4) * 2;
                        const h16x4 zo = *(LAS h16x4*)zp;
                        const h16x4 gv = *(const h16x4*)(graw + t4);
                        float x[6]; x[0] = t4 > 0 ? (float)graw[t4 - 1] : 0.f; x[5] = t4 + 4 < S ? (float)graw[t4 + 4] : 0.f;
#pragma unroll
                        for (int e = 0; e < 4; ++e) x[e + 1] = (float)gv[e];
                        h16x4 zn;
#pragma unroll
                        for (int e = 0; e < 4; ++e) { const float gc = w0 * x[e] + w1 * x[e + 1] + w2 * x[e + 2] + bb; const float y = (rt == 0 ? acc0[4 * g + e] : acc1[4 * g + e]) * HY_FINV;
                            zn[e] = (h16)(gc * (y + sk * (float)zo[e])); }
                        if (n == 0) *(LAS h16x4*)zp = zn; else *(h16x4*)(hT + ((size_t)(batch * 512 + c)) * S + t4) = zn;
                    }
            }
        }
    }
    __syncthreads();
}
__device__ __forceinline__ void phase_mixprep(const Params& p, LAS char* lds) {
    constexpr int LDT = 520;
    LAS h16* tile = (LAS h16*)lds;
    const h16* aout = PH(WS_AOUT); const h16* hT = PH(WS_HT); h16* mix = PH(WS_MIX);
    const int tid = threadIdx.x, lane = tid & 63, wid = tid >> 6;
    for (int u = blockIdx.x; u < T / 64; u += gridDim.x) {
        const int m0 = u * 64, b = m0 >> 12, t0 = m0 & 4095;
        __syncthreads();
        for (int i = tid; i < 512 * 8; i += NTHR) { const int c = i >> 3, j = i & 7;
            const h16x8 v = *(const h16x8*)(hT + ((size_t)(b * 512 + c)) * S + t0 + j * 8);
#pragma unroll
            for (int e = 0; e < 8; ++e) tile[(j * 8 + e) * LDT + c] = v[e]; }
        __syncthreads();
        for (int rr = 0; rr < 8; ++rr) {
            const int r = wid * 8 + rr; const size_t m = (size_t)(m0 + r);
            const h16x8 hv = *(LAS h16x8*)(tile + r * LDT + lane * 8);
            const h16x8 av = *(const h16x8*)(aout + m * 512 + lane * 8);
            float sh = 0.f, sa = 0.f;
#pragma unroll
            for (int e = 0; e < 8; ++e) { const float x = (float)hv[e], y = (float)av[e]; sh += x * x; sa += y * y; }
            sh = wave_sum(sh); sa = wave_sum(sa);
            const float rh = rstd_of(sh, 512), ra = rstd_of(sa, 512);
            h16x8 oh, oa;
#pragma unroll
            for (int e = 0; e < 8; ++e) { oh[e] = (h16)((float)hv[e] * rh); oa[e] = (h16)((float)av[e] * ra); }
            *(h16x8*)(mix + m * D + lane * 8) = oa; *(h16x8*)(mix + m * D + 512 + lane * 8) = oh;
        }
    }
    __syncthreads();
}
constexpr int XA_KROW = 528, XA_VROW = 136, XA_KB = 64 * XA_KROW, XA_VB = 128 * XA_VROW, XA_BUF = XA_KB + XA_VB;
static_assert(2 * XA_BUF <= LDS_BYTES, "xattn lds");
__device__ __forceinline__ void phase_xattn(const Params& p, LAS char* lds) {
    const int tid = threadIdx.x, lane = tid & 63, wid = __builtin_amdgcn_readfirstlane(tid >> 6), r32 = lane & 31, hi = lane >> 5;
    const h16* qc = PH(WS_QC); h16* oc = PH(WS_OC); const h16* Kc = PH(WS_KC); const h16* VcT = PH(WS_VCT);
    const int G = gridDim.x, bx = blockIdx.x, vid = (G % 8 == 0) ? (bx % 8) * (G / 8) + bx / 8 : bx;
    for (int u = vid; u < NB * MH * 16; u += G) {
        const int bh = u >> 4, b = bh >> 2, h = bh & 3, q0 = (u & 15) * 256 + wid * 32;
        const h16* qrow = qc + ((size_t)(b * S + q0 + r32)) * D + h * MHD; h16* orow = oc + ((size_t)(b * S + q0 + r32)) * D + h * MHD;
        h16x8 qf[16];
#pragma unroll
        for (int s_ = 0; s_ < 16; ++s_) qf[s_] = *(const h16x8*)(qrow + 16 * s_ + 8 * hi);
        const h16* Ksrc = Kc + ((size_t)(b * MEMT + (tid >> 5))) * D + h * MHD + (tid & 31) * 8;
        const h16* Vsrc = VcT + ((size_t)(bh * MHD + (tid >> 3))) * MEMT + (tid & 7) * 8;
        const int kdst = (tid >> 5) * XA_KROW + (tid & 31) * 16, vdst = XA_KB + (tid >> 3) * XA_VROW + (tid & 7) * 16;
        h16x8 kr[4], vr[2];
#pragma unroll
        for (int j = 0; j < 4; ++j) kr[j] = *(const h16x8*)(Ksrc + (size_t)(16 * j) * D);
#pragma unroll
        for (int j = 0; j < 2; ++j) vr[j] = *(const h16x8*)(Vsrc + (size_t)(64 * j) * MEMT);
        __syncthreads();
#pragma unroll
        for (int j = 0; j < 4; ++j) *(LAS h16x8*)(lds + kdst + 16 * j * XA_KROW) = kr[j];
#pragma unroll
        for (int j = 0; j < 2; ++j) { LAS char* vn = lds + vdst + 64 * j * XA_VROW; *(LAS h16x4*)vn = (h16x4){vr[j][0], vr[j][1], vr[j][2], vr[j][3]}; *(LAS h16x4*)(vn + 8) = (h16x4){vr[j][4], vr[j][5], vr[j][6], vr[j][7]}; }
        __syncthreads();
        f32x16 o[4]; float m = -1e30f, l = 0.f;
#pragma unroll
        for (int dt = 0; dt < 4; ++dt)
#pragma unroll
            for (int r = 0; r < 16; ++r) o[dt][r] = 0.f;
        for (int st = 0; st < 8; ++st) {
            const int t = st & 3, pass = st >> 2;
            if (st + 1 < 8) { const int t1 = (st + 1) & 3, p1 = (st + 1) >> 2;
#pragma unroll
                for (int j = 0; j < 4; ++j) kr[j] = *(const h16x8*)(Ksrc + (size_t)(64 * t1 + 16 * j) * D);
#pragma unroll
                for (int j = 0; j < 2; ++j) vr[j] = *(const h16x8*)(Vsrc + (size_t)(128 * p1 + 64 * j) * MEMT + 64 * t1); }
            LAS char* kb = lds + (st & 1) * XA_BUF; LAS char* vb = kb + XA_KB;
            f32x16 p0, p1_;
#pragma unroll
            for (int r = 0; r < 16; ++r) { p0[r] = 0.f; p1_[r] = 0.f; }
#pragma unroll
            for (int s_ = 0; s_ < 16; ++s_) {
                const h16x8 a0 = *(LAS h16x8*)(kb + r32 * XA_KROW + s_ * 32 + hi * 16);
                const h16x8 a1 = *(LAS h16x8*)(kb + (32 + r32) * XA_KROW + s_ * 32 + hi * 16);
                p0 = __builtin_amdgcn_mfma_f32_32x32x16_f16(a0, qf[s_], p0, 0, 0, 0);
                p1_ = __builtin_amdgcn_mfma_f32_32x32x16_f16(a1, qf[s_], p1_, 0, 0, 0);
            }
            float mx = fmaxf(p0[0], p1_[0]);
#pragma unroll
            for (int r = 1; r < 16; ++r) mx = fmaxf(mx, fmaxf(p0[r], p1_[r]));
            mx = fmaxf(mx, __shfl_xor(mx, 32));
            const float mn = fmaxf(m, mx), al = __builtin_amdgcn_exp2f(m - mn); m = mn;
            float rs = 0.f;
#pragma unroll
            for (int r = 0; r < 16; ++r) { p0[r] = __builtin_amdgcn_exp2f(p0[r] - mn); p1_[r] = __builtin_amdgcn_exp2f(p1_[r] - mn); rs += p0[r] + p1_[r]; }
            l = l * al + rs;
#pragma unroll
            for (int dt = 0; dt < 4; ++dt)
#pragma unroll
                for (int r = 0; r < 16; ++r) o[dt][r] *= al;
            h16x8 pf[2][2];
#pragma unroll
            for (int j = 0; j < 8; ++j) { pf[0][0][j] = (h16)p0[j]; pf[0][1][j] = (h16)p0[8 + j]; pf[1][0][j] = (h16)p1_[j]; pf[1][1][j] = (h16)p1_[8 + j]; }
#pragma unroll
            for (int kh = 0; kh < 2; ++kh)
#pragma unroll
                for (int s_ = 0; s_ < 2; ++s_)
#pragma unroll
                    for (int dt = 0; dt < 4; ++dt) {
                        LAS char* v0 = vb + (dt * 32 + r32) * XA_VROW + (kh * 32 + 16 * s_ + 4 * hi) * 2;
                        const h16x4 a = *(LAS h16x4*)v0, c = *(LAS h16x4*)(v0 + 16);
                        const h16x8 vf = {a[0], a[1], a[2], a[3], c[0], c[1], c[2], c[3]};
                        o[dt] = __builtin_amdgcn_mfma_f32_32x32x16_f16(vf, pf[kh][s_], o[dt], 0, 0, 0);
                    }
            if (st + 1 < 8) {
                LAS char* nb = lds + ((st + 1) & 1) * XA_BUF;
#pragma unroll
                for (int j = 0; j < 4; ++j) *(LAS h16x8*)(nb + kdst + 16 * j * XA_KROW) = kr[j];
#pragma unroll
                for (int j = 0; j < 2; ++j) { LAS char* vn = nb + vdst + 64 * j * XA_VROW; *(LAS h16x4*)vn = (h16x4){vr[j][0], vr[j][1], vr[j][2], vr[j][3]}; *(LAS h16x4*)(vn + 8) = (h16x4){vr[j][4], vr[j][5], vr[j][6], vr[j][7]}; }
            }
            if (t == 3) {
                const float il = 1.f / (l + __shfl_xor(l, 32));
                h16* op = orow + pass * 128 + 4 * hi;
#pragma unroll
                for (int dt = 0; dt < 4; ++dt)
#pragma unroll
                    for (int g = 0; g < 4; ++g) {
                        *(h16x4*)(op + dt * 32 + 8 * g) = (h16x4){(h16)(o[dt][4 * g] * il), (h16)(o[dt][4 * g + 1] * il), (h16)(o[dt][4 * g + 2] * il), (h16)(o[dt][4 * g + 3] * il)};
                        o[dt][4 * g] = 0.f; o[dt][4 * g + 1] = 0.f; o[dt][4 * g + 2] = 0.f; o[dt][4 * g + 3] = 0.f; }
                m = -1e30f; l = 0.f;
            }
            __syncthreads();
        }
    }
    __syncthreads();
}
__device__ __forceinline__ void phase_route(const Params& p) {
    const float* X = p.X; const float* g = p.in[27]; const float* wrg = p.in[28]; const float* brg = p.in[29]; const float* wre = p.in[30]; const float* bre = p.in[31];
    float* ssx2 = PF(WS_SSX2); float* tokw = PF(WS_TOKW); int* cnt = PI(WS_CTL); int* list = PI(WS_LIST);
    const int lane = threadIdx.x & 63, gw = blockIdx.x * NWAVE + (threadIdx.x >> 6), NGW = gridDim.x * NWAVE;
    for (int m = gw; m < T; m += NGW) {
        float ss = 0.f;
#pragma unroll 4
        for (int i = 0; i < 16; ++i) { const float xv = X[(size_t)m * D + lane + 64 * i]; ss += xv * xv; }
        ss = wave_sum(ss);
        const float rs = rstd_of(ss, D);
        float lg[36];
#pragma unroll
        for (int j = 0; j < 36; ++j) lg[j] = 0.f;
#pragma unroll 1
        for (int i = 0; i < 16; ++i) { const int k = lane + 64 * i; const float tv = X[(size_t)m * D + k] * rs * g[k];
            const f32x4 wg4 = *(const f32x4*)(wrg + k * 4);
#pragma unroll
            for (int j = 0; j < 4; ++j) lg[j] += tv * wg4[j];
#pragma unroll
            for (int j4 = 0; j4 < 8; ++j4) { const f32x4 we4 = *(const f32x4*)(wre + k * 32 + j4 * 4);
#pragma unroll
                for (int j = 0; j < 4; ++j) lg[4 + j4 * 4 + j] += tv * we4[j]; } }
#pragma unroll
        for (int j = 0; j < 36; ++j) lg[j] = wave_sum(lg[j]);
        if (lane == 0) {
            ssx2[m] = ss;
            float gl[4]; int gi = 0; float gm = -1e30f;
#pragma unroll
            for (int j = 0; j < 4; ++j) { gl[j] = lg[j] + brg[j]; if (gl[j] > gm) { gm = gl[j]; gi = j; } }
            float gs = 0.f;
#pragma unroll
            for (int j = 0; j < 4; ++j) gs += expf(gl[j] - gm);
            const float pg = 1.f / gs;
            float e1 = -1e30f, e2 = -1e30f; int i1 = 0, i2 = 0;
#pragma unroll
            for (int g4 = 0; g4 < 4; ++g4) if (g4 == gi) {
#pragma unroll
                for (int j = 0; j < 8; ++j) { const float v = lg[4 + g4 * 8 + j] + bre[g4 * 8 + j];
                    if (v > e1) { e2 = e1; i2 = i1; e1 = v; i1 = j; } else if (v > e2) { e2 = v; i2 = j; } } }
            const float p2 = 1.f / (1.f + expf(e1 - e2)), p1 = 1.f - p2;
            const int ea = gi * 8 + i1, eb = gi * 8 + i2;
            tokw[m * 2] = pg * p1; tokw[m * 2 + 1] = pg * p2;
            const int pa = atomicAdd(&cnt[ea], 1), pb = atomicAdd(&cnt[eb], 1);
            list[ea * T + pa] = m * 2; list[eb * T + pb] = m * 2 + 1;
        }
    }
}
struct RowGather { const h16* A; const int* lst; int Me; __device__ __forceinline__ const h16* operator()(int m) const { const int pr = m < Me ? lst[m] : lst[0]; return A + (size_t)(pr >> 1) * D; } };
struct RowClamp { const h16* A; int Me; __device__ __forceinline__ const h16* operator()(int m) const { return A + (size_t)(m < Me ? m : 0) * DE; } };
struct EGu { const int* lst; int Me; const float* ssx2; const float* tokw; h16* hb;
    __device__ __forceinline__ void row32(int m, int nb, f32x4 va, f32x4 vb) const {
        if (m >= Me) return;
        const int pr = lst[m]; const float rs = rstd_of(ssx2[pr >> 1], D), w = tokw[pr];
        h16x4 o;
#pragma unroll
        for (int j = 0; j < 4; ++j) { const float a = va[j] * rs, bb = vb[j] * rs; o[j] = (h16)(a / (1.f + __expf(-a)) * bb * w); }
        *(h16x4*)(hb + (size_t)m * DE + (nb >> 5) * 16 + (nb & 31)) = o;
    } };
struct EDn { const int* lst; int Me; h16* yb;
    __device__ __forceinline__ void row32(int m, int nb, f32x4 va, f32x4 vb) const {
        if (m >= Me) return;
        h16* y = yb + (size_t)lst[m] * D + nb;
        *(h16x4*)y = cvt4(va); *(h16x4*)(y + 16) = cvt4(vb);
    } };
template <bool DOWN>
__device__ __forceinline__ void phase_moe(const Params& p, LAS char* lds) {
    const int* cnt = PI(WS_CTL);
    const int G = gridDim.x, bx = blockIdx.x, vid = (G % 8 == 0) ? (bx % 8) * (G / 8) + bx / 8 : bx;
    constexpr int NTN = DOWN ? D / G_BN : 512 / G_BN;
    int tbase = 0, off = 0;
    int tix = vid;
    for (int e = 0; e < NE; ++e) {
        const int Me = cnt[e], nmt = (Me + G_BM - 1) / G_BM, nte = nmt * NTN;
        const int* lst = PI(WS_LIST) + (size_t)e * T;
        for (; tix < tbase + nte; tix += G) {
            const int lt = tix - tbase, mt = lt / NTN, nt_ = lt - mt * NTN;
            if (!DOWN) gemm_tile<true>(lds, RowGather{PH(WS_X2H), lst, Me}, PH(WS_WGU) + (size_t)e * 512 * D, D, D, mt * G_BM, nt_ * G_BN,
                                       EGu{lst, Me, PF(WS_SSX2), PF(WS_TOKW), PH(WS_HB) + (size_t)off * DE});
            else gemm_tile<true>(lds, RowClamp{PH(WS_HB) + (size_t)off * DE, Me}, PH(WS_WDN) + (size_t)e * D * DE, DE, DE, mt * G_BM, nt_ * G_BN,
                                 EDn{lst, Me, PH(WS_YB)});
        }
        tbase += nte; off += Me;
    }
}
__device__ __forceinline__ void phase_final(const Params& p) {
    const float* X = p.X; const h16* yb = PH(WS_YB); const float* g = p.in[35]; float* out = p.X;
    const int lane = threadIdx.x & 63, gw = blockIdx.x * NWAVE + (threadIdx.x >> 6), NGW = gridDim.x * NWAVE;
    for (int m = gw; m < T; m += NGW) {
        f32x4 v[4]; float ss = 0.f;
#pragma unroll
        for (int i = 0; i < 4; ++i) { const int k = (lane + 64 * i) * 4;
            const f32x4 xv = *(const f32x4*)(X + (size_t)m * D + k); const h16x4 y0 = *(const h16x4*)(yb + ((size_t)m * 2) * D + k), y1 = *(const h16x4*)(yb + ((size_t)m * 2 + 1) * D + k);
#pragma unroll
            for (int j = 0; j < 4; ++j) { v[i][j] = xv[j] + (float)y0[j] + (float)y1[j]; ss += v[i][j] * v[i][j]; } }
        ss = wave_sum(ss); const float rs = rstd_of(ss, D);
#pragma unroll
        for (int i = 0; i < 4; ++i) { const int k = (lane + 64 * i) * 4; const f32x4 gv = *(const f32x4*)(g + k); *(f32x4*)(out + (size_t)m * D + k) = v[i] * rs * gv; }
    }
}

#define XB_TMO      128
#define XB_XCNT(j)  (256  + 64 * (j))
#define XB_XSUB(j)  (1280 + 64 * (j))
#define XB_XGEN(j)  (2304 + 64 * (j))
#define XB_TOP      3328
#define XB_TOPGEN   3392
#define XCD_BAR_WORDS 3456
#define XB_SPIN_CAP (1u << 18)
__device__ __forceinline__ unsigned xb_ld(unsigned* p)              { return __hip_atomic_load(p, __ATOMIC_RELAXED, __HIP_MEMORY_SCOPE_AGENT); }
__device__ __forceinline__ unsigned xb_add(unsigned* p, unsigned v) { return __hip_atomic_fetch_add(p, v, __ATOMIC_RELAXED, __HIP_MEMORY_SCOPE_AGENT); }
__device__ __forceinline__ unsigned xb_xcc_id() { return (unsigned)__builtin_amdgcn_s_getreg((3 << 11) | 20) & 0xFu; }
#define XB_SPIN(cond, bar) do { unsigned _sp = 0; while (cond) { __builtin_amdgcn_s_sleep(1); \
    if ((++_sp & 255u) == 0u) { if (xb_ld(&(bar)[XB_TMO])) break; if (_sp > XB_SPIN_CAP) { atomicAdd(&(bar)[XB_TMO], 1u); break; } } } } while (0)
struct XcdBarrier { unsigned* bar; unsigned x; volatile LAS unsigned* st; };
__device__ __forceinline__ XcdBarrier xcd_barrier_post(unsigned* bar, volatile LAS unsigned* st) {
    XcdBarrier b; b.bar = bar; b.x = xb_xcc_id(); b.st = st;
    if (threadIdx.x == 0) (void)xb_add(&bar[XB_XCNT(b.x)], 1u);
    return b;
}
__device__ __forceinline__ void xcd_barrier_complete(unsigned* bar, unsigned x, unsigned& nloc, unsigned& nx) {
    const unsigned G = gridDim.x * gridDim.y * gridDim.z;
    unsigned sum, cnt, mine, sp = 0u;
    for (;;) {
        sum = 0u; cnt = 0u; mine = 0u;
#pragma unroll
        for (unsigned j = 0; j < 16; ++j) { const unsigned c = xb_ld(&bar[XB_XCNT(j)]); sum += c; cnt += (c > 0u) ? 1u : 0u; mine = (j == x) ? c : mine; }
        if (sum == G) break;
        __builtin_amdgcn_s_sleep(1);
        if ((++sp & 255u) == 0u) { if (xb_ld(&bar[XB_TMO])) break; if (sp > XB_SPIN_CAP) { atomicAdd(&bar[XB_TMO], 1u); break; } }
    }
    nloc = mine > 0u ? mine : 1u; nx = cnt > 0u ? cnt : 1u;
}
__device__ __forceinline__ void xcd_barrier(const XcdBarrier& b) {
    asm volatile("s_waitcnt vmcnt(0)" ::: "memory");
    __syncthreads();
    if (threadIdx.x == 0) {
        unsigned* bar = b.bar;
        __builtin_amdgcn_s_waitcnt(0);
        unsigned nloc = b.st[0], nx = b.st[1];
        if (nloc == 0u) { xcd_barrier_complete(bar, b.x, nloc, nx); b.st[0] = nloc; b.st[1] = nx; }
        const unsigned old = xb_add(&bar[XB_XSUB(b.x)], 1u);
        const unsigned gen = old / nloc;
        if (old + 1u == (gen + 1u) * nloc) {
            __builtin_amdgcn_fence(__ATOMIC_RELEASE, "agent");
            asm volatile("s_waitcnt vmcnt(0)" ::: "memory");
            const unsigned og = xb_add(&bar[XB_TOP], 1u);
            const unsigned tg = og / nx;
            if (og + 1u == (tg + 1u) * nx) xb_add(&bar[XB_TOPGEN], 1u);
            else XB_SPIN(xb_ld(&bar[XB_TOPGEN]) == tg, bar);
            __builtin_amdgcn_fence(__ATOMIC_ACQUIRE, "agent");
            xb_add(&bar[XB_XGEN(b.x)], 1u);
            asm volatile("s_waitcnt vmcnt(0)" ::: "memory");
        } else {
            XB_SPIN(xb_ld(&bar[XB_XGEN(b.x)]) == gen, bar);
            __builtin_amdgcn_fence(__ATOMIC_ACQUIRE, "agent");
            asm volatile("s_waitcnt vmcnt(0)" ::: "memory");
        }
    }
    __syncthreads();
}

#ifndef REP_PHASE
#define REP_PHASE -1
#endif
__global__ void __launch_bounds__(NTHR) mega(Params p, int ph_lo, int ph_hi) {
    extern __shared__ __attribute__((aligned(16))) char lds_raw[];
    LAS char* lds = (LAS char*)lds_raw;
    cg::grid_group grid = cg::this_grid();
    volatile LAS unsigned* misc = (volatile LAS unsigned*)(lds + LDS_BYTES - 64);
    if (threadIdx.x < 16) misc[threadIdx.x] = 0u;
    __syncthreads();
    const XcdBarrier bar = xcd_barrier_post((unsigned*)(p.ws + WS_BAR), misc);
#define PHASE(k) if (ph_lo <= (k) && (k) < ph_hi) for (int rep_ = 0; rep_ < ((k) == REP_PHASE ? 2 : 1); ++rep_)
#define SEAM(k) if (ph_lo <= (k) && (k) + 1 < ph_hi) { if ((k) == 0) grid.sync(); else xcd_barrier(bar); }
    PHASE(0) { phase_prep(p, lds); }
    SEAM(0);
    PHASE(1) {
        gemm_job<false>(lds, PH(WS_XH), D, PH(WS_WIN), D, T, 1536, D, EHy{PF(WS_SSX), PH(WS_HYT)});
        gemm_job<true>(lds, PH(WS_XH), D, PH(WS_WIN) + (size_t)1536 * D, D, T, 512, D, ELat{PF(WS_SSX), PH(WS_LAT), rep_ ? nullptr : PF(WS_SSQ), PF(WS_SSKV)});
        gemm_job<true>(lds, PH(WS_MEMH), D, PH(WS_WMKV), D, MROWS, 1024, D, EKc{PF(WS_SSMEM), PH(WS_KC)});
        gemm_job<false>(lds, PH(WS_MEMH), D, PH(WS_WMKV) + (size_t)1024 * D, D, MROWS, 1024, D, EVc{PF(WS_SSMEM), PH(WS_VCT)}, 32);
        phase_filt3(p);
    }
    SEAM(1);
    PHASE(2) {
        gemm_job<true>(lds, PH(WS_LAT), LAT, PH(WS_WUQ), 256, T, 768, 256, EQ{PF(WS_SSQ), PF(WS_ROPE), PH(WS_Q)});
        gemm_job<true>(lds, PH(WS_LAT) + 256, LAT, PH(WS_WUKV), 128, T, 512, 128, EK{PF(WS_SSKV), PH(WS_K)}, 128);
        gemm_job<false>(lds, PH(WS_LAT) + 256, LAT, PH(WS_WUKV) + (size_t)512 * 128, 128, T, 512, 128, EV{PF(WS_SSKV), PH(WS_VT)}, 128);
        phase_krot(p);
    }
    SEAM(2);
    PHASE(3) { phase_attn(p, lds); }
    PHASE(13) { phase_hyena(p, lds); }
    SEAM(3);
    PHASE(4) { phase_mixprep(p, lds); }
    SEAM(4);
    PHASE(5) { gemm_job<true>(lds, PH(WS_MIX), D, PH(WS_WOUT), D, T, D, D, ERes{p.in[0], p.X, PH(WS_X1H), rep_ ? nullptr : PF(WS_SSX1)}); }
    SEAM(5);
    PHASE(6) { gemm_job<true>(lds, PH(WS_X1H), D, PH(WS_WMQ), D, T, D, D, EMq{PF(WS_SSX1), PH(WS_QC)}); }
    SEAM(6);
    PHASE(7) { phase_xattn(p, lds); }
    SEAM(7);
    PHASE(8) { gemm_job<true>(lds, PH(WS_OC), D, PH(WS_WMO), D, T, D, D, ERes{p.X, p.X, PH(WS_X2H), nullptr}); }
    SEAM(8);
    PHASE(9) { phase_route(p); }
    SEAM(9);
    PHASE(10) { phase_moe<false>(p, lds); }
    SEAM(10);
    PHASE(11) { phase_moe<true>(p, lds); }
    SEAM(11);
    PHASE(12) { phase_final(p); }
}

extern "C" void kernel_launch(void* const* d_in, const int* in_sizes, int n_in, void* d_out, int out_size, void* d_ws, size_t ws_size, hipStream_t st) {
    Params p{};
    for (int i = 0; i < 36; ++i) p.in[i] = (const float*)d_in[i];
    p.X = (float*)d_out; p.ws = (char*)d_ws;
    static int grid = 0;
    if (!grid) {
        (void)hipFuncSetAttribute((const void*)mega, hipFuncAttributeMaxDynamicSharedMemorySize, LDS_BYTES);
        int dev = 0, cus = 0, per_cu = 0;
        (void)hipGetDevice(&dev);
        (void)hipDeviceGetAttribute(&cus, hipDeviceAttributeMultiprocessorCount, dev);
        (void)hipOccupancyMaxActiveBlocksPerMultiprocessor(&per_cu, (const void*)mega, NTHR, LDS_BYTES);
        if (per_cu < 1) { fprintf(stderr, "kernel_launch: occupancy query says %d blocks/CU\n", per_cu); per_cu = 1; }
        grid = cus;
    }
    (void)hipMemsetAsync((char*)d_ws + WS_CTL, 0, 32 * 1024, st);
    int lo = 0, hi = 14;
    void* args[] = {&p, &lo, &hi};
    hipError_t e = hipLaunchCooperativeKernel((const void*)mega, dim3(grid), dim3(NTHR), args, LDS_BYTES, st);
    if (e != hipSuccess) fprintf(stderr, "cooperative launch failed: %s (grid %d)\n", hipGetErrorString(e), grid);
    (void)in_sizes; (void)n_in; (void)out_size; (void)ws_size;
}
```

```cpp
#include <hip/hip_runtime.h>
#include <cstdint>
#include <cstdio>
#include <hip/hip_cooperative_groups.h>
namespace cg = cooperative_groups;
typedef _Float16 h16;

constexpr int NB = 4, S = 4096, D = 1024, T = NB * S, MEMT = 256, MROWS = NB * MEMT;
constexpr int NH = 8, HYW = 512;
constexpr int LAT = 416, INC = 1952;
constexpr int MH = 4, MHD = 256;
constexpr int NE = 32, DE = 256;
constexpr float EPS = 1e-6f;
constexpr float LOG2E = 1.4426950408889634f;
constexpr float QSCALE = 0.10206207261596575f * LOG2E;
constexpr float CSCALE = 0.0625f * LOG2E;

constexpr size_t MiB = 1u << 20;
constexpr size_t WS_CTL = 0;
constexpr size_t WS_SSX = 64 * 1024, WS_SSQ = 128 * 1024, WS_SSKV = 192 * 1024, WS_SSA = 256 * 1024, WS_SSH = 320 * 1024,
                 WS_SSX1 = 384 * 1024, WS_SSX2 = 448 * 1024, WS_SSMEM = 512 * 1024, WS_TOKE = 576 * 1024, WS_TOKW = 704 * 1024,
                 WS_TOKP = 832 * 1024;
constexpr size_t WS_WIN = 2 * MiB, WS_WUQ = 6 * MiB, WS_WUKV = 6 * MiB + 512 * 1024, WS_WOUT = 7 * MiB, WS_WMQ = 9 * MiB,
                 WS_WMKV = 11 * MiB, WS_WMO = 15 * MiB, WS_MEMH = 17 * MiB, WS_KC = 19 * MiB, WS_VCT = 21 * MiB, WS_R = 23 * MiB,
                 WS_WGU = 39 * MiB, WS_WDN = 71 * MiB, WS_LAT = 87 * MiB, WS_HYT = 101 * MiB, WS_XH = 149 * MiB, WS_Q = 149 * MiB,
                 WS_K = 173 * MiB, WS_VT = 197 * MiB, WS_AOUT = 213 * MiB, WS_HT = 229 * MiB, WS_LIST = 245 * MiB, WS_H2 = 247 * MiB;
constexpr size_t WS_OC = 183 * MiB, WS_BAR = 16 * 1024;
constexpr size_t WS_MIX = 87 * MiB, WS_X1H = 119 * MiB, WS_QC = 151 * MiB, WS_X2H = 87 * MiB, WS_HB = 119 * MiB, WS_YB = 135 * MiB;

__device__ __forceinline__ float wave_sum(float v) {
#pragma unroll
    for (int o = 1; o < 64; o <<= 1) v += __shfl_xor(v, o);
    return v;
}
__device__ __forceinline__ float rstd_of(float ss, int n) { return 1.0f / sqrtf(ss / (float)n + EPS); }

#define LAS __attribute__((address_space(3)))
typedef _Float16 h16x8 __attribute__((ext_vector_type(8)));
typedef _Float16 h16x4 __attribute__((ext_vector_type(4)));
typedef _Float16 h16x2 __attribute__((ext_vector_type(2)));
typedef float f32x4 __attribute__((ext_vector_type(4)));
typedef float f32x16 __attribute__((ext_vector_type(16)));
constexpr int NTHR = 512, NWAVE = 8;
constexpr int LDS_BYTES = 150 * 1024;
constexpr size_t WS_ROPE = 248 * MiB;
constexpr float HY_FSCALE = 256.f, HY_FINV = 1.f / 256.f;

struct Params {
    const float* in[36]; float* X; char* ws;
};
#define PF(off) ((float*)(p.ws + (off)))
#define PH(off) ((h16*)(p.ws + (off)))
#define PI(off) ((int*)(p.ws + (off)))

constexpr int G_BM = 256, G_BN = 128, G_BK = 64, G_AB = G_BM * G_BK * 2, G_BB = G_BN * G_BK * 2, G_STAGE = G_AB + G_BB;
static_assert(3 * G_STAGE <= LDS_BYTES, "lds");
__device__ __forceinline__ void glds16(const void* g, LAS char* l) { __builtin_amdgcn_global_load_lds((const unsigned*)g, (LAS unsigned*)l, 16, 0, 0); }

template <bool SWAP, class RowPtr, class Epi>
__device__ __forceinline__ void gemm_tile(LAS char* lds, const RowPtr& rowptr, const h16* __restrict__ Wt, int ldw, int K, int m0, int n0, const Epi& epi) {
    const int tid = threadIdx.x, lane = tid & 63, wid = __builtin_amdgcn_readfirstlane(tid >> 6);
    const int wm = wid >> 1, wn = wid & 1, fr = lane & 15, fq = lane >> 4;
    const h16* asrc[4]; const h16* bsrc[2];
#pragma unroll
    for (int i = 0; i < 4; ++i) { const int r = wid * 32 + i * 8 + (lane >> 3); const int ch = (lane & 7) ^ ((r >> 1) & 7); asrc[i] = rowptr(m0 + r) + ch * 8; }
#pragma unroll
    for (int i = 0; i < 2; ++i) { const int r = wid * 16 + i * 8 + (lane >> 3); const int ch = (lane & 7) ^ ((r >> 1) & 7); bsrc[i] = Wt + (size_t)(n0 + r) * ldw + ch * 8; }
    const int sw = fr >> 1;
    const int aoff = (wm * 64 + fr) * 128 + ((fq ^ sw) * 16);
    const int boff = G_AB + (wn * 64 + fr) * 128 + ((fq ^ sw) * 16);
    f32x4 acc[4][4];
#pragma unroll
    for (int i = 0; i < 4; ++i)
#pragma unroll
        for (int j = 0; j < 4; ++j) acc[i][j] = (f32x4){0.f, 0.f, 0.f, 0.f};
    const int nt = K / G_BK;
    asm volatile("s_waitcnt vmcnt(0)" ::: "memory");
#define G_STAGE_ISSUE(buf, kt) do { LAS char* sa_ = lds + (buf) * G_STAGE + wid * 4096; \
        _Pragma("unroll") for (int i_ = 0; i_ < 4; ++i_) glds16(asrc[i_] + (kt) * G_BK, sa_ + i_ * 1024); \
        LAS char* sb_ = lds + (buf) * G_STAGE + G_AB + wid * 2048; \
        _Pragma("unroll") for (int i_ = 0; i_ < 2; ++i_) glds16(bsrc[i_] + (kt) * G_BK, sb_ + i_ * 1024); } while (0)
    G_STAGE_ISSUE(0, 0);
    if (nt > 1) G_STAGE_ISSUE(1, 1);
    int buf = 0;
    for (int t = 0; t < nt; ++t) {
        if (t + 1 < nt) asm volatile("s_waitcnt vmcnt(6)" ::: "memory"); else asm volatile("s_waitcnt vmcnt(0)" ::: "memory");
        __builtin_amdgcn_s_barrier();
        if (t + 2 < nt) { const int nb_ = buf >= 1 ? buf - 1 : 2; G_STAGE_ISSUE(nb_, t + 2); }
        LAS char* base = lds + buf * G_STAGE;
#pragma unroll
        for (int kk = 0; kk < 2; ++kk) {
            h16x8 a[4], b[4];
#pragma unroll
            for (int i = 0; i < 4; ++i) { a[i] = *(LAS h16x8*)(base + ((aoff ^ (kk * 64)) + i * 2048)); b[i] = *(LAS h16x8*)(base + ((boff ^ (kk * 64)) + i * 2048)); }
#pragma unroll
            for (int i = 0; i < 4; ++i)
#pragma unroll
                for (int j = 0; j < 4; ++j)
                    acc[i][j] = SWAP ? __builtin_amdgcn_mfma_f32_16x16x32_f16(b[j], a[i], acc[i][j], 0, 0, 0)
                                     : __builtin_amdgcn_mfma_f32_16x16x32_f16(a[i], b[j], acc[i][j], 0, 0, 0);
        }
        buf = buf == 2 ? 0 : buf + 1;
    }
#undef G_STAGE_ISSUE
    asm volatile("s_waitcnt lgkmcnt(0)" ::: "memory");
    __builtin_amdgcn_s_barrier();
    if constexpr (SWAP) {
#pragma unroll
        for (int i = 0; i < 4; ++i)
#pragma unroll
            for (int jp = 0; jp < 2; ++jp) epi.row32(m0 + wm * 64 + i * 16 + fr, n0 + wn * 64 + jp * 32 + fq * 4, acc[i][2 * jp], acc[i][2 * jp + 1]);
    } else {
#pragma unroll
        for (int i = 0; i < 4; ++i)
#pragma unroll
            for (int j = 0; j < 4; ++j) epi.col4(m0 + wm * 64 + i * 16 + fq * 4, n0 + wn * 64 + j * 16 + fr, acc[i][j]);
    }
}
struct RowDense { const h16* A; int lda; __device__ __forceinline__ const h16* operator()(int m) const { return A + (size_t)m * lda; } };

__device__ __forceinline__ h16x4 cvt4(f32x4 v) { return (h16x4){(h16)v[0], (h16)v[1], (h16)v[2], (h16)v[3]}; }
__device__ __forceinline__ float rowgrp_sum(float v) { v += __shfl_xor(v, 16); v += __shfl_xor(v, 32); return v; }

struct EHy {
    const float* ssx; h16* hyT;
    __device__ __forceinline__ void col4(int mr, int n, f32x4 v) const {
        const f32x4 ss = *(const f32x4*)(ssx + mr);
        v[0] *= rstd_of(ss[0], D); v[1] *= rstd_of(ss[1], D); v[2] *= rstd_of(ss[2], D); v[3] *= rstd_of(ss[3], D);
        const int b = mr >> 12, t = mr & 4095;
        *(h16x4*)(hyT + ((size_t)(b * 1536 + n)) * S + t) = cvt4(v);
    } };
struct ELat {
    const float* ssx; h16* lat; float* ssq; float* sskv;
    __device__ __forceinline__ void row32(int m, int nb, f32x4 va, f32x4 vb) const {
        const float r = rstd_of(ssx[m], D); va *= r; vb *= r;
        if (nb < LAT) { *(h16x4*)(lat + (size_t)m * LAT + nb) = cvt4(va); *(h16x4*)(lat + (size_t)m * LAT + nb + 16) = cvt4(vb); }
        float s = va[0] * va[0] + va[1] * va[1] + va[2] * va[2] + va[3] * va[3] + vb[0] * vb[0] + vb[1] * vb[1] + vb[2] * vb[2] + vb[3] * vb[3];
        s = rowgrp_sum(s);
        if (ssq && (threadIdx.x & 63) < 16 && nb < 384) atomicAdd((nb < 256 ? ssq : sskv) + m, s);
    } };
struct EQ {
    const float* ssq; const float* rope; h16* Q;
    __device__ __forceinline__ void row32(int m, int nb, f32x4 va, f32x4 vb) const {
        const float r = rstd_of(ssq[m], 256) * QSCALE; va *= r; vb *= r;
        const int b = m >> 12, t = m & 4095, blk = nb >> 5, h = blk / 3, part = blk - 3 * h, c = nb & 31;
        if (part == 2) {
            const float* rp = rope + ((size_t)t * 16 + c) * 2;
#pragma unroll
            for (int j = 0; j < 4; ++j) { const float cs = rp[2 * j], sn = rp[2 * j + 1]; const float q1 = va[j], q2 = vb[j]; va[j] = q1 * cs - q2 * sn; vb[j] = q1 * sn + q2 * cs; }
        }
        h16* q = Q + ((size_t)((b * NH + h) * S + t)) * 96 + part * 32 + c;
        *(h16x4*)q = cvt4(va); *(h16x4*)(q + 16) = cvt4(vb);
    } };
struct EK {
    const float* sskv; h16* K;
    __device__ __forceinline__ void row32(int m, int nb, f32x4 va, f32x4 vb) const {
        const float r = rstd_of(sskv[m], 128); va *= r; vb *= r;
        const int b = m >> 12, t = m & 4095, h = nb >> 6, j = nb & 63;
        h16* k = K + ((size_t)((b * NH + h) * S + t)) * 96 + j;
        *(h16x4*)k = cvt4(va); *(h16x4*)(k + 16) = cvt4(vb);
    } };
struct EV {
    const float* sskv; h16* Vt;
    __device__ __forceinline__ void col4(int mr, int n, f32x4 v) const {
        const f32x4 ss = *(const f32x4*)(sskv + mr);
        v[0] *= rstd_of(ss[0], 128); v[1] *= rstd_of(ss[1], 128); v[2] *= rstd_of(ss[2], 128); v[3] *= rstd_of(ss[3], 128);
        const int b = mr >> 12, t = mr & 4095;
        *(h16x4*)(Vt + ((size_t)(b * 512 + n)) * S + t) = cvt4(v);
    } };
struct EKc {
    const float* ss; h16* Kc;
    __device__ __forceinline__ void row32(int m, int nb, f32x4 va, f32x4 vb) const {
        const float r = rstd_of(ss[m], D); va *= r; vb *= r;
        *(h16x4*)(Kc + (size_t)m * D + nb) = cvt4(va); *(h16x4*)(Kc + (size_t)m * D + nb + 16) = cvt4(vb);
    } };
struct EVc {
    const float* ss; h16* VcT;
    __device__ __forceinline__ void col4(int mr, int n, f32x4 v) const {
        const f32x4 s4 = *(const f32x4*)(ss + mr);
        v[0] *= rstd_of(s4[0], D); v[1] *= rstd_of(s4[1], D); v[2] *= rstd_of(s4[2], D); v[3] *= rstd_of(s4[3], D);
        const int b = mr >> 8, mm = mr & 255;
        *(h16x4*)(VcT + ((size_t)(b * 1024 + n)) * MEMT + mm) = cvt4(v);
    } };
struct ERes {
    const float* xin; float* X; h16* xh; float* ss;
    __device__ __forceinline__ void row32(int m, int nb, f32x4 va, f32x4 vb) const {
        const size_t i = (size_t)m * D + nb;
        va += *(const f32x4*)(xin + i); vb += *(const f32x4*)(xin + i + 16);
        *(f32x4*)(X + i) = va; *(f32x4*)(X + i + 16) = vb;
        *(h16x4*)(xh + i) = cvt4(va); *(h16x4*)(xh + i + 16) = cvt4(vb);
        float s = va[0] * va[0] + va[1] * va[1] + va[2] * va[2] + va[3] * va[3] + vb[0] * vb[0] + vb[1] * vb[1] + vb[2] * vb[2] + vb[3] * vb[3];
        s = rowgrp_sum(s);
        if (ss && (threadIdx.x & 63) < 16) atomicAdd(ss + m, s);
    } };
struct EMq {
    const float* ss; h16* qc;
    __device__ __forceinline__ void row32(int m, int nb, f32x4 va, f32x4 vb) const {
        const float r = rstd_of(ss[m], D) * CSCALE; va *= r; vb *= r;
        *(h16x4*)(qc + (size_t)m * D + nb) = cvt4(va); *(h16x4*)(qc + (size_t)m * D + nb + 16) = cvt4(vb);
    } };

template <bool SWAP, class Epi>
__device__ __forceinline__ void gemm_job(LAS char* lds, const h16* A, int lda, const h16* Wt, int ldw, int M, int N, int K, const Epi& epi, int first = 0) {
    const int ntn = N / G_BN, ntiles = (M / G_BM) * ntn;
    const RowDense rp{A, lda};
    const int G = gridDim.x, bx = blockIdx.x, vid = (G % 8 == 0) ? (bx % 8) * (G / 8) + bx / 8 : bx;
    for (int tix = (vid + G - first % G) % G; tix < ntiles; tix += G) {
        const int mt = tix / ntn, nt_ = tix - mt * ntn;
        gemm_tile<SWAP>(lds, rp, Wt, ldw, K, mt * G_BM, nt_ * G_BN, epi);
    }
}

template <class RowMap, class Gain>
__device__ __forceinline__ void wt_item(const float* W, int N, int K, h16* Wt, LAS float* scr, int k0, int n0, int lane, const RowMap& rowmap, const Gain& gain) {
#pragma unroll
    for (int i = 0; i < 32; ++i) { const int kk = 2 * i + (lane >> 5); scr[kk * 33 + (lane & 31)] = W[(size_t)(k0 + kk) * N + n0 + (lane & 31)] * gain(k0 + kk); }
    asm volatile("s_waitcnt lgkmcnt(0)" ::: "memory");
    const int c = lane & 7;
#pragma unroll
    for (int j = 0; j < 4; ++j) { const int n = (lane >> 3) + 8 * j; const LAS float* s = scr + (8 * c) * 33 + n;
        h16x8 o = {(h16)s[0], (h16)s[33], (h16)s[66], (h16)s[99], (h16)s[132], (h16)s[165], (h16)s[198], (h16)s[231]};
        *(h16x8*)(Wt + (size_t)rowmap(n0 + n) * K + k0 + 8 * c) = o; }
    asm volatile("s_waitcnt lgkmcnt(0)" ::: "memory");
}
struct GainNone { __device__ __forceinline__ float operator()(int) const { return 1.f; } };
struct Gain1 { const float* g; __device__ __forceinline__ float operator()(int k) const { return g[k]; } };
struct Gain2 { const float* g; const float* g2; __device__ __forceinline__ float operator()(int k) const { return k < 512 ? g[k] : g2[k - 512]; } };
struct MapId { __device__ __forceinline__ int operator()(int n) const { return n; } };
struct MapIn { __device__ __forceinline__ int operator()(int n) const { return n < LAT ? 1536 + n : n - LAT; } };
struct MapKV { __device__ __forceinline__ int operator()(int n) const { const int h = n >> 7, j = n & 127; return j < 64 ? h * 64 + j : 512 + h * 64 + (j - 64); } };
struct MapG { int up; __device__ __forceinline__ int operator()(int j) const { return 32 * (j >> 4) + (j & 15) + up; } };

__device__ __forceinline__ void phase_prep(const Params& p, LAS char* lds) {
    const int tid = threadIdx.x, lane = tid & 63, wid = tid >> 6;
    const int gw = blockIdx.x * NWAVE + wid, NGW = gridDim.x * NWAVE, gt = blockIdx.x * NTHR + tid, NGT = gridDim.x * NTHR;
    LAS float* scr = (LAS float*)(lds + wid * 16384);
    for (int i = gt; i < 5 * 16384; i += NGT) PF(WS_SSQ)[i] = 0.f;
    for (int row = gw; row < T + MROWS; row += NGW) {
        const bool isx = row < T; const int r = isx ? row : row - T;
        const f32x4* src = (const f32x4*)((isx ? p.in[0] : p.in[1]) + (size_t)r * D) + lane;
        h16* dst = (isx ? PH(WS_XH) : PH(WS_MEMH)) + (size_t)r * D;
        float s = 0.f;
#pragma unroll
        for (int j = 0; j < 4; ++j) { const f32x4 v = src[64 * j]; s += v[0] * v[0] + v[1] * v[1] + v[2] * v[2] + v[3] * v[3]; *(h16x4*)(dst + (lane + 64 * j) * 4) = cvt4(v); }
        s = wave_sum(s);
        if (lane == 0) (isx ? PF(WS_SSX) : PF(WS_SSMEM))[r] = s;
    }
    {
        constexpr int I_IN = 16 * 61, I_UQ = 4 * 24, I_UKV = 2 * 32, I_SQ = 16 * 32, I_MKV = 16 * 64, I_EX = 16 * 8, I_DN = 4 * 32;
        constexpr int NIT = I_IN + I_UQ + I_UKV + 3 * I_SQ + I_MKV + NE * (2 * I_EX + I_DN);
        for (int it = gw; it < NIT; it += NGW) {
            int r = it;
            if (r < I_IN) { wt_item(p.in[3], INC, D, PH(WS_WIN), scr, (r / 61) * 64, (r % 61) * 32, lane, MapIn{}, Gain1{p.in[2]}); continue; } r -= I_IN;
            if (r < I_UQ) { wt_item(p.in[6], 768, 256, PH(WS_WUQ), scr, (r / 24) * 64, (r % 24) * 32, lane, MapId{}, Gain1{p.in[4]}); continue; } r -= I_UQ;
            if (r < I_UKV) { wt_item(p.in[7], 1024, 128, PH(WS_WUKV), scr, (r / 32) * 64, (r % 32) * 32, lane, MapKV{}, Gain1{p.in[5]}); continue; } r -= I_UKV;
            if (r < I_SQ) { wt_item(p.in[21], D, D, PH(WS_WOUT), scr, (r / 32) * 64, (r % 32) * 32, lane, MapId{}, Gain2{p.in[19], p.in[20]}); continue; } r -= I_SQ;
            if (r < I_SQ) { wt_item(p.in[24], D, D, PH(WS_WMQ), scr, (r / 32) * 64, (r % 32) * 32, lane, MapId{}, Gain1{p.in[22]}); continue; } r -= I_SQ;
            if (r < I_SQ) { wt_item(p.in[26], D, D, PH(WS_WMO), scr, (r / 32) * 64, (r % 32) * 32, lane, MapId{}, GainNone{}); continue; } r -= I_SQ;
            if (r < I_MKV) { wt_item(p.in[25], 2048, D, PH(WS_WMKV), scr, (r / 64) * 64, (r % 64) * 32, lane, MapId{}, Gain1{p.in[23]}); continue; } r -= I_MKV;
            const int e = r / (2 * I_EX + I_DN); r -= e * (2 * I_EX + I_DN);
            if (r < I_EX) { wt_item(p.in[32] + (size_t)e * D * DE, DE, D, PH(WS_WGU) + (size_t)e * 512 * D, scr, (r / 8) * 64, (r % 8) * 32, lane, MapG{0}, Gain1{p.in[27]}); continue; } r -= I_EX;
            if (r < I_EX) { wt_item(p.in[33] + (size_t)e * D * DE, DE, D, PH(WS_WGU) + (size_t)e * 512 * D, scr, (r / 8) * 64, (r % 8) * 32, lane, MapG{16}, Gain1{p.in[27]}); continue; } r -= I_EX;
            wt_item(p.in[34] + (size_t)e * DE * D, D, DE, PH(WS_WDN) + (size_t)e * D * DE, scr, (r / 32) * 64, (r % 32) * 32, lane, MapId{}, GainNone{});
        }
        for (int i = gt; i < 96 * D / 8; i += NGT) *(h16x8*)(PH(WS_WIN) + (size_t)INC * D + (size_t)i * 8) = (h16x8){0, 0, 0, 0, 0, 0, 0, 0};
    }
    for (int i = gt; i < S * 16; i += NGT) { const int t = i >> 4, pp = i & 15; const float inv = exp2f(-(float)pp * (13.287712379549449f / 16.0f)); float sn, cs; sincosf((float)t * inv, &sn, &cs);
        PF(WS_ROPE)[2 * i] = cs; PF(WS_ROPE)[2 * i + 1] = sn; }
    {
        LAS float* zf = scr; LAS float* h1 = scr + 64;
        const float* w1 = p.in[10]; const float* b1 = p.in[11]; const float* freq = p.in[12]; const float* w2 = p.in[13]; const float* b2 = p.in[14];
        for (int t = gw; t < S; t += NGW) {
            const int j = lane;
            if (j < 33) { float v;
                if (j == 0) v = (float)t / (float)S;
                else { const int bi = (j - 1) & 15; const float band = 1e-4f + (float)bi * ((15.0f - 1e-4f) / 15.0f);
                    double rev = (double)t * (double)band / (double)S; rev -= floor(rev); const float r2 = (float)(2.0 * rev);
                    v = (j <= 16) ? cospif(r2) : -sinpif(r2); }
                zf[j] = v; }
            asm volatile("s_waitcnt lgkmcnt(0)" ::: "memory");
            float a = b1[j];
            for (int i = 0; i < 33; ++i) a += zf[i] * w1[i * 64 + j];
            h1[j] = sinf(freq[j] * a);
            asm volatile("s_waitcnt lgkmcnt(0)" ::: "memory");
            float c = b2[j];
            for (int i = 0; i < 64; ++i) c += h1[i] * w2[i * 64 + j];
            PF(WS_H2)[t * 64 + j] = sinf(freq[64 + j] * c);
            asm volatile("s_waitcnt lgkmcnt(0)" ::: "memory");
        }
    }
}
__device__ __forceinline__ void phase_filt3(const Params& p, LAS char* lds) {
    const float* H2 = PF(WS_H2); const float* w3 = p.in[15]; const float* b3 = p.in[16]; const float* decay = p.in[17]; h16* R = PH(WS_R);
    LAS h16* tile = (LAS h16*)lds;
    LAS float* wl = (LAS float*)(lds + 65536);
    LAS float* cb = wl + 512;
    const int tid = threadIdx.x;
    for (int it = blockIdx.x; it < 256; it += gridDim.x) {
        const int o = it >> 7, c0 = (it & 127) * 4;
        __syncthreads();
        { const int j = tid >> 3, e = tid & 7, col = o * 1024 + (e >> 2) * 512 + c0 + (e & 3);
          wl[tid] = w3[j * 2048 + col];
          if (tid < 8) { const int cl = o * 1024 + (tid >> 2) * 512 + c0 + (tid & 3); cb[tid] = b3[cl]; cb[8 + tid] = fabsf(decay[cl]) * (1.0f / (float)S); } }
        __syncthreads();
        for (int i = 0; i < 8; ++i) {
            const int tau = tid + 512 * i;
            float acc[8];
#pragma unroll
            for (int e = 0; e < 8; ++e) acc[e] = cb[e];
#pragma unroll
            for (int j4 = 0; j4 < 16; ++j4) {
                const f32x4 hv = *(const f32x4*)(H2 + tau * 64 + j4 * 4);
#pragma unroll
                for (int jj = 0; jj < 4; ++jj) {
                    const f32x4 wa = *(LAS f32x4*)(wl + (j4 * 4 + jj) * 8), wb = *(LAS f32x4*)(wl + (j4 * 4 + jj) * 8 + 4);
                    acc[0] += hv[jj] * wa[0]; acc[1] += hv[jj] * wa[1]; acc[2] += hv[jj] * wa[2]; acc[3] += hv[jj] * wa[3];
                    acc[4] += hv[jj] * wb[0]; acc[5] += hv[jj] * wb[1]; acc[6] += hv[jj] * wb[2]; acc[7] += hv[jj] * wb[3];
                }
            }
#pragma unroll
            for (int e = 0; e < 8; ++e) {
                const float v = acc[e] * HY_FSCALE * __expf(-(float)tau * cb[8 + e]);
                const int ch = e & 3, dir = e >> 2;
                int u; float val = v;
                if (dir == 0) u = 4096 - tau;
                else { u = tau == 0 ? 0 : 4096 + tau; if (tau == 0) val = 0.f; }
                tile[ch * 8192 + u] = (h16)val;
            }
        }
        __syncthreads();
        for (int i = tid; i < 4 * 1024; i += NTHR) { const int ch = i >> 10, k = i & 1023;
            *(h16x8*)(R + ((size_t)(o * 512 + c0 + ch)) * 8192 + k * 8) = *(LAS h16x8*)(tile + ch * 8192 + k * 8); }
    }
    __syncthreads();
}
__device__ __forceinline__ void phase_krot(const Params& p) {
    const int gt = blockIdx.x * NTHR + threadIdx.x, NGT = gridDim.x * NTHR;
    const h16* lat = PH(WS_LAT); h16* K = PH(WS_K); const float* rope = PF(WS_ROPE);
    for (int i = gt; i < T * 4; i += NGT) {
        const int m = i >> 2, p0 = (i & 3) * 4, b = m >> 12, t = m & 4095;
        const h16x4 k1 = *(const h16x4*)(lat + (size_t)m * LAT + 384 + p0), k2 = *(const h16x4*)(lat + (size_t)m * LAT + 400 + p0);
        h16x4 o1, o2;
#pragma unroll
        for (int j = 0; j < 4; ++j) { const float cs = rope[((size_t)t * 16 + p0 + j) * 2], sn = rope[((size_t)t * 16 + p0 + j) * 2 + 1];
            const float a = (float)k1[j], c = (float)k2[j]; o1[j] = (h16)(a * cs - c * sn); o2[j] = (h16)(a * sn + c * cs); }
#pragma unroll
        for (int h = 0; h < NH; ++h) { h16* kp = K + ((size_t)((b * NH + h) * S + t)) * 96 + 64 + p0; *(h16x4*)kp = o1; *(h16x4*)(kp + 16) = o2; }
    }
}


constexpr int AT_KROW = 208, AT_VROW = 136, AT_KB = 64 * AT_KROW, AT_VB = 64 * AT_VROW, AT_BUF = AT_KB + AT_VB;
__device__ __forceinline__ void phase_attn(const Params& p, LAS char* lds) {
    const int tid = threadIdx.x, lane = tid & 63, wid = __builtin_amdgcn_readfirstlane(tid >> 6), r32 = lane & 31, hi = lane >> 5;
    const h16* Qg = PH(WS_Q); const h16* Kg = PH(WS_K); const h16* Vtg = PH(WS_VT); h16* aout = PH(WS_AOUT);
    const int k0r = tid / 12, k0c = tid - 12 * k0r, c1 = tid + 512, k1r = c1 / 12, k1c = c1 - 12 * k1r;
    const int vdv = tid >> 3, vc = tid & 7;
    const int G = gridDim.x, bx = blockIdx.x, vid = (G % 8 == 0) ? (bx % 8) * (G / 8) + bx / 8 : bx;
    for (int u = vid; u < NB * NH * 16; u += G) {
        const int bh = u >> 4, q0 = (u & 15) * 256 + wid * 32;
        h16x8 qf[6];
        { const h16* qp = Qg + ((size_t)bh * S + q0 + r32) * 96 + 8 * hi;
#pragma unroll
          for (int s_ = 0; s_ < 6; ++s_) qf[s_] = *(const h16x8*)(qp + 16 * s_); }
        const h16* Kb = Kg + (size_t)bh * S * 96; const h16* Vb = Vtg + (size_t)bh * 64 * S + (size_t)vdv * S + vc * 8;
        h16x8 kr0, kr1, vr;
        kr0 = *(const h16x8*)(Kb + tid * 8); kr1 = kr0; if (tid < 256) kr1 = *(const h16x8*)(Kb + c1 * 8); vr = *(const h16x8*)(Vb);
        __syncthreads();
        { *(LAS h16x8*)(lds + k0r * AT_KROW + k0c * 16) = kr0; if (tid < 256) *(LAS h16x8*)(lds + k1r * AT_KROW + k1c * 16) = kr1;
          LAS char* vn = lds + AT_KB + vdv * AT_VROW + vc * 16; *(LAS h16x4*)vn = (h16x4){vr[0], vr[1], vr[2], vr[3]}; *(LAS h16x4*)(vn + 8) = (h16x4){vr[4], vr[5], vr[6], vr[7]}; }
        __syncthreads();
        f32x16 o0, o1;
#pragma unroll
        for (int r = 0; r < 16; ++r) { o0[r] = 0.f; o1[r] = 0.f; }
        float m = -1e30f, l = 0.f;
        for (int t = 0; t < S / 64; ++t) {
            if (t + 1 < S / 64) {
                const h16* kn = Kb + (size_t)(t + 1) * 64 * 96;
                kr0 = *(const h16x8*)(kn + tid * 8); if (tid < 256) kr1 = *(const h16x8*)(kn + c1 * 8); vr = *(const h16x8*)(Vb + (t + 1) * 64);
            }
            LAS char* kb = lds + (t & 1) * AT_BUF; LAS char* vb = kb + AT_KB;
            f32x16 p0, p1;
#pragma unroll
            for (int r = 0; r < 16; ++r) { p0[r] = 0.f; p1[r] = 0.f; }
#pragma unroll
            for (int s_ = 0; s_ < 6; ++s_) {
                const h16x8 a0 = *(LAS h16x8*)(kb + r32 * AT_KROW + s_ * 32 + hi * 16);
                const h16x8 a1 = *(LAS h16x8*)(kb + (32 + r32) * AT_KROW + s_ * 32 + hi * 16);
                p0 = __builtin_amdgcn_mfma_f32_32x32x16_f16(a0, qf[s_], p0, 0, 0, 0);
                p1 = __builtin_amdgcn_mfma_f32_32x32x16_f16(a1, qf[s_], p1, 0, 0, 0);
            }
            float mx = fmaxf(p0[0], p1[0]);
#pragma unroll
            for (int r = 1; r < 16; ++r) mx = fmaxf(mx, fmaxf(p0[r], p1[r]));
            mx = fmaxf(mx, __shfl_xor(mx, 32));
            const float mn = fmaxf(m, mx), al = __builtin_amdgcn_exp2f(m - mn); m = mn;
            float rs = 0.f;
#pragma unroll
            for (int r = 0; r < 16; ++r) { p0[r] = __builtin_amdgcn_exp2f(p0[r] - mn); p1[r] = __builtin_amdgcn_exp2f(p1[r] - mn); rs += p0[r] + p1[r]; }
            l = l * al + rs;
#pragma unroll
            for (int r = 0; r < 16; ++r) { o0[r] *= al; o1[r] *= al; }
            h16x8 pf[2][2];
#pragma unroll
            for (int j = 0; j < 8; ++j) { pf[0][0][j] = (h16)p0[j]; pf[0][1][j] = (h16)p0[8 + j]; pf[1][0][j] = (h16)p1[j]; pf[1][1][j] = (h16)p1[8 + j]; }
#pragma unroll
            for (int kh = 0; kh < 2; ++kh)
#pragma unroll
                for (int s_ = 0; s_ < 2; ++s_) {
                    LAS char* v0 = vb + r32 * AT_VROW + (kh * 32 + 16 * s_ + 4 * hi) * 2;
                    const h16x4 a = *(LAS h16x4*)v0, b = *(LAS h16x4*)(v0 + 16);
                    const h16x4 c = *(LAS h16x4*)(v0 + 32 * AT_VROW), d = *(LAS h16x4*)(v0 + 32 * AT_VROW + 16);
                    const h16x8 vf0 = {a[0], a[1], a[2], a[3], b[0], b[1], b[2], b[3]}, vf1 = {c[0], c[1], c[2], c[3], d[0], d[1], d[2], d[3]};
                    o0 = __builtin_amdgcn_mfma_f32_32x32x16_f16(vf0, pf[kh][s_], o0, 0, 0, 0);
                    o1 = __builtin_amdgcn_mfma_f32_32x32x16_f16(vf1, pf[kh][s_], o1, 0, 0, 0);
                }
            if (t + 1 < S / 64) {
                LAS char* kn = lds + ((t + 1) & 1) * AT_BUF;
                *(LAS h16x8*)(kn + k0r * AT_KROW + k0c * 16) = kr0; if (tid < 256) *(LAS h16x8*)(kn + k1r * AT_KROW + k1c * 16) = kr1;
                LAS char* vn = kn + AT_KB + vdv * AT_VROW + vc * 16; *(LAS h16x4*)vn = (h16x4){vr[0], vr[1], vr[2], vr[3]}; *(LAS h16x4*)(vn + 8) = (h16x4){vr[4], vr[5], vr[6], vr[7]};
            }
            __syncthreads();
        }
        const float il = 1.f / (l + __shfl_xor(l, 32));
        const int b = bh >> 3, h = bh & 7;
        h16* ap = aout + ((size_t)(b * S + q0 + r32)) * 512 + h * 64 + 4 * hi;
#pragma unroll
        for (int g = 0; g < 4; ++g) {
            *(h16x4*)(ap + 8 * g) = (h16x4){(h16)(o0[4 * g] * il), (h16)(o0[4 * g + 1] * il), (h16)(o0[4 * g + 2] * il), (h16)(o0[4 * g + 3] * il)};
            *(h16x4*)(ap + 32 + 8 * g) = (h16x4){(h16)(o1[4 * g] * il), (h16)(o1[4 * g + 1] * il), (h16)(o1[4 * g + 2] * il), (h16)(o1[4 * g + 3] * il)};
        }
    }
    __syncthreads();
}
constexpr int HY_CS = 16448, HY_ZOFF = 4 * HY_CS, HY_ZB = 11584, HY_LDS = HY_ZOFF + 4 * HY_ZB;
static_assert(HY_LDS <= LDS_BYTES, "hyena lds");
__device__ __forceinline__ void phase_hyena(const Params& p, LAS char* lds) {
    const int tid = threadIdx.x, lane = tid & 63, wid = __builtin_amdgcn_readfirstlane(tid >> 6), r32 = lane & 31, hi = lane >> 5;
    const h16* hyT = PH(WS_HYT); const h16* Rg = PH(WS_R); const float* convw = p.in[8]; const float* convb = p.in[9]; const float* skip = p.in[18]; h16* hT = PH(WS_HT);
    const int G = gridDim.x, bx = blockIdx.x, vid = (G % 8 == 0) ? (bx % 8) * (G / 8) + bx / 8 : bx;
    __syncthreads();
    for (int i = tid; i < 4 * 16 * 36; i += NTHR) { const int batch = i / 576, rem = i - batch * 576, blk = rem / 36, w = rem - blk * 36, bi = blk < 8 ? blk : 64 + blk;
        *(LAS unsigned*)(lds + HY_ZOFF + batch * HY_ZB + bi * 144 + w * 4) = 0u; }
    const int i0 = wid * 8, q = r32 & 3, ii = r32 >> 2, batch = r32 & 3;
    const int abase = q * HY_CS + 2 * (4096 + 8 * hi - (r32 - q));
    const int bbase = HY_ZOFF + batch * HY_ZB + ((i0 + ii + 8) * 72 + 8 * hi) * 2;
    for (int c = vid; c < HYW; c += G) {
        for (int n = 0; n < 2; ++n) {
            __syncthreads();
            { const h16* Rc = Rg + ((size_t)(n * 512 + c)) * 8192;
              for (int k = tid; k < 1024; k += NTHR) { const h16x8 v = *(const h16x8*)(Rc + k * 8);
                  *(LAS h16x8*)(lds + k * 16) = v;
#pragma unroll
                  for (int qq = 1; qq < 4; ++qq)
#pragma unroll
                      for (int e = 0; e < 8; ++e) *(LAS h16*)(lds + qq * HY_CS + (k * 8 + e + qq) * 2) = v[e]; } }
            if (n == 0) {
                const int ch = 1024 + c; const float w0 = convw[ch], w1 = convw[1536 + ch], w2 = convw[3072 + ch], bb = convb[ch];
                for (int i = tid; i < 4 * 512; i += NTHR) { const int bt = i >> 9, t0 = (i & 511) * 8; const h16* raw = hyT + ((size_t)(bt * 1536 + ch)) * S + t0;
                    const h16x8 v = *(const h16x8*)raw; float x[10]; x[0] = t0 > 0 ? (float)raw[-1] : 0.f; x[9] = t0 + 8 < S ? (float)raw[8] : 0.f;
#pragma unroll
                    for (int e = 0; e < 8; ++e) x[e + 1] = (float)v[e];
                    h16x8 o;
#pragma unroll
                    for (int e = 0; e < 8; ++e) o[e] = (h16)(w0 * x[e] + w1 * x[e + 1] + w2 * x[e + 2] + bb);
                    *(LAS h16x8*)(lds + HY_ZOFF + bt * HY_ZB + (((t0 >> 6) + 8) * 72 + (t0 & 63)) * 2) = o; }
            }
            __syncthreads();
            f32x16 acc0, acc1;
#pragma unroll
            for (int r = 0; r < 16; ++r) { acc0[r] = 0.f; acc1[r] = 0.f; }
            for (int d = i0 - 63; d <= i0 + 7; ++d) {
                LAS char* ap = lds + abase - 128 * d; LAS char* bp = lds + bbase - 144 * d;
#pragma unroll
                for (int kc = 0; kc < 4; ++kc) {
                    const h16x8 bf = *(LAS h16x8*)(bp + 32 * kc);
                    const h16x4 a0l = *(LAS h16x4*)(ap + 32 * kc), a0h = *(LAS h16x4*)(ap + 32 * kc + 8);
                    const h16x4 a1l = *(LAS h16x4*)(ap + 32 * kc - 64), a1h = *(LAS h16x4*)(ap + 32 * kc - 56);
                    const h16x8 af0 = {a0l[0], a0l[1], a0l[2], a0l[3], a0h[0], a0h[1], a0h[2], a0h[3]}, af1 = {a1l[0], a1l[1], a1l[2], a1l[3], a1h[0], a1h[1], a1h[2], a1h[3]};
                    acc0 = __builtin_amdgcn_mfma_f32_32x32x16_f16(af0, bf, acc0, 0, 0, 0);
                    acc1 = __builtin_amdgcn_mfma_f32_32x32x16_f16(af1, bf, acc1, 0, 0, 0);
                }
            }
            __syncthreads();
            {
                const int gch = n == 0 ? c : 512 + c; const float w0 = convw[gch], w1 = convw[1536 + gch], w2 = convw[3072 + gch], bb = convb[gch], sk = skip[n * 512 + c];
                const h16* graw = hyT + ((size_t)(batch * 1536 + gch)) * S;
#pragma unroll
                for (int rt = 0; rt < 2; ++rt)
#pragma unroll
                    for (int g = 0; g < 4; ++g) {
                        const int a4 = 32 * rt + 8 * g + 4 * hi, t4 = 64 * (i0 + ii) + a4;
                        LAS char* zp = lds + HY_ZOFF + batch * HY_ZB + ((i0 + ii + 8) * 72 + a4) * 2;
                        const h16x4 zo = *(LAS h16x4*)zp;
                        const h16x4 gv = *(const h16x4*)(graw + t4);
                        float x[6]; x[0] = t4 > 0 ? (float)graw[t4 - 1] : 0.f; x[5] = t4 + 4 < S ? (float)graw[t4 + 4] : 0.f;
#pragma unroll
                        for (int e = 0; e < 4; ++e) x[e + 1] = (float)gv[e];
                        h16x4 zn;
#pragma unroll
                        for (int e = 0; e < 4; ++e) { const float gc = w0 * x[e] + w1 * x[e + 1] + w2 * x[e + 2] + bb; const float y = (rt == 0 ? acc0[4 * g + e] : acc1[4 * g + e]) * HY_FINV;
                            zn[e] = (h16)(gc * (y + sk * (float)zo[e])); }
                        if (n == 0) *(LAS h16x4*)zp = zn; else *(h16x4*)(hT + ((size_t)(batch * 512 + c)) * S + t4) = zn;
                    }
            }
        }
    }
    __syncthreads();
}
__device__ __forceinline__ void phase_mixprep(const Params& p, LAS char* lds) {
    constexpr int LDT = 520;
    LAS h16* tile = (LAS h16*)lds;
    const h16* aout = PH(WS_AOUT); const h16* hT = PH(WS_HT); h16* mix = PH(WS_MIX);
    const int tid = threadIdx.x, lane = tid & 63, wid = tid >> 6;
    for (int u = blockIdx.x; u < T / 64; u += gridDim.x) {
        const int m0 = u * 64, b = m0 >> 12, t0 = m0 & 4095;
        __syncthreads();
        for (int i = tid; i < 512 * 8; i += NTHR) { const int c = i >> 3, j = i & 7;
            const h16x8 v = *(const h16x8*)(hT + ((size_t)(b * 512 + c)) * S + t0 + j * 8);
#pragma unroll
            for (int e = 0; e < 8; ++e) tile[(j * 8 + e) * LDT + c] = v[e]; }
        __syncthreads();
        for (int rr = 0; rr < 8; ++rr) {
            const int r = wid * 8 + rr; const size_t m = (size_t)(m0 + r);
            const h16x8 hv = *(LAS h16x8*)(tile + r * LDT + lane * 8);
            const h16x8 av = *(const h16x8*)(aout + m * 512 + lane * 8);
            float sh = 0.f, sa = 0.f;
#pragma unroll
            for (int e = 0; e < 8; ++e) { const float x = (float)hv[e], y = (float)av[e]; sh += x * x; sa += y * y; }
            sh = wave_sum(sh); sa = wave_sum(sa);
            const float rh = rstd_of(sh, 512), ra = rstd_of(sa, 512);
            h16x8 oh, oa;
#pragma unroll
            for (int e = 0; e < 8; ++e) { oh[e] = (h16)((float)hv[e] * rh); oa[e] = (h16)((float)av[e] * ra); }
            *(h16x8*)(mix + m * D + lane * 8) = oa; *(h16x8*)(mix + m * D + 512 + lane * 8) = oh;
        }
    }
    __syncthreads();
}
constexpr int XA_KROW = 528, XA_VROW = 136, XA_KB = 64 * XA_KROW, XA_VB = 128 * XA_VROW, XA_BUF = XA_KB + XA_VB;
static_assert(2 * XA_BUF <= LDS_BYTES, "xattn lds");
__device__ __forceinline__ void phase_xattn(const Params& p, LAS char* lds) {
    const int tid = threadIdx.x, lane = tid & 63, wid = __builtin_amdgcn_readfirstlane(tid >> 6), r32 = lane & 31, hi = lane >> 5;
    const h16* qc = PH(WS_QC); h16* oc = PH(WS_OC); const h16* Kc = PH(WS_KC); const h16* VcT = PH(WS_VCT);
    const int G = gridDim.x, bx = blockIdx.x, vid = (G % 8 == 0) ? (bx % 8) * (G / 8) + bx / 8 : bx;
    for (int u = vid; u < NB * MH * 16; u += G) {
        const int bh = u >> 4, b = bh >> 2, h = bh & 3, q0 = (u & 15) * 256 + wid * 32;
        const h16* qrow = qc + ((size_t)(b * S + q0 + r32)) * D + h * MHD; h16* orow = oc + ((size_t)(b * S + q0 + r32)) * D + h * MHD;
        h16x8 qf[16];
#pragma unroll
        for (int s_ = 0; s_ < 16; ++s_) qf[s_] = *(const h16x8*)(qrow + 16 * s_ + 8 * hi);
        const h16* Ksrc = Kc + ((size_t)(b * MEMT + (tid >> 5))) * D + h * MHD + (tid & 31) * 8;
        const h16* Vsrc = VcT + ((size_t)(bh * MHD + (tid >> 3))) * MEMT + (tid & 7) * 8;
        const int kdst = (tid >> 5) * XA_KROW + (tid & 31) * 16, vdst = XA_KB + (tid >> 3) * XA_VROW + (tid & 7) * 16;
        h16x8 kr[4], vr[2];
#pragma unroll
        for (int j = 0; j < 4; ++j) kr[j] = *(const h16x8*)(Ksrc + (size_t)(16 * j) * D);
#pragma unroll
        for (int j = 0; j < 2; ++j) vr[j] = *(const h16x8*)(Vsrc + (size_t)(64 * j) * MEMT);
        __syncthreads();
#pragma unroll
        for (int j = 0; j < 4; ++j) *(LAS h16x8*)(lds + kdst + 16 * j * XA_KROW) = kr[j];
#pragma unroll
        for (int j = 0; j < 2; ++j) { LAS char* vn = lds + vdst + 64 * j * XA_VROW; *(LAS h16x4*)vn = (h16x4){vr[j][0], vr[j][1], vr[j][2], vr[j][3]}; *(LAS h16x4*)(vn + 8) = (h16x4){vr[j][4], vr[j][5], vr[j][6], vr[j][7]}; }
        __syncthreads();
        f32x16 o[4]; float m = -1e30f, l = 0.f;
#pragma unroll
        for (int dt = 0; dt < 4; ++dt)
#pragma unroll
            for (int r = 0; r < 16; ++r) o[dt][r] = 0.f;
        for (int st = 0; st < 8; ++st) {
            const int t = st & 3, pass = st >> 2;
            if (st + 1 < 8) { const int t1 = (st + 1) & 3, p1 = (st + 1) >> 2;
#pragma unroll
                for (int j = 0; j < 4; ++j) kr[j] = *(const h16x8*)(Ksrc + (size_t)(64 * t1 + 16 * j) * D);
#pragma unroll
                for (int j = 0; j < 2; ++j) vr[j] = *(const h16x8*)(Vsrc + (size_t)(128 * p1 + 64 * j) * MEMT + 64 * t1); }
            LAS char* kb = lds + (st & 1) * XA_BUF; LAS char* vb = kb + XA_KB;
            f32x16 p0, p1_;
#pragma unroll
            for (int r = 0; r < 16; ++r) { p0[r] = 0.f; p1_[r] = 0.f; }
#pragma unroll
            for (int s_ = 0; s_ < 16; ++s_) {
                const h16x8 a0 = *(LAS h16x8*)(kb + r32 * XA_KROW + s_ * 32 + hi * 16);
                const h16x8 a1 = *(LAS h16x8*)(kb + (32 + r32) * XA_KROW + s_ * 32 + hi * 16);
                p0 = __builtin_amdgcn_mfma_f32_32x32x16_f16(a0, qf[s_], p0, 0, 0, 0);
                p1_ = __builtin_amdgcn_mfma_f32_32x32x16_f16(a1, qf[s_], p1_, 0, 0, 0);
            }
            float mx = fmaxf(p0[0], p1_[0]);
#pragma unroll
            for (int r = 1; r < 16; ++r) mx = fmaxf(mx, fmaxf(p0[r], p1_[r]));
            mx = fmaxf(mx, __shfl_xor(mx, 32));
            const float mn = fmaxf(m, mx), al = __builtin_amdgcn_exp2f(m - mn); m = mn;
            float rs = 0.f;
#pragma unroll
            for (int r = 0; r < 16; ++r) { p0[r] = __builtin_amdgcn_exp2f(p0[r] - mn); p1_[r] = __builtin_amdgcn_exp2f(p1_[r] - mn); rs += p0[r] + p1_[r]; }
            l = l * al + rs;
#pragma unroll
            for (int dt = 0; dt < 4; ++dt)
#pragma unroll
                for (int r = 0; r < 16; ++r) o[dt][r] *= al;
            h16x8 pf[2][2];
#pragma unroll
            for (int j = 0; j < 8; ++j) { pf[0][0][j] = (h16)p0[j]; pf[0][1][j] = (h16)p0[8 + j]; pf[1][0][j] = (h16)p1_[j]; pf[1][1][j] = (h16)p1_[8 + j]; }
#pragma unroll
            for (int kh = 0; kh < 2; ++kh)
#pragma unroll
                for (int s_ = 0; s_ < 2; ++s_)
#pragma unroll
                    for (int dt = 0; dt < 4; ++dt) {
                        LAS char* v0 = vb + (dt * 32 + r32) * XA_VROW + (kh * 32 + 16 * s_ + 4 * hi) * 2;
                        const h16x4 a = *(LAS h16x4*)v0, c = *(LAS h16x4*)(v0 + 16);
                        const h16x8 vf = {a[0], a[1], a[2], a[3], c[0], c[1], c[2], c[3]};
                        o[dt] = __builtin_amdgcn_mfma_f32_32x32x16_f16(vf, pf[kh][s_], o[dt], 0, 0, 0);
                    }
            if (st + 1 < 8) {
                LAS char* nb = lds + ((st + 1) & 1) * XA_BUF;
#pragma unroll
                for (int j = 0; j < 4; ++j) *(LAS h16x8*)(nb + kdst + 16 * j * XA_KROW) = kr[j];
#pragma unroll
                for (int j = 0; j < 2; ++j) { LAS char* vn = nb + vdst + 64 * j * XA_VROW; *(LAS h16x4*)vn = (h16x4){vr[j][0], vr[j][1], vr[j][2], vr[j][3]}; *(LAS h16x4*)(vn + 8) = (h16x4){vr[j][4], vr[j][5], vr[j][6], vr[j][7]}; }
            }
            if (t == 3) {
                const float il = 1.f / (l + __shfl_xor(l, 32));
                h16* op = orow + pass * 128 + 4 * hi;
#pragma unroll
                for (int dt = 0; dt < 4; ++dt)
#pragma unroll
                    for (int g = 0; g < 4; ++g) {
                        *(h16x4*)(op + dt * 32 + 8 * g) = (h16x4){(h16)(o[dt][4 * g] * il), (h16)(o[dt][4 * g + 1] * il), (h16)(o[dt][4 * g + 2] * il), (h16)(o[dt][4 * g + 3] * il)};
                        o[dt][4 * g] = 0.f; o[dt][4 * g + 1] = 0.f; o[dt][4 * g + 2] = 0.f; o[dt][4 * g + 3] = 0.f; }
                m = -1e30f; l = 0.f;
            }
            __syncthreads();
        }
    }
    __syncthreads();
}
__device__ __forceinline__ void phase_route(const Params& p) {
    const float* X = p.X; const float* g = p.in[27]; const float* wrg = p.in[28]; const float* brg = p.in[29]; const float* wre = p.in[30]; const float* bre = p.in[31];
    float* ssx2 = PF(WS_SSX2); float* tokw = PF(WS_TOKW); int* cnt = PI(WS_CTL); int* list = PI(WS_LIST);
    const int lane = threadIdx.x & 63, gw = blockIdx.x * NWAVE + (threadIdx.x >> 6), NGW = gridDim.x * NWAVE;
    for (int m = gw; m < T; m += NGW) {
        float ss = 0.f;
#pragma unroll 4
        for (int i = 0; i < 16; ++i) { const float xv = X[(size_t)m * D + lane + 64 * i]; ss += xv * xv; }
        ss = wave_sum(ss);
        const float rs = rstd_of(ss, D);
        float lg[36];
#pragma unroll
        for (int j = 0; j < 36; ++j) lg[j] = 0.f;
#pragma unroll 1
        for (int i = 0; i < 16; ++i) { const int k = lane + 64 * i; const float tv = X[(size_t)m * D + k] * rs * g[k];
            const f32x4 wg4 = *(const f32x4*)(wrg + k * 4);
#pragma unroll
            for (int j = 0; j < 4; ++j) lg[j] += tv * wg4[j];
#pragma unroll
            for (int j4 = 0; j4 < 8; ++j4) { const f32x4 we4 = *(const f32x4*)(wre + k * 32 + j4 * 4);
#pragma unroll
                for (int j = 0; j < 4; ++j) lg[4 + j4 * 4 + j] += tv * we4[j]; } }
#pragma unroll
        for (int j = 0; j < 36; ++j) lg[j] = wave_sum(lg[j]);
        if (lane == 0) {
            ssx2[m] = ss;
            float gl[4]; int gi = 0; float gm = -1e30f;
#pragma unroll
            for (int j = 0; j < 4; ++j) { gl[j] = lg[j] + brg[j]; if (gl[j] > gm) { gm = gl[j]; gi = j; } }
            float gs = 0.f;
#pragma unroll
            for (int j = 0; j < 4; ++j) gs += expf(gl[j] - gm);
            const float pg = 1.f / gs;
            float e1 = -1e30f, e2 = -1e30f; int i1 = 0, i2 = 0;
#pragma unroll
            for (int g4 = 0; g4 < 4; ++g4) if (g4 == gi) {
#pragma unroll
                for (int j = 0; j < 8; ++j) { const float v = lg[4 + g4 * 8 + j] + bre[g4 * 8 + j];
                    if (v > e1) { e2 = e1; i2 = i1; e1 = v; i1 = j; } else if (v > e2) { e2 = v; i2 = j; } } }
            const float p2 = 1.f / (1.f + expf(e1 - e2)), p1 = 1.f - p2;
            const int ea = gi * 8 + i1, eb = gi * 8 + i2;
            tokw[m * 2] = pg * p1; tokw[m * 2 + 1] = pg * p2;
            const int pa = atomicAdd(&cnt[ea], 1), pb = atomicAdd(&cnt[eb], 1);
            list[ea * T + pa] = m * 2; list[eb * T + pb] = m * 2 + 1;
        }
    }
}
struct RowGather { const h16* A; const int* lst; int Me; __device__ __forceinline__ const h16* operator()(int m) const { const int pr = m < Me ? lst[m] : lst[0]; return A + (size_t)(pr >> 1) * D; } };
struct RowClamp { const h16* A; int Me; __device__ __forceinline__ const h16* operator()(int m) const { return A + (size_t)(m < Me ? m : 0) * DE; } };
struct EGu { const int* lst; int Me; const float* ssx2; const float* tokw; h16* hb;
    __device__ __forceinline__ void row32(int m, int nb, f32x4 va, f32x4 vb) const {
        if (m >= Me) return;
        const int pr = lst[m]; const float rs = rstd_of(ssx2[pr >> 1], D), w = tokw[pr];
        h16x4 o;
#pragma unroll
        for (int j = 0; j < 4; ++j) { const float a = va[j] * rs, bb = vb[j] * rs; o[j] = (h16)(a / (1.f + __expf(-a)) * bb * w); }
        *(h16x4*)(hb + (size_t)m * DE + (nb >> 5) * 16 + (nb & 31)) = o;
    } };
struct EDn { const int* lst; int Me; h16* yb;
    __device__ __forceinline__ void row32(int m, int nb, f32x4 va, f32x4 vb) const {
        if (m >= Me) return;
        h16* y = yb + (size_t)lst[m] * D + nb;
        *(h16x4*)y = cvt4(va); *(h16x4*)(y + 16) = cvt4(vb);
    } };
template <bool DOWN>
__device__ __forceinline__ void phase_moe(const Params& p, LAS char* lds) {
    const int* cnt = PI(WS_CTL);
    const int G = gridDim.x, bx = blockIdx.x, vid = (G % 8 == 0) ? (bx % 8) * (G / 8) + bx / 8 : bx;
    constexpr int NTN = DOWN ? D / G_BN : 512 / G_BN;
    int tbase = 0, off = 0;
    int tix = vid;
    for (int e = 0; e < NE; ++e) {
        const int Me = cnt[e], nmt = (Me + G_BM - 1) / G_BM, nte = nmt * NTN;
        const int* lst = PI(WS_LIST) + (size_t)e * T;
        for (; tix < tbase + nte; tix += G) {
            const int lt = tix - tbase, mt = lt / NTN, nt_ = lt - mt * NTN;
            if (!DOWN) gemm_tile<true>(lds, RowGather{PH(WS_X2H), lst, Me}, PH(WS_WGU) + (size_t)e * 512 * D, D, D, mt * G_BM, nt_ * G_BN,
                                       EGu{lst, Me, PF(WS_SSX2), PF(WS_TOKW), PH(WS_HB) + (size_t)off * DE});
            else gemm_tile<true>(lds, RowClamp{PH(WS_HB) + (size_t)off * DE, Me}, PH(WS_WDN) + (size_t)e * D * DE, DE, DE, mt * G_BM, nt_ * G_BN,
                                 EDn{lst, Me, PH(WS_YB)});
        }
        tbase += nte; off += Me;
    }
}
__device__ __forceinline__ void phase_final(const Params& p) {
    const float* X = p.X; const h16* yb = PH(WS_YB); const float* g = p.in[35]; float* out = p.X;
    const int lane = threadIdx.x & 63, gw = blockIdx.x * NWAVE + (threadIdx.x >> 6), NGW = gridDim.x * NWAVE;
    for (int m = gw; m < T; m += NGW) {
        f32x4 v[4]; float ss = 0.f;
#pragma unroll
        for (int i = 0; i < 4; ++i) { const int k = (lane + 64 * i) * 4;
            const f32x4 xv = *(const f32x4*)(X + (size_t)m * D + k); const h16x4 y0 = *(const h16x4*)(yb + ((size_t)m * 2) * D + k), y1 = *(const h16x4*)(yb + ((size_t)m * 2 + 1) * D + k);
#pragma unroll
            for (int j = 0; j < 4; ++j) { v[i][j] = xv[j] + (float)y0[j] + (float)y1[j]; ss += v[i][j] * v[i][j]; } }
        ss = wave_sum(ss); const float rs = rstd_of(ss, D);
#pragma unroll
        for (int i = 0; i < 4; ++i) { const int k = (lane + 64 * i) * 4; const f32x4 gv = *(const f32x4*)(g + k); *(f32x4*)(out + (size_t)m * D + k) = v[i] * rs * gv; }
    }
}

#define XB_TMO      128
#define XB_XCNT(j)  (256  + 64 * (j))
#define XB_XSUB(j)  (1280 + 64 * (j))
#define XB_XGEN(j)  (2304 + 64 * (j))
#define XB_TOP      3328
#define XB_TOPGEN   3392
#define XCD_BAR_WORDS 3456
#define XB_SPIN_CAP (1u << 18)
__device__ __forceinline__ unsigned xb_ld(unsigned* p)              { return __hip_atomic_load(p, __ATOMIC_RELAXED, __HIP_MEMORY_SCOPE_AGENT); }
__device__ __forceinline__ unsigned xb_add(unsigned* p, unsigned v) { return __hip_atomic_fetch_add(p, v, __ATOMIC_RELAXED, __HIP_MEMORY_SCOPE_AGENT); }
__device__ __forceinline__ unsigned xb_xcc_id() { return (unsigned)__builtin_amdgcn_s_getreg((3 << 11) | 20) & 0xFu; }
#define XB_SPIN(cond, bar) do { unsigned _sp = 0; while (cond) { __builtin_amdgcn_s_sleep(1); \
    if ((++_sp & 255u) == 0u) { if (xb_ld(&(bar)[XB_TMO])) break; if (_sp > XB_SPIN_CAP) { atomicAdd(&(bar)[XB_TMO], 1u); break; } } } } while (0)
struct XcdBarrier { unsigned* bar; unsigned x; volatile LAS unsigned* st; };
__device__ __forceinline__ XcdBarrier xcd_barrier_post(unsigned* bar, volatile LAS unsigned* st) {
    XcdBarrier b; b.bar = bar; b.x = xb_xcc_id(); b.st = st;
    if (threadIdx.x == 0) (void)xb_add(&bar[XB_XCNT(b.x)], 1u);
    return b;
}
__device__ __forceinline__ void xcd_barrier_complete(unsigned* bar, unsigned x, unsigned& nloc, unsigned& nx) {
    const unsigned G = gridDim.x * gridDim.y * gridDim.z;
    unsigned sum, cnt, mine, sp = 0u;
    for (;;) {
        sum = 0u; cnt = 0u; mine = 0u;
#pragma unroll
        for (unsigned j = 0; j < 16; ++j) { const unsigned c = xb_ld(&bar[XB_XCNT(j)]); sum += c; cnt += (c > 0u) ? 1u : 0u; mine = (j == x) ? c : mine; }
        if (sum == G) break;
        __builtin_amdgcn_s_sleep(1);
        if ((++sp & 255u) == 0u) { if (xb_ld(&bar[XB_TMO])) break; if (sp > XB_SPIN_CAP) { atomicAdd(&bar[XB_TMO], 1u); break; } }
    }
    nloc = mine > 0u ? mine : 1u; nx = cnt > 0u ? cnt : 1u;
}
__device__ __forceinline__ void xcd_barrier(const XcdBarrier& b) {
    asm volatile("s_waitcnt vmcnt(0)" ::: "memory");
    __syncthreads();
    if (threadIdx.x == 0) {
        unsigned* bar = b.bar;
        __builtin_amdgcn_s_waitcnt(0);
        unsigned nloc = b.st[0], nx = b.st[1];
        if (nloc == 0u) { xcd_barrier_complete(bar, b.x, nloc, nx); b.st[0] = nloc; b.st[1] = nx; }
        const unsigned old = xb_add(&bar[XB_XSUB(b.x)], 1u);
        const unsigned gen = old / nloc;
        if (old + 1u == (gen + 1u) * nloc) {
            __builtin_amdgcn_fence(__ATOMIC_RELEASE, "agent");
            asm volatile("s_waitcnt vmcnt(0)" ::: "memory");
            const unsigned og = xb_add(&bar[XB_TOP], 1u);
            const unsigned tg = og / nx;
            if (og + 1u == (tg + 1u) * nx) xb_add(&bar[XB_TOPGEN], 1u);
            else XB_SPIN(xb_ld(&bar[XB_TOPGEN]) == tg, bar);
            __builtin_amdgcn_fence(__ATOMIC_ACQUIRE, "agent");
            xb_add(&bar[XB_XGEN(b.x)], 1u);
            asm volatile("s_waitcnt vmcnt(0)" ::: "memory");
        } else {
            XB_SPIN(xb_ld(&bar[XB_XGEN(b.x)]) == gen, bar);
            __builtin_amdgcn_fence(__ATOMIC_ACQUIRE, "agent");
            asm volatile("s_waitcnt vmcnt(0)" ::: "memory");
        }
    }
    __syncthreads();
}

#ifndef REP_PHASE
#define REP_PHASE -1
#endif
__global__ void __launch_bounds__(NTHR) mega(Params p, int ph_lo, int ph_hi) {
    extern __shared__ __attribute__((aligned(16))) char lds_raw[];
    LAS char* lds = (LAS char*)lds_raw;
    cg::grid_group grid = cg::this_grid();
    volatile LAS unsigned* misc = (volatile LAS unsigned*)(lds + LDS_BYTES - 64);
    if (threadIdx.x < 16) misc[threadIdx.x] = 0u;
    __syncthreads();
    const XcdBarrier bar = xcd_barrier_post((unsigned*)(p.ws + WS_BAR), misc);
#define PHASE(k) if (ph_lo <= (k) && (k) < ph_hi) for (int rep_ = 0; rep_ < ((k) == REP_PHASE ? 2 : 1); ++rep_)
#define SEAM(k) if (ph_lo <= (k) && (k) + 1 < ph_hi) { if ((k) == 0) grid.sync(); else xcd_barrier(bar); }
    PHASE(0) { phase_prep(p, lds); }
    SEAM(0);
    PHASE(1) {
        gemm_job<false>(lds, PH(WS_XH), D, PH(WS_WIN), D, T, 1536, D, EHy{PF(WS_SSX), PH(WS_HYT)});
        gemm_job<true>(lds, PH(WS_XH), D, PH(WS_WIN) + (size_t)1536 * D, D, T, 512, D, ELat{PF(WS_SSX), PH(WS_LAT), rep_ ? nullptr : PF(WS_SSQ), PF(WS_SSKV)});
    }
    PHASE(14) {
        gemm_job<true>(lds, PH(WS_MEMH), D, PH(WS_WMKV), D, MROWS, 1024, D, EKc{PF(WS_SSMEM), PH(WS_KC)});
        gemm_job<false>(lds, PH(WS_MEMH), D, PH(WS_WMKV) + (size_t)1024 * D, D, MROWS, 1024, D, EVc{PF(WS_SSMEM), PH(WS_VCT)}, 32);
    }
    SEAM(1);
    PHASE(2) {
        gemm_job<true>(lds, PH(WS_LAT), LAT, PH(WS_WUQ), 256, T, 768, 256, EQ{PF(WS_SSQ), PF(WS_ROPE), PH(WS_Q)});
        gemm_job<true>(lds, PH(WS_LAT) + 256, LAT, PH(WS_WUKV), 128, T, 512, 128, EK{PF(WS_SSKV), PH(WS_K)}, 128);
        gemm_job<false>(lds, PH(WS_LAT) + 256, LAT, PH(WS_WUKV) + (size_t)512 * 128, 128, T, 512, 128, EV{PF(WS_SSKV), PH(WS_VT)}, 128);
        phase_krot(p);
    }
    PHASE(15) { phase_filt3(p, lds); }
    SEAM(2);
    PHASE(3) { phase_attn(p, lds); }
    PHASE(13) { phase_hyena(p, lds); }
    SEAM(3);
    PHASE(4) { phase_mixprep(p, lds); }
    SEAM(4);
    PHASE(5) { gemm_job<true>(lds, PH(WS_MIX), D, PH(WS_WOUT), D, T, D, D, ERes{p.in[0], p.X, PH(WS_X1H), rep_ ? nullptr : PF(WS_SSX1)}); }
    SEAM(5);
    PHASE(6) { gemm_job<true>(lds, PH(WS_X1H), D, PH(WS_WMQ), D, T, D, D, EMq{PF(WS_SSX1), PH(WS_QC)}); }
    SEAM(6);
    PHASE(7) { phase_xattn(p, lds); }
    SEAM(7);
    PHASE(8) { gemm_job<true>(lds, PH(WS_OC), D, PH(WS_WMO), D, T, D, D, ERes{p.X, p.X, PH(WS_X2H), nullptr}); }
    SEAM(8);
    PHASE(9) { phase_route(p); }
    SEAM(9);
    PHASE(10) { phase_moe<false>(p, lds); }
    SEAM(10);
    PHASE(11) { phase_moe<true>(p, lds); }
    SEAM(11);
    PHASE(12) { phase_final(p); }
}

extern "C" void kernel_launch(void* const* d_in, const int* in_sizes, int n_in, void* d_out, int out_size, void* d_ws, size_t ws_size, hipStream_t st) {
    Params p{};
    for (int i = 0; i < 36; ++i) p.in[i] = (const float*)d_in[i];
    p.X = (float*)d_out; p.ws = (char*)d_ws;
    static int grid = 0;
    if (!grid) {
        (void)hipFuncSetAttribute((const void*)mega, hipFuncAttributeMaxDynamicSharedMemorySize, LDS_BYTES);
        int dev = 0, cus = 0, per_cu = 0;
        (void)hipGetDevice(&dev);
        (void)hipDeviceGetAttribute(&cus, hipDeviceAttributeMultiprocessorCount, dev);
        (void)hipOccupancyMaxActiveBlocksPerMultiprocessor(&per_cu, (const void*)mega, NTHR, LDS_BYTES);
        if (per_cu < 1) { fprintf(stderr, "kernel_launch: occupancy query says %d blocks/CU\n", per_cu); per_cu = 1; }
        grid = cus;
    }
    (void)hipMemsetAsync((char*)d_ws + WS_CTL, 0, 32 * 1024, st);
    int lo = 0, hi = 16;
    void* args[] = {&p, &lo, &hi};
    hipError_t e = hipLaunchCooperativeKernel((const void*)mega, dim3(grid), dim3(NTHR), args, LDS_BYTES, st);
    if (e != hipSuccess) fprintf(stderr, "cooperative launch failed: %s (grid %d)\n", hipGetErrorString(e), grid);
    (void)in_sizes; (void)n_in; (void)out_size; (void)ws_size;
}
```

```cpp
#include <hip/hip_runtime.h>
#include <cstdint>
#include <cstdio>
#include <hip/hip_cooperative_groups.h>
namespace cg = cooperative_groups;
typedef _Float16 h16;

constexpr int NB = 4, S = 4096, D = 1024, T = NB * S, MEMT = 256, MROWS = NB * MEMT;
constexpr int NH = 8, HYW = 512;
constexpr int LAT = 416, INC = 1952;
constexpr int MH = 4, MHD = 256;
constexpr int NE = 32, DE = 256;
constexpr float EPS = 1e-6f;
constexpr float LOG2E = 1.4426950408889634f;
constexpr float QSCALE = 0.10206207261596575f * LOG2E;
constexpr float CSCALE = 0.0625f * LOG2E;

constexpr size_t MiB = 1u << 20;
constexpr size_t WS_CTL = 0;
constexpr size_t WS_SSX = 64 * 1024, WS_SSQ = 128 * 1024, WS_SSKV = 192 * 1024, WS_SSA = 256 * 1024, WS_SSH = 320 * 1024,
                 WS_SSX1 = 384 * 1024, WS_SSX2 = 448 * 1024, WS_SSMEM = 512 * 1024, WS_TOKE = 576 * 1024, WS_TOKW = 704 * 1024,
                 WS_TOKP = 832 * 1024;
constexpr size_t WS_WIN = 2 * MiB, WS_WUQ = 6 * MiB, WS_WUKV = 6 * MiB + 512 * 1024, WS_WOUT = 7 * MiB, WS_WMQ = 9 * MiB,
                 WS_WMKV = 11 * MiB, WS_WMO = 15 * MiB, WS_MEMH = 17 * MiB, WS_KC = 19 * MiB, WS_VCT = 21 * MiB, WS_R = 23 * MiB,
                 WS_WGU = 39 * MiB, WS_WDN = 71 * MiB, WS_LAT = 87 * MiB, WS_HYT = 101 * MiB, WS_XH = 149 * MiB, WS_Q = 149 * MiB,
                 WS_K = 173 * MiB, WS_VT = 197 * MiB, WS_AOUT = 213 * MiB, WS_HT = 229 * MiB, WS_LIST = 245 * MiB, WS_H2 = 247 * MiB;
constexpr size_t WS_OC = 183 * MiB, WS_BAR = 16 * 1024;
constexpr size_t WS_MIX = 87 * MiB, WS_X1H = 119 * MiB, WS_QC = 151 * MiB, WS_X2H = 87 * MiB, WS_HB = 119 * MiB, WS_YB = 135 * MiB;

__device__ __forceinline__ float wave_sum(float v) {
#pragma unroll
    for (int o = 1; o < 64; o <<= 1) v += __shfl_xor(v, o);
    return v;
}
__device__ __forceinline__ float rstd_of(float ss, int n) { return 1.0f / sqrtf(ss / (float)n + EPS); }

#define LAS __attribute__((address_space(3)))
typedef _Float16 h16x8 __attribute__((ext_vector_type(8)));
typedef _Float16 h16x4 __attribute__((ext_vector_type(4)));
typedef _Float16 h16x2 __attribute__((ext_vector_type(2)));
typedef float f32x4 __attribute__((ext_vector_type(4)));
typedef float f32x16 __attribute__((ext_vector_type(16)));
constexpr int NTHR = 512, NWAVE = 8;
constexpr int LDS_BYTES = 150 * 1024;
constexpr size_t WS_ROPE = 248 * MiB;
constexpr float HY_FSCALE = 256.f, HY_FINV = 1.f / 256.f;

struct Params {
    const float* in[36]; float* X; char* ws;
};
#define PF(off) ((float*)(p.ws + (off)))
#define PH(off) ((h16*)(p.ws + (off)))
#define PI(off) ((int*)(p.ws + (off)))

constexpr int G_BM = 256, G_BN = 128, G_BK = 64, G_AB = G_BM * G_BK * 2, G_BB = G_BN * G_BK * 2, G_STAGE = G_AB + G_BB;
static_assert(3 * G_STAGE <= LDS_BYTES, "lds");
__device__ __forceinline__ void glds16(const void* g, LAS char* l) { __builtin_amdgcn_global_load_lds((const unsigned*)g, (LAS unsigned*)l, 16, 0, 0); }

template <bool SWAP, class RowPtr, class Epi>
__device__ __forceinline__ void gemm_tile(LAS char* lds, const RowPtr& rowptr, const h16* __restrict__ Wt, int ldw, int K, int m0, int n0, const Epi& epi) {
    const int tid = threadIdx.x, lane = tid & 63, wid = __builtin_amdgcn_readfirstlane(tid >> 6);
    const int wm = wid >> 1, wn = wid & 1, fr = lane & 15, fq = lane >> 4;
    const h16* asrc[4]; const h16* bsrc[2];
#pragma unroll
    for (int i = 0; i < 4; ++i) { const int r = wid * 32 + i * 8 + (lane >> 3); const int ch = (lane & 7) ^ ((r >> 1) & 7); asrc[i] = rowptr(m0 + r) + ch * 8; }
#pragma unroll
    for (int i = 0; i < 2; ++i) { const int r = wid * 16 + i * 8 + (lane >> 3); const int ch = (lane & 7) ^ ((r >> 1) & 7); bsrc[i] = Wt + (size_t)(n0 + r) * ldw + ch * 8; }
    const int sw = fr >> 1;
    const int aoff = (wm * 64 + fr) * 128 + ((fq ^ sw) * 16);
    const int boff = G_AB + (wn * 64 + fr) * 128 + ((fq ^ sw) * 16);
    f32x4 acc[4][4];
#pragma unroll
    for (int i = 0; i < 4; ++i)
#pragma unroll
        for (int j = 0; j < 4; ++j) acc[i][j] = (f32x4){0.f, 0.f, 0.f, 0.f};
    const int nt = K / G_BK;
    asm volatile("s_waitcnt vmcnt(0)" ::: "memory");
#define G_STAGE_ISSUE(buf, kt) do { LAS char* sa_ = lds + (buf) * G_STAGE + wid * 4096; \
        _Pragma("unroll") for (int i_ = 0; i_ < 4; ++i_) glds16(asrc[i_] + (kt) * G_BK, sa_ + i_ * 1024); \
        LAS char* sb_ = lds + (buf) * G_STAGE + G_AB + wid * 2048; \
        _Pragma("unroll") for (int i_ = 0; i_ < 2; ++i_) glds16(bsrc[i_] + (kt) * G_BK, sb_ + i_ * 1024); } while (0)
    G_STAGE_ISSUE(0, 0);
    if (nt > 1) G_STAGE_ISSUE(1, 1);
    int buf = 0;
    for (int t = 0; t < nt; ++t) {
        if (t + 1 < nt) asm volatile("s_waitcnt vmcnt(6)" ::: "memory"); else asm volatile("s_waitcnt vmcnt(0)" ::: "memory");
        __builtin_amdgcn_s_barrier();
        if (t + 2 < nt) { const int nb_ = buf >= 1 ? buf - 1 : 2; G_STAGE_ISSUE(nb_, t + 2); }
        LAS char* base = lds + buf * G_STAGE;
#pragma unroll
        for (int kk = 0; kk < 2; ++kk) {
            h16x8 a[4], b[4];
#pragma unroll
            for (int i = 0; i < 4; ++i) { a[i] = *(LAS h16x8*)(base + ((aoff ^ (kk * 64)) + i * 2048)); b[i] = *(LAS h16x8*)(base + ((boff ^ (kk * 64)) + i * 2048)); }
#pragma unroll
            for (int i = 0; i < 4; ++i)
#pragma unroll
                for (int j = 0; j < 4; ++j)
                    acc[i][j] = SWAP ? __builtin_amdgcn_mfma_f32_16x16x32_f16(b[j], a[i], acc[i][j], 0, 0, 0)
                                     : __builtin_amdgcn_mfma_f32_16x16x32_f16(a[i], b[j], acc[i][j], 0, 0, 0);
        }
        buf = buf == 2 ? 0 : buf + 1;
    }
#undef G_STAGE_ISSUE
    asm volatile("s_waitcnt lgkmcnt(0)" ::: "memory");
    __builtin_amdgcn_s_barrier();
    if constexpr (SWAP) {
#pragma unroll
        for (int i = 0; i < 4; ++i)
#pragma unroll
            for (int jp = 0; jp < 2; ++jp) epi.row32(m0 + wm * 64 + i * 16 + fr, n0 + wn * 64 + jp * 32 + fq * 4, acc[i][2 * jp], acc[i][2 * jp + 1]);
    } else {
#pragma unroll
        for (int i = 0; i < 4; ++i)
#pragma unroll
            for (int j = 0; j < 4; ++j) epi.col4(m0 + wm * 64 + i * 16 + fq * 4, n0 + wn * 64 + j * 16 + fr, acc[i][j]);
    }
}
struct RowDense { const h16* A; int lda; __device__ __forceinline__ const h16* operator()(int m) const { return A + (size_t)m * lda; } };

__device__ __forceinline__ h16x4 cvt4(f32x4 v) { return (h16x4){(h16)v[0], (h16)v[1], (h16)v[2], (h16)v[3]}; }
__device__ __forceinline__ float rowgrp_sum(float v) { v += __shfl_xor(v, 16); v += __shfl_xor(v, 32); return v; }

struct EHy {
    const float* ssx; h16* hyT;
    __device__ __forceinline__ void col4(int mr, int n, f32x4 v) const {
        const f32x4 ss = *(const f32x4*)(ssx + mr);
        v[0] *= rstd_of(ss[0], D); v[1] *= rstd_of(ss[1], D); v[2] *= rstd_of(ss[2], D); v[3] *= rstd_of(ss[3], D);
        const int b = mr >> 12, t = mr & 4095;
        *(h16x4*)(hyT + ((size_t)(b * 1536 + n)) * S + t) = cvt4(v);
    } };
struct ELat {
    const float* ssx; h16* lat; float* ssq; float* sskv;
    __device__ __forceinline__ void row32(int m, int nb, f32x4 va, f32x4 vb) const {
        const float r = rstd_of(ssx[m], D); va *= r; vb *= r;
        if (nb < LAT) { *(h16x4*)(lat + (size_t)m * LAT + nb) = cvt4(va); *(h16x4*)(lat + (size_t)m * LAT + nb + 16) = cvt4(vb); }
        float s = va[0] * va[0] + va[1] * va[1] + va[2] * va[2] + va[3] * va[3] + vb[0] * vb[0] + vb[1] * vb[1] + vb[2] * vb[2] + vb[3] * vb[3];
        s = rowgrp_sum(s);
        if (ssq && (threadIdx.x & 63) < 16 && nb < 384) atomicAdd((nb < 256 ? ssq : sskv) + m, s);
    } };
struct EQ {
    const float* ssq; const float* rope; h16* Q;
    __device__ __forceinline__ void row32(int m, int nb, f32x4 va, f32x4 vb) const {
        const float r = rstd_of(ssq[m], 256) * QSCALE; va *= r; vb *= r;
        const int b = m >> 12, t = m & 4095, blk = nb >> 5, h = blk / 3, part = blk - 3 * h, c = nb & 31;
        if (part == 2) {
            const float* rp = rope + ((size_t)t * 16 + c) * 2;
#pragma unroll
            for (int j = 0; j < 4; ++j) { const float cs = rp[2 * j], sn = rp[2 * j + 1]; const float q1 = va[j], q2 = vb[j]; va[j] = q1 * cs - q2 * sn; vb[j] = q1 * sn + q2 * cs; }
        }
        h16* q = Q + ((size_t)((b * NH + h) * S + t)) * 96 + part * 32 + c;
        *(h16x4*)q = cvt4(va); *(h16x4*)(q + 16) = cvt4(vb);
    } };
struct EK {
    const float* sskv; h16* K;
    __device__ __forceinline__ void row32(int m, int nb, f32x4 va, f32x4 vb) const {
        const float r = rstd_of(sskv[m], 128); va *= r; vb *= r;
        const int b = m >> 12, t = m & 4095, h = nb >> 6, j = nb & 63;
        h16* k = K + ((size_t)((b * NH + h) * S + t)) * 96 + j;
        *(h16x4*)k = cvt4(va); *(h16x4*)(k + 16) = cvt4(vb);
    } };
struct EV {
    const float* sskv; h16* Vt;
    __device__ __forceinline__ void col4(int mr, int n, f32x4 v) const {
        const f32x4 ss = *(const f32x4*)(sskv + mr);
        v[0] *= rstd_of(ss[0], 128); v[1] *= rstd_of(ss[1], 128); v[2] *= rstd_of(ss[2], 128); v[3] *= rstd_of(ss[3], 128);
        const int b = mr >> 12, t = mr & 4095;
        *(h16x4*)(Vt + ((size_t)(b * 512 + n)) * S + t) = cvt4(v);
    } };
struct EKc {
    const float* ss; h16* Kc;
    __device__ __forceinline__ void row32(int m, int nb, f32x4 va, f32x4 vb) const {
        const float r = rstd_of(ss[m], D); va *= r; vb *= r;
        *(h16x4*)(Kc + (size_t)m * D + nb) = cvt4(va); *(h16x4*)(Kc + (size_t)m * D + nb + 16) = cvt4(vb);
    } };
struct EVc {
    const float* ss; h16* VcT;
    __device__ __forceinline__ void col4(int mr, int n, f32x4 v) const {
        const f32x4 s4 = *(const f32x4*)(ss + mr);
        v[0] *= rstd_of(s4[0], D); v[1] *= rstd_of(s4[1], D); v[2] *= rstd_of(s4[2], D); v[3] *= rstd_of(s4[3], D);
        const int b = mr >> 8, mm = mr & 255;
        *(h16x4*)(VcT + ((size_t)(b * 1024 + n)) * MEMT + mm) = cvt4(v);
    } };
struct ERes {
    const float* xin; float* X; h16* xh; float* ss;
    __device__ __forceinline__ void row32(int m, int nb, f32x4 va, f32x4 vb) const {
        const size_t i = (size_t)m * D + nb;
        va += *(const f32x4*)(xin + i); vb += *(const f32x4*)(xin + i + 16);
        *(f32x4*)(X + i) = va; *(f32x4*)(X + i + 16) = vb;
        *(h16x4*)(xh + i) = cvt4(va); *(h16x4*)(xh + i + 16) = cvt4(vb);
        float s = va[0] * va[0] + va[1] * va[1] + va[2] * va[2] + va[3] * va[3] + vb[0] * vb[0] + vb[1] * vb[1] + vb[2] * vb[2] + vb[3] * vb[3];
        s = rowgrp_sum(s);
        if (ss && (threadIdx.x & 63) < 16) atomicAdd(ss + m, s);
    } };
struct EMq {
    const float* ss; h16* qc;
    __device__ __forceinline__ void row32(int m, int nb, f32x4 va, f32x4 vb) const {
        const float r = rstd_of(ss[m], D) * CSCALE; va *= r; vb *= r;
        *(h16x4*)(qc + (size_t)m * D + nb) = cvt4(va); *(h16x4*)(qc + (size_t)m * D + nb + 16) = cvt4(vb);
    } };

template <bool SWAP, class Epi>
__device__ __forceinline__ void gemm_job(LAS char* lds, const h16* A, int lda, const h16* Wt, int ldw, int M, int N, int K, const Epi& epi, int first = 0) {
    const int ntn = N / G_BN, ntiles = (M / G_BM) * ntn;
    const RowDense rp{A, lda};
    const int G = gridDim.x, bx = blockIdx.x, vid = (G % 8 == 0) ? (bx % 8) * (G / 8) + bx / 8 : bx;
    for (int tix = (vid + G - first % G) % G; tix < ntiles; tix += G) {
        const int mt = tix / ntn, nt_ = tix - mt * ntn;
        gemm_tile<SWAP>(lds, rp, Wt, ldw, K, mt * G_BM, nt_ * G_BN, epi);
    }
}

template <class RowMap, class Gain>
__device__ __forceinline__ void wt_item(const float* W, int N, int K, h16* Wt, LAS float* scr, int k0, int n0, int lane, const RowMap& rowmap, const Gain& gain) {
#pragma unroll
    for (int i = 0; i < 32; ++i) { const int kk = 2 * i + (lane >> 5); scr[kk * 33 + (lane & 31)] = W[(size_t)(k0 + kk) * N + n0 + (lane & 31)] * gain(k0 + kk); }
    asm volatile("s_waitcnt lgkmcnt(0)" ::: "memory");
    const int c = lane & 7;
#pragma unroll
    for (int j = 0; j < 4; ++j) { const int n = (lane >> 3) + 8 * j; const LAS float* s = scr + (8 * c) * 33 + n;
        h16x8 o = {(h16)s[0], (h16)s[33], (h16)s[66], (h16)s[99], (h16)s[132], (h16)s[165], (h16)s[198], (h16)s[231]};
        *(h16x8*)(Wt + (size_t)rowmap(n0 + n) * K + k0 + 8 * c) = o; }
    asm volatile("s_waitcnt lgkmcnt(0)" ::: "memory");
}
struct GainNone { __device__ __forceinline__ float operator()(int) const { return 1.f; } };
struct Gain1 { const float* g; __device__ __forceinline__ float operator()(int k) const { return g[k]; } };
struct Gain2 { const float* g; const float* g2; __device__ __forceinline__ float operator()(int k) const { return k < 512 ? g[k] : g2[k - 512]; } };
struct MapId { __device__ __forceinline__ int operator()(int n) const { return n; } };
struct MapIn { __device__ __forceinline__ int operator()(int n) const { return n < LAT ? 1536 + n : n - LAT; } };
struct MapKV { __device__ __forceinline__ int operator()(int n) const { const int h = n >> 7, j = n & 127; return j < 64 ? h * 64 + j : 512 + h * 64 + (j - 64); } };
struct MapG { int up; __device__ __forceinline__ int operator()(int j) const { return 32 * (j >> 4) + (j & 15) + up; } };

__device__ __forceinline__ void phase_prep(const Params& p, LAS char* lds) {
    const int tid = threadIdx.x, lane = tid & 63, wid = tid >> 6;
    const int gw = blockIdx.x * NWAVE + wid, NGW = gridDim.x * NWAVE, gt = blockIdx.x * NTHR + tid, NGT = gridDim.x * NTHR;
    LAS float* scr = (LAS float*)(lds + wid * 16384);
    for (int i = gt; i < 5 * 16384; i += NGT) PF(WS_SSQ)[i] = 0.f;
    for (int row = gw; row < T + MROWS; row += NGW) {
        const bool isx = row < T; const int r = isx ? row : row - T;
        const f32x4* src = (const f32x4*)((isx ? p.in[0] : p.in[1]) + (size_t)r * D) + lane;
        h16* dst = (isx ? PH(WS_XH) : PH(WS_MEMH)) + (size_t)r * D;
        float s = 0.f;
#pragma unroll
        for (int j = 0; j < 4; ++j) { const f32x4 v = src[64 * j]; s += v[0] * v[0] + v[1] * v[1] + v[2] * v[2] + v[3] * v[3]; *(h16x4*)(dst + (lane + 64 * j) * 4) = cvt4(v); }
        s = wave_sum(s);
        if (lane == 0) (isx ? PF(WS_SSX) : PF(WS_SSMEM))[r] = s;
    }
    {
        constexpr int I_IN = 16 * 61, I_UQ = 4 * 24, I_UKV = 2 * 32, I_SQ = 16 * 32, I_MKV = 16 * 64, I_EX = 16 * 8, I_DN = 4 * 32;
        constexpr int NIT = I_IN + I_UQ + I_UKV + 3 * I_SQ + I_MKV + NE * (2 * I_EX + I_DN);
        for (int it = gw; it < NIT; it += NGW) {
            int r = it;
            if (r < I_IN) { wt_item(p.in[3], INC, D, PH(WS_WIN), scr, (r / 61) * 64, (r % 61) * 32, lane, MapIn{}, Gain1{p.in[2]}); continue; } r -= I_IN;
            if (r < I_UQ) { wt_item(p.in[6], 768, 256, PH(WS_WUQ), scr, (r / 24) * 64, (r % 24) * 32, lane, MapId{}, Gain1{p.in[4]}); continue; } r -= I_UQ;
            if (r < I_UKV) { wt_item(p.in[7], 1024, 128, PH(WS_WUKV), scr, (r / 32) * 64, (r % 32) * 32, lane, MapKV{}, Gain1{p.in[5]}); continue; } r -= I_UKV;
            if (r < I_SQ) { wt_item(p.in[21], D, D, PH(WS_WOUT), scr, (r / 32) * 64, (r % 32) * 32, lane, MapId{}, Gain2{p.in[19], p.in[20]}); continue; } r -= I_SQ;
            if (r < I_SQ) { wt_item(p.in[24], D, D, PH(WS_WMQ), scr, (r / 32) * 64, (r % 32) * 32, lane, MapId{}, Gain1{p.in[22]}); continue; } r -= I_SQ;
            if (r < I_SQ) { wt_item(p.in[26], D, D, PH(WS_WMO), scr, (r / 32) * 64, (r % 32) * 32, lane, MapId{}, GainNone{}); continue; } r -= I_SQ;
            if (r < I_MKV) { wt_item(p.in[25], 2048, D, PH(WS_WMKV), scr, (r / 64) * 64, (r % 64) * 32, lane, MapId{}, Gain1{p.in[23]}); continue; } r -= I_MKV;
            const int e = r / (2 * I_EX + I_DN); r -= e * (2 * I_EX + I_DN);
            if (r < I_EX) { wt_item(p.in[32] + (size_t)e * D * DE, DE, D, PH(WS_WGU) + (size_t)e * 512 * D, scr, (r / 8) * 64, (r % 8) * 32, lane, MapG{0}, Gain1{p.in[27]}); continue; } r -= I_EX;
            if (r < I_EX) { wt_item(p.in[33] + (size_t)e * D * DE, DE, D, PH(WS_WGU) + (size_t)e * 512 * D, scr, (r / 8) * 64, (r % 8) * 32, lane, MapG{16}, Gain1{p.in[27]}); continue; } r -= I_EX;
            wt_item(p.in[34] + (size_t)e * DE * D, D, DE, PH(WS_WDN) + (size_t)e * D * DE, scr, (r / 32) * 64, (r % 32) * 32, lane, MapId{}, GainNone{});
        }
        for (int i = gt; i < 96 * D / 8; i += NGT) *(h16x8*)(PH(WS_WIN) + (size_t)INC * D + (size_t)i * 8) = (h16x8){0, 0, 0, 0, 0, 0, 0, 0};
    }
    for (int i = gt; i < S * 16; i += NGT) { const int t = i >> 4, pp = i & 15; const float inv = exp2f(-(float)pp * (13.287712379549449f / 16.0f)); float sn, cs; sincosf((float)t * inv, &sn, &cs);
        PF(WS_ROPE)[2 * i] = cs; PF(WS_ROPE)[2 * i + 1] = sn; }
    {
        LAS float* zf = scr; LAS float* h1 = scr + 64;
        const float* w1 = p.in[10]; const float* b1 = p.in[11]; const float* freq = p.in[12]; const float* w2 = p.in[13]; const float* b2 = p.in[14];
        for (int t = gw; t < S; t += NGW) {
            const int j = lane;
            if (j < 33) { float v;
                if (j == 0) v = (float)t / (float)S;
                else { const int bi = (j - 1) & 15; const float band = 1e-4f + (float)bi * ((15.0f - 1e-4f) / 15.0f);
                    double rev = (double)t * (double)band / (double)S; rev -= floor(rev); const float r2 = (float)(2.0 * rev);
                    v = (j <= 16) ? cospif(r2) : -sinpif(r2); }
                zf[j] = v; }
            asm volatile("s_waitcnt lgkmcnt(0)" ::: "memory");
            float a = b1[j];
            for (int i = 0; i < 33; ++i) a += zf[i] * w1[i * 64 + j];
            h1[j] = sinf(freq[j] * a);
            asm volatile("s_waitcnt lgkmcnt(0)" ::: "memory");
            float c = b2[j];
            for (int i = 0; i < 64; ++i) c += h1[i] * w2[i * 64 + j];
            PF(WS_H2)[t * 64 + j] = sinf(freq[64 + j] * c);
            asm volatile("s_waitcnt lgkmcnt(0)" ::: "memory");
        }
    }
}
__device__ __forceinline__ void phase_filt3(const Params& p, LAS char* lds) {
    const float* H2 = PF(WS_H2); const float* w3 = p.in[15]; const float* b3 = p.in[16]; const float* decay = p.in[17]; h16* R = PH(WS_R);
    LAS h16* tile = (LAS h16*)lds;
    LAS float* wl = (LAS float*)(lds + 65536);
    LAS float* cb = wl + 512;
    const int tid = threadIdx.x;
    for (int it = blockIdx.x; it < 256; it += gridDim.x) {
        const int o = it >> 7, c0 = (it & 127) * 4;
        __syncthreads();
        { const int j = tid >> 3, e = tid & 7, col = o * 1024 + (e >> 2) * 512 + c0 + (e & 3);
          wl[tid] = w3[j * 2048 + col];
          if (tid < 8) { const int cl = o * 1024 + (tid >> 2) * 512 + c0 + (tid & 3); cb[tid] = b3[cl]; cb[8 + tid] = fabsf(decay[cl]) * (1.0f / (float)S); } }
        __syncthreads();
        for (int i = 0; i < 8; ++i) {
            const int tau = tid + 512 * i;
            float acc[8];
#pragma unroll
            for (int e = 0; e < 8; ++e) acc[e] = cb[e];
#pragma unroll
            for (int j4 = 0; j4 < 16; ++j4) {
                const f32x4 hv = *(const f32x4*)(H2 + tau * 64 + j4 * 4);
#pragma unroll
                for (int jj = 0; jj < 4; ++jj) {
                    const f32x4 wa = *(LAS f32x4*)(wl + (j4 * 4 + jj) * 8), wb = *(LAS f32x4*)(wl + (j4 * 4 + jj) * 8 + 4);
                    acc[0] += hv[jj] * wa[0]; acc[1] += hv[jj] * wa[1]; acc[2] += hv[jj] * wa[2]; acc[3] += hv[jj] * wa[3];
                    acc[4] += hv[jj] * wb[0]; acc[5] += hv[jj] * wb[1]; acc[6] += hv[jj] * wb[2]; acc[7] += hv[jj] * wb[3];
                }
            }
#pragma unroll
            for (int e = 0; e < 8; ++e) {
                const float v = acc[e] * HY_FSCALE * __expf(-(float)tau * cb[8 + e]);
                const int ch = e & 3, dir = e >> 2;
                int u; float val = v;
                if (dir == 0) u = 4096 - tau;
                else { u = tau == 0 ? 0 : 4096 + tau; if (tau == 0) val = 0.f; }
                tile[ch * 8192 + u] = (h16)val;
            }
        }
        __syncthreads();
        for (int i = tid; i < 4 * 1024; i += NTHR) { const int ch = i >> 10, k = i & 1023;
            *(h16x8*)(R + ((size_t)(o * 512 + c0 + ch)) * 8192 + k * 8) = *(LAS h16x8*)(tile + ch * 8192 + k * 8); }
    }
    __syncthreads();
}
__device__ __forceinline__ void phase_krot(const Params& p) {
    const int gt = blockIdx.x * NTHR + threadIdx.x, NGT = gridDim.x * NTHR;
    const h16* lat = PH(WS_LAT); h16* K = PH(WS_K); const float* rope = PF(WS_ROPE);
    for (int i = gt; i < T * 4; i += NGT) {
        const int m = i >> 2, p0 = (i & 3) * 4, b = m >> 12, t = m & 4095;
        const h16x4 k1 = *(const h16x4*)(lat + (size_t)m * LAT + 384 + p0), k2 = *(const h16x4*)(lat + (size_t)m * LAT + 400 + p0);
        h16x4 o1, o2;
#pragma unroll
        for (int j = 0; j < 4; ++j) { const float cs = rope[((size_t)t * 16 + p0 + j) * 2], sn = rope[((size_t)t * 16 + p0 + j) * 2 + 1];
            const float a = (float)k1[j], c = (float)k2[j]; o1[j] = (h16)(a * cs - c * sn); o2[j] = (h16)(a * sn + c * cs); }
#pragma unroll
        for (int h = 0; h < NH; ++h) { h16* kp = K + ((size_t)((b * NH + h) * S + t)) * 96 + 64 + p0; *(h16x4*)kp = o1; *(h16x4*)(kp + 16) = o2; }
    }
}


constexpr int AT_KROW = 208, AT_VROW = 136, AT_KB = 64 * AT_KROW, AT_VB = 64 * AT_VROW, AT_BUF = AT_KB + AT_VB;
__device__ __forceinline__ void phase_attn(const Params& p, LAS char* lds) {
    const int tid = threadIdx.x, lane = tid & 63, wid = __builtin_amdgcn_readfirstlane(tid >> 6), r32 = lane & 31, hi = lane >> 5;
    const h16* Qg = PH(WS_Q); const h16* Kg = PH(WS_K); const h16* Vtg = PH(WS_VT); h16* aout = PH(WS_AOUT);
    const int k0r = tid / 12, k0c = tid - 12 * k0r, c1 = tid + 512, k1r = c1 / 12, k1c = c1 - 12 * k1r;
    const int vdv = tid >> 3, vc = tid & 7;
    const int G = gridDim.x, bx = blockIdx.x, vid = (G % 8 == 0) ? (bx % 8) * (G / 8) + bx / 8 : bx;
    for (int u = vid; u < NB * NH * 16; u += G) {
        const int bh = u >> 4, q0 = (u & 15) * 256 + wid * 32;
        h16x8 qf[6];
        { const h16* qp = Qg + ((size_t)bh * S + q0 + r32) * 96 + 8 * hi;
#pragma unroll
          for (int s_ = 0; s_ < 6; ++s_) qf[s_] = *(const h16x8*)(qp + 16 * s_); }
        const h16* Kb = Kg + (size_t)bh * S * 96; const h16* Vb = Vtg + (size_t)bh * 64 * S + (size_t)vdv * S + vc * 8;
        h16x8 kr0, kr1, vr;
        kr0 = *(const h16x8*)(Kb + tid * 8); kr1 = kr0; if (tid < 256) kr1 = *(const h16x8*)(Kb + c1 * 8); vr = *(const h16x8*)(Vb);
        __syncthreads();
        { *(LAS h16x8*)(lds + k0r * AT_KROW + k0c * 16) = kr0; if (tid < 256) *(LAS h16x8*)(lds + k1r * AT_KROW + k1c * 16) = kr1;
          LAS char* vn = lds + AT_KB + vdv * AT_VROW + vc * 16; *(LAS h16x4*)vn = (h16x4){vr[0], vr[1], vr[2], vr[3]}; *(LAS h16x4*)(vn + 8) = (h16x4){vr[4], vr[5], vr[6], vr[7]}; }
        __syncthreads();
        f32x16 o0, o1;
#pragma unroll
        for (int r = 0; r < 16; ++r) { o0[r] = 0.f; o1[r] = 0.f; }
        float m = -1e30f, l = 0.f;
        for (int t = 0; t < S / 64; ++t) {
            if (t + 1 < S / 64) {
                const h16* kn = Kb + (size_t)(t + 1) * 64 * 96;
                kr0 = *(const h16x8*)(kn + tid * 8); if (tid < 256) kr1 = *(const h16x8*)(kn + c1 * 8); vr = *(const h16x8*)(Vb + (t + 1) * 64);
            }
            LAS char* kb = lds + (t & 1) * AT_BUF; LAS char* vb = kb + AT_KB;
            f32x16 p0, p1;
#pragma unroll
            for (int r = 0; r < 16; ++r) { p0[r] = 0.f; p1[r] = 0.f; }
#pragma unroll
            for (int s_ = 0; s_ < 6; ++s_) {
                const h16x8 a0 = *(LAS h16x8*)(kb + r32 * AT_KROW + s_ * 32 + hi * 16);
                const h16x8 a1 = *(LAS h16x8*)(kb + (32 + r32) * AT_KROW + s_ * 32 + hi * 16);
                p0 = __builtin_amdgcn_mfma_f32_32x32x16_f16(a0, qf[s_], p0, 0, 0, 0);
                p1 = __builtin_amdgcn_mfma_f32_32x32x16_f16(a1, qf[s_], p1, 0, 0, 0);
            }
            float mx = fmaxf(p0[0], p1[0]);
#pragma unroll
            for (int r = 1; r < 16; ++r) mx = fmaxf(mx, fmaxf(p0[r], p1[r]));
            mx = fmaxf(mx, __shfl_xor(mx, 32));
            const float mn = fmaxf(m, mx), al = __builtin_amdgcn_exp2f(m - mn); m = mn;
            float rs = 0.f;
#pragma unroll
            for (int r = 0; r < 16; ++r) { p0[r] = __builtin_amdgcn_exp2f(p0[r] - mn); p1[r] = __builtin_amdgcn_exp2f(p1[r] - mn); rs += p0[r] + p1[r]; }
            l = l * al + rs;
#pragma unroll
            for (int r = 0; r < 16; ++r) { o0[r] *= al; o1[r] *= al; }
            h16x8 pf[2][2];
#pragma unroll
            for (int j = 0; j < 8; ++j) { pf[0][0][j] = (h16)p0[j]; pf[0][1][j] = (h16)p0[8 + j]; pf[1][0][j] = (h16)p1[j]; pf[1][1][j] = (h16)p1[8 + j]; }
#pragma unroll
            for (int kh = 0; kh < 2; ++kh)
#pragma unroll
                for (int s_ = 0; s_ < 2; ++s_) {
                    LAS char* v0 = vb + r32 * AT_VROW + (kh * 32 + 16 * s_ + 4 * hi) * 2;
                    const h16x4 a = *(LAS h16x4*)v0, b = *(LAS h16x4*)(v0 + 16);
                    const h16x4 c = *(LAS h16x4*)(v0 + 32 * AT_VROW), d = *(LAS h16x4*)(v0 + 32 * AT_VROW + 16);
                    const h16x8 vf0 = {a[0], a[1], a[2], a[3], b[0], b[1], b[2], b[3]}, vf1 = {c[0], c[1], c[2], c[3], d[0], d[1], d[2], d[3]};
                    o0 = __builtin_amdgcn_mfma_f32_32x32x16_f16(vf0, pf[kh][s_], o0, 0, 0, 0);
                    o1 = __builtin_amdgcn_mfma_f32_32x32x16_f16(vf1, pf[kh][s_], o1, 0, 0, 0);
                }
            if (t + 1 < S / 64) {
                LAS char* kn = lds + ((t + 1) & 1) * AT_BUF;
                *(LAS h16x8*)(kn + k0r * AT_KROW + k0c * 16) = kr0; if (tid < 256) *(LAS h16x8*)(kn + k1r * AT_KROW + k1c * 16) = kr1;
                LAS char* vn = kn + AT_KB + vdv * AT_VROW + vc * 16; *(LAS h16x4*)vn = (h16x4){vr[0], vr[1], vr[2], vr[3]}; *(LAS h16x4*)(vn + 8) = (h16x4){vr[4], vr[5], vr[6], vr[7]};
            }
            __syncthreads();
        }
        const float il = 1.f / (l + __shfl_xor(l, 32));
        const int b = bh >> 3, h = bh & 7;
        h16* ap = aout + ((size_t)(b * S + q0 + r32)) * 512 + h * 64 + 4 * hi;
#pragma unroll
        for (int g = 0; g < 4; ++g) {
            *(h16x4*)(ap + 8 * g) = (h16x4){(h16)(o0[4 * g] * il), (h16)(o0[4 * g + 1] * il), (h16)(o0[4 * g + 2] * il), (h16)(o0[4 * g + 3] * il)};
            *(h16x4*)(ap + 32 + 8 * g) = (h16x4){(h16)(o1[4 * g] * il), (h16)(o1[4 * g + 1] * il), (h16)(o1[4 * g + 2] * il), (h16)(o1[4 * g + 3] * il)};
        }
    }
    __syncthreads();
}
constexpr int HY_CS = 16448, HY_ZOFF = 4 * HY_CS, HY_ZB = 11584, HY_LDS = HY_ZOFF + 4 * HY_ZB;
static_assert(HY_LDS <= LDS_BYTES, "hyena lds");
__device__ __forceinline__ void phase_hyena(const Params& p, LAS char* lds) {
    const int tid = threadIdx.x, lane = tid & 63, wid = __builtin_amdgcn_readfirstlane(tid >> 6), r32 = lane & 31, hi = lane >> 5;
    const h16* hyT = PH(WS_HYT); const h16* Rg = PH(WS_R); const float* convw = p.in[8]; const float* convb = p.in[9]; const float* skip = p.in[18]; h16* hT = PH(WS_HT);
    const int G = gridDim.x, bx = blockIdx.x, vid = (G % 8 == 0) ? (bx % 8) * (G / 8) + bx / 8 : bx;
    __syncthreads();
    for (int i = tid; i < 4 * 16 * 36; i += NTHR) { const int batch = i / 576, rem = i - batch * 576, blk = rem / 36, w = rem - blk * 36, bi = blk < 8 ? blk : 64 + blk;
        *(LAS unsigned*)(lds + HY_ZOFF + batch * HY_ZB + bi * 144 + w * 4) = 0u; }
    const int i0 = wid * 8, q = r32 & 3, ii = r32 >> 2, batch = r32 & 3;
    const int abase = q * HY_CS + 2 * (4096 + 8 * hi - (r32 - q));
    const int bbase = HY_ZOFF + batch * HY_ZB + ((i0 + ii + 8) * 72 + 8 * hi) * 2;
    for (int c = vid; c < HYW; c += G) {
        for (int n = 0; n < 2; ++n) {
            __syncthreads();
            { const unsigned* Rc = (const unsigned*)(Rg + ((size_t)(n * 512 + c)) * 8192);
#pragma unroll
              for (int i = 0; i < 8; ++i) { const int w = tid + NTHR * i; const unsigned cur = Rc[w], prv = w > 0 ? Rc[w - 1] : 0u, odd = (prv >> 16) | (cur << 16);
                  *(LAS unsigned*)(lds + w * 4) = cur; *(LAS unsigned*)(lds + 2 * HY_CS + (w + 1) * 4) = cur;
                  *(LAS unsigned*)(lds + HY_CS + w * 4) = odd; *(LAS unsigned*)(lds + 3 * HY_CS + (w + 1) * 4) = odd; }
              if (tid == 0) { const unsigned last = Rc[4095] >> 16; *(LAS unsigned*)(lds + HY_CS + 4096 * 4) = last; *(LAS unsigned*)(lds + 3 * HY_CS + 4097 * 4) = last; } }
            if (n == 0) {
                const int ch = 1024 + c; const float w0 = convw[ch], w1 = convw[1536 + ch], w2 = convw[3072 + ch], bb = convb[ch];
                for (int i = tid; i < 4 * 512; i += NTHR) { const int bt = i >> 9, t0 = (i & 511) * 8; const h16* raw = hyT + ((size_t)(bt * 1536 + ch)) * S + t0;
                    const h16x8 v = *(const h16x8*)raw; float x[10]; x[0] = t0 > 0 ? (float)raw[-1] : 0.f; x[9] = t0 + 8 < S ? (float)raw[8] : 0.f;
#pragma unroll
                    for (int e = 0; e < 8; ++e) x[e + 1] = (float)v[e];
                    h16x8 o;
#pragma unroll
                    for (int e = 0; e < 8; ++e) o[e] = (h16)(w0 * x[e] + w1 * x[e + 1] + w2 * x[e + 2] + bb);
                    *(LAS h16x8*)(lds + HY_ZOFF + bt * HY_ZB + (((t0 >> 6) + 8) * 72 + (t0 & 63)) * 2) = o; }
            }
            __syncthreads();
            const int gch = n == 0 ? c : 512 + c;
            h16x4 gpre[8]; h16 gpl[8], gpr[8];
            { const h16* graw = hyT + ((size_t)(batch * 1536 + gch)) * S;
#pragma unroll
              for (int rt = 0; rt < 2; ++rt)
#pragma unroll
                  for (int g = 0; g < 4; ++g) { const int t4 = 64 * (i0 + ii) + 32 * rt + 8 * g + 4 * hi;
                      gpre[rt * 4 + g] = *(const h16x4*)(graw + t4); gpl[rt * 4 + g] = t4 > 0 ? graw[t4 - 1] : (h16)0.f; gpr[rt * 4 + g] = t4 + 4 < S ? graw[t4 + 4] : (h16)0.f; } }
            f32x16 acc0, acc1;
#pragma unroll
            for (int r = 0; r < 16; ++r) { acc0[r] = 0.f; acc1[r] = 0.f; }
#define HY_LDA(dst, ptr) do { const h16x4 l_ = *(volatile LAS h16x4*)(ptr), h_ = *(volatile LAS h16x4*)((ptr) + 8); dst = (h16x8){l_[0], l_[1], l_[2], l_[3], h_[0], h_[1], h_[2], h_[3]}; } while (0)
#define HY_LOAD(Sx, d_) do { LAS char* ap_ = lds + abase - 128 * (d_); LAS char* bp_ = lds + bbase - 144 * (d_); \
        HY_LDA(Sx##m32, ap_ - 64); HY_LDA(Sx##m16, ap_ - 32); HY_LDA(Sx##p0, ap_); HY_LDA(Sx##p16, ap_ + 32); \
        Sx##b0 = *(volatile LAS h16x8*)(bp_); Sx##b1 = *(volatile LAS h16x8*)(bp_ + 32); Sx##b2 = *(volatile LAS h16x8*)(bp_ + 64); Sx##b3 = *(volatile LAS h16x8*)(bp_ + 96); } while (0)
#define HY_MMA(Sx) do { \
        acc0 = __builtin_amdgcn_mfma_f32_32x32x16_f16(Sx##p0, Sx##b0, acc0, 0, 0, 0); acc1 = __builtin_amdgcn_mfma_f32_32x32x16_f16(Sx##m32, Sx##b0, acc1, 0, 0, 0); \
        acc0 = __builtin_amdgcn_mfma_f32_32x32x16_f16(Sx##p16, Sx##b1, acc0, 0, 0, 0); acc1 = __builtin_amdgcn_mfma_f32_32x32x16_f16(Sx##m16, Sx##b1, acc1, 0, 0, 0); \
        acc0 = __builtin_amdgcn_mfma_f32_32x32x16_f16(c32, Sx##b2, acc0, 0, 0, 0); acc1 = __builtin_amdgcn_mfma_f32_32x32x16_f16(Sx##p0, Sx##b2, acc1, 0, 0, 0); \
        acc0 = __builtin_amdgcn_mfma_f32_32x32x16_f16(c48, Sx##b3, acc0, 0, 0, 0); acc1 = __builtin_amdgcn_mfma_f32_32x32x16_f16(Sx##p16, Sx##b3, acc1, 0, 0, 0); \
        c32 = Sx##m32; c48 = Sx##m16; } while (0)
            h16x8 c32, c48, Xm32, Xm16, Xp0, Xp16, Xb0, Xb1, Xb2, Xb3, Ym32, Ym16, Yp0, Yp16, Yb0, Yb1, Yb2, Yb3;
            { LAS char* ap = lds + abase - 128 * (i0 - 64); HY_LDA(c32, ap - 64); HY_LDA(c48, ap - 32); }
            HY_LOAD(X, i0 - 63);
            for (int d = i0 - 63; d < i0 + 7; d += 2) {
                HY_LOAD(Y, d + 1);
                HY_MMA(X);
                HY_LOAD(X, d + 2);
                HY_MMA(Y);
            }
            HY_MMA(X);
#undef HY_LDA
#undef HY_LOAD
#undef HY_MMA
            __syncthreads();
            {
                const float w0 = convw[gch], w1 = convw[1536 + gch], w2 = convw[3072 + gch], bb = convb[gch], sk = skip[n * 512 + c];
#pragma unroll
                for (int rt = 0; rt < 2; ++rt)
#pragma unroll
                    for (int g = 0; g < 4; ++g) {
                        const int a4 = 32 * rt + 8 * g + 4 * hi, t4 = 64 * (i0 + ii) + a4;
                        LAS char* zp = lds + HY_ZOFF + batch * HY_ZB + ((i0 + ii + 8) * 72 + a4) * 2;
                        const h16x4 zo = *(LAS h16x4*)zp;
                        const h16x4 gv = gpre[rt * 4 + g];
                        float x[6]; x[0] = (float)gpl[rt * 4 + g]; x[5] = (float)gpr[rt * 4 + g];
#pragma unroll
                        for (int e = 0; e < 4; ++e) x[e + 1] = (float)gv[e];
                        h16x4 zn;
#pragma unroll
                        for (int e = 0; e < 4; ++e) { const float gc = w0 * x[e] + w1 * x[e + 1] + w2 * x[e + 2] + bb; const float y = (rt == 0 ? acc0[4 * g + e] : acc1[4 * g + e]) * HY_FINV;
                            zn[e] = (h16)(gc * (y + sk * (float)zo[e])); }
                        if (n == 0) *(LAS h16x4*)zp = zn; else *(h16x4*)(hT + ((size_t)(batch * 512 + c)) * S + t4) = zn;
                    }
            }
        }
    }
    __syncthreads();
}
__device__ __forceinline__ void phase_mixprep(const Params& p, LAS char* lds) {
    constexpr int LDT = 520;
    LAS h16* tile = (LAS h16*)lds;
    const h16* aout = PH(WS_AOUT); const h16* hT = PH(WS_HT); h16* mix = PH(WS_MIX);
    const int tid = threadIdx.x, lane = tid & 63, wid = tid >> 6;
    for (int u = blockIdx.x; u < T / 64; u += gridDim.x) {
        const int m0 = u * 64, b = m0 >> 12, t0 = m0 & 4095;
        __syncthreads();
        for (int i = tid; i < 512 * 8; i += NTHR) { const int c = i >> 3, j = i & 7;
            const h16x8 v = *(const h16x8*)(hT + ((size_t)(b * 512 + c)) * S + t0 + j * 8);
#pragma unroll
            for (int e = 0; e < 8; ++e) tile[(j * 8 + e) * LDT + c] = v[e]; }
        __syncthreads();
        for (int rr = 0; rr < 8; ++rr) {
            const int r = wid * 8 + rr; const size_t m = (size_t)(m0 + r);
            const h16x8 hv = *(LAS h16x8*)(tile + r * LDT + lane * 8);
            const h16x8 av = *(const h16x8*)(aout + m * 512 + lane * 8);
            float sh = 0.f, sa = 0.f;
#pragma unroll
            for (int e = 0; e < 8; ++e) { const float x = (float)hv[e], y = (float)av[e]; sh += x * x; sa += y * y; }
            sh = wave_sum(sh); sa = wave_sum(sa);
            const float rh = rstd_of(sh, 512), ra = rstd_of(sa, 512);
            h16x8 oh, oa;
#pragma unroll
            for (int e = 0; e < 8; ++e) { oh[e] = (h16)((float)hv[e] * rh); oa[e] = (h16)((float)av[e] * ra); }
            *(h16x8*)(mix + m * D + lane * 8) = oa; *(h16x8*)(mix + m * D + 512 + lane * 8) = oh;
        }
    }
    __syncthreads();
}
constexpr int XA_KROW = 528, XA_VROW = 136, XA_KB = 64 * XA_KROW, XA_VB = 128 * XA_VROW, XA_BUF = XA_KB + XA_VB;
static_assert(2 * XA_BUF <= LDS_BYTES, "xattn lds");
__device__ __forceinline__ void phase_xattn(const Params& p, LAS char* lds) {
    const int tid = threadIdx.x, lane = tid & 63, wid = __builtin_amdgcn_readfirstlane(tid >> 6), r32 = lane & 31, hi = lane >> 5;
    const h16* qc = PH(WS_QC); h16* oc = PH(WS_OC); const h16* Kc = PH(WS_KC); const h16* VcT = PH(WS_VCT);
    const int G = gridDim.x, bx = blockIdx.x, vid = (G % 8 == 0) ? (bx % 8) * (G / 8) + bx / 8 : bx;
    for (int u = vid; u < NB * MH * 16; u += G) {
        const int bh = u >> 4, b = bh >> 2, h = bh & 3, q0 = (u & 15) * 256 + wid * 32;
        const h16* qrow = qc + ((size_t)(b * S + q0 + r32)) * D + h * MHD; h16* orow = oc + ((size_t)(b * S + q0 + r32)) * D + h * MHD;
        h16x8 qf[16];
#pragma unroll
        for (int s_ = 0; s_ < 16; ++s_) qf[s_] = *(const h16x8*)(qrow + 16 * s_ + 8 * hi);
        const h16* Ksrc = Kc + ((size_t)(b * MEMT + (tid >> 5))) * D + h * MHD + (tid & 31) * 8;
        const h16* Vsrc = VcT + ((size_t)(bh * MHD + (tid >> 3))) * MEMT + (tid & 7) * 8;
        const int kdst = (tid >> 5) * XA_KROW + (tid & 31) * 16, vdst = XA_KB + (tid >> 3) * XA_VROW + (tid & 7) * 16;
        h16x8 kr[4], vr[2];
#pragma unroll
        for (int j = 0; j < 4; ++j) kr[j] = *(const h16x8*)(Ksrc + (size_t)(16 * j) * D);
#pragma unroll
        for (int j = 0; j < 2; ++j) vr[j] = *(const h16x8*)(Vsrc + (size_t)(64 * j) * MEMT);
        __syncthreads();
#pragma unroll
        for (int j = 0; j < 4; ++j) *(LAS h16x8*)(lds + kdst + 16 * j * XA_KROW) = kr[j];
#pragma unroll
        for (int j = 0; j < 2; ++j) { LAS char* vn = lds + vdst + 64 * j * XA_VROW; *(LAS h16x4*)vn = (h16x4){vr[j][0], vr[j][1], vr[j][2], vr[j][3]}; *(LAS h16x4*)(vn + 8) = (h16x4){vr[j][4], vr[j][5], vr[j][6], vr[j][7]}; }
        __syncthreads();
        f32x16 o[4]; float m = -1e30f, l = 0.f;
#pragma unroll
        for (int dt = 0; dt < 4; ++dt)
#pragma unroll
            for (int r = 0; r < 16; ++r) o[dt][r] = 0.f;
        for (int st = 0; st < 8; ++st) {
            const int t = st & 3, pass = st >> 2;
            if (st + 1 < 8) { const int t1 = (st + 1) & 3, p1 = (st + 1) >> 2;
#pragma unroll
                for (int j = 0; j < 4; ++j) kr[j] = *(const h16x8*)(Ksrc + (size_t)(64 * t1 + 16 * j) * D);
#pragma unroll
                for (int j = 0; j < 2; ++j) vr[j] = *(const h16x8*)(Vsrc + (size_t)(128 * p1 + 64 * j) * MEMT + 64 * t1); }
            LAS char* kb = lds + (st & 1) * XA_BUF; LAS char* vb = kb + XA_KB;
            f32x16 p0, p1_;
#pragma unroll
            for (int r = 0; r < 16; ++r) { p0[r] = 0.f; p1_[r] = 0.f; }
#pragma unroll
            for (int s_ = 0; s_ < 16; ++s_) {
                const h16x8 a0 = *(LAS h16x8*)(kb + r32 * XA_KROW + s_ * 32 + hi * 16);
                const h16x8 a1 = *(LAS h16x8*)(kb + (32 + r32) * XA_KROW + s_ * 32 + hi * 16);
                p0 = __builtin_amdgcn_mfma_f32_32x32x16_f16(a0, qf[s_], p0, 0, 0, 0);
                p1_ = __builtin_amdgcn_mfma_f32_32x32x16_f16(a1, qf[s_], p1_, 0, 0, 0);
            }
            float mx = fmaxf(p0[0], p1_[0]);
#pragma unroll
            for (int r = 1; r < 16; ++r) mx = fmaxf(mx, fmaxf(p0[r], p1_[r]));
            mx = fmaxf(mx, __shfl_xor(mx, 32));
            const float mn = fmaxf(m, mx), al = __builtin_amdgcn_exp2f(m - mn); m = mn;
            float rs = 0.f;
#pragma unroll
            for (int r = 0; r < 16; ++r) { p0[r] = __builtin_amdgcn_exp2f(p0[r] - mn); p1_[r] = __builtin_amdgcn_exp2f(p1_[r] - mn); rs += p0[r] + p1_[r]; }
            l = l * al + rs;
#pragma unroll
            for (int dt = 0; dt < 4; ++dt)
#pragma unroll
                for (int r = 0; r < 16; ++r) o[dt][r] *= al;
            h16x8 pf[2][2];
#pragma unroll
            for (int j = 0; j < 8; ++j) { pf[0][0][j] = (h16)p0[j]; pf[0][1][j] = (h16)p0[8 + j]; pf[1][0][j] = (h16)p1_[j]; pf[1][1][j] = (h16)p1_[8 + j]; }
#pragma unroll
            for (int kh = 0; kh < 2; ++kh)
#pragma unroll
                for (int s_ = 0; s_ < 2; ++s_)
#pragma unroll
                    for (int dt = 0; dt < 4; ++dt) {
                        LAS char* v0 = vb + (dt * 32 + r32) * XA_VROW + (kh * 32 + 16 * s_ + 4 * hi) * 2;
                        const h16x4 a = *(LAS h16x4*)v0, c = *(LAS h16x4*)(v0 + 16);
                        const h16x8 vf = {a[0], a[1], a[2], a[3], c[0], c[1], c[2], c[3]};
                        o[dt] = __builtin_amdgcn_mfma_f32_32x32x16_f16(vf, pf[kh][s_], o[dt], 0, 0, 0);
                    }
            if (st + 1 < 8) {
                LAS char* nb = lds + ((st + 1) & 1) * XA_BUF;
#pragma unroll
                for (int j = 0; j < 4; ++j) *(LAS h16x8*)(nb + kdst + 16 * j * XA_KROW) = kr[j];
#pragma unroll
                for (int j = 0; j < 2; ++j) { LAS char* vn = nb + vdst + 64 * j * XA_VROW; *(LAS h16x4*)vn = (h16x4){vr[j][0], vr[j][1], vr[j][2], vr[j][3]}; *(LAS h16x4*)(vn + 8) = (h16x4){vr[j][4], vr[j][5], vr[j][6], vr[j][7]}; }
            }
            if (t == 3) {
                const float il = 1.f / (l + __shfl_xor(l, 32));
                h16* op = orow + pass * 128 + 4 * hi;
#pragma unroll
                for (int dt = 0; dt < 4; ++dt)
#pragma unroll
                    for (int g = 0; g < 4; ++g) {
                        *(h16x4*)(op + dt * 32 + 8 * g) = (h16x4){(h16)(o[dt][4 * g] * il), (h16)(o[dt][4 * g + 1] * il), (h16)(o[dt][4 * g + 2] * il), (h16)(o[dt][4 * g + 3] * il)};
                        o[dt][4 * g] = 0.f; o[dt][4 * g + 1] = 0.f; o[dt][4 * g + 2] = 0.f; o[dt][4 * g + 3] = 0.f; }
                m = -1e30f; l = 0.f;
            }
            __syncthreads();
        }
    }
    __syncthreads();
}
__device__ __forceinline__ void phase_route(const Params& p) {
    const float* X = p.X; const float* g = p.in[27]; const float* wrg = p.in[28]; const float* brg = p.in[29]; const float* wre = p.in[30]; const float* bre = p.in[31];
    float* ssx2 = PF(WS_SSX2); float* tokw = PF(WS_TOKW); int* cnt = PI(WS_CTL); int* list = PI(WS_LIST);
    const int lane = threadIdx.x & 63, gw = blockIdx.x * NWAVE + (threadIdx.x >> 6), NGW = gridDim.x * NWAVE;
    for (int m = gw; m < T; m += NGW) {
        float ss = 0.f;
#pragma unroll 4
        for (int i = 0; i < 16; ++i) { const float xv = X[(size_t)m * D + lane + 64 * i]; ss += xv * xv; }
        ss = wave_sum(ss);
        const float rs = rstd_of(ss, D);
        float lg[36];
#pragma unroll
        for (int j = 0; j < 36; ++j) lg[j] = 0.f;
#pragma unroll 1
        for (int i = 0; i < 16; ++i) { const int k = lane + 64 * i; const float tv = X[(size_t)m * D + k] * rs * g[k];
            const f32x4 wg4 = *(const f32x4*)(wrg + k * 4);
#pragma unroll
            for (int j = 0; j < 4; ++j) lg[j] += tv * wg4[j];
#pragma unroll
            for (int j4 = 0; j4 < 8; ++j4) { const f32x4 we4 = *(const f32x4*)(wre + k * 32 + j4 * 4);
#pragma unroll
                for (int j = 0; j < 4; ++j) lg[4 + j4 * 4 + j] += tv * we4[j]; } }
#pragma unroll
        for (int j = 0; j < 36; ++j) lg[j] = wave_sum(lg[j]);
        if (lane == 0) {
            ssx2[m] = ss;
            float gl[4]; int gi = 0; float gm = -1e30f;
#pragma unroll
            for (int j = 0; j < 4; ++j) { gl[j] = lg[j] + brg[j]; if (gl[j] > gm) { gm = gl[j]; gi = j; } }
            float gs = 0.f;
#pragma unroll
            for (int j = 0; j < 4; ++j) gs += expf(gl[j] - gm);
            const float pg = 1.f / gs;
            float e1 = -1e30f, e2 = -1e30f; int i1 = 0, i2 = 0;
#pragma unroll
            for (int g4 = 0; g4 < 4; ++g4) if (g4 == gi) {
#pragma unroll
                for (int j = 0; j < 8; ++j) { const float v = lg[4 + g4 * 8 + j] + bre[g4 * 8 + j];
                    if (v > e1) { e2 = e1; i2 = i1; e1 = v; i1 = j; } else if (v > e2) { e2 = v; i2 = j; } } }
            const float p2 = 1.f / (1.f + expf(e1 - e2)), p1 = 1.f - p2;
            const int ea = gi * 8 + i1, eb = gi * 8 + i2;
            tokw[m * 2] = pg * p1; tokw[m * 2 + 1] = pg * p2;
            const int pa = atomicAdd(&cnt[ea], 1), pb = atomicAdd(&cnt[eb], 1);
            list[ea * T + pa] = m * 2; list[eb * T + pb] = m * 2 + 1;
        }
    }
}
struct RowGather { const h16* A; const int* lst; int Me; __device__ __forceinline__ const h16* operator()(int m) const { const int pr = m < Me ? lst[m] : lst[0]; return A + (size_t)(pr >> 1) * D; } };
struct RowClamp { const h16* A; int Me; __device__ __forceinline__ const h16* operator()(int m) const { return A + (size_t)(m < Me ? m : 0) * DE; } };
struct EGu { const int* lst; int Me; const float* ssx2; const float* tokw; h16* hb;
    __device__ __forceinline__ void row32(int m, int nb, f32x4 va, f32x4 vb) const {
        if (m >= Me) return;
        const int pr = lst[m]; const float rs = rstd_of(ssx2[pr >> 1], D), w = tokw[pr];
        h16x4 o;
#pragma unroll
        for (int j = 0; j < 4; ++j) { const float a = va[j] * rs, bb = vb[j] * rs; o[j] = (h16)(a / (1.f + __expf(-a)) * bb * w); }
        *(h16x4*)(hb + (size_t)m * DE + (nb >> 5) * 16 + (nb & 31)) = o;
    } };
struct EDn { const int* lst; int Me; h16* yb;
    __device__ __forceinline__ void row32(int m, int nb, f32x4 va, f32x4 vb) const {
        if (m >= Me) return;
        h16* y = yb + (size_t)lst[m] * D + nb;
        *(h16x4*)y = cvt4(va); *(h16x4*)(y + 16) = cvt4(vb);
    } };
template <bool DOWN>
__device__ __forceinline__ void phase_moe(const Params& p, LAS char* lds) {
    const int* cnt = PI(WS_CTL);
    const int G = gridDim.x, bx = blockIdx.x, vid = (G % 8 == 0) ? (bx % 8) * (G / 8) + bx / 8 : bx;
    constexpr int NTN = DOWN ? D / G_BN : 512 / G_BN;
    int tbase = 0, off = 0;
    int tix = vid;
    for (int e = 0; e < NE; ++e) {
        const int Me = cnt[e], nmt = (Me + G_BM - 1) / G_BM, nte = nmt * NTN;
        const int* lst = PI(WS_LIST) + (size_t)e * T;
        for (; tix < tbase + nte; tix += G) {
            const int lt = tix - tbase, mt = lt / NTN, nt_ = lt - mt * NTN;
            if (!DOWN) gemm_tile<true>(lds, RowGather{PH(WS_X2H), lst, Me}, PH(WS_WGU) + (size_t)e * 512 * D, D, D, mt * G_BM, nt_ * G_BN,
                                       EGu{lst, Me, PF(WS_SSX2), PF(WS_TOKW), PH(WS_HB) + (size_t)off * DE});
            else gemm_tile<true>(lds, RowClamp{PH(WS_HB) + (size_t)off * DE, Me}, PH(WS_WDN) + (size_t)e * D * DE, DE, DE, mt * G_BM, nt_ * G_BN,
                                 EDn{lst, Me, PH(WS_YB)});
        }
        tbase += nte; off += Me;
    }
}
__device__ __forceinline__ void phase_final(const Params& p) {
    const float* X = p.X; const h16* yb = PH(WS_YB); const float* g = p.in[35]; float* out = p.X;
    const int lane = threadIdx.x & 63, gw = blockIdx.x * NWAVE + (threadIdx.x >> 6), NGW = gridDim.x * NWAVE;
    for (int m = gw; m < T; m += NGW) {
        f32x4 v[4]; float ss = 0.f;
#pragma unroll
        for (int i = 0; i < 4; ++i) { const int k = (lane + 64 * i) * 4;
            const f32x4 xv = *(const f32x4*)(X + (size_t)m * D + k); const h16x4 y0 = *(const h16x4*)(yb + ((size_t)m * 2) * D + k), y1 = *(const h16x4*)(yb + ((size_t)m * 2 + 1) * D + k);
#pragma unroll
            for (int j = 0; j < 4; ++j) { v[i][j] = xv[j] + (float)y0[j] + (float)y1[j]; ss += v[i][j] * v[i][j]; } }
        ss = wave_sum(ss); const float rs = rstd_of(ss, D);
#pragma unroll
        for (int i = 0; i < 4; ++i) { const int k = (lane + 64 * i) * 4; const f32x4 gv = *(const f32x4*)(g + k); *(f32x4*)(out + (size_t)m * D + k) = v[i] * rs * gv; }
    }
}

#define XB_TMO      128
#define XB_XCNT(j)  (256  + 64 * (j))
#define XB_XSUB(j)  (1280 + 64 * (j))
#define XB_XGEN(j)  (2304 + 64 * (j))
#define XB_TOP      3328
#define XB_TOPGEN   3392
#define XCD_BAR_WORDS 3456
#define XB_SPIN_CAP (1u << 18)
__device__ __forceinline__ unsigned xb_ld(unsigned* p)              { return __hip_atomic_load(p, __ATOMIC_RELAXED, __HIP_MEMORY_SCOPE_AGENT); }
__device__ __forceinline__ unsigned xb_add(unsigned* p, unsigned v) { return __hip_atomic_fetch_add(p, v, __ATOMIC_RELAXED, __HIP_MEMORY_SCOPE_AGENT); }
__device__ __forceinline__ unsigned xb_xcc_id() { return (unsigned)__builtin_amdgcn_s_getreg((3 << 11) | 20) & 0xFu; }
#define XB_SPIN(cond, bar) do { unsigned _sp = 0; while (cond) { __builtin_amdgcn_s_sleep(1); \
    if ((++_sp & 255u) == 0u) { if (xb_ld(&(bar)[XB_TMO])) break; if (_sp > XB_SPIN_CAP) { atomicAdd(&(bar)[XB_TMO], 1u); break; } } } } while (0)
struct XcdBarrier { unsigned* bar; unsigned x; volatile LAS unsigned* st; };
__device__ __forceinline__ XcdBarrier xcd_barrier_post(unsigned* bar, volatile LAS unsigned* st) {
    XcdBarrier b; b.bar = bar; b.x = xb_xcc_id(); b.st = st;
    if (threadIdx.x == 0) (void)xb_add(&bar[XB_XCNT(b.x)], 1u);
    return b;
}
__device__ __forceinline__ void xcd_barrier_complete(unsigned* bar, unsigned x, unsigned& nloc, unsigned& nx) {
    const unsigned G = gridDim.x * gridDim.y * gridDim.z;
    unsigned sum, cnt, mine, sp = 0u;
    for (;;) {
        sum = 0u; cnt = 0u; mine = 0u;
#pragma unroll
        for (unsigned j = 0; j < 16; ++j) { const unsigned c = xb_ld(&bar[XB_XCNT(j)]); sum += c; cnt += (c > 0u) ? 1u : 0u; mine = (j == x) ? c : mine; }
        if (sum == G) break;
        __builtin_amdgcn_s_sleep(1);
        if ((++sp & 255u) == 0u) { if (xb_ld(&bar[XB_TMO])) break; if (sp > XB_SPIN_CAP) { atomicAdd(&bar[XB_TMO], 1u); break; } }
    }
    nloc = mine > 0u ? mine : 1u; nx = cnt > 0u ? cnt : 1u;
}
__device__ __forceinline__ void xcd_barrier(const XcdBarrier& b) {
    asm volatile("s_waitcnt vmcnt(0)" ::: "memory");
    __syncthreads();
    if (threadIdx.x == 0) {
        unsigned* bar = b.bar;
        __builtin_amdgcn_s_waitcnt(0);
        unsigned nloc = b.st[0], nx = b.st[1];
        if (nloc == 0u) { xcd_barrier_complete(bar, b.x, nloc, nx); b.st[0] = nloc; b.st[1] = nx; }
        const unsigned old = xb_add(&bar[XB_XSUB(b.x)], 1u);
        const unsigned gen = old / nloc;
        if (old + 1u == (gen + 1u) * nloc) {
            __builtin_amdgcn_fence(__ATOMIC_RELEASE, "agent");
            asm volatile("s_waitcnt vmcnt(0)" ::: "memory");
            const unsigned og = xb_add(&bar[XB_TOP], 1u);
            const unsigned tg = og / nx;
            if (og + 1u == (tg + 1u) * nx) xb_add(&bar[XB_TOPGEN], 1u);
            else XB_SPIN(xb_ld(&bar[XB_TOPGEN]) == tg, bar);
            __builtin_amdgcn_fence(__ATOMIC_ACQUIRE, "agent");
            xb_add(&bar[XB_XGEN(b.x)], 1u);
            asm volatile("s_waitcnt vmcnt(0)" ::: "memory");
        } else {
            XB_SPIN(xb_ld(&bar[XB_XGEN(b.x)]) == gen, bar);
            __builtin_amdgcn_fence(__ATOMIC_ACQUIRE, "agent");
            asm volatile("s_waitcnt vmcnt(0)" ::: "memory");
        }
    }
    __syncthreads();
}

#ifndef REP_PHASE
#define REP_PHASE -1
#endif
__global__ void __launch_bounds__(NTHR) mega(Params p, int ph_lo, int ph_hi) {
    extern __shared__ __attribute__((aligned(16))) char lds_raw[];
    LAS char* lds = (LAS char*)lds_raw;
    cg::grid_group grid = cg::this_grid();
    volatile LAS unsigned* misc = (volatile LAS unsigned*)(lds + LDS_BYTES - 64);
    if (threadIdx.x < 16) misc[threadIdx.x] = 0u;
    __syncthreads();
    const XcdBarrier bar = xcd_barrier_post((unsigned*)(p.ws + WS_BAR), misc);
#define PHASE(k) if (ph_lo <= (k) && (k) < ph_hi) for (int rep_ = 0; rep_ < ((k) == REP_PHASE ? 2 : 1); ++rep_)
#define SEAM(k) if (ph_lo <= (k) && (k) + 1 < ph_hi) { if ((k) == 0) grid.sync(); else xcd_barrier(bar); }
    PHASE(0) { phase_prep(p, lds); }
    SEAM(0);
    PHASE(1) {
        gemm_job<false>(lds, PH(WS_XH), D, PH(WS_WIN), D, T, 1536, D, EHy{PF(WS_SSX), PH(WS_HYT)});
        gemm_job<true>(lds, PH(WS_XH), D, PH(WS_WIN) + (size_t)1536 * D, D, T, 512, D, ELat{PF(WS_SSX), PH(WS_LAT), rep_ ? nullptr : PF(WS_SSQ), PF(WS_SSKV)});
    }
    PHASE(14) {
        gemm_job<true>(lds, PH(WS_MEMH), D, PH(WS_WMKV), D, MROWS, 1024, D, EKc{PF(WS_SSMEM), PH(WS_KC)});
        gemm_job<false>(lds, PH(WS_MEMH), D, PH(WS_WMKV) + (size_t)1024 * D, D, MROWS, 1024, D, EVc{PF(WS_SSMEM), PH(WS_VCT)}, 32);
    }
    SEAM(1);
    PHASE(2) {
        gemm_job<true>(lds, PH(WS_LAT), LAT, PH(WS_WUQ), 256, T, 768, 256, EQ{PF(WS_SSQ), PF(WS_ROPE), PH(WS_Q)});
        gemm_job<true>(lds, PH(WS_LAT) + 256, LAT, PH(WS_WUKV), 128, T, 512, 128, EK{PF(WS_SSKV), PH(WS_K)}, 128);
        gemm_job<false>(lds, PH(WS_LAT) + 256, LAT, PH(WS_WUKV) + (size_t)512 * 128, 128, T, 512, 128, EV{PF(WS_SSKV), PH(WS_VT)}, 128);
        phase_krot(p);
    }
    PHASE(15) { phase_filt3(p, lds); }
    SEAM(2);
    PHASE(3) { phase_attn(p, lds); }
    PHASE(13) { phase_hyena(p, lds); }
    SEAM(3);
    PHASE(4) { phase_mixprep(p, lds); }
    SEAM(4);
    PHASE(5) { gemm_job<true>(lds, PH(WS_MIX), D, PH(WS_WOUT), D, T, D, D, ERes{p.in[0], p.X, PH(WS_X1H), rep_ ? nullptr : PF(WS_SSX1)}); }
    SEAM(5);
    PHASE(6) { gemm_job<true>(lds, PH(WS_X1H), D, PH(WS_WMQ), D, T, D, D, EMq{PF(WS_SSX1), PH(WS_QC)}); }
    SEAM(6);
    PHASE(7) { phase_xattn(p, lds); }
    SEAM(7);
    PHASE(8) { gemm_job<true>(lds, PH(WS_OC), D, PH(WS_WMO), D, T, D, D, ERes{p.X, p.X, PH(WS_X2H), nullptr}); }
    SEAM(8);
    PHASE(9) { phase_route(p); }
    SEAM(9);
    PHASE(10) { phase_moe<false>(p, lds); }
    SEAM(10);
    PHASE(11) { phase_moe<true>(p, lds); }
    SEAM(11);
    PHASE(12) { phase_final(p); }
}

extern "C" void kernel_launch(void* const* d_in, const int* in_sizes, int n_in, void* d_out, int out_size, void* d_ws, size_t ws_size, hipStream_t st) {
    Params p{};
    for (int i = 0; i < 36; ++i) p.in[i] = (const float*)d_in[i];
    p.X = (float*)d_out; p.ws = (char*)d_ws;
    static int grid = 0;
    if (!grid) {
        (void)hipFuncSetAttribute((const void*)mega, hipFuncAttributeMaxDynamicSharedMemorySize, LDS_BYTES);
        int dev = 0, cus = 0, per_cu = 0;
        (void)hipGetDevice(&dev);
        (void)hipDeviceGetAttribute(&cus, hipDeviceAttributeMultiprocessorCount, dev);
        (void)hipOccupancyMaxActiveBlocksPerMultiprocessor(&per_cu, (const void*)mega, NTHR, LDS_BYTES);
        if (per_cu < 1) { fprintf(stderr, "kernel_launch: occupancy query says %d blocks/CU\n", per_cu); per_cu = 1; }
        grid = cus;
    }
    (void)hipMemsetAsync((char*)d_ws + WS_CTL, 0, 32 * 1024, st);
    int lo = 0, hi = 16;
    void* args[] = {&p, &lo, &hi};
    hipError_t e = hipLaunchCooperativeKernel((const void*)mega, dim3(grid), dim3(NTHR), args, LDS_BYTES, st);
    if (e != hipSuccess) fprintf(stderr, "cooperative launch failed: %s (grid %d)\n", hipGetErrorString(e), grid);
    (void)in_sizes; (void)n_in; (void)out_size; (void)ws_size;
}
```

```cpp
#include <hip/hip_runtime.h>
#include <cstdint>
#include <cstdio>
#include <hip/hip_cooperative_groups.h>
namespace cg = cooperative_groups;
typedef _Float16 h16;

constexpr int NB = 4, S = 4096, D = 1024, T = NB * S, MEMT = 256, MROWS = NB * MEMT;
constexpr int NH = 8, HYW = 512;
constexpr int LAT = 416, INC = 1952;
constexpr int MH = 4, MHD = 256;
constexpr int NE = 32, DE = 256;
constexpr float EPS = 1e-6f;
constexpr float LOG2E = 1.4426950408889634f;
constexpr float QSCALE = 0.10206207261596575f * LOG2E;
constexpr float CSCALE = 0.0625f * LOG2E;

constexpr size_t MiB = 1u << 20;
constexpr size_t WS_CTL = 0;
constexpr size_t WS_SSX = 64 * 1024, WS_SSQ = 128 * 1024, WS_SSKV = 192 * 1024, WS_SSA = 256 * 1024, WS_SSH = 320 * 1024,
                 WS_SSX1 = 384 * 1024, WS_SSX2 = 448 * 1024, WS_SSMEM = 512 * 1024, WS_TOKE = 576 * 1024, WS_TOKW = 704 * 1024,
                 WS_TOKP = 832 * 1024;
constexpr size_t WS_WIN = 2 * MiB, WS_WUQ = 6 * MiB, WS_WUKV = 6 * MiB + 512 * 1024, WS_WOUT = 7 * MiB, WS_WMQ = 9 * MiB,
                 WS_WMKV = 11 * MiB, WS_WMO = 15 * MiB, WS_MEMH = 17 * MiB, WS_KC = 19 * MiB, WS_VCT = 21 * MiB, WS_R = 23 * MiB,
                 WS_WGU = 39 * MiB, WS_WDN = 71 * MiB, WS_LAT = 87 * MiB, WS_HYT = 101 * MiB, WS_XH = 149 * MiB, WS_Q = 149 * MiB,
                 WS_K = 173 * MiB, WS_VT = 197 * MiB, WS_AOUT = 213 * MiB, WS_HT = 229 * MiB, WS_LIST = 245 * MiB, WS_H2 = 247 * MiB;
constexpr size_t WS_OC = 183 * MiB, WS_BAR = 16 * 1024;
constexpr size_t WS_MIX = 87 * MiB, WS_X1H = 119 * MiB, WS_QC = 151 * MiB, WS_X2H = 87 * MiB, WS_HB = 119 * MiB, WS_YB = 135 * MiB;

__device__ __forceinline__ float wave_sum(float v) {
#pragma unroll
    for (int o = 1; o < 64; o <<= 1) v += __shfl_xor(v, o);
    return v;
}
__device__ __forceinline__ float rstd_of(float ss, int n) { return 1.0f / sqrtf(ss / (float)n + EPS); }

#define LAS __attribute__((address_space(3)))
typedef _Float16 h16x8 __attribute__((ext_vector_type(8)));
typedef _Float16 h16x4 __attribute__((ext_vector_type(4)));
typedef _Float16 h16x2 __attribute__((ext_vector_type(2)));
typedef float f32x4 __attribute__((ext_vector_type(4)));
typedef float f32x16 __attribute__((ext_vector_type(16)));
constexpr int NTHR = 512, NWAVE = 8;
constexpr int LDS_BYTES = 150 * 1024;
constexpr size_t WS_ROPE = 248 * MiB;
constexpr float HY_FSCALE = 256.f, HY_FINV = 1.f / 256.f;

struct Params {
    const float* in[36]; float* X; char* ws;
};
#define PF(off) ((float*)(p.ws + (off)))
#define PH(off) ((h16*)(p.ws + (off)))
#define PI(off) ((int*)(p.ws + (off)))

constexpr int G_BM = 256, G_BN = 128, G_BK = 64, G_AB = G_BM * G_BK * 2, G_BB = G_BN * G_BK * 2, G_STAGE = G_AB + G_BB;
static_assert(3 * G_STAGE <= LDS_BYTES, "lds");
__device__ __forceinline__ void glds16(const void* g, LAS char* l) { __builtin_amdgcn_global_load_lds((const unsigned*)g, (LAS unsigned*)l, 16, 0, 0); }

template <bool SWAP, class RowPtr, class Epi>
__device__ __forceinline__ void gemm_tile(LAS char* lds, const RowPtr& rowptr, const h16* __restrict__ Wt, int ldw, int K, int m0, int n0, const Epi& epi) {
    const int tid = threadIdx.x, lane = tid & 63, wid = __builtin_amdgcn_readfirstlane(tid >> 6);
    const int wm = wid >> 1, wn = wid & 1, fr = lane & 15, fq = lane >> 4;
    const h16* asrc[4]; const h16* bsrc[2];
#pragma unroll
    for (int i = 0; i < 4; ++i) { const int r = wid * 32 + i * 8 + (lane >> 3); const int ch = (lane & 7) ^ ((r >> 1) & 7); asrc[i] = rowptr(m0 + r) + ch * 8; }
#pragma unroll
    for (int i = 0; i < 2; ++i) { const int r = wid * 16 + i * 8 + (lane >> 3); const int ch = (lane & 7) ^ ((r >> 1) & 7); bsrc[i] = Wt + (size_t)(n0 + r) * ldw + ch * 8; }
    const int sw = fr >> 1;
    const int aoff = (wm * 64 + fr) * 128 + ((fq ^ sw) * 16);
    const int boff = G_AB + (wn * 64 + fr) * 128 + ((fq ^ sw) * 16);
    f32x4 acc[4][4];
#pragma unroll
    for (int i = 0; i < 4; ++i)
#pragma unroll
        for (int j = 0; j < 4; ++j) acc[i][j] = (f32x4){0.f, 0.f, 0.f, 0.f};
    const int nt = K / G_BK;
    asm volatile("s_waitcnt vmcnt(0)" ::: "memory");
#define G_STAGE_ISSUE(buf, kt) do { LAS char* sa_ = lds + (buf) * G_STAGE + wid * 4096; \
        _Pragma("unroll") for (int i_ = 0; i_ < 4; ++i_) glds16(asrc[i_] + (kt) * G_BK, sa_ + i_ * 1024); \
        LAS char* sb_ = lds + (buf) * G_STAGE + G_AB + wid * 2048; \
        _Pragma("unroll") for (int i_ = 0; i_ < 2; ++i_) glds16(bsrc[i_] + (kt) * G_BK, sb_ + i_ * 1024); } while (0)
    G_STAGE_ISSUE(0, 0);
    if (nt > 1) G_STAGE_ISSUE(1, 1);
    int buf = 0;
    for (int t = 0; t < nt; ++t) {
        if (t + 1 < nt) asm volatile("s_waitcnt vmcnt(6)" ::: "memory"); else asm volatile("s_waitcnt vmcnt(0)" ::: "memory");
        __builtin_amdgcn_s_barrier();
        if (t + 2 < nt) { const int nb_ = buf >= 1 ? buf - 1 : 2; G_STAGE_ISSUE(nb_, t + 2); }
        LAS char* base = lds + buf * G_STAGE;
#pragma unroll
        for (int kk = 0; kk < 2; ++kk) {
            h16x8 a[4], b[4];
#pragma unroll
            for (int i = 0; i < 4; ++i) { a[i] = *(LAS h16x8*)(base + ((aoff ^ (kk * 64)) + i * 2048)); b[i] = *(LAS h16x8*)(base + ((boff ^ (kk * 64)) + i * 2048)); }
#pragma unroll
            for (int i = 0; i < 4; ++i)
#pragma unroll
                for (int j = 0; j < 4; ++j)
                    acc[i][j] = SWAP ? __builtin_amdgcn_mfma_f32_16x16x32_f16(b[j], a[i], acc[i][j], 0, 0, 0)
                                     : __builtin_amdgcn_mfma_f32_16x16x32_f16(a[i], b[j], acc[i][j], 0, 0, 0);
        }
        buf = buf == 2 ? 0 : buf + 1;
    }
#undef G_STAGE_ISSUE
    asm volatile("s_waitcnt lgkmcnt(0)" ::: "memory");
    __builtin_amdgcn_s_barrier();
    if constexpr (SWAP) {
#pragma unroll
        for (int i = 0; i < 4; ++i)
#pragma unroll
            for (int jp = 0; jp < 2; ++jp) epi.row32(m0 + wm * 64 + i * 16 + fr, n0 + wn * 64 + jp * 32 + fq * 4, acc[i][2 * jp], acc[i][2 * jp + 1]);
    } else {
#pragma unroll
        for (int i = 0; i < 4; ++i)
#pragma unroll
            for (int j = 0; j < 4; ++j) epi.col4(m0 + wm * 64 + i * 16 + fq * 4, n0 + wn * 64 + j * 16 + fr, acc[i][j]);
    }
}
struct RowDense { const h16* A; int lda; __device__ __forceinline__ const h16* operator()(int m) const { return A + (size_t)m * lda; } };

__device__ __forceinline__ h16x4 cvt4(f32x4 v) { return (h16x4){(h16)v[0], (h16)v[1], (h16)v[2], (h16)v[3]}; }
__device__ __forceinline__ float rowgrp_sum(float v) { v += __shfl_xor(v, 16); v += __shfl_xor(v, 32); return v; }

struct EHy {
    const float* ssx; h16* hyT;
    __device__ __forceinline__ void col4(int mr, int n, f32x4 v) const {
        const f32x4 ss = *(const f32x4*)(ssx + mr);
        v[0] *= rstd_of(ss[0], D); v[1] *= rstd_of(ss[1], D); v[2] *= rstd_of(ss[2], D); v[3] *= rstd_of(ss[3], D);
        const int b = mr >> 12, t = mr & 4095;
        *(h16x4*)(hyT + ((size_t)(b * 1536 + n)) * S + t) = cvt4(v);
    } };
struct ELat {
    const float* ssx; h16* lat; float* ssq; float* sskv;
    __device__ __forceinline__ void row32(int m, int nb, f32x4 va, f32x4 vb) const {
        const float r = rstd_of(ssx[m], D); va *= r; vb *= r;
        if (nb < LAT) { *(h16x4*)(lat + (size_t)m * LAT + nb) = cvt4(va); *(h16x4*)(lat + (size_t)m * LAT + nb + 16) = cvt4(vb); }
        float s = va[0] * va[0] + va[1] * va[1] + va[2] * va[2] + va[3] * va[3] + vb[0] * vb[0] + vb[1] * vb[1] + vb[2] * vb[2] + vb[3] * vb[3];
        s = rowgrp_sum(s);
        if (ssq && (threadIdx.x & 63) < 16 && nb < 384) atomicAdd((nb < 256 ? ssq : sskv) + m, s);
    } };
struct EQ {
    const float* ssq; const float* rope; h16* Q;
    __device__ __forceinline__ void row32(int m, int nb, f32x4 va, f32x4 vb) const {
        const float r = rstd_of(ssq[m], 256) * QSCALE; va *= r; vb *= r;
        const int b = m >> 12, t = m & 4095, blk = nb >> 5, h = blk / 3, part = blk - 3 * h, c = nb & 31;
        if (part == 2) {
            const float* rp = rope + ((size_t)t * 16 + c) * 2;
#pragma unroll
            for (int j = 0; j < 4; ++j) { const float cs = rp[2 * j], sn = rp[2 * j + 1]; const float q1 = va[j], q2 = vb[j]; va[j] = q1 * cs - q2 * sn; vb[j] = q1 * sn + q2 * cs; }
        }
        h16* q = Q + ((size_t)((b * NH + h) * S + t)) * 96 + part * 32 + c;
        *(h16x4*)q = cvt4(va); *(h16x4*)(q + 16) = cvt4(vb);
    } };
struct EK {
    const float* sskv; h16* K;
    __device__ __forceinline__ void row32(int m, int nb, f32x4 va, f32x4 vb) const {
        const float r = rstd_of(sskv[m], 128); va *= r; vb *= r;
        const int b = m >> 12, t = m & 4095, h = nb >> 6, j = nb & 63;
        h16* k = K + ((size_t)((b * NH + h) * S + t)) * 96 + j;
        *(h16x4*)k = cvt4(va); *(h16x4*)(k + 16) = cvt4(vb);
    } };
struct EV {
    const float* sskv; h16* Vt;
    __device__ __forceinline__ void col4(int mr, int n, f32x4 v) const {
        const f32x4 ss = *(const f32x4*)(sskv + mr);
        v[0] *= rstd_of(ss[0], 128); v[1] *= rstd_of(ss[1], 128); v[2] *= rstd_of(ss[2], 128); v[3] *= rstd_of(ss[3], 128);
        const int b = mr >> 12, t = mr & 4095;
        *(h16x4*)(Vt + ((size_t)(b * 512 + n)) * S + t) = cvt4(v);
    } };
struct EKc {
    const float* ss; h16* Kc;
    __device__ __forceinline__ void row32(int m, int nb, f32x4 va, f32x4 vb) const {
        const float r = rstd_of(ss[m], D); va *= r; vb *= r;
        *(h16x4*)(Kc + (size_t)m * D + nb) = cvt4(va); *(h16x4*)(Kc + (size_t)m * D + nb + 16) = cvt4(vb);
    } };
struct EVc {
    const float* ss; h16* VcT;
    __device__ __forceinline__ void col4(int mr, int n, f32x4 v) const {
        const f32x4 s4 = *(const f32x4*)(ss + mr);
        v[0] *= rstd_of(s4[0], D); v[1] *= rstd_of(s4[1], D); v[2] *= rstd_of(s4[2], D); v[3] *= rstd_of(s4[3], D);
        const int b = mr >> 8, mm = mr & 255;
        *(h16x4*)(VcT + ((size_t)(b * 1024 + n)) * MEMT + mm) = cvt4(v);
    } };
struct ERes {
    const float* xin; float* X; h16* xh; float* ss;
    __device__ __forceinline__ void row32(int m, int nb, f32x4 va, f32x4 vb) const {
        const size_t i = (size_t)m * D + nb;
        va += *(const f32x4*)(xin + i); vb += *(const f32x4*)(xin + i + 16);
        *(f32x4*)(X + i) = va; *(f32x4*)(X + i + 16) = vb;
        *(h16x4*)(xh + i) = cvt4(va); *(h16x4*)(xh + i + 16) = cvt4(vb);
        float s = va[0] * va[0] + va[1] * va[1] + va[2] * va[2] + va[3] * va[3] + vb[0] * vb[0] + vb[1] * vb[1] + vb[2] * vb[2] + vb[3] * vb[3];
        s = rowgrp_sum(s);
        if (ss && (threadIdx.x & 63) < 16) atomicAdd(ss + m, s);
    } };
struct EMq {
    const float* ss; h16* qc;
    __device__ __forceinline__ void row32(int m, int nb, f32x4 va, f32x4 vb) const {
        const float r = rstd_of(ss[m], D) * CSCALE; va *= r; vb *= r;
        *(h16x4*)(qc + (size_t)m * D + nb) = cvt4(va); *(h16x4*)(qc + (size_t)m * D + nb + 16) = cvt4(vb);
    } };

template <bool SWAP, class Epi>
__device__ __forceinline__ void gemm_job(LAS char* lds, const h16* A, int lda, const h16* Wt, int ldw, int M, int N, int K, const Epi& epi, int first = 0) {
    const int ntn = N / G_BN, ntiles = (M / G_BM) * ntn;
    const RowDense rp{A, lda};
    const int G = gridDim.x, bx = blockIdx.x, vid = (G % 8 == 0) ? (bx % 8) * (G / 8) + bx / 8 : bx;
    for (int tix = (vid + G - first % G) % G; tix < ntiles; tix += G) {
        const int mt = tix / ntn, nt_ = tix - mt * ntn;
        gemm_tile<SWAP>(lds, rp, Wt, ldw, K, mt * G_BM, nt_ * G_BN, epi);
    }
}

template <class RowMap, class Gain>
__device__ __forceinline__ void wt_item(const float* W, int N, int K, h16* Wt, LAS float* scr, int k0, int n0, int lane, const RowMap& rowmap, const Gain& gain) {
#pragma unroll
    for (int i = 0; i < 32; ++i) { const int kk = 2 * i + (lane >> 5); scr[kk * 33 + (lane & 31)] = W[(size_t)(k0 + kk) * N + n0 + (lane & 31)] * gain(k0 + kk); }
    asm volatile("s_waitcnt lgkmcnt(0)" ::: "memory");
    const int c = lane & 7;
#pragma unroll
    for (int j = 0; j < 4; ++j) { const int n = (lane >> 3) + 8 * j; const LAS float* s = scr + (8 * c) * 33 + n;
        h16x8 o = {(h16)s[0], (h16)s[33], (h16)s[66], (h16)s[99], (h16)s[132], (h16)s[165], (h16)s[198], (h16)s[231]};
        *(h16x8*)(Wt + (size_t)rowmap(n0 + n) * K + k0 + 8 * c) = o; }
    asm volatile("s_waitcnt lgkmcnt(0)" ::: "memory");
}
struct GainNone { __device__ __forceinline__ float operator()(int) const { return 1.f; } };
struct Gain1 { const float* g; __device__ __forceinline__ float operator()(int k) const { return g[k]; } };
struct Gain2 { const float* g; const float* g2; __device__ __forceinline__ float operator()(int k) const { return k < 512 ? g[k] : g2[k - 512]; } };
struct MapId { __device__ __forceinline__ int operator()(int n) const { return n; } };
struct MapIn { __device__ __forceinline__ int operator()(int n) const { return n < LAT ? 1536 + n : n - LAT; } };
struct MapKV { __device__ __forceinline__ int operator()(int n) const { const int h = n >> 7, j = n & 127; return j < 64 ? h * 64 + j : 512 + h * 64 + (j - 64); } };
struct MapG { int up; __device__ __forceinline__ int operator()(int j) const { return 32 * (j >> 4) + (j & 15) + up; } };

__device__ __forceinline__ void phase_prep(const Params& p, LAS char* lds) {
    const int tid = threadIdx.x, lane = tid & 63, wid = tid >> 6;
    const int gw = blockIdx.x * NWAVE + wid, NGW = gridDim.x * NWAVE, gt = blockIdx.x * NTHR + tid, NGT = gridDim.x * NTHR;
    LAS float* scr = (LAS float*)(lds + wid * 16384);
    for (int i = gt; i < 5 * 16384; i += NGT) PF(WS_SSQ)[i] = 0.f;
    for (int row = gw; row < T + MROWS; row += NGW) {
        const bool isx = row < T; const int r = isx ? row : row - T;
        const f32x4* src = (const f32x4*)((isx ? p.in[0] : p.in[1]) + (size_t)r * D) + lane;
        h16* dst = (isx ? PH(WS_XH) : PH(WS_MEMH)) + (size_t)r * D;
        float s = 0.f;
#pragma unroll
        for (int j = 0; j < 4; ++j) { const f32x4 v = src[64 * j]; s += v[0] * v[0] + v[1] * v[1] + v[2] * v[2] + v[3] * v[3]; *(h16x4*)(dst + (lane + 64 * j) * 4) = cvt4(v); }
        s = wave_sum(s);
        if (lane == 0) (isx ? PF(WS_SSX) : PF(WS_SSMEM))[r] = s;
    }
    {
        constexpr int I_IN = 16 * 61, I_UQ = 4 * 24, I_UKV = 2 * 32, I_SQ = 16 * 32, I_MKV = 16 * 64, I_EX = 16 * 8, I_DN = 4 * 32;
        constexpr int NIT = I_IN + I_UQ + I_UKV + 3 * I_SQ + I_MKV + NE * (2 * I_EX + I_DN);
        for (int it = gw; it < NIT; it += NGW) {
            int r = it;
            if (r < I_IN) { wt_item(p.in[3], INC, D, PH(WS_WIN), scr, (r / 61) * 64, (r % 61) * 32, lane, MapIn{}, Gain1{p.in[2]}); continue; } r -= I_IN;
            if (r < I_UQ) { wt_item(p.in[6], 768, 256, PH(WS_WUQ), scr, (r / 24) * 64, (r % 24) * 32, lane, MapId{}, Gain1{p.in[4]}); continue; } r -= I_UQ;
            if (r < I_UKV) { wt_item(p.in[7], 1024, 128, PH(WS_WUKV), scr, (r / 32) * 64, (r % 32) * 32, lane, MapKV{}, Gain1{p.in[5]}); continue; } r -= I_UKV;
            if (r < I_SQ) { wt_item(p.in[21], D, D, PH(WS_WOUT), scr, (r / 32) * 64, (r % 32) * 32, lane, MapId{}, Gain2{p.in[19], p.in[20]}); continue; } r -= I_SQ;
            if (r < I_SQ) { wt_item(p.in[24], D, D, PH(WS_WMQ), scr, (r / 32) * 64, (r % 32) * 32, lane, MapId{}, Gain1{p.in[22]}); continue; } r -= I_SQ;
            if (r < I_SQ) { wt_item(p.in[26], D, D, PH(WS_WMO), scr, (r / 32) * 64, (r % 32) * 32, lane, MapId{}, GainNone{}); continue; } r -= I_SQ;
            if (r < I_MKV) { wt_item(p.in[25], 2048, D, PH(WS_WMKV), scr, (r / 64) * 64, (r % 64) * 32, lane, MapId{}, Gain1{p.in[23]}); continue; } r -= I_MKV;
            const int e = r / (2 * I_EX + I_DN); r -= e * (2 * I_EX + I_DN);
            if (r < I_EX) { wt_item(p.in[32] + (size_t)e * D * DE, DE, D, PH(WS_WGU) + (size_t)e * 512 * D, scr, (r / 8) * 64, (r % 8) * 32, lane, MapG{0}, Gain1{p.in[27]}); continue; } r -= I_EX;
            if (r < I_EX) { wt_item(p.in[33] + (size_t)e * D * DE, DE, D, PH(WS_WGU) + (size_t)e * 512 * D, scr, (r / 8) * 64, (r % 8) * 32, lane, MapG{16}, Gain1{p.in[27]}); continue; } r -= I_EX;
            wt_item(p.in[34] + (size_t)e * DE * D, D, DE, PH(WS_WDN) + (size_t)e * D * DE, scr, (r / 32) * 64, (r % 32) * 32, lane, MapId{}, GainNone{});
        }
        for (int i = gt; i < 96 * D / 8; i += NGT) *(h16x8*)(PH(WS_WIN) + (size_t)INC * D + (size_t)i * 8) = (h16x8){0, 0, 0, 0, 0, 0, 0, 0};
    }
    for (int i = gt; i < S * 16; i += NGT) { const int t = i >> 4, pp = i & 15; const float inv = exp2f(-(float)pp * (13.287712379549449f / 16.0f)); float sn, cs; sincosf((float)t * inv, &sn, &cs);
        PF(WS_ROPE)[2 * i] = cs; PF(WS_ROPE)[2 * i + 1] = sn; }
    {
        LAS float* zf = scr; LAS float* h1 = scr + 64;
        const float* w1 = p.in[10]; const float* b1 = p.in[11]; const float* freq = p.in[12]; const float* w2 = p.in[13]; const float* b2 = p.in[14];
        for (int t = gw; t < S; t += NGW) {
            const int j = lane;
            if (j < 33) { float v;
                if (j == 0) v = (float)t / (float)S;
                else { const int bi = (j - 1) & 15; const float band = 1e-4f + (float)bi * ((15.0f - 1e-4f) / 15.0f);
                    double rev = (double)t * (double)band / (double)S; rev -= floor(rev); const float r2 = (float)(2.0 * rev);
                    v = (j <= 16) ? cospif(r2) : -sinpif(r2); }
                zf[j] = v; }
            asm volatile("s_waitcnt lgkmcnt(0)" ::: "memory");
            float a = b1[j];
            for (int i = 0; i < 33; ++i) a += zf[i] * w1[i * 64 + j];
            h1[j] = sinf(freq[j] * a);
            asm volatile("s_waitcnt lgkmcnt(0)" ::: "memory");
            float c = b2[j];
            for (int i = 0; i < 64; ++i) c += h1[i] * w2[i * 64 + j];
            PF(WS_H2)[t * 64 + j] = sinf(freq[64 + j] * c);
            asm volatile("s_waitcnt lgkmcnt(0)" ::: "memory");
        }
    }
}
__device__ __forceinline__ void phase_filt3(const Params& p, LAS char* lds) {
    const float* H2 = PF(WS_H2); const float* w3 = p.in[15]; const float* b3 = p.in[16]; const float* decay = p.in[17]; h16* R = PH(WS_R);
    LAS h16* tile = (LAS h16*)lds;
    LAS float* wl = (LAS float*)(lds + 65536);
    LAS float* cb = wl + 512;
    const int tid = threadIdx.x;
    for (int it = blockIdx.x; it < 256; it += gridDim.x) {
        const int o = it >> 7, c0 = (it & 127) * 4;
        __syncthreads();
        { const int j = tid >> 3, e = tid & 7, col = o * 1024 + (e >> 2) * 512 + c0 + (e & 3);
          wl[tid] = w3[j * 2048 + col];
          if (tid < 8) { const int cl = o * 1024 + (tid >> 2) * 512 + c0 + (tid & 3); cb[tid] = b3[cl]; cb[8 + tid] = fabsf(decay[cl]) * (1.0f / (float)S); } }
        __syncthreads();
        for (int i = 0; i < 8; ++i) {
            const int tau = tid + 512 * i;
            float acc[8];
#pragma unroll
            for (int e = 0; e < 8; ++e) acc[e] = cb[e];
#pragma unroll
            for (int j4 = 0; j4 < 16; ++j4) {
                const f32x4 hv = *(const f32x4*)(H2 + tau * 64 + j4 * 4);
#pragma unroll
                for (int jj = 0; jj < 4; ++jj) {
                    const f32x4 wa = *(LAS f32x4*)(wl + (j4 * 4 + jj) * 8), wb = *(LAS f32x4*)(wl + (j4 * 4 + jj) * 8 + 4);
                    acc[0] += hv[jj] * wa[0]; acc[1] += hv[jj] * wa[1]; acc[2] += hv[jj] * wa[2]; acc[3] += hv[jj] * wa[3];
                    acc[4] += hv[jj] * wb[0]; acc[5] += hv[jj] * wb[1]; acc[6] += hv[jj] * wb[2]; acc[7] += hv[jj] * wb[3];
                }
            }
#pragma unroll
            for (int e = 0; e < 8; ++e) {
                const float v = acc[e] * HY_FSCALE * __expf(-(float)tau * cb[8 + e]);
                const int ch = e & 3, dir = e >> 2;
                int u; float val = v;
                if (dir == 0) u = 4096 - tau;
                else { u = tau == 0 ? 0 : 4096 + tau; if (tau == 0) val = 0.f; }
                tile[ch * 8192 + u] = (h16)val;
            }
        }
        __syncthreads();
        for (int i = tid; i < 4 * 1024; i += NTHR) { const int ch = i >> 10, k = i & 1023;
            *(h16x8*)(R + ((size_t)(o * 512 + c0 + ch)) * 8192 + k * 8) = *(LAS h16x8*)(tile + ch * 8192 + k * 8); }
    }
    __syncthreads();
}
__device__ __forceinline__ void phase_krot(const Params& p) {
    const int gt = blockIdx.x * NTHR + threadIdx.x, NGT = gridDim.x * NTHR;
    const h16* lat = PH(WS_LAT); h16* K = PH(WS_K); const float* rope = PF(WS_ROPE);
    for (int i = gt; i < T * 4; i += NGT) {
        const int m = i >> 2, p0 = (i & 3) * 4, b = m >> 12, t = m & 4095;
        const h16x4 k1 = *(const h16x4*)(lat + (size_t)m * LAT + 384 + p0), k2 = *(const h16x4*)(lat + (size_t)m * LAT + 400 + p0);
        h16x4 o1, o2;
#pragma unroll
        for (int j = 0; j < 4; ++j) { const float cs = rope[((size_t)t * 16 + p0 + j) * 2], sn = rope[((size_t)t * 16 + p0 + j) * 2 + 1];
            const float a = (float)k1[j], c = (float)k2[j]; o1[j] = (h16)(a * cs - c * sn); o2[j] = (h16)(a * sn + c * cs); }
#pragma unroll
        for (int h = 0; h < NH; ++h) { h16* kp = K + ((size_t)((b * NH + h) * S + t)) * 96 + 64 + p0; *(h16x4*)kp = o1; *(h16x4*)(kp + 16) = o2; }
    }
}


constexpr int AT_KROW = 208, AT_VROW = 136, AT_KB = 64 * AT_KROW, AT_VB = 64 * AT_VROW, AT_BUF = AT_KB + AT_VB;
__device__ __forceinline__ void phase_attn(const Params& p, LAS char* lds) {
    const int tid = threadIdx.x, lane = tid & 63, wid = __builtin_amdgcn_readfirstlane(tid >> 6), r32 = lane & 31, hi = lane >> 5;
    const h16* Qg = PH(WS_Q); const h16* Kg = PH(WS_K); const h16* Vtg = PH(WS_VT); h16* aout = PH(WS_AOUT);
    const int k0r = tid / 12, k0c = tid - 12 * k0r, c1 = tid + 512, k1r = c1 / 12, k1c = c1 - 12 * k1r;
    const int vdv = tid >> 3, vc = tid & 7;
    const int G = gridDim.x, bx = blockIdx.x, vid = (G % 8 == 0) ? (bx % 8) * (G / 8) + bx / 8 : bx;
    for (int u = vid; u < NB * NH * 16; u += G) {
        const int bh = u >> 4, q0 = (u & 15) * 256 + wid * 32;
        h16x8 qf[6];
        { const h16* qp = Qg + ((size_t)bh * S + q0 + r32) * 96 + 8 * hi;
#pragma unroll
          for (int s_ = 0; s_ < 6; ++s_) qf[s_] = *(const h16x8*)(qp + 16 * s_); }
        const h16* Kb = Kg + (size_t)bh * S * 96; const h16* Vb = Vtg + (size_t)bh * 64 * S + (size_t)vdv * S + vc * 8;
        h16x8 kr0, kr1, vr;
        kr0 = *(const h16x8*)(Kb + tid * 8); kr1 = kr0; if (tid < 256) kr1 = *(const h16x8*)(Kb + c1 * 8); vr = *(const h16x8*)(Vb);
        __syncthreads();
        { *(LAS h16x8*)(lds + k0r * AT_KROW + k0c * 16) = kr0; if (tid < 256) *(LAS h16x8*)(lds + k1r * AT_KROW + k1c * 16) = kr1;
          LAS char* vn = lds + AT_KB + vdv * AT_VROW + vc * 16; *(LAS h16x4*)vn = (h16x4){vr[0], vr[1], vr[2], vr[3]}; *(LAS h16x4*)(vn + 8) = (h16x4){vr[4], vr[5], vr[6], vr[7]}; }
        __syncthreads();
        f32x16 o0, o1;
#pragma unroll
        for (int r = 0; r < 16; ++r) { o0[r] = 0.f; o1[r] = 0.f; }
        float m = -1e30f, l = 0.f;
        for (int t = 0; t < S / 64; ++t) {
            if (t + 1 < S / 64) {
                const h16* kn = Kb + (size_t)(t + 1) * 64 * 96;
                kr0 = *(const h16x8*)(kn + tid * 8); if (tid < 256) kr1 = *(const h16x8*)(kn + c1 * 8); vr = *(const h16x8*)(Vb + (t + 1) * 64);
            }
            LAS char* kb = lds + (t & 1) * AT_BUF; LAS char* vb = kb + AT_KB;
            f32x16 p0, p1;
#pragma unroll
            for (int r = 0; r < 16; ++r) { p0[r] = 0.f; p1[r] = 0.f; }
#pragma unroll
            for (int s_ = 0; s_ < 6; ++s_) {
                const h16x8 a0 = *(LAS h16x8*)(kb + r32 * AT_KROW + s_ * 32 + hi * 16);
                const h16x8 a1 = *(LAS h16x8*)(kb + (32 + r32) * AT_KROW + s_ * 32 + hi * 16);
                p0 = __builtin_amdgcn_mfma_f32_32x32x16_f16(a0, qf[s_], p0, 0, 0, 0);
                p1 = __builtin_amdgcn_mfma_f32_32x32x16_f16(a1, qf[s_], p1, 0, 0, 0);
            }
            float mx = fmaxf(p0[0], p1[0]);
#pragma unroll
            for (int r = 1; r < 16; ++r) mx = fmaxf(mx, fmaxf(p0[r], p1[r]));
            mx = fmaxf(mx, __shfl_xor(mx, 32));
            const float mn = fmaxf(m, mx), al = __builtin_amdgcn_exp2f(m - mn); m = mn;
            float rs = 0.f;
#pragma unroll
            for (int r = 0; r < 16; ++r) { p0[r] = __builtin_amdgcn_exp2f(p0[r] - mn); p1[r] = __builtin_amdgcn_exp2f(p1[r] - mn); rs += p0[r] + p1[r]; }
            l = l * al + rs;
#pragma unroll
            for (int r = 0; r < 16; ++r) { o0[r] *= al; o1[r] *= al; }
            h16x8 pf[2][2];
#pragma unroll
            for (int j = 0; j < 8; ++j) { pf[0][0][j] = (h16)p0[j]; pf[0][1][j] = (h16)p0[8 + j]; pf[1][0][j] = (h16)p1[j]; pf[1][1][j] = (h16)p1[8 + j]; }
#pragma unroll
            for (int kh = 0; kh < 2; ++kh)
#pragma unroll
                for (int s_ = 0; s_ < 2; ++s_) {
                    LAS char* v0 = vb + r32 * AT_VROW + (kh * 32 + 16 * s_ + 4 * hi) * 2;
                    const h16x4 a = *(LAS h16x4*)v0, b = *(LAS h16x4*)(v0 + 16);
                    const h16x4 c = *(LAS h16x4*)(v0 + 32 * AT_VROW), d = *(LAS h16x4*)(v0 + 32 * AT_VROW + 16);
                    const h16x8 vf0 = {a[0], a[1], a[2], a[3], b[0], b[1], b[2], b[3]}, vf1 = {c[0], c[1], c[2], c[3], d[0], d[1], d[2], d[3]};
                    o0 = __builtin_amdgcn_mfma_f32_32x32x16_f16(vf0, pf[kh][s_], o0, 0, 0, 0);
                    o1 = __builtin_amdgcn_mfma_f32_32x32x16_f16(vf1, pf[kh][s_], o1, 0, 0, 0);
                }
            if (t + 1 < S / 64) {
                LAS char* kn = lds + ((t + 1) & 1) * AT_BUF;
                *(LAS h16x8*)(kn + k0r * AT_KROW + k0c * 16) = kr0; if (tid < 256) *(LAS h16x8*)(kn + k1r * AT_KROW + k1c * 16) = kr1;
                LAS char* vn = kn + AT_KB + vdv * AT_VROW + vc * 16; *(LAS h16x4*)vn = (h16x4){vr[0], vr[1], vr[2], vr[3]}; *(LAS h16x4*)(vn + 8) = (h16x4){vr[4], vr[5], vr[6], vr[7]};
            }
            __syncthreads();
        }
        const float il = 1.f / (l + __shfl_xor(l, 32));
        const int b = bh >> 3, h = bh & 7;
        h16* ap = aout + ((size_t)(b * S + q0 + r32)) * 512 + h * 64 + 4 * hi;
#pragma unroll
        for (int g = 0; g < 4; ++g) {
            *(h16x4*)(ap + 8 * g) = (h16x4){(h16)(o0[4 * g] * il), (h16)(o0[4 * g + 1] * il), (h16)(o0[4 * g + 2] * il), (h16)(o0[4 * g + 3] * il)};
            *(h16x4*)(ap + 32 + 8 * g) = (h16x4){(h16)(o1[4 * g] * il), (h16)(o1[4 * g + 1] * il), (h16)(o1[4 * g + 2] * il), (h16)(o1[4 * g + 3] * il)};
        }
    }
    __syncthreads();
}
constexpr int HY_CS = 16448, HY_ZOFF = 4 * HY_CS, HY_ZB = 11584, HY_LDS = HY_ZOFF + 4 * HY_ZB;
static_assert(HY_LDS <= LDS_BYTES, "hyena lds");
__device__ __forceinline__ void phase_hyena(const Params& p, LAS char* lds) {
    const int tid = threadIdx.x, lane = tid & 63, wid = __builtin_amdgcn_readfirstlane(tid >> 6), r32 = lane & 31, hi = lane >> 5;
    const h16* hyT = PH(WS_HYT); const h16* Rg = PH(WS_R); const float* convw = p.in[8]; const float* convb = p.in[9]; const float* skip = p.in[18]; h16* hT = PH(WS_HT);
    const int G = gridDim.x, bx = blockIdx.x, vid = (G % 8 == 0) ? (bx % 8) * (G / 8) + bx / 8 : bx;
    __syncthreads();
    for (int i = tid; i < 4 * 16 * 36; i += NTHR) { const int batch = i / 576, rem = i - batch * 576, blk = rem / 36, w = rem - blk * 36, bi = blk < 8 ? blk : 64 + blk;
        *(LAS unsigned*)(lds + HY_ZOFF + batch * HY_ZB + bi * 144 + w * 4) = 0u; }
    const int i0 = wid * 8, q = r32 & 3, ii = r32 >> 2, batch = r32 & 3;
    const int abase = q * HY_CS + 2 * (4096 + 8 * hi - (r32 - q));
    const int bbase = HY_ZOFF + batch * HY_ZB + ((i0 + ii + 8) * 72 + 8 * hi) * 2;
    for (int c = vid; c < HYW; c += G) {
        for (int n = 0; n < 2; ++n) {
            __syncthreads();
            { const unsigned* Rc = (const unsigned*)(Rg + ((size_t)(n * 512 + c)) * 8192);
#pragma unroll
              for (int i = 0; i < 8; ++i) { const int w = tid + NTHR * i; const unsigned cur = Rc[w], prv = w > 0 ? Rc[w - 1] : 0u, odd = (prv >> 16) | (cur << 16);
                  *(LAS unsigned*)(lds + w * 4) = cur; *(LAS unsigned*)(lds + 2 * HY_CS + (w + 1) * 4) = cur;
                  *(LAS unsigned*)(lds + HY_CS + w * 4) = odd; *(LAS unsigned*)(lds + 3 * HY_CS + (w + 1) * 4) = odd; }
              if (tid == 0) { const unsigned last = Rc[4095] >> 16; *(LAS unsigned*)(lds + HY_CS + 4096 * 4) = last; *(LAS unsigned*)(lds + 3 * HY_CS + 4097 * 4) = last; } }
            if (n == 0) {
                const int ch = 1024 + c; const float w0 = convw[ch], w1 = convw[1536 + ch], w2 = convw[3072 + ch], bb = convb[ch];
                for (int i = tid; i < 4 * 512; i += NTHR) { const int bt = i >> 9, t0 = (i & 511) * 8; const h16* raw = hyT + ((size_t)(bt * 1536 + ch)) * S + t0;
                    const h16x8 v = *(const h16x8*)raw; float x[10]; x[0] = t0 > 0 ? (float)raw[-1] : 0.f; x[9] = t0 + 8 < S ? (float)raw[8] : 0.f;
#pragma unroll
                    for (int e = 0; e < 8; ++e) x[e + 1] = (float)v[e];
                    h16x8 o;
#pragma unroll
                    for (int e = 0; e < 8; ++e) o[e] = (h16)(w0 * x[e] + w1 * x[e + 1] + w2 * x[e + 2] + bb);
                    *(LAS h16x8*)(lds + HY_ZOFF + bt * HY_ZB + (((t0 >> 6) + 8) * 72 + (t0 & 63)) * 2) = o; }
            }
            __syncthreads();
            const int gch = n == 0 ? c : 512 + c;
            h16x4 gpre[8]; h16 gpl[8], gpr[8];
            { const h16* graw = hyT + ((size_t)(batch * 1536 + gch)) * S;
#pragma unroll
              for (int rt = 0; rt < 2; ++rt)
#pragma unroll
                  for (int g = 0; g < 4; ++g) { const int t4 = 64 * (i0 + ii) + 32 * rt + 8 * g + 4 * hi;
                      gpre[rt * 4 + g] = *(const h16x4*)(graw + t4); gpl[rt * 4 + g] = t4 > 0 ? graw[t4 - 1] : (h16)0.f; gpr[rt * 4 + g] = t4 + 4 < S ? graw[t4 + 4] : (h16)0.f; } }
            f32x16 acc0, acc1;
#pragma unroll
            for (int r = 0; r < 16; ++r) { acc0[r] = 0.f; acc1[r] = 0.f; }
#define HY_LDA(dst, ptr) do { const h16x4 l_ = *(volatile LAS h16x4*)(ptr), h_ = *(volatile LAS h16x4*)((ptr) + 8); dst = (h16x8){l_[0], l_[1], l_[2], l_[3], h_[0], h_[1], h_[2], h_[3]}; } while (0)
#define HY_LOAD(Sx, d_) do { LAS char* ap_ = lds + abase - 128 * (d_); LAS char* bp_ = lds + bbase - 144 * (d_); \
        HY_LDA(Sx##m32, ap_ - 64); HY_LDA(Sx##m16, ap_ - 32); HY_LDA(Sx##p0, ap_); HY_LDA(Sx##p16, ap_ + 32); \
        Sx##b0 = *(volatile LAS h16x8*)(bp_); Sx##b1 = *(volatile LAS h16x8*)(bp_ + 32); Sx##b2 = *(volatile LAS h16x8*)(bp_ + 64); Sx##b3 = *(volatile LAS h16x8*)(bp_ + 96); } while (0)
#define HY_MMA(Sx) do { \
        acc0 = __builtin_amdgcn_mfma_f32_32x32x16_f16(Sx##p0, Sx##b0, acc0, 0, 0, 0); acc1 = __builtin_amdgcn_mfma_f32_32x32x16_f16(Sx##m32, Sx##b0, acc1, 0, 0, 0); \
        acc0 = __builtin_amdgcn_mfma_f32_32x32x16_f16(Sx##p16, Sx##b1, acc0, 0, 0, 0); acc1 = __builtin_amdgcn_mfma_f32_32x32x16_f16(Sx##m16, Sx##b1, acc1, 0, 0, 0); \
        acc0 = __builtin_amdgcn_mfma_f32_32x32x16_f16(c32, Sx##b2, acc0, 0, 0, 0); acc1 = __builtin_amdgcn_mfma_f32_32x32x16_f16(Sx##p0, Sx##b2, acc1, 0, 0, 0); \
        acc0 = __builtin_amdgcn_mfma_f32_32x32x16_f16(c48, Sx##b3, acc0, 0, 0, 0); acc1 = __builtin_amdgcn_mfma_f32_32x32x16_f16(Sx##p16, Sx##b3, acc1, 0, 0, 0); \
        c32 = Sx##m32; c48 = Sx##m16; } while (0)
            h16x8 c32, c48, Xm32, Xm16, Xp0, Xp16, Xb0, Xb1, Xb2, Xb3, Ym32, Ym16, Yp0, Yp16, Yb0, Yb1, Yb2, Yb3;
            { LAS char* ap = lds + abase - 128 * (i0 - 64); HY_LDA(c32, ap - 64); HY_LDA(c48, ap - 32); }
            HY_LOAD(X, i0 - 63);
            for (int d = i0 - 63; d < i0 + 7; d += 2) {
                HY_LOAD(Y, d + 1);
                HY_MMA(X);
                HY_LOAD(X, d + 2);
                HY_MMA(Y);
            }
            HY_MMA(X);
#undef HY_LDA
#undef HY_LOAD
#undef HY_MMA
            __syncthreads();
            {
                const float w0 = convw[gch], w1 = convw[1536 + gch], w2 = convw[3072 + gch], bb = convb[gch], sk = skip[n * 512 + c];
#pragma unroll
                for (int rt = 0; rt < 2; ++rt)
#pragma unroll
                    for (int g = 0; g < 4; ++g) {
                        const int a4 = 32 * rt + 8 * g + 4 * hi, t4 = 64 * (i0 + ii) + a4;
                        LAS char* zp = lds + HY_ZOFF + batch * HY_ZB + ((i0 + ii + 8) * 72 + a4) * 2;
                        const h16x4 zo = *(LAS h16x4*)zp;
                        const h16x4 gv = gpre[rt * 4 + g];
                        float x[6]; x[0] = (float)gpl[rt * 4 + g]; x[5] = (float)gpr[rt * 4 + g];
#pragma unroll
                        for (int e = 0; e < 4; ++e) x[e + 1] = (float)gv[e];
                        h16x4 zn;
#pragma unroll
                        for (int e = 0; e < 4; ++e) { const float gc = w0 * x[e] + w1 * x[e + 1] + w2 * x[e + 2] + bb; const float y = (rt == 0 ? acc0[4 * g + e] : acc1[4 * g + e]) * HY_FINV;
                            zn[e] = (h16)(gc * (y + sk * (float)zo[e])); }
                        if (n == 0) *(LAS h16x4*)zp = zn; else *(h16x4*)(hT + ((size_t)(batch * 512 + c)) * S + t4) = zn;
                    }
            }
        }
    }
    __syncthreads();
}
__device__ __forceinline__ void phase_mixprep(const Params& p, LAS char* lds) {
    constexpr int LDT = 520;
    LAS h16* tile = (LAS h16*)lds;
    const h16* aout = PH(WS_AOUT); const h16* hT = PH(WS_HT); h16* mix = PH(WS_MIX);
    const int tid = threadIdx.x, lane = tid & 63, wid = tid >> 6;
    for (int u = blockIdx.x; u < T / 64; u += gridDim.x) {
        const int m0 = u * 64, b = m0 >> 12, t0 = m0 & 4095;
        __syncthreads();
        for (int i = tid; i < 512 * 8; i += NTHR) { const int c = i >> 3, j = i & 7;
            const h16x8 v = *(const h16x8*)(hT + ((size_t)(b * 512 + c)) * S + t0 + j * 8);
#pragma unroll
            for (int e = 0; e < 8; ++e) tile[(j * 8 + e) * LDT + c] = v[e]; }
        __syncthreads();
        for (int rr = 0; rr < 8; ++rr) {
            const int r = wid * 8 + rr; const size_t m = (size_t)(m0 + r);
            const h16x8 hv = *(LAS h16x8*)(tile + r * LDT + lane * 8);
            const h16x8 av = *(const h16x8*)(aout + m * 512 + lane * 8);
            float sh = 0.f, sa = 0.f;
#pragma unroll
            for (int e = 0; e < 8; ++e) { const float x = (float)hv[e], y = (float)av[e]; sh += x * x; sa += y * y; }
            sh = wave_sum(sh); sa = wave_sum(sa);
            const float rh = rstd_of(sh, 512), ra = rstd_of(sa, 512);
            h16x8 oh, oa;
#pragma unroll
            for (int e = 0; e < 8; ++e) { oh[e] = (h16)((float)hv[e] * rh); oa[e] = (h16)((float)av[e] * ra); }
            *(h16x8*)(mix + m * D + lane * 8) = oa; *(h16x8*)(mix + m * D + 512 + lane * 8) = oh;
        }
    }
    __syncthreads();
}
constexpr int XA_KROW = 528, XA_VROW = 136, XA_KB = 64 * XA_KROW, XA_VB = 128 * XA_VROW, XA_BUF = XA_KB + XA_VB;
static_assert(2 * XA_BUF <= LDS_BYTES, "xattn lds");
__device__ __forceinline__ void phase_xattn(const Params& p, LAS char* lds) {
    const int tid = threadIdx.x, lane = tid & 63, wid = __builtin_amdgcn_readfirstlane(tid >> 6), r32 = lane & 31, hi = lane >> 5;
    const h16* qc = PH(WS_QC); h16* oc = PH(WS_OC); const h16* Kc = PH(WS_KC); const h16* VcT = PH(WS_VCT);
    const int G = gridDim.x, bx = blockIdx.x, vid = (G % 8 == 0) ? (bx % 8) * (G / 8) + bx / 8 : bx;
    for (int u = vid; u < NB * MH * 16; u += G) {
        const int bh = u >> 4, b = bh >> 2, h = bh & 3, q0 = (u & 15) * 256 + wid * 32;
        const h16* qrow = qc + ((size_t)(b * S + q0 + r32)) * D + h * MHD; h16* orow = oc + ((size_t)(b * S + q0 + r32)) * D + h * MHD;
        h16x8 qf[16];
#pragma unroll
        for (int s_ = 0; s_ < 16; ++s_) qf[s_] = *(const h16x8*)(qrow + 16 * s_ + 8 * hi);
        const h16* Ksrc = Kc + ((size_t)(b * MEMT + (tid >> 5))) * D + h * MHD + (tid & 31) * 8;
        const h16* Vsrc = VcT + ((size_t)(bh * MHD + (tid >> 3))) * MEMT + (tid & 7) * 8;
        const int kdst = (tid >> 5) * XA_KROW + (tid & 31) * 16, vdst = XA_KB + (tid >> 3) * XA_VROW + (tid & 7) * 16;
        h16x8 kr[4], vr[2];
#pragma unroll
        for (int j = 0; j < 4; ++j) kr[j] = *(const h16x8*)(Ksrc + (size_t)(16 * j) * D);
#pragma unroll
        for (int j = 0; j < 2; ++j) vr[j] = *(const h16x8*)(Vsrc + (size_t)(64 * j) * MEMT);
        __syncthreads();
#pragma unroll
        for (int j = 0; j < 4; ++j) *(LAS h16x8*)(lds + kdst + 16 * j * XA_KROW) = kr[j];
#pragma unroll
        for (int j = 0; j < 2; ++j) { LAS char* vn = lds + vdst + 64 * j * XA_VROW; *(LAS h16x4*)vn = (h16x4){vr[j][0], vr[j][1], vr[j][2], vr[j][3]}; *(LAS h16x4*)(vn + 8) = (h16x4){vr[j][4], vr[j][5], vr[j][6], vr[j][7]}; }
        __syncthreads();
        f32x16 o[4]; float m = -1e30f, l = 0.f;
#pragma unroll
        for (int dt = 0; dt < 4; ++dt)
#pragma unroll
            for (int r = 0; r < 16; ++r) o[dt][r] = 0.f;
        for (int st = 0; st < 8; ++st) {
            const int t = st & 3, pass = st >> 2;
            if (st + 1 < 8) { const int t1 = (st + 1) & 3, p1 = (st + 1) >> 2;
#pragma unroll
                for (int j = 0; j < 4; ++j) kr[j] = *(const h16x8*)(Ksrc + (size_t)(64 * t1 + 16 * j) * D);
#pragma unroll
                for (int j = 0; j < 2; ++j) vr[j] = *(const h16x8*)(Vsrc + (size_t)(128 * p1 + 64 * j) * MEMT + 64 * t1); }
            LAS char* kb = lds + (st & 1) * XA_BUF; LAS char* vb = kb + XA_KB;
            f32x16 p0, p1_;
#pragma unroll
            for (int r = 0; r < 16; ++r) { p0[r] = 0.f; p1_[r] = 0.f; }
#pragma unroll
            for (int s_ = 0; s_ < 16; ++s_) {
                const h16x8 a0 = *(LAS h16x8*)(kb + r32 * XA_KROW + s_ * 32 + hi * 16);
                const h16x8 a1 = *(LAS h16x8*)(kb + (32 + r32) * XA_KROW + s_ * 32 + hi * 16);
                p0 = __builtin_amdgcn_mfma_f32_32x32x16_f16(a0, qf[s_], p0, 0, 0, 0);
                p1_ = __builtin_amdgcn_mfma_f32_32x32x16_f16(a1, qf[s_], p1_, 0, 0, 0);
            }
            float mx = fmaxf(p0[0], p1_[0]);
#pragma unroll
            for (int r = 1; r < 16; ++r) mx = fmaxf(mx, fmaxf(p0[r], p1_[r]));
            mx = fmaxf(mx, __shfl_xor(mx, 32));
            const float mn = fmaxf(m, mx), al = __builtin_amdgcn_exp2f(m - mn); m = mn;
            float rs = 0.f;
#pragma unroll
            for (int r = 0; r < 16; ++r) { p0[r] = __builtin_amdgcn_exp2f(p0[r] - mn); p1_[r] = __builtin_amdgcn_exp2f(p1_[r] - mn); rs += p0[r] + p1_[r]; }
            l = l * al + rs;
#pragma unroll
            for (int dt = 0; dt < 4; ++dt)
#pragma unroll
                for (int r = 0; r < 16; ++r) o[dt][r] *= al;
            h16x8 pf[2][2];
#pragma unroll
            for (int j = 0; j < 8; ++j) { pf[0][0][j] = (h16)p0[j]; pf[0][1][j] = (h16)p0[8 + j]; pf[1][0][j] = (h16)p1_[j]; pf[1][1][j] = (h16)p1_[8 + j]; }
#pragma unroll
            for (int kh = 0; kh < 2; ++kh)
#pragma unroll
                for (int s_ = 0; s_ < 2; ++s_)
#pragma unroll
                    for (int dt = 0; dt < 4; ++dt) {
                        LAS char* v0 = vb + (dt * 32 + r32) * XA_VROW + (kh * 32 + 16 * s_ + 4 * hi) * 2;
                        const h16x4 a = *(LAS h16x4*)v0, c = *(LAS h16x4*)(v0 + 16);
                        const h16x8 vf = {a[0], a[1], a[2], a[3], c[0], c[1], c[2], c[3]};
                        o[dt] = __builtin_amdgcn_mfma_f32_32x32x16_f16(vf, pf[kh][s_], o[dt], 0, 0, 0);
                    }
            if (st + 1 < 8) {
                LAS char* nb = lds + ((st + 1) & 1) * XA_BUF;
#pragma unroll
                for (int j = 0; j < 4; ++j) *(LAS h16x8*)(nb + kdst + 16 * j * XA_KROW) = kr[j];
#pragma unroll
                for (int j = 0; j < 2; ++j) { LAS char* vn = nb + vdst + 64 * j * XA_VROW; *(LAS h16x4*)vn = (h16x4){vr[j][0], vr[j][1], vr[j][2], vr[j][3]}; *(LAS h16x4*)(vn + 8) = (h16x4){vr[j][4], vr[j][5], vr[j][6], vr[j][7]}; }
            }
            if (t == 3) {
                const float il = 1.f / (l + __shfl_xor(l, 32));
                h16* op = orow + pass * 128 + 4 * hi;
#pragma unroll
                for (int dt = 0; dt < 4; ++dt)
#pragma unroll
                    for (int g = 0; g < 4; ++g) {
                        *(h16x4*)(op + dt * 32 + 8 * g) = (h16x4){(h16)(o[dt][4 * g] * il), (h16)(o[dt][4 * g + 1] * il), (h16)(o[dt][4 * g + 2] * il), (h16)(o[dt][4 * g + 3] * il)};
                        o[dt][4 * g] = 0.f; o[dt][4 * g + 1] = 0.f; o[dt][4 * g + 2] = 0.f; o[dt][4 * g + 3] = 0.f; }
                m = -1e30f; l = 0.f;
            }
            __syncthreads();
        }
    }
    __syncthreads();
}
__device__ __forceinline__ void phase_route(const Params& p, LAS char* lds, bool dry) {
    const float* X = p.X; const float* g = p.in[27]; const float* wrg = p.in[28]; const float* brg = p.in[29]; const float* wre = p.in[30]; const float* bre = p.in[31];
    float* ssx2 = PF(WS_SSX2); float* tokw = PF(WS_TOKW); int* cnt = PI(WS_CTL); int* list = PI(WS_LIST);
    LAS float* W = (LAS float*)lds;
    const int tid = threadIdx.x, lane = tid & 63, wid = tid >> 6;
    __syncthreads();
    for (int i = tid; i < D * 36; i += NTHR) { const int k = i / 36, j = i - 36 * k; W[i] = g[k] * (j < 4 ? wrg[k * 4 + j] : wre[k * 32 + (j - 4)]); }
    __syncthreads();
    const int b5 = (lane >> 5) & 1, b4 = (lane >> 4) & 1;
    for (int m0 = (blockIdx.x * NWAVE + wid) * 4; m0 < T; m0 += gridDim.x * NWAVE * 4) {
        float acc[4][36]; float ss[4];
#pragma unroll
        for (int t = 0; t < 4; ++t) { ss[t] = 0.f;
#pragma unroll
            for (int j = 0; j < 36; ++j) acc[t][j] = 0.f; }
#pragma unroll 2
        for (int i = 0; i < 16; ++i) {
            const int k = lane + 64 * i;
            float xv[4];
#pragma unroll
            for (int t = 0; t < 4; ++t) { xv[t] = X[(size_t)(m0 + t) * D + k]; ss[t] += xv[t] * xv[t]; }
#pragma unroll
            for (int j4 = 0; j4 < 9; ++j4) { const f32x4 w = *(LAS f32x4*)(W + k * 36 + j4 * 4);
#pragma unroll
                for (int t = 0; t < 4; ++t) { acc[t][j4 * 4] += xv[t] * w[0]; acc[t][j4 * 4 + 1] += xv[t] * w[1]; acc[t][j4 * 4 + 2] += xv[t] * w[2]; acc[t][j4 * 4 + 3] += xv[t] * w[3]; } }
        }
#pragma unroll
        for (int t = 0; t < 4; ++t) {
            const int m = m0 + t;
            const float sst = wave_sum(ss[t]); const float rs = rstd_of(sst, D);
            float a18[18], a9[9];
#pragma unroll
            for (int j = 0; j < 18; ++j) { const float lo = acc[t][j], hi_ = acc[t][j + 18]; const float keep = b5 ? hi_ : lo, send = b5 ? lo : hi_; a18[j] = keep + __shfl_xor(send, 32); }
#pragma unroll
            for (int j = 0; j < 9; ++j) { const float lo = a18[j], hi_ = a18[j + 9]; const float keep = b4 ? hi_ : lo, send = b4 ? lo : hi_; a9[j] = keep + __shfl_xor(send, 16); }
#pragma unroll
            for (int j = 0; j < 9; ++j) { float v = a9[j]; v += __shfl_xor(v, 8); v += __shfl_xor(v, 4); v += __shfl_xor(v, 2); v += __shfl_xor(v, 1); a9[j] = v * rs; }
            float lg[36];
#pragma unroll
            for (int s_ = 0; s_ < 4; ++s_)
#pragma unroll
                for (int j = 0; j < 9; ++j) lg[9 * s_ + j] = __builtin_bit_cast(float, __builtin_amdgcn_readlane(__builtin_bit_cast(int, a9[j]), 16 * s_));
            float gl[4]; int gi = 0; float gm = -1e30f;
#pragma unroll
            for (int j = 0; j < 4; ++j) { gl[j] = lg[j] + brg[j]; if (gl[j] > gm) { gm = gl[j]; gi = j; } }
            float gs = 0.f;
#pragma unroll
            for (int j = 0; j < 4; ++j) gs += expf(gl[j] - gm);
            const float pg = 1.f / gs;
            float e1 = -1e30f, e2 = -1e30f; int i1 = 0, i2 = 0;
#pragma unroll
            for (int g4 = 0; g4 < 4; ++g4) if (g4 == gi) {
#pragma unroll
                for (int j = 0; j < 8; ++j) { const float v = lg[4 + g4 * 8 + j] + bre[g4 * 8 + j];
                    if (v > e1) { e2 = e1; i2 = i1; e1 = v; i1 = j; } else if (v > e2) { e2 = v; i2 = j; } } }
            if (lane == 0) {
                const float p2 = 1.f / (1.f + expf(e1 - e2)), p1 = 1.f - p2;
                const int ea = gi * 8 + i1, eb = gi * 8 + i2;
                ssx2[m] = sst; tokw[m * 2] = pg * p1; tokw[m * 2 + 1] = pg * p2;
                if (!dry) { const int pa = atomicAdd(&cnt[ea], 1), pb = atomicAdd(&cnt[eb], 1); list[ea * T + pa] = m * 2; list[eb * T + pb] = m * 2 + 1; }
            }
        }
    }
    __syncthreads();
}
struct RowGather { const h16* A; const int* lst; int Me; __device__ __forceinline__ const h16* operator()(int m) const { const int pr = m < Me ? lst[m] : lst[0]; return A + (size_t)(pr >> 1) * D; } };
struct RowClamp { const h16* A; int Me; __device__ __forceinline__ const h16* operator()(int m) const { return A + (size_t)(m < Me ? m : 0) * DE; } };
struct EGu { const int* lst; int Me; const float* ssx2; const float* tokw; h16* hb;
    __device__ __forceinline__ void row32(int m, int nb, f32x4 va, f32x4 vb) const {
        if (m >= Me) return;
        const int pr = lst[m]; const float rs = rstd_of(ssx2[pr >> 1], D), w = tokw[pr];
        h16x4 o;
#pragma unroll
        for (int j = 0; j < 4; ++j) { const float a = va[j] * rs, bb = vb[j] * rs; o[j] = (h16)(a / (1.f + __expf(-a)) * bb * w); }
        *(h16x4*)(hb + (size_t)m * DE + (nb >> 5) * 16 + (nb & 31)) = o;
    } };
struct EDn { const int* lst; int Me; h16* yb;
    __device__ __forceinline__ void row32(int m, int nb, f32x4 va, f32x4 vb) const {
        if (m >= Me) return;
        h16* y = yb + (size_t)lst[m] * D + nb;
        *(h16x4*)y = cvt4(va); *(h16x4*)(y + 16) = cvt4(vb);
    } };
template <bool DOWN>
__device__ __forceinline__ void phase_moe(const Params& p, LAS char* lds) {
    const int* cnt = PI(WS_CTL);
    const int G = gridDim.x, bx = blockIdx.x, vid = (G % 8 == 0) ? (bx % 8) * (G / 8) + bx / 8 : bx;
    constexpr int NTN = DOWN ? D / G_BN : 512 / G_BN;
    int tbase = 0, off = 0;
    int tix = vid;
    for (int e = 0; e < NE; ++e) {
        const int Me = cnt[e], nmt = (Me + G_BM - 1) / G_BM, nte = nmt * NTN;
        const int* lst = PI(WS_LIST) + (size_t)e * T;
        for (; tix < tbase + nte; tix += G) {
            const int lt = tix - tbase, mt = lt / NTN, nt_ = lt - mt * NTN;
            if (!DOWN) gemm_tile<true>(lds, RowGather{PH(WS_X2H), lst, Me}, PH(WS_WGU) + (size_t)e * 512 * D, D, D, mt * G_BM, nt_ * G_BN,
                                       EGu{lst, Me, PF(WS_SSX2), PF(WS_TOKW), PH(WS_HB) + (size_t)off * DE});
            else gemm_tile<true>(lds, RowClamp{PH(WS_HB) + (size_t)off * DE, Me}, PH(WS_WDN) + (size_t)e * D * DE, DE, DE, mt * G_BM, nt_ * G_BN,
                                 EDn{lst, Me, PH(WS_YB)});
        }
        tbase += nte; off += Me;
    }
}
__device__ __forceinline__ void phase_final(const Params& p) {
    const float* X = p.X; const h16* yb = PH(WS_YB); const float* g = p.in[35]; float* out = p.X;
    const int lane = threadIdx.x & 63, gw = blockIdx.x * NWAVE + (threadIdx.x >> 6), NGW = gridDim.x * NWAVE;
    for (int m = gw; m < T; m += NGW) {
        f32x4 v[4]; float ss = 0.f;
#pragma unroll
        for (int i = 0; i < 4; ++i) { const int k = (lane + 64 * i) * 4;
            const f32x4 xv = *(const f32x4*)(X + (size_t)m * D + k); const h16x4 y0 = *(const h16x4*)(yb + ((size_t)m * 2) * D + k), y1 = *(const h16x4*)(yb + ((size_t)m * 2 + 1) * D + k);
#pragma unroll
            for (int j = 0; j < 4; ++j) { v[i][j] = xv[j] + (float)y0[j] + (float)y1[j]; ss += v[i][j] * v[i][j]; } }
        ss = wave_sum(ss); const float rs = rstd_of(ss, D);
#pragma unroll
        for (int i = 0; i < 4; ++i) { const int k = (lane + 64 * i) * 4; const f32x4 gv = *(const f32x4*)(g + k); *(f32x4*)(out + (size_t)m * D + k) = v[i] * rs * gv; }
    }
}

#define XB_TMO      128
#define XB_XCNT(j)  (256  + 64 * (j))
#define XB_XSUB(j)  (1280 + 64 * (j))
#define XB_XGEN(j)  (2304 + 64 * (j))
#define XB_TOP      3328
#define XB_TOPGEN   3392
#define XCD_BAR_WORDS 3456
#define XB_SPIN_CAP (1u << 18)
__device__ __forceinline__ unsigned xb_ld(unsigned* p)              { return __hip_atomic_load(p, __ATOMIC_RELAXED, __HIP_MEMORY_SCOPE_AGENT); }
__device__ __forceinline__ unsigned xb_add(unsigned* p, unsigned v) { return __hip_atomic_fetch_add(p, v, __ATOMIC_RELAXED, __HIP_MEMORY_SCOPE_AGENT); }
__device__ __forceinline__ unsigned xb_xcc_id() { return (unsigned)__builtin_amdgcn_s_getreg((3 << 11) | 20) & 0xFu; }
#define XB_SPIN(cond, bar) do { unsigned _sp = 0; while (cond) { __builtin_amdgcn_s_sleep(1); \
    if ((++_sp & 255u) == 0u) { if (xb_ld(&(bar)[XB_TMO])) break; if (_sp > XB_SPIN_CAP) { atomicAdd(&(bar)[XB_TMO], 1u); break; } } } } while (0)
struct XcdBarrier { unsigned* bar; unsigned x; volatile LAS unsigned* st; };
__device__ __forceinline__ XcdBarrier xcd_barrier_post(unsigned* bar, volatile LAS unsigned* st) {
    XcdBarrier b; b.bar = bar; b.x = xb_xcc_id(); b.st = st;
    if (threadIdx.x == 0) (void)xb_add(&bar[XB_XCNT(b.x)], 1u);
    return b;
}
__device__ __forceinline__ void xcd_barrier_complete(unsigned* bar, unsigned x, unsigned& nloc, unsigned& nx) {
    const unsigned G = gridDim.x * gridDim.y * gridDim.z;
    unsigned sum, cnt, mine, sp = 0u;
    for (;;) {
        sum = 0u; cnt = 0u; mine = 0u;
#pragma unroll
        for (unsigned j = 0; j < 16; ++j) { const unsigned c = xb_ld(&bar[XB_XCNT(j)]); sum += c; cnt += (c > 0u) ? 1u : 0u; mine = (j == x) ? c : mine; }
        if (sum == G) break;
        __builtin_amdgcn_s_sleep(1);
        if ((++sp & 255u) == 0u) { if (xb_ld(&bar[XB_TMO])) break; if (sp > XB_SPIN_CAP) { atomicAdd(&bar[XB_TMO], 1u); break; } }
    }
    nloc = mine > 0u ? mine : 1u; nx = cnt > 0u ? cnt : 1u;
}
__device__ __forceinline__ void xcd_barrier(const XcdBarrier& b) {
    asm volatile("s_waitcnt vmcnt(0)" ::: "memory");
    __syncthreads();
    if (threadIdx.x == 0) {
        unsigned* bar = b.bar;
        __builtin_amdgcn_s_waitcnt(0);
        unsigned nloc = b.st[0], nx = b.st[1];
        if (nloc == 0u) { xcd_barrier_complete(bar, b.x, nloc, nx); b.st[0] = nloc; b.st[1] = nx; }
        const unsigned old = xb_add(&bar[XB_XSUB(b.x)], 1u);
        const unsigned gen = old / nloc;
        if (old + 1u == (gen + 1u) * nloc) {
            __builtin_amdgcn_fence(__ATOMIC_RELEASE, "agent");
            asm volatile("s_waitcnt vmcnt(0)" ::: "memory");
            const unsigned og = xb_add(&bar[XB_TOP], 1u);
            const unsigned tg = og / nx;
            if (og + 1u == (tg + 1u) * nx) xb_add(&bar[XB_TOPGEN], 1u);
            else XB_SPIN(xb_ld(&bar[XB_TOPGEN]) == tg, bar);
            __builtin_amdgcn_fence(__ATOMIC_ACQUIRE, "agent");
            xb_add(&bar[XB_XGEN(b.x)], 1u);
            asm volatile("s_waitcnt vmcnt(0)" ::: "memory");
        } else {
            XB_SPIN(xb_ld(&bar[XB_XGEN(b.x)]) == gen, bar);
            __builtin_amdgcn_fence(__ATOMIC_ACQUIRE, "agent");
            asm volatile("s_waitcnt vmcnt(0)" ::: "memory");
        }
    }
    __syncthreads();
}

#ifndef REP_PHASE
#define REP_PHASE -1
#endif
__global__ void __launch_bounds__(NTHR) mega(Params p, int ph_lo, int ph_hi) {
    extern __shared__ __attribute__((aligned(16))) char lds_raw[];
    LAS char* lds = (LAS char*)lds_raw;
    cg::grid_group grid = cg::this_grid();
    volatile LAS unsigned* misc = (volatile LAS unsigned*)(lds + LDS_BYTES - 64);
    if (threadIdx.x < 16) misc[threadIdx.x] = 0u;
    __syncthreads();
    const XcdBarrier bar = xcd_barrier_post((unsigned*)(p.ws + WS_BAR), misc);
#define PHASE(k) if (ph_lo <= (k) && (k) < ph_hi) for (int rep_ = 0; rep_ < ((k) == REP_PHASE ? 2 : 1); ++rep_)
#define SEAM(k) if (ph_lo <= (k) && (k) + 1 < ph_hi) { if ((k) == 0) grid.sync(); else xcd_barrier(bar); }
    PHASE(0) { phase_prep(p, lds); }
    SEAM(0);
    PHASE(1) {
        gemm_job<false>(lds, PH(WS_XH), D, PH(WS_WIN), D, T, 1536, D, EHy{PF(WS_SSX), PH(WS_HYT)});
        gemm_job<true>(lds, PH(WS_XH), D, PH(WS_WIN) + (size_t)1536 * D, D, T, 512, D, ELat{PF(WS_SSX), PH(WS_LAT), rep_ ? nullptr : PF(WS_SSQ), PF(WS_SSKV)});
    }
    PHASE(14) {
        gemm_job<true>(lds, PH(WS_MEMH), D, PH(WS_WMKV), D, MROWS, 1024, D, EKc{PF(WS_SSMEM), PH(WS_KC)});
        gemm_job<false>(lds, PH(WS_MEMH), D, PH(WS_WMKV) + (size_t)1024 * D, D, MROWS, 1024, D, EVc{PF(WS_SSMEM), PH(WS_VCT)}, 32);
    }
    SEAM(1);
    PHASE(2) {
        gemm_job<true>(lds, PH(WS_LAT), LAT, PH(WS_WUQ), 256, T, 768, 256, EQ{PF(WS_SSQ), PF(WS_ROPE), PH(WS_Q)});
        gemm_job<true>(lds, PH(WS_LAT) + 256, LAT, PH(WS_WUKV), 128, T, 512, 128, EK{PF(WS_SSKV), PH(WS_K)}, 128);
        gemm_job<false>(lds, PH(WS_LAT) + 256, LAT, PH(WS_WUKV) + (size_t)512 * 128, 128, T, 512, 128, EV{PF(WS_SSKV), PH(WS_VT)}, 128);
        phase_krot(p);
    }
    PHASE(15) { phase_filt3(p, lds); }
    SEAM(2);
    PHASE(3) { phase_attn(p, lds); }
    PHASE(13) { phase_hyena(p, lds); }
    SEAM(3);
    PHASE(4) { phase_mixprep(p, lds); }
    SEAM(4);
    PHASE(5) { gemm_job<true>(lds, PH(WS_MIX), D, PH(WS_WOUT), D, T, D, D, ERes{p.in[0], p.X, PH(WS_X1H), rep_ ? nullptr : PF(WS_SSX1)}); }
    SEAM(5);
    PHASE(6) { gemm_job<true>(lds, PH(WS_X1H), D, PH(WS_WMQ), D, T, D, D, EMq{PF(WS_SSX1), PH(WS_QC)}); }
    SEAM(6);
    PHASE(7) { phase_xattn(p, lds); }
    SEAM(7);
    PHASE(8) { gemm_job<true>(lds, PH(WS_OC), D, PH(WS_WMO), D, T, D, D, ERes{p.X, p.X, PH(WS_X2H), nullptr}); }
    SEAM(8);
    PHASE(9) { phase_route(p, lds, rep_ != 0); }
    SEAM(9);
    PHASE(10) { phase_moe<false>(p, lds); }
    SEAM(10);
    PHASE(11) { phase_moe<true>(p, lds); }
    SEAM(11);
    PHASE(12) { phase_final(p); }
}

extern "C" void kernel_launch(void* const* d_in, const int* in_sizes, int n_in, void* d_out, int out_size, void* d_ws, size_t ws_size, hipStream_t st) {
    Params p{};
    for (int i = 0; i < 36; ++i) p.in[i] = (const float*)d_in[i];
    p.X = (float*)d_out; p.ws = (char*)d_ws;
    static int grid = 0;
    if (!grid) {
        (void)hipFuncSetAttribute((const void*)mega, hipFuncAttributeMaxDynamicSharedMemorySize, LDS_BYTES);
        int dev = 0, cus = 0, per_cu = 0;
        (void)hipGetDevice(&dev);
        (void)hipDeviceGetAttribute(&cus, hipDeviceAttributeMultiprocessorCount, dev);
        (void)hipOccupancyMaxActiveBlocksPerMultiprocessor(&per_cu, (const void*)mega, NTHR, LDS_BYTES);
        if (per_cu < 1) { fprintf(stderr, "kernel_launch: occupancy query says %d blocks/CU\n", per_cu); per_cu = 1; }
        grid = cus;
    }
    (void)hipMemsetAsync((char*)d_ws + WS_CTL, 0, 32 * 1024, st);
    int lo = 0, hi = 16;
    void* args[] = {&p, &lo, &hi};
    hipError_t e = hipLaunchCooperativeKernel((const void*)mega, dim3(grid), dim3(NTHR), args, LDS_BYTES, st);
    if (e != hipSuccess) fprintf(stderr, "cooperative launch failed: %s (grid %d)\n", hipGetErrorString(e), grid);
    (void)in_sizes; (void)n_in; (void)out_size; (void)ws_size;
}
```

```cpp
#include <hip/hip_runtime.h>
#include <cstdint>
#include <cstdio>
#include <hip/hip_cooperative_groups.h>
namespace cg = cooperative_groups;
typedef _Float16 h16;

constexpr int NB = 4, S = 4096, D = 1024, T = NB * S, MEMT = 256, MROWS = NB * MEMT;
constexpr int NH = 8, HYW = 512;
constexpr int LAT = 416, INC = 1952;
constexpr int MH = 4, MHD = 256;
constexpr int NE = 32, DE = 256;
constexpr float EPS = 1e-6f;
constexpr float LOG2E = 1.4426950408889634f;
constexpr float QSCALE = 0.10206207261596575f * LOG2E;
constexpr float CSCALE = 0.0625f * LOG2E;

constexpr size_t MiB = 1u << 20;
constexpr size_t WS_CTL = 0;
constexpr size_t WS_SSX = 64 * 1024, WS_SSQ = 128 * 1024, WS_SSKV = 192 * 1024, WS_SSA = 256 * 1024, WS_SSH = 320 * 1024,
                 WS_SSX1 = 384 * 1024, WS_SSX2 = 448 * 1024, WS_SSMEM = 512 * 1024, WS_TOKE = 576 * 1024, WS_TOKW = 704 * 1024,
                 WS_TOKP = 832 * 1024;
constexpr size_t WS_WIN = 2 * MiB, WS_WUQ = 6 * MiB, WS_WUKV = 6 * MiB + 512 * 1024, WS_WOUT = 7 * MiB, WS_WMQ = 9 * MiB,
                 WS_WMKV = 11 * MiB, WS_WMO = 15 * MiB, WS_MEMH = 17 * MiB, WS_KC = 19 * MiB, WS_VCT = 21 * MiB, WS_R = 23 * MiB,
                 WS_WGU = 39 * MiB, WS_WDN = 71 * MiB, WS_LAT = 87 * MiB, WS_HYT = 101 * MiB, WS_XH = 149 * MiB, WS_Q = 149 * MiB,
                 WS_K = 173 * MiB, WS_VT = 197 * MiB, WS_AOUT = 213 * MiB, WS_HT = 229 * MiB, WS_LIST = 245 * MiB, WS_H2 = 247 * MiB;
constexpr size_t WS_OC = 183 * MiB, WS_BAR = 16 * 1024;
constexpr size_t WS_MIX = 87 * MiB, WS_X1H = 119 * MiB, WS_QC = 151 * MiB, WS_X2H = 87 * MiB, WS_HB = 119 * MiB, WS_YB = 135 * MiB;

__device__ __forceinline__ float wave_sum(float v) {
#pragma unroll
    for (int o = 1; o < 64; o <<= 1) v += __shfl_xor(v, o);
    return v;
}
__device__ __forceinline__ float rstd_of(float ss, int n) { return 1.0f / sqrtf(ss / (float)n + EPS); }

#define LAS __attribute__((address_space(3)))
typedef _Float16 h16x8 __attribute__((ext_vector_type(8)));
typedef _Float16 h16x4 __attribute__((ext_vector_type(4)));
typedef _Float16 h16x2 __attribute__((ext_vector_type(2)));
typedef float f32x4 __attribute__((ext_vector_type(4)));
typedef float f32x16 __attribute__((ext_vector_type(16)));
constexpr int NTHR = 512, NWAVE = 8;
constexpr int LDS_BYTES = 150 * 1024;
constexpr size_t WS_ROPE = 248 * MiB;
constexpr float HY_FSCALE = 256.f, HY_FINV = 1.f / 256.f;

struct Params {
    const float* in[36]; float* X; char* ws;
};
#define PF(off) ((float*)(p.ws + (off)))
#define PH(off) ((h16*)(p.ws + (off)))
#define PI(off) ((int*)(p.ws + (off)))

constexpr int G_BM = 256, G_BN = 128, G_BK = 64, G_AB = G_BM * G_BK * 2, G_BB = G_BN * G_BK * 2, G_STAGE = G_AB + G_BB;
static_assert(3 * G_STAGE <= LDS_BYTES, "lds");
__device__ __forceinline__ void glds16(const void* g, LAS char* l) { __builtin_amdgcn_global_load_lds((const unsigned*)g, (LAS unsigned*)l, 16, 0, 0); }

template <bool SWAP, class RowPtr, class Epi, int DBG = 0>
__device__ __forceinline__ void gemm_tile(LAS char* lds, const RowPtr& rowptr, const h16* __restrict__ Wt, int ldw, int K, int m0, int n0, const Epi& epi) {
    const int tid = threadIdx.x, lane = tid & 63, wid = __builtin_amdgcn_readfirstlane(tid >> 6);
    const int wm = wid >> 1, wn = wid & 1, fr = lane & 15, fq = lane >> 4;
    const h16* asrc[4]; const h16* bsrc[2];
#pragma unroll
    for (int i = 0; i < 4; ++i) { const int r = wid * 32 + i * 8 + (lane >> 3); const int ch = (lane & 7) ^ ((r >> 1) & 7); asrc[i] = rowptr(m0 + r) + ch * 8; }
#pragma unroll
    for (int i = 0; i < 2; ++i) { const int r = wid * 16 + i * 8 + (lane >> 3); const int ch = (lane & 7) ^ ((r >> 1) & 7); bsrc[i] = Wt + (size_t)(n0 + r) * ldw + ch * 8; }
    const int sw = fr >> 1;
    const int aoff = (wm * 64 + fr) * 128 + ((fq ^ sw) * 16);
    const int boff = G_AB + (wn * 64 + fr) * 128 + ((fq ^ sw) * 16);
    f32x4 acc[4][4];
#pragma unroll
    for (int i = 0; i < 4; ++i)
#pragma unroll
        for (int j = 0; j < 4; ++j) acc[i][j] = (f32x4){0.f, 0.f, 0.f, 0.f};
    const int nt = K / G_BK;
    asm volatile("s_waitcnt vmcnt(0)" ::: "memory");
#define G_STAGE_ISSUE(buf, kt) do { if (DBG == 2) break; LAS char* sa_ = lds + (buf) * G_STAGE + wid * 4096; \
        _Pragma("unroll") for (int i_ = 0; i_ < 4; ++i_) glds16(asrc[i_] + (kt) * G_BK, sa_ + i_ * 1024); \
        LAS char* sb_ = lds + (buf) * G_STAGE + G_AB + wid * 2048; \
        _Pragma("unroll") for (int i_ = 0; i_ < 2; ++i_) glds16(bsrc[i_] + (kt) * G_BK, sb_ + i_ * 1024); } while (0)
#define G_LDF(FA, FB, base_, kk_) do { _Pragma("unroll") for (int i_ = 0; i_ < 4; ++i_) { FA[i_] = *(LAS h16x8*)((base_) + ((aoff ^ ((kk_) * 64)) + i_ * 2048)); FB[i_] = *(LAS h16x8*)((base_) + ((boff ^ ((kk_) * 64)) + i_ * 2048)); } } while (0)
#define G_MMA(FA, FB) do { if (DBG == 1) { _Pragma("unroll") for (int i_ = 0; i_ < 4; ++i_) asm volatile("" :: "v"(FA[i_]), "v"(FB[i_])); break; } _Pragma("unroll") for (int i_ = 0; i_ < 4; ++i_) _Pragma("unroll") for (int j_ = 0; j_ < 4; ++j_) \
        acc[i_][j_] = SWAP ? __builtin_amdgcn_mfma_f32_16x16x32_f16(FB[j_], FA[i_], acc[i_][j_], 0, 0, 0) : __builtin_amdgcn_mfma_f32_16x16x32_f16(FA[i_], FB[j_], acc[i_][j_], 0, 0, 0); } while (0)
    G_STAGE_ISSUE(0, 0);
    if (nt > 1) G_STAGE_ISSUE(1, 1);
    if (nt > 2) G_STAGE_ISSUE(2, 2);
    if (nt > 2) asm volatile("s_waitcnt vmcnt(12)" ::: "memory"); else if (nt > 1) asm volatile("s_waitcnt vmcnt(6)" ::: "memory"); else asm volatile("s_waitcnt vmcnt(0)" ::: "memory");
    __builtin_amdgcn_s_barrier();
    h16x8 xa[4], xb[4], ya[4], yb[4];
    G_LDF(xa, xb, lds, 0);
    int buf = 0;
    for (int t = 0; t < nt; ++t) {
        LAS char* base = lds + buf * G_STAGE;
        const int nbuf = buf == 2 ? 0 : buf + 1;
        G_LDF(ya, yb, base, 1);
        __builtin_amdgcn_sched_barrier(0);
        G_MMA(xa, xb);
        __builtin_amdgcn_sched_barrier(0);
        asm volatile("s_waitcnt lgkmcnt(0)" ::: "memory");
        if (t + 1 < nt) {
            if (t + 2 < nt) asm volatile("s_waitcnt vmcnt(6)" ::: "memory"); else asm volatile("s_waitcnt vmcnt(0)" ::: "memory");
            __builtin_amdgcn_s_barrier();
            if (t + 3 < nt) G_STAGE_ISSUE(buf, t + 3);
            G_LDF(xa, xb, lds + nbuf * G_STAGE, 0);
        }
        __builtin_amdgcn_sched_barrier(0);
        G_MMA(ya, yb);
        __builtin_amdgcn_sched_barrier(0);
        buf = nbuf;
    }
#undef G_STAGE_ISSUE
#undef G_LDF
#undef G_MMA
    __builtin_amdgcn_s_barrier();
    if constexpr (SWAP) {
#pragma unroll
        for (int i = 0; i < 4; ++i)
#pragma unroll
            for (int jp = 0; jp < 2; ++jp) epi.row32(m0 + wm * 64 + i * 16 + fr, n0 + wn * 64 + jp * 32 + fq * 4, acc[i][2 * jp], acc[i][2 * jp + 1]);
    } else {
#pragma unroll
        for (int i = 0; i < 4; ++i)
#pragma unroll
            for (int j = 0; j < 4; ++j) epi.col4(m0 + wm * 64 + i * 16 + fq * 4, n0 + wn * 64 + j * 16 + fr, acc[i][j]);
    }
}
struct ENull { __device__ __forceinline__ void row32(int, int, f32x4 va, f32x4 vb) const { asm volatile("" :: "v"(va), "v"(vb)); } };
struct RowDense { const h16* A; int lda; __device__ __forceinline__ const h16* operator()(int m) const { return A + (size_t)m * lda; } };

__device__ __forceinline__ h16x4 cvt4(f32x4 v) { return (h16x4){(h16)v[0], (h16)v[1], (h16)v[2], (h16)v[3]}; }
__device__ __forceinline__ float rowgrp_sum(float v) { v += __shfl_xor(v, 16); v += __shfl_xor(v, 32); return v; }

struct EHy {
    const float* ssx; h16* hyT;
    __device__ __forceinline__ void col4(int mr, int n, f32x4 v) const {
        const f32x4 ss = *(const f32x4*)(ssx + mr);
        v[0] *= rstd_of(ss[0], D); v[1] *= rstd_of(ss[1], D); v[2] *= rstd_of(ss[2], D); v[3] *= rstd_of(ss[3], D);
        const int b = mr >> 12, t = mr & 4095;
        *(h16x4*)(hyT + ((size_t)(b * 1536 + n)) * S + t) = cvt4(v);
    } };
struct ELat {
    const float* ssx; h16* lat; float* ssq; float* sskv;
    __device__ __forceinline__ void row32(int m, int nb, f32x4 va, f32x4 vb) const {
        const float r = rstd_of(ssx[m], D); va *= r; vb *= r;
        if (nb < LAT) { *(h16x4*)(lat + (size_t)m * LAT + nb) = cvt4(va); *(h16x4*)(lat + (size_t)m * LAT + nb + 16) = cvt4(vb); }
        float s = va[0] * va[0] + va[1] * va[1] + va[2] * va[2] + va[3] * va[3] + vb[0] * vb[0] + vb[1] * vb[1] + vb[2] * vb[2] + vb[3] * vb[3];
        s = rowgrp_sum(s);
        if (ssq && (threadIdx.x & 63) < 16 && nb < 384) atomicAdd((nb < 256 ? ssq : sskv) + m, s);
    } };
struct EQ {
    const float* ssq; const float* rope; h16* Q;
    __device__ __forceinline__ void row32(int m, int nb, f32x4 va, f32x4 vb) const {
        const float r = rstd_of(ssq[m], 256) * QSCALE; va *= r; vb *= r;
        const int b = m >> 12, t = m & 4095, blk = nb >> 5, h = blk / 3, part = blk - 3 * h, c = nb & 31;
        if (part == 2) {
            const float* rp = rope + ((size_t)t * 16 + c) * 2;
#pragma unroll
            for (int j = 0; j < 4; ++j) { const float cs = rp[2 * j], sn = rp[2 * j + 1]; const float q1 = va[j], q2 = vb[j]; va[j] = q1 * cs - q2 * sn; vb[j] = q1 * sn + q2 * cs; }
        }
        h16* q = Q + ((size_t)((b * NH + h) * S + t)) * 96 + part * 32 + c;
        *(h16x4*)q = cvt4(va); *(h16x4*)(q + 16) = cvt4(vb);
    } };
struct EK {
    const float* sskv; h16* K;
    __device__ __forceinline__ void row32(int m, int nb, f32x4 va, f32x4 vb) const {
        const float r = rstd_of(sskv[m], 128); va *= r; vb *= r;
        const int b = m >> 12, t = m & 4095, h = nb >> 6, j = nb & 63;
        h16* k = K + ((size_t)((b * NH + h) * S + t)) * 96 + j;
        *(h16x4*)k = cvt4(va); *(h16x4*)(k + 16) = cvt4(vb);
    } };
struct EV {
    const float* sskv; h16* Vt;
    __device__ __forceinline__ void col4(int mr, int n, f32x4 v) const {
        const f32x4 ss = *(const f32x4*)(sskv + mr);
        v[0] *= rstd_of(ss[0], 128); v[1] *= rstd_of(ss[1], 128); v[2] *= rstd_of(ss[2], 128); v[3] *= rstd_of(ss[3], 128);
        const int b = mr >> 12, t = mr & 4095;
        *(h16x4*)(Vt + ((size_t)(b * 512 + n)) * S + t) = cvt4(v);
    } };
struct EKc {
    const float* ss; h16* Kc;
    __device__ __forceinline__ void row32(int m, int nb, f32x4 va, f32x4 vb) const {
        const float r = rstd_of(ss[m], D); va *= r; vb *= r;
        *(h16x4*)(Kc + (size_t)m * D + nb) = cvt4(va); *(h16x4*)(Kc + (size_t)m * D + nb + 16) = cvt4(vb);
    } };
struct EVc {
    const float* ss; h16* VcT;
    __device__ __forceinline__ void col4(int mr, int n, f32x4 v) const {
        const f32x4 s4 = *(const f32x4*)(ss + mr);
        v[0] *= rstd_of(s4[0], D); v[1] *= rstd_of(s4[1], D); v[2] *= rstd_of(s4[2], D); v[3] *= rstd_of(s4[3], D);
        const int b = mr >> 8, mm = mr & 255;
        *(h16x4*)(VcT + ((size_t)(b * 1024 + n)) * MEMT + mm) = cvt4(v);
    } };
struct ERes {
    const float* xin; float* X; h16* xh; float* ss;
    __device__ __forceinline__ void row32(int m, int nb, f32x4 va, f32x4 vb) const {
        const size_t i = (size_t)m * D + nb;
        va += *(const f32x4*)(xin + i); vb += *(const f32x4*)(xin + i + 16);
        *(f32x4*)(X + i) = va; *(f32x4*)(X + i + 16) = vb;
        *(h16x4*)(xh + i) = cvt4(va); *(h16x4*)(xh + i + 16) = cvt4(vb);
        float s = va[0] * va[0] + va[1] * va[1] + va[2] * va[2] + va[3] * va[3] + vb[0] * vb[0] + vb[1] * vb[1] + vb[2] * vb[2] + vb[3] * vb[3];
        s = rowgrp_sum(s);
        if (ss && (threadIdx.x & 63) < 16) atomicAdd(ss + m, s);
    } };
struct EMq {
    const float* ss; h16* qc;
    __device__ __forceinline__ void row32(int m, int nb, f32x4 va, f32x4 vb) const {
        const float r = rstd_of(ss[m], D) * CSCALE; va *= r; vb *= r;
        *(h16x4*)(qc + (size_t)m * D + nb) = cvt4(va); *(h16x4*)(qc + (size_t)m * D + nb + 16) = cvt4(vb);
    } };


namespace pg8 {
#define PG8_LAS __attribute__((address_space(3)))
typedef unsigned short bf16_t;
typedef short bf16x8 __attribute__((ext_vector_type(8)));
constexpr int BM = 256, BK = 64, HALF = 128, HTB = HALF * BK * 2  , STAGE_BYTES = 8 * HTB, NXCD = 8, WGM = 8;

__host__ __device__ __forceinline__ int lds_byte(int r, int c) { const int st = (r >> 4) * 2 + (c >> 5), rr = r & 15, cc = c & 31, ob = rr * 64 + cc * 2; return st * 1024 + (ob ^ (((ob >> 9) & 1) << 5)); }
__host__ __device__ __forceinline__ void stage_rc(int b, int& R, int& C) { const int st = b / 1024, sb = b % 1024, swz = sb ^ (((sb >> 9) & 1) << 5); R = (st >> 1) * 16 + swz / 64; C = (st & 1) * 32 + (swz % 64) / 2; }
__host__ __device__ __forceinline__ int perm32(int rho) { const int n = rho >> 4, i = rho & 15; return 8 * (i >> 2) + 4 * n + (i & 3); }

struct Unit { int pm, pn; };
struct Gemm { const bf16_t* A; const bf16_t* Bt; int M, N, K; };

struct StaticOrder {
    int nM, nN, nwg, G, c;
    __host__ __device__ void init(int M, int N, int G_, int c_) { nM = M / BM; nN = N / BM; nwg = nM * nN; G = G_; c = c_; }
    __host__ __device__ bool next(int i, Unit& u) const {
        const long L = (long)i * G + c; if (L >= nwg) return false;
        int wgid = (int)L; { const int q = nwg / NXCD, r = nwg % NXCD, xcd = wgid % NXCD, off = wgid / NXCD; wgid = (xcd < r ? xcd * (q + 1) : r * (q + 1) + (xcd - r) * q) + off; }
        const int nig = WGM * nN, gid = wgid / nig, fm = gid * WGM, gsz = (nM - fm) < WGM ? (nM - fm) : WGM;
        u.pm = fm + ((wgid % nig) % gsz); u.pn = (wgid % nig) / gsz; return true;
    }
    __device__ __forceinline__ void a_ready(const Unit&) const {}
    __device__ __forceinline__ void done(const Unit&) const {}
};

template <class Epi, class Sched, bool ALIGN_EPI = false, bool SP2 = false>
__device__ __forceinline__ void gemm_phase(PG8_LAS unsigned char* lds, const Gemm g, const Sched& S, const Epi& E) {
    const int tid = threadIdx.x, wid = __builtin_amdgcn_readfirstlane(tid >> 6), lane = tid & 63, wr = wid >> 2, wc = wid & 3, fr = lane & 15, fq = lane >> 4;
    const int K = g.K, nt = K / BK;
    unsigned voffA[2], voffB[2];
#pragma unroll
    for (int i = 0; i < 2; ++i) { int R, C; stage_rc(tid * 16 + i * 8192, R, C); const int Rb = Epi::PERM ? ((R & ~31) + perm32(R & 31)) : R;
        voffA[i] = (unsigned)(R * K + C) * 2u; voffB[i] = (unsigned)(Rb * K + C) * 2u; }
    const size_t kstep = (size_t)(BK * 2);
    const size_t hstep = (size_t)HALF * K * 2;
    const size_t tstep = 2 * hstep;
    const unsigned ldsw = (unsigned)wid * 1024u;
    const int aoff = lds_byte(wr * 64 + fr, fq * 8), boff = lds_byte(wc * 32 + fr, fq * 8);
#define PG8_SA(b, h) (((b) * 2 + (h)) * HTB)
#define PG8_SB(b, h) ((4 + (b) * 2 + (h)) * HTB)
#define PG8_STAGE(bufoff, gbase, voff) do { _Pragma("unroll") for (int _i = 0; _i < 2; ++_i) \
        __builtin_amdgcn_global_load_lds((const unsigned*)((const char*)(gbase) + (voff)[_i]), (PG8_LAS unsigned*)(lds + (bufoff) + ldsw + _i * 8192), 16, 0, 0); } while (0)
#define PG8_LDA(dst, b, h) do { _Pragma("unroll") for (int m = 0; m < 4; ++m) _Pragma("unroll") for (int k = 0; k < 2; ++k) dst[m][k] = *(const PG8_LAS bf16x8*)(lds + PG8_SA(b, h) + aoff + m * 2048 + k * 1024); } while (0)
#define PG8_LDB(dst, b, h) do { _Pragma("unroll") for (int n = 0; n < 2; ++n) _Pragma("unroll") for (int k = 0; k < 2; ++k) dst[n][k] = *(const PG8_LAS bf16x8*)(lds + PG8_SB(b, h) + boff + n * 2048 + k * 1024); } while (0)
#define PG8_MMA(ai, bj, At, Bt) do { __builtin_amdgcn_s_setprio(1); _Pragma("unroll") for (int m = 0; m < 4; ++m) _Pragma("unroll") for (int n = 0; n < 2; ++n) _Pragma("unroll") for (int k = 0; k < 2; ++k) \
        acc[ai][bj][m][n] = __builtin_amdgcn_mfma_f32_16x16x32_f16(__builtin_bit_cast(h16x8, Bt[n][k]), __builtin_bit_cast(h16x8, At[m][k]), acc[ai][bj][m][n], 0, 0, 0); __builtin_amdgcn_s_setprio(0); } while (0)
#define PG8_WAIT_V(n) asm volatile("s_waitcnt vmcnt(" #n ")" ::: "memory")
#define PG8_WAIT_L(n) asm volatile("s_waitcnt lgkmcnt(" #n ")" ::: "memory")
#define PG8_BAR __builtin_amdgcn_s_barrier()
#define PG8_SCHED __builtin_amdgcn_sched_barrier(0)
    Unit cur, nxt; int ui = 0;
    if (!S.next(0, cur)) return;
    f32x4 acc[2][2][4][2];
#pragma unroll
    for (int a = 0; a < 2; ++a)
#pragma unroll
        for (int b = 0; b < 2; ++b)
#pragma unroll
            for (int m = 0; m < 4; ++m)
#pragma unroll
                for (int n = 0; n < 2; ++n) acc[a][b][m][n] = (f32x4){0.f, 0.f, 0.f, 0.f};
    bf16x8 At[4][2], B0[2][2], B1[2][2];
    const char* cA = (const char*)g.A + (size_t)cur.pm * tstep; const char* cB = (const char*)g.Bt + (size_t)cur.pn * tstep;
    S.a_ready(cur);
    if constexpr (SP2) {
        PG8_STAGE(PG8_SB(0, 0), cB, voffB); PG8_STAGE(PG8_SB(0, 1), cB + hstep, voffB); PG8_STAGE(PG8_SA(0, 0), cA, voffA); PG8_STAGE(PG8_SA(0, 1), cA + hstep, voffA);
        if (wr == 1) PG8_BAR;
        PG8_WAIT_V(2); PG8_BAR;
        PG8_STAGE(PG8_SB(1, 0), cB + kstep, voffB); PG8_STAGE(PG8_SA(1, 0), cA + kstep, voffA); PG8_STAGE(PG8_SB(1, 1), cB + hstep + kstep, voffB);
        PG8_WAIT_V(6); PG8_BAR;
    } else {
        PG8_STAGE(PG8_SB(0, 0), cB, voffB); PG8_STAGE(PG8_SA(0, 0), cA, voffA); PG8_STAGE(PG8_SB(0, 1), cB + hstep, voffB); PG8_STAGE(PG8_SA(0, 1), cA + hstep, voffA);
        if (wr == 1) PG8_BAR;
        PG8_WAIT_V(4); PG8_BAR;
        PG8_STAGE(PG8_SB(1, 0), cB + kstep, voffB); PG8_STAGE(PG8_SA(1, 0), cA + kstep, voffA); PG8_STAGE(PG8_SB(1, 1), cB + hstep + kstep, voffB);
        PG8_WAIT_V(6); PG8_BAR;
    }
    for (;;) {
        const bool has_next = S.next(ui + 1, nxt);
        const char* nA = has_next ? (const char*)g.A + (size_t)nxt.pm * tstep : cA; const char* nB = has_next ? (const char*)g.Bt + (size_t)nxt.pn * tstep : cB;
        for (int t = 0; t < nt; t += 2) {
            const bool last = (t == nt - 2);
            const char* a1 = cA + (size_t)(t + 1) * kstep;
            const char* a2 = last ? nA : cA + (size_t)(t + 2) * kstep; const char* b2 = last ? nB : cB + (size_t)(t + 2) * kstep;
            const char* a3 = a2 + kstep; const char* b3 = b2 + kstep;
            if (last && has_next) S.a_ready(nxt);
            if constexpr (SP2) {
            PG8_LDB(B0, 0, 0); PG8_LDB(B1, 0, 1); PG8_SCHED; PG8_LDA(At, 0, 0); PG8_STAGE(PG8_SA(1, 1), a1 + hstep, voffA);
            PG8_WAIT_V(8); PG8_WAIT_L(0); PG8_BAR; PG8_MMA(0, 0, At, B0); PG8_MMA(0, 1, At, B1); PG8_BAR; PG8_SCHED;
            PG8_LDA(At, 0, 1); PG8_STAGE(PG8_SB(0, 0), b2, voffB); PG8_STAGE(PG8_SB(0, 1), b2 + hstep, voffB); PG8_STAGE(PG8_SA(0, 0), a2, voffA);
            PG8_WAIT_V(8); PG8_WAIT_L(0); PG8_BAR; PG8_MMA(1, 0, At, B0); PG8_MMA(1, 1, At, B1); PG8_BAR; PG8_SCHED;
            PG8_LDB(B0, 1, 0); PG8_LDB(B1, 1, 1); PG8_SCHED; PG8_LDA(At, 1, 0); PG8_STAGE(PG8_SA(0, 1), a2 + hstep, voffA);
            PG8_WAIT_V(8); PG8_WAIT_L(0); PG8_BAR; PG8_MMA(0, 0, At, B0); PG8_MMA(0, 1, At, B1); PG8_BAR; PG8_SCHED;
            PG8_LDA(At, 1, 1); PG8_STAGE(PG8_SB(1, 0), b3, voffB); PG8_STAGE(PG8_SB(1, 1), b3 + hstep, voffB); PG8_STAGE(PG8_SA(1, 0), a3, voffA);
            PG8_WAIT_V(8); PG8_WAIT_L(0); PG8_BAR; PG8_MMA(1, 0, At, B0); PG8_MMA(1, 1, At, B1); PG8_BAR; PG8_SCHED;
            } else {
            PG8_LDB(B0, 0, 0); PG8_SCHED; PG8_LDA(At, 0, 0); PG8_STAGE(PG8_SA(1, 1), a1 + hstep, voffA);
            PG8_WAIT_L(8); PG8_BAR; PG8_WAIT_L(0); PG8_MMA(0, 0, At, B0); PG8_BAR; PG8_SCHED;
            PG8_LDB(B1, 0, 1); PG8_STAGE(PG8_SB(0, 0), b2, voffB);
            PG8_BAR; PG8_WAIT_L(0); PG8_MMA(0, 1, At, B1); PG8_BAR;
            PG8_LDA(At, 0, 1); PG8_STAGE(PG8_SA(0, 0), a2, voffA);
            PG8_BAR; PG8_WAIT_L(0); PG8_MMA(1, 0, At, B0); PG8_BAR; PG8_SCHED;
            PG8_STAGE(PG8_SB(0, 1), b2 + hstep, voffB);
            PG8_WAIT_V(6); PG8_BAR; PG8_MMA(1, 1, At, B1); PG8_BAR;
            PG8_LDB(B0, 1, 0); PG8_SCHED; PG8_LDA(At, 1, 0); PG8_STAGE(PG8_SA(0, 1), a2 + hstep, voffA);
            PG8_WAIT_L(8); PG8_BAR; PG8_WAIT_L(0); PG8_MMA(0, 0, At, B0); PG8_BAR; PG8_SCHED;
            PG8_LDB(B1, 1, 1); PG8_STAGE(PG8_SB(1, 0), b3, voffB);
            PG8_BAR; PG8_WAIT_L(0); PG8_MMA(0, 1, At, B1); PG8_BAR;
            PG8_LDA(At, 1, 1); PG8_STAGE(PG8_SA(1, 0), a3, voffA);
            PG8_BAR; PG8_WAIT_L(0); PG8_MMA(1, 0, At, B0); PG8_BAR; PG8_SCHED;
            PG8_STAGE(PG8_SB(1, 1), b3 + hstep, voffB);
            PG8_WAIT_V(6); PG8_BAR; PG8_MMA(1, 1, At, B1); PG8_BAR;
            }
        }
        if constexpr (ALIGN_EPI) { if (wr == 0) PG8_BAR; }
        if constexpr (!Epi::AFTER_DRAIN) { E(acc, cur, wr, wc, fr, fq); S.done(cur); }
        if (!has_next) break;
#pragma unroll
        for (int a = 0; a < 2; ++a)
#pragma unroll
            for (int b = 0; b < 2; ++b)
#pragma unroll
                for (int m = 0; m < 4; ++m)
#pragma unroll
                    for (int n = 0; n < 2; ++n) acc[a][b][m][n] = (f32x4){0.f, 0.f, 0.f, 0.f};
        cur = nxt; cA = nA; cB = nB; ++ui;
        if constexpr (ALIGN_EPI) { if (wr == 1) PG8_BAR; }
    }
    PG8_WAIT_V(0);
    if constexpr (!ALIGN_EPI) { if (wr == 0) PG8_BAR; }
    PG8_BAR;
    if constexpr (Epi::AFTER_DRAIN) { E.fused(acc, cur, wr, wc, fr, fq, lds, wid, lane); S.done(cur); }
#undef PG8_SA
#undef PG8_SB
#undef PG8_STAGE
#undef PG8_LDA
#undef PG8_LDB
#undef PG8_MMA
#undef PG8_WAIT_V
#undef PG8_WAIT_L
#undef PG8_BAR
#undef PG8_SCHED
}
}
template <class F> struct PgRow {
    static constexpr bool PERM = false, AFTER_DRAIN = false; F f;
    __device__ __forceinline__ void operator()(const f32x4 (&acc)[2][2][4][2], const pg8::Unit& u, int wr, int wc, int fr, int fq) const {
#pragma unroll
        for (int ai = 0; ai < 2; ++ai)
#pragma unroll
            for (int m = 0; m < 4; ++m) { const int row = u.pm * 256 + ai * 128 + wr * 64 + m * 16 + fr;
#pragma unroll
                for (int bj = 0; bj < 2; ++bj) f.row32(row, u.pn * 256 + bj * 128 + wc * 32 + fq * 4, acc[ai][bj][m][0], acc[ai][bj][m][1]); }
    } };
struct EInProj {
    static constexpr bool PERM = false, AFTER_DRAIN = true;
    const float* ssx; h16* hyT; ELat lat; int pn_off;
    __device__ __forceinline__ void fused(f32x4 (&acc)[2][2][4][2], const pg8::Unit& u0, int wr, int wc, int fr, int fq, PG8_LAS unsigned char* ldsb, int wid, int lane) const {
        pg8::Unit u = u0; u.pn += pn_off;
        if (u.pn >= 6) {
#pragma unroll
            for (int ai = 0; ai < 2; ++ai)
#pragma unroll
                for (int m = 0; m < 4; ++m) { const int row = u.pm * 256 + ai * 128 + wr * 64 + m * 16 + fr;
#pragma unroll
                    for (int bj = 0; bj < 2; ++bj) lat.row32(row, (u.pn - 6) * 256 + bj * 128 + wc * 32 + fq * 4, acc[ai][bj][m][0], acc[ai][bj][m][1]); }
            return;
        }
        constexpr int TP = 264;
        LAS h16* tile = (LAS h16*)ldsb;
#pragma unroll
        for (int ai = 0; ai < 2; ++ai)
#pragma unroll
            for (int m = 0; m < 4; ++m) { const int rl = ai * 128 + wr * 64 + m * 16 + fr; const float rs = rstd_of(ssx[u.pm * 256 + rl], D);
#pragma unroll
                for (int bj = 0; bj < 2; ++bj)
#pragma unroll
                    for (int n = 0; n < 2; ++n)
#pragma unroll
                        for (int j = 0; j < 4; ++j) tile[(bj * 128 + wc * 32 + n * 16 + fq * 4 + j) * TP + rl] = (h16)(acc[ai][bj][m][n][j] * rs); }
        asm volatile("s_waitcnt lgkmcnt(0)" ::: "memory"); __builtin_amdgcn_s_barrier(); asm volatile("" ::: "memory");
        const int row0 = u.pm * 256, b = row0 >> 12, t0 = row0 & 4095, tid = wid * 64 + lane;
#pragma unroll
        for (int i = 0; i < 16; ++i) { const int idx = tid + 512 * i, ch = idx >> 5, c8 = idx & 31;
            *(h16x8*)(hyT + ((size_t)(b * 1536 + u.pn * 256 + ch)) * S + t0 + c8 * 8) = *(LAS h16x8*)(tile + ch * TP + c8 * 8); }
        asm volatile("s_waitcnt lgkmcnt(0)" ::: "memory"); __builtin_amdgcn_s_barrier(); asm volatile("" ::: "memory");
    } };
template <class Epi, bool ALIGN>
__device__ __forceinline__ void pg_gemm(LAS char* lds, const h16* A, const h16* Bt, int M, int N, int K, const Epi& E) {
    asm volatile("s_waitcnt vmcnt(0) lgkmcnt(0)" ::: "memory"); __syncthreads();
    pg8::Gemm g{(const pg8::bf16_t*)A, (const pg8::bf16_t*)Bt, M, N, K};
    pg8::StaticOrder So; So.init(M, N, (int)gridDim.x, (int)blockIdx.x);
    pg8::gemm_phase<Epi, pg8::StaticOrder, ALIGN, true>((PG8_LAS unsigned char*)lds, g, So, E);
    asm volatile("s_waitcnt vmcnt(0) lgkmcnt(0)" ::: "memory"); __syncthreads();
}

template <bool SWAP, class Epi, int DBG = 0>
__device__ __forceinline__ void gemm_job(LAS char* lds, const h16* A, int lda, const h16* Wt, int ldw, int M, int N, int K, const Epi& epi, int first = 0) {
    const int ntn = N / G_BN, ntiles = (M / G_BM) * ntn;
    const RowDense rp{A, lda};
    const int G = gridDim.x, bx = blockIdx.x, vid = (G % 8 == 0) ? (bx % 8) * (G / 8) + bx / 8 : bx;
    for (int tix = (vid + G - first % G) % G; tix < ntiles; tix += G) {
        const int mt = tix / ntn, nt_ = tix - mt * ntn;
        gemm_tile<SWAP, RowDense, Epi, DBG>(lds, rp, Wt, ldw, K, mt * G_BM, nt_ * G_BN, epi);
    }
}

template <class RowMap, class Gain>
__device__ __forceinline__ void wt_item(const float* W, int N, int K, h16* Wt, LAS float* scr, int k0, int n0, int lane, const RowMap& rowmap, const Gain& gain) {
#pragma unroll
    for (int i = 0; i < 32; ++i) { const int kk = 2 * i + (lane >> 5); scr[kk * 33 + (lane & 31)] = W[(size_t)(k0 + kk) * N + n0 + (lane & 31)] * gain(k0 + kk); }
    asm volatile("s_waitcnt lgkmcnt(0)" ::: "memory");
    const int c = lane & 7;
#pragma unroll
    for (int j = 0; j < 4; ++j) { const int n = (lane >> 3) + 8 * j; const LAS float* s = scr + (8 * c) * 33 + n;
        h16x8 o = {(h16)s[0], (h16)s[33], (h16)s[66], (h16)s[99], (h16)s[132], (h16)s[165], (h16)s[198], (h16)s[231]};
        *(h16x8*)(Wt + (size_t)rowmap(n0 + n) * K + k0 + 8 * c) = o; }
    asm volatile("s_waitcnt lgkmcnt(0)" ::: "memory");
}
struct GainNone { __device__ __forceinline__ float operator()(int) const { return 1.f; } };
struct Gain1 { const float* g; __device__ __forceinline__ float operator()(int k) const { return g[k]; } };
struct Gain2 { const float* g; const float* g2; __device__ __forceinline__ float operator()(int k) const { return k < 512 ? g[k] : g2[k - 512]; } };
struct MapId { __device__ __forceinline__ int operator()(int n) const { return n; } };
struct MapIn { __device__ __forceinline__ int operator()(int n) const { return n < LAT ? 1536 + n : n - LAT; } };
struct MapKV { __device__ __forceinline__ int operator()(int n) const { const int h = n >> 7, j = n & 127; return j < 64 ? h * 64 + j : 512 + h * 64 + (j - 64); } };
struct MapG { int up; __device__ __forceinline__ int operator()(int j) const { return 32 * (j >> 4) + (j & 15) + up; } };

__device__ __forceinline__ void phase_prep(const Params& p, LAS char* lds) {
    const int tid = threadIdx.x, lane = tid & 63, wid = tid >> 6;
    const int gw = blockIdx.x * NWAVE + wid, NGW = gridDim.x * NWAVE, gt = blockIdx.x * NTHR + tid, NGT = gridDim.x * NTHR;
    LAS float* scr = (LAS float*)(lds + wid * 16384);
    for (int i = gt; i < 5 * 16384; i += NGT) PF(WS_SSQ)[i] = 0.f;
    for (int row = gw; row < T + MROWS; row += NGW) {
        const bool isx = row < T; const int r = isx ? row : row - T;
        const f32x4* src = (const f32x4*)((isx ? p.in[0] : p.in[1]) + (size_t)r * D) + lane;
        h16* dst = (isx ? PH(WS_XH) : PH(WS_MEMH)) + (size_t)r * D;
        float s = 0.f;
#pragma unroll
        for (int j = 0; j < 4; ++j) { const f32x4 v = src[64 * j]; s += v[0] * v[0] + v[1] * v[1] + v[2] * v[2] + v[3] * v[3]; *(h16x4*)(dst + (lane + 64 * j) * 4) = cvt4(v); }
        s = wave_sum(s);
        if (lane == 0) (isx ? PF(WS_SSX) : PF(WS_SSMEM))[r] = s;
    }
}
__device__ __forceinline__ void phase_prep_w(const Params& p, LAS char* lds) {
    const int tid = threadIdx.x, lane = tid & 63, wid = tid >> 6;
    const int gw = blockIdx.x * NWAVE + wid, NGW = gridDim.x * NWAVE, gt = blockIdx.x * NTHR + tid, NGT = gridDim.x * NTHR;
    LAS float* scr = (LAS float*)(lds + wid * 16384);
    (void)lane; (void)gw; (void)NGW; (void)gt; (void)NGT; (void)scr;
    {
        constexpr int I_IN = 16 * 61, I_UQ = 4 * 24, I_UKV = 2 * 32, I_SQ = 16 * 32, I_MKV = 16 * 64, I_EX = 16 * 8, I_DN = 4 * 32;
        constexpr int NIT = I_IN + I_UQ + I_UKV + 3 * I_SQ + I_MKV + NE * (2 * I_EX + I_DN);
        for (int it = gw; it < NIT; it += NGW) {
            int r = it;
            if (r < I_IN) { wt_item(p.in[3], INC, D, PH(WS_WIN), scr, (r / 61) * 64, (r % 61) * 32, lane, MapIn{}, Gain1{p.in[2]}); continue; } r -= I_IN;
            if (r < I_UQ) { wt_item(p.in[6], 768, 256, PH(WS_WUQ), scr, (r / 24) * 64, (r % 24) * 32, lane, MapId{}, Gain1{p.in[4]}); continue; } r -= I_UQ;
            if (r < I_UKV) { wt_item(p.in[7], 1024, 128, PH(WS_WUKV), scr, (r / 32) * 64, (r % 32) * 32, lane, MapKV{}, Gain1{p.in[5]}); continue; } r -= I_UKV;
            if (r < I_SQ) { wt_item(p.in[21], D, D, PH(WS_WOUT), scr, (r / 32) * 64, (r % 32) * 32, lane, MapId{}, Gain2{p.in[19], p.in[20]}); continue; } r -= I_SQ;
            if (r < I_SQ) { wt_item(p.in[24], D, D, PH(WS_WMQ), scr, (r / 32) * 64, (r % 32) * 32, lane, MapId{}, Gain1{p.in[22]}); continue; } r -= I_SQ;
            if (r < I_SQ) { wt_item(p.in[26], D, D, PH(WS_WMO), scr, (r / 32) * 64, (r % 32) * 32, lane, MapId{}, GainNone{}); continue; } r -= I_SQ;
            if (r < I_MKV) { wt_item(p.in[25], 2048, D, PH(WS_WMKV), scr, (r / 64) * 64, (r % 64) * 32, lane, MapId{}, Gain1{p.in[23]}); continue; } r -= I_MKV;
            const int e = r / (2 * I_EX + I_DN); r -= e * (2 * I_EX + I_DN);
            if (r < I_EX) { wt_item(p.in[32] + (size_t)e * D * DE, DE, D, PH(WS_WGU) + (size_t)e * 512 * D, scr, (r / 8) * 64, (r % 8) * 32, lane, MapG{0}, Gain1{p.in[27]}); continue; } r -= I_EX;
            if (r < I_EX) { wt_item(p.in[33] + (size_t)e * D * DE, DE, D, PH(WS_WGU) + (size_t)e * 512 * D, scr, (r / 8) * 64, (r % 8) * 32, lane, MapG{16}, Gain1{p.in[27]}); continue; } r -= I_EX;
            wt_item(p.in[34] + (size_t)e * DE * D, D, DE, PH(WS_WDN) + (size_t)e * D * DE, scr, (r / 32) * 64, (r % 32) * 32, lane, MapId{}, GainNone{});
        }
        for (int i = gt; i < 96 * D / 8; i += NGT) *(h16x8*)(PH(WS_WIN) + (size_t)INC * D + (size_t)i * 8) = (h16x8){0, 0, 0, 0, 0, 0, 0, 0};
    }
}
__device__ __forceinline__ void phase_prep_s(const Params& p, LAS char* lds) {
    const int tid = threadIdx.x, lane = tid & 63, wid = tid >> 6;
    const int gw = blockIdx.x * NWAVE + wid, NGW = gridDim.x * NWAVE, gt = blockIdx.x * NTHR + tid, NGT = gridDim.x * NTHR;
    LAS float* scr = (LAS float*)(lds + wid * 16384);
    (void)lane; (void)gw; (void)NGW; (void)gt; (void)NGT; (void)scr;
    for (int i = gt; i < S * 16; i += NGT) { const int t = i >> 4, pp = i & 15; const float inv = exp2f(-(float)pp * (13.287712379549449f / 16.0f)); float sn, cs; sincosf((float)t * inv, &sn, &cs);
        PF(WS_ROPE)[2 * i] = cs; PF(WS_ROPE)[2 * i + 1] = sn; }
    {
        LAS float* zf = scr; LAS float* h1 = scr + 64;
        const float* w1 = p.in[10]; const float* b1 = p.in[11]; const float* freq = p.in[12]; const float* w2 = p.in[13]; const float* b2 = p.in[14];
        for (int t = gw; t < S; t += NGW) {
            const int j = lane;
            if (j < 33) { float v;
                if (j == 0) v = (float)t / (float)S;
                else { const int bi = (j - 1) & 15; const float band = 1e-4f + (float)bi * ((15.0f - 1e-4f) / 15.0f);
                    double rev = (double)t * (double)band / (double)S; rev -= floor(rev); const float r2 = (float)(2.0 * rev);
                    v = (j <= 16) ? cospif(r2) : -sinpif(r2); }
                zf[j] = v; }
            asm volatile("s_waitcnt lgkmcnt(0)" ::: "memory");
            float a = b1[j];
            for (int i = 0; i < 33; ++i) a += zf[i] * w1[i * 64 + j];
            h1[j] = sinf(freq[j] * a);
            asm volatile("s_waitcnt lgkmcnt(0)" ::: "memory");
            float c = b2[j];
            for (int i = 0; i < 64; ++i) c += h1[i] * w2[i * 64 + j];
            PF(WS_H2)[t * 64 + j] = sinf(freq[64 + j] * c);
            asm volatile("s_waitcnt lgkmcnt(0)" ::: "memory");
        }
    }
}
__device__ __forceinline__ void phase_filt3(const Params& p, LAS char* lds) {
    const float* H2 = PF(WS_H2); const float* w3 = p.in[15]; const float* b3 = p.in[16]; const float* decay = p.in[17]; h16* R = PH(WS_R);
    LAS h16* tile = (LAS h16*)lds;
    LAS float* wl = (LAS float*)(lds + 65536);
    LAS float* cb = wl + 512;
    const int tid = threadIdx.x;
    for (int it = blockIdx.x; it < 256; it += gridDim.x) {
        const int o = it >> 7, c0 = (it & 127) * 4;
        __syncthreads();
        { const int j = tid >> 3, e = tid & 7, col = o * 1024 + (e >> 2) * 512 + c0 + (e & 3);
          wl[tid] = w3[j * 2048 + col];
          if (tid < 8) { const int cl = o * 1024 + (tid >> 2) * 512 + c0 + (tid & 3); cb[tid] = b3[cl]; cb[8 + tid] = fabsf(decay[cl]) * (1.0f / (float)S); } }
        __syncthreads();
        for (int i = 0; i < 8; ++i) {
            const int tau = tid + 512 * i;
            float acc[8];
#pragma unroll
            for (int e = 0; e < 8; ++e) acc[e] = cb[e];
#pragma unroll
            for (int j4 = 0; j4 < 16; ++j4) {
                const f32x4 hv = *(const f32x4*)(H2 + tau * 64 + j4 * 4);
#pragma unroll
                for (int jj = 0; jj < 4; ++jj) {
                    const f32x4 wa = *(LAS f32x4*)(wl + (j4 * 4 + jj) * 8), wb = *(LAS f32x4*)(wl + (j4 * 4 + jj) * 8 + 4);
                    acc[0] += hv[jj] * wa[0]; acc[1] += hv[jj] * wa[1]; acc[2] += hv[jj] * wa[2]; acc[3] += hv[jj] * wa[3];
                    acc[4] += hv[jj] * wb[0]; acc[5] += hv[jj] * wb[1]; acc[6] += hv[jj] * wb[2]; acc[7] += hv[jj] * wb[3];
                }
            }
#pragma unroll
            for (int e = 0; e < 8; ++e) {
                const float v = acc[e] * HY_FSCALE * __expf(-(float)tau * cb[8 + e]);
                const int ch = e & 3, dir = e >> 2;
                int u; float val = v;
                if (dir == 0) u = 4096 - tau;
                else { u = tau == 0 ? 0 : 4096 + tau; if (tau == 0) val = 0.f; }
                tile[ch * 8192 + u] = (h16)val;
            }
        }
        __syncthreads();
        for (int i = tid; i < 4 * 1024; i += NTHR) { const int ch = i >> 10, k = i & 1023;
            *(h16x8*)(R + ((size_t)(o * 512 + c0 + ch)) * 8192 + k * 8) = *(LAS h16x8*)(tile + ch * 8192 + k * 8); }
    }
    __syncthreads();
}
__device__ __forceinline__ void phase_krot(const Params& p) {
    const int gt = blockIdx.x * NTHR + threadIdx.x, NGT = gridDim.x * NTHR;
    const h16* lat = PH(WS_LAT); h16* K = PH(WS_K); const float* rope = PF(WS_ROPE);
    for (int i = gt; i < T * 4; i += NGT) {
        const int m = i >> 2, p0 = (i & 3) * 4, b = m >> 12, t = m & 4095;
        const h16x4 k1 = *(const h16x4*)(lat + (size_t)m * LAT + 384 + p0), k2 = *(const h16x4*)(lat + (size_t)m * LAT + 400 + p0);
        h16x4 o1, o2;
#pragma unroll
        for (int j = 0; j < 4; ++j) { const float cs = rope[((size_t)t * 16 + p0 + j) * 2], sn = rope[((size_t)t * 16 + p0 + j) * 2 + 1];
            const float a = (float)k1[j], c = (float)k2[j]; o1[j] = (h16)(a * cs - c * sn); o2[j] = (h16)(a * sn + c * cs); }
#pragma unroll
        for (int h = 0; h < NH; ++h) { h16* kp = K + ((size_t)((b * NH + h) * S + t)) * 96 + 64 + p0; *(h16x4*)kp = o1; *(h16x4*)(kp + 16) = o2; }
    }
}


constexpr int AT_KROW = 208, AT_VROW = 136, AT_KB = 64 * AT_KROW, AT_VB = 64 * AT_VROW, AT_BUF = AT_KB + AT_VB;
__device__ __forceinline__ void phase_attn(const Params& p, LAS char* lds) {
    const int tid = threadIdx.x, lane = tid & 63, wid = __builtin_amdgcn_readfirstlane(tid >> 6), r32 = lane & 31, hi = lane >> 5;
    const h16* Qg = PH(WS_Q); const h16* Kg = PH(WS_K); const h16* Vtg = PH(WS_VT); h16* aout = PH(WS_AOUT);
    const int k0r = tid / 12, k0c = tid - 12 * k0r, c1 = tid + 512, k1r = c1 / 12, k1c = c1 - 12 * k1r;
    const int vdv = tid >> 3, vc = tid & 7;
    const int G = gridDim.x, bx = blockIdx.x, vid = (G % 8 == 0) ? (bx % 8) * (G / 8) + bx / 8 : bx;
    for (int u = vid; u < NB * NH * 16; u += G) {
        const int bh = u >> 4, q0 = (u & 15) * 256 + wid * 32;
        h16x8 qf[6];
        { const h16* qp = Qg + ((size_t)bh * S + q0 + r32) * 96 + 8 * hi;
#pragma unroll
          for (int s_ = 0; s_ < 6; ++s_) qf[s_] = *(const h16x8*)(qp + 16 * s_); }
        const h16* Kb = Kg + (size_t)bh * S * 96; const h16* Vb = Vtg + (size_t)bh * 64 * S + (size_t)vdv * S + vc * 8;
        h16x8 kr0, kr1, vr;
        kr0 = *(const h16x8*)(Kb + tid * 8); kr1 = kr0; if (tid < 256) kr1 = *(const h16x8*)(Kb + c1 * 8); vr = *(const h16x8*)(Vb);
        __syncthreads();
        { *(LAS h16x8*)(lds + k0r * AT_KROW + k0c * 16) = kr0; if (tid < 256) *(LAS h16x8*)(lds + k1r * AT_KROW + k1c * 16) = kr1;
          LAS char* vn = lds + AT_KB + vdv * AT_VROW + vc * 16; *(LAS h16x4*)vn = (h16x4){vr[0], vr[1], vr[2], vr[3]}; *(LAS h16x4*)(vn + 8) = (h16x4){vr[4], vr[5], vr[6], vr[7]}; }
        __syncthreads();
        f32x16 o0, o1;
#pragma unroll
        for (int r = 0; r < 16; ++r) { o0[r] = 0.f; o1[r] = 0.f; }
        float m = -1e30f, l = 0.f;
        for (int t = 0; t < S / 64; ++t) {
            if (t + 1 < S / 64) {
                const h16* kn = Kb + (size_t)(t + 1) * 64 * 96;
                kr0 = *(const h16x8*)(kn + tid * 8); if (tid < 256) kr1 = *(const h16x8*)(kn + c1 * 8); vr = *(const h16x8*)(Vb + (t + 1) * 64);
            }
            LAS char* kb = lds + (t & 1) * AT_BUF; LAS char* vb = kb + AT_KB;
            f32x16 p0, p1;
#pragma unroll
            for (int r = 0; r < 16; ++r) { p0[r] = 0.f; p1[r] = 0.f; }
            h16x8 ka[6], kc[6];
#pragma unroll
            for (int s_ = 0; s_ < 6; ++s_) { ka[s_] = *(LAS h16x8*)(kb + r32 * AT_KROW + s_ * 32 + hi * 16); kc[s_] = *(LAS h16x8*)(kb + (32 + r32) * AT_KROW + s_ * 32 + hi * 16); }
            __builtin_amdgcn_sched_barrier(0);
#pragma unroll
            for (int s_ = 0; s_ < 6; ++s_) {
                p0 = __builtin_amdgcn_mfma_f32_32x32x16_f16(ka[s_], qf[s_], p0, 0, 0, 0);
                p1 = __builtin_amdgcn_mfma_f32_32x32x16_f16(kc[s_], qf[s_], p1, 0, 0, 0);
            }
            __builtin_amdgcn_sched_barrier(0);
            h16x8 va[4], vc2[4];
            { LAS char* vb_ = vb + r32 * AT_VROW + 8 * hi;
#pragma unroll
              for (int f_ = 0; f_ < 4; ++f_) {
                  const h16x4 a_ = *(LAS h16x4*)(vb_ + f_ * 32), b_ = *(LAS h16x4*)(vb_ + f_ * 32 + 16), c_ = *(LAS h16x4*)(vb_ + 32 * AT_VROW + f_ * 32), d_ = *(LAS h16x4*)(vb_ + 32 * AT_VROW + f_ * 32 + 16);
                  va[f_] = (h16x8){a_[0], a_[1], a_[2], a_[3], b_[0], b_[1], b_[2], b_[3]}; vc2[f_] = (h16x8){c_[0], c_[1], c_[2], c_[3], d_[0], d_[1], d_[2], d_[3]}; } }
            __builtin_amdgcn_sched_barrier(0);
            float mx = fmaxf(p0[0], p1[0]);
#pragma unroll
            for (int r = 1; r < 16; ++r) mx = fmaxf(mx, fmaxf(p0[r], p1[r]));
            mx = fmaxf(mx, __shfl_xor(mx, 32));
            const float mn = fmaxf(m, mx), al = __builtin_amdgcn_exp2f(m - mn); m = mn;
            float rs = 0.f;
#pragma unroll
            for (int r = 0; r < 16; ++r) { p0[r] = __builtin_amdgcn_exp2f(p0[r] - mn); p1[r] = __builtin_amdgcn_exp2f(p1[r] - mn); rs += p0[r] + p1[r]; }
            l = l * al + rs;
#pragma unroll
            for (int r = 0; r < 16; ++r) { o0[r] *= al; o1[r] *= al; }
            h16x8 pf[4];
#pragma unroll
            for (int j = 0; j < 8; ++j) { pf[0][j] = (h16)p0[j]; pf[1][j] = (h16)p0[8 + j]; pf[2][j] = (h16)p1[j]; pf[3][j] = (h16)p1[8 + j]; }
#pragma unroll
            for (int f_ = 0; f_ < 4; ++f_) {
                o0 = __builtin_amdgcn_mfma_f32_32x32x16_f16(va[f_], pf[f_], o0, 0, 0, 0);
                o1 = __builtin_amdgcn_mfma_f32_32x32x16_f16(vc2[f_], pf[f_], o1, 0, 0, 0);
            }
            if (t + 1 < S / 64) {
                LAS char* kn = lds + ((t + 1) & 1) * AT_BUF;
                *(LAS h16x8*)(kn + k0r * AT_KROW + k0c * 16) = kr0; if (tid < 256) *(LAS h16x8*)(kn + k1r * AT_KROW + k1c * 16) = kr1;
                LAS char* vn = kn + AT_KB + vdv * AT_VROW + vc * 16; *(LAS h16x4*)vn = (h16x4){vr[0], vr[1], vr[2], vr[3]}; *(LAS h16x4*)(vn + 8) = (h16x4){vr[4], vr[5], vr[6], vr[7]};
            }
            __syncthreads();
        }
        const float il = 1.f / (l + __shfl_xor(l, 32));
        const int b = bh >> 3, h = bh & 7;
        h16* ap = aout + ((size_t)(b * S + q0 + r32)) * 512 + h * 64 + 4 * hi;
#pragma unroll
        for (int g = 0; g < 4; ++g) {
            *(h16x4*)(ap + 8 * g) = (h16x4){(h16)(o0[4 * g] * il), (h16)(o0[4 * g + 1] * il), (h16)(o0[4 * g + 2] * il), (h16)(o0[4 * g + 3] * il)};
            *(h16x4*)(ap + 32 + 8 * g) = (h16x4){(h16)(o1[4 * g] * il), (h16)(o1[4 * g + 1] * il), (h16)(o1[4 * g + 2] * il), (h16)(o1[4 * g + 3] * il)};
        }
    }
    __syncthreads();
}
constexpr int HY_CS = 16448, HY_ZOFF = 4 * HY_CS, HY_ZB = 11584, HY_LDS = HY_ZOFF + 4 * HY_ZB;
static_assert(HY_LDS <= LDS_BYTES, "hyena lds");
__device__ __forceinline__ void phase_hyena(const Params& p, LAS char* lds) {
    const int tid = threadIdx.x, lane = tid & 63, wid = __builtin_amdgcn_readfirstlane(tid >> 6), r32 = lane & 31, hi = lane >> 5;
    const h16* hyT = PH(WS_HYT); const h16* Rg = PH(WS_R); const float* convw = p.in[8]; const float* convb = p.in[9]; const float* skip = p.in[18]; h16* hT = PH(WS_HT);
    const int G = gridDim.x, bx = blockIdx.x, vid = (G % 8 == 0) ? (bx % 8) * (G / 8) + bx / 8 : bx;
    __syncthreads();
    for (int i = tid; i < 4 * 16 * 36; i += NTHR) { const int batch = i / 576, rem = i - batch * 576, blk = rem / 36, w = rem - blk * 36, bi = blk < 8 ? blk : 64 + blk;
        *(LAS unsigned*)(lds + HY_ZOFF + batch * HY_ZB + bi * 144 + w * 4) = 0u; }
    const int i0 = wid * 8, q = r32 & 3, ii = r32 >> 2, batch = r32 & 3;
    const int abase = q * HY_CS + 2 * (4096 + 8 * hi - (r32 - q));
    const int bbase = HY_ZOFF + batch * HY_ZB + ((i0 + ii + 8) * 72 + 8 * hi) * 2;
    for (int c = vid; c < HYW; c += G) {
        for (int n = 0; n < 2; ++n) {
            __syncthreads();
            { const unsigned* Rc = (const unsigned*)(Rg + ((size_t)(n * 512 + c)) * 8192);
#pragma unroll
              for (int i = 0; i < 8; ++i) { const int w = tid + NTHR * i; const unsigned cur = Rc[w], prv = w > 0 ? Rc[w - 1] : 0u, odd = (prv >> 16) | (cur << 16);
                  *(LAS unsigned*)(lds + w * 4) = cur; *(LAS unsigned*)(lds + 2 * HY_CS + (w + 1) * 4) = cur;
                  *(LAS unsigned*)(lds + HY_CS + w * 4) = odd; *(LAS unsigned*)(lds + 3 * HY_CS + (w + 1) * 4) = odd; }
              if (tid == 0) { const unsigned last = Rc[4095] >> 16; *(LAS unsigned*)(lds + HY_CS + 4096 * 4) = last; *(LAS unsigned*)(lds + 3 * HY_CS + 4097 * 4) = last; } }
            if (n == 0) {
                const int ch = 1024 + c; const float w0 = convw[ch], w1 = convw[1536 + ch], w2 = convw[3072 + ch], bb = convb[ch];
                for (int i = tid; i < 4 * 512; i += NTHR) { const int bt = i >> 9, t0 = (i & 511) * 8; const h16* raw = hyT + ((size_t)(bt * 1536 + ch)) * S + t0;
                    const h16x8 v = *(const h16x8*)raw; float x[10]; x[0] = t0 > 0 ? (float)raw[-1] : 0.f; x[9] = t0 + 8 < S ? (float)raw[8] : 0.f;
#pragma unroll
                    for (int e = 0; e < 8; ++e) x[e + 1] = (float)v[e];
                    h16x8 o;
#pragma unroll
                    for (int e = 0; e < 8; ++e) o[e] = (h16)(w0 * x[e] + w1 * x[e + 1] + w2 * x[e + 2] + bb);
                    *(LAS h16x8*)(lds + HY_ZOFF + bt * HY_ZB + (((t0 >> 6) + 8) * 72 + (t0 & 63)) * 2) = o; }
            }
            __syncthreads();
            const int gch = n == 0 ? c : 512 + c;
            h16x4 gpre[8]; h16 gpl[8], gpr[8];
            { const h16* graw = hyT + ((size_t)(batch * 1536 + gch)) * S;
#pragma unroll
              for (int rt = 0; rt < 2; ++rt)
#pragma unroll
                  for (int g = 0; g < 4; ++g) { const int t4 = 64 * (i0 + ii) + 32 * rt + 8 * g + 4 * hi;
                      gpre[rt * 4 + g] = *(const h16x4*)(graw + t4); gpl[rt * 4 + g] = t4 > 0 ? graw[t4 - 1] : (h16)0.f; gpr[rt * 4 + g] = t4 + 4 < S ? graw[t4 + 4] : (h16)0.f; } }
            f32x16 acc0, acc1;
#pragma unroll
            for (int r = 0; r < 16; ++r) { acc0[r] = 0.f; acc1[r] = 0.f; }
#define HY_LDA(dst, ptr) do { const h16x4 l_ = *(volatile LAS h16x4*)(ptr), h_ = *(volatile LAS h16x4*)((ptr) + 8); dst = (h16x8){l_[0], l_[1], l_[2], l_[3], h_[0], h_[1], h_[2], h_[3]}; } while (0)
#define HY_LOAD(Sx, d_) do { LAS char* ap_ = lds + abase - 128 * (d_); LAS char* bp_ = lds + bbase - 144 * (d_); \
        HY_LDA(Sx##m32, ap_ - 64); HY_LDA(Sx##m16, ap_ - 32); HY_LDA(Sx##p0, ap_); HY_LDA(Sx##p16, ap_ + 32); \
        Sx##b0 = *(volatile LAS h16x8*)(bp_); Sx##b1 = *(volatile LAS h16x8*)(bp_ + 32); Sx##b2 = *(volatile LAS h16x8*)(bp_ + 64); Sx##b3 = *(volatile LAS h16x8*)(bp_ + 96); } while (0)
#define HY_MMA(Sx) do { \
        acc0 = __builtin_amdgcn_mfma_f32_32x32x16_f16(Sx##p0, Sx##b0, acc0, 0, 0, 0); acc1 = __builtin_amdgcn_mfma_f32_32x32x16_f16(Sx##m32, Sx##b0, acc1, 0, 0, 0); \
        acc0 = __builtin_amdgcn_mfma_f32_32x32x16_f16(Sx##p16, Sx##b1, acc0, 0, 0, 0); acc1 = __builtin_amdgcn_mfma_f32_32x32x16_f16(Sx##m16, Sx##b1, acc1, 0, 0, 0); \
        acc0 = __builtin_amdgcn_mfma_f32_32x32x16_f16(c32, Sx##b2, acc0, 0, 0, 0); acc1 = __builtin_amdgcn_mfma_f32_32x32x16_f16(Sx##p0, Sx##b2, acc1, 0, 0, 0); \
        acc0 = __builtin_amdgcn_mfma_f32_32x32x16_f16(c48, Sx##b3, acc0, 0, 0, 0); acc1 = __builtin_amdgcn_mfma_f32_32x32x16_f16(Sx##p16, Sx##b3, acc1, 0, 0, 0); \
        c32 = Sx##m32; c48 = Sx##m16; } while (0)
            h16x8 c32, c48, Xm32, Xm16, Xp0, Xp16, Xb0, Xb1, Xb2, Xb3, Ym32, Ym16, Yp0, Yp16, Yb0, Yb1, Yb2, Yb3;
            { LAS char* ap = lds + abase - 128 * (i0 - 64); HY_LDA(c32, ap - 64); HY_LDA(c48, ap - 32); }
            HY_LOAD(X, i0 - 63);
            for (int d = i0 - 63; d < i0 + 7; d += 2) {
                HY_LOAD(Y, d + 1);
                HY_MMA(X);
                HY_LOAD(X, d + 2);
                HY_MMA(Y);
            }
            HY_MMA(X);
#undef HY_LDA
#undef HY_LOAD
#undef HY_MMA
            __syncthreads();
            {
                const float w0 = convw[gch], w1 = convw[1536 + gch], w2 = convw[3072 + gch], bb = convb[gch], sk = skip[n * 512 + c];
#pragma unroll
                for (int rt = 0; rt < 2; ++rt)
#pragma unroll
                    for (int g = 0; g < 4; ++g) {
                        const int a4 = 32 * rt + 8 * g + 4 * hi, t4 = 64 * (i0 + ii) + a4;
                        LAS char* zp = lds + HY_ZOFF + batch * HY_ZB + ((i0 + ii + 8) * 72 + a4) * 2;
                        const h16x4 zo = *(LAS h16x4*)zp;
                        const h16x4 gv = gpre[rt * 4 + g];
                        float x[6]; x[0] = (float)gpl[rt * 4 + g]; x[5] = (float)gpr[rt * 4 + g];
#pragma unroll
                        for (int e = 0; e < 4; ++e) x[e + 1] = (float)gv[e];
                        h16x4 zn;
#pragma unroll
                        for (int e = 0; e < 4; ++e) { const float gc = w0 * x[e] + w1 * x[e + 1] + w2 * x[e + 2] + bb; const float y = (rt == 0 ? acc0[4 * g + e] : acc1[4 * g + e]) * HY_FINV;
                            zn[e] = (h16)(gc * (y + sk * (float)zo[e])); }
                        if (n == 0) *(LAS h16x4*)zp = zn; else *(h16x4*)(hT + ((size_t)(batch * 512 + c)) * S + t4) = zn;
                    }
            }
        }
    }
    __syncthreads();
}
__device__ __forceinline__ void phase_mixprep(const Params& p, LAS char* lds) {
    constexpr int LDT = 520;
    LAS h16* tile = (LAS h16*)lds;
    const h16* aout = PH(WS_AOUT); const h16* hT = PH(WS_HT); h16* mix = PH(WS_MIX);
    const int tid = threadIdx.x, lane = tid & 63, wid = tid >> 6;
    for (int u = blockIdx.x; u < T / 64; u += gridDim.x) {
        const int m0 = u * 64, b = m0 >> 12, t0 = m0 & 4095;
        __syncthreads();
        for (int i = tid; i < 512 * 8; i += NTHR) { const int c = i >> 3, j = i & 7;
            const h16x8 v = *(const h16x8*)(hT + ((size_t)(b * 512 + c)) * S + t0 + j * 8);
#pragma unroll
            for (int e = 0; e < 8; ++e) tile[(j * 8 + e) * LDT + c] = v[e]; }
        __syncthreads();
        for (int rr = 0; rr < 8; ++rr) {
            const int r = wid * 8 + rr; const size_t m = (size_t)(m0 + r);
            const h16x8 hv = *(LAS h16x8*)(tile + r * LDT + lane * 8);
            const h16x8 av = *(const h16x8*)(aout + m * 512 + lane * 8);
            float sh = 0.f, sa = 0.f;
#pragma unroll
            for (int e = 0; e < 8; ++e) { const float x = (float)hv[e], y = (float)av[e]; sh += x * x; sa += y * y; }
            sh = wave_sum(sh); sa = wave_sum(sa);
            const float rh = rstd_of(sh, 512), ra = rstd_of(sa, 512);
            h16x8 oh, oa;
#pragma unroll
            for (int e = 0; e < 8; ++e) { oh[e] = (h16)((float)hv[e] * rh); oa[e] = (h16)((float)av[e] * ra); }
            *(h16x8*)(mix + m * D + lane * 8) = oa; *(h16x8*)(mix + m * D + 512 + lane * 8) = oh;
        }
    }
    __syncthreads();
}
constexpr int XA_KROW = 528, XA_VROW = 136, XA_KB = 64 * XA_KROW, XA_VB = 128 * XA_VROW, XA_BUF = XA_KB + XA_VB;
static_assert(2 * XA_BUF <= LDS_BYTES, "xattn lds");
__device__ __forceinline__ void phase_xattn(const Params& p, LAS char* lds) {
    const int tid = threadIdx.x, lane = tid & 63, wid = __builtin_amdgcn_readfirstlane(tid >> 6), r32 = lane & 31, hi = lane >> 5;
    const h16* qc = PH(WS_QC); h16* oc = PH(WS_OC); const h16* Kc = PH(WS_KC); const h16* VcT = PH(WS_VCT);
    const int G = gridDim.x, bx = blockIdx.x, vid = (G % 8 == 0) ? (bx % 8) * (G / 8) + bx / 8 : bx;
    for (int u = vid; u < NB * MH * 16; u += G) {
        const int bh = u >> 4, b = bh >> 2, h = bh & 3, q0 = (u & 15) * 256 + wid * 32;
        const h16* qrow = qc + ((size_t)(b * S + q0 + r32)) * D + h * MHD; h16* orow = oc + ((size_t)(b * S + q0 + r32)) * D + h * MHD;
        h16x8 qf[16];
#pragma unroll
        for (int s_ = 0; s_ < 16; ++s_) qf[s_] = *(const h16x8*)(qrow + 16 * s_ + 8 * hi);
        const h16* Ksrc = Kc + ((size_t)(b * MEMT + (tid >> 5))) * D + h * MHD + (tid & 31) * 8;
        const h16* Vsrc = VcT + ((size_t)(bh * MHD + (tid >> 3))) * MEMT + (tid & 7) * 8;
        const int kdst = (tid >> 5) * XA_KROW + (tid & 31) * 16, vdst = XA_KB + (tid >> 3) * XA_VROW + (tid & 7) * 16;
        h16x8 kr[4], vr[2];
#pragma unroll
        for (int j = 0; j < 4; ++j) kr[j] = *(const h16x8*)(Ksrc + (size_t)(16 * j) * D);
#pragma unroll
        for (int j = 0; j < 2; ++j) vr[j] = *(const h16x8*)(Vsrc + (size_t)(64 * j) * MEMT);
        __syncthreads();
#pragma unroll
        for (int j = 0; j < 4; ++j) *(LAS h16x8*)(lds + kdst + 16 * j * XA_KROW) = kr[j];
#pragma unroll
        for (int j = 0; j < 2; ++j) { LAS char* vn = lds + vdst + 64 * j * XA_VROW; *(LAS h16x4*)vn = (h16x4){vr[j][0], vr[j][1], vr[j][2], vr[j][3]}; *(LAS h16x4*)(vn + 8) = (h16x4){vr[j][4], vr[j][5], vr[j][6], vr[j][7]}; }
        __syncthreads();
        f32x16 o[4]; float m = -1e30f, l = 0.f;
#pragma unroll
        for (int dt = 0; dt < 4; ++dt)
#pragma unroll
            for (int r = 0; r < 16; ++r) o[dt][r] = 0.f;
        for (int st = 0; st < 8; ++st) {
            const int t = st & 3, pass = st >> 2;
            if (st + 1 < 8) { const int t1 = (st + 1) & 3, p1 = (st + 1) >> 2;
#pragma unroll
                for (int j = 0; j < 4; ++j) kr[j] = *(const h16x8*)(Ksrc + (size_t)(64 * t1 + 16 * j) * D);
#pragma unroll
                for (int j = 0; j < 2; ++j) vr[j] = *(const h16x8*)(Vsrc + (size_t)(128 * p1 + 64 * j) * MEMT + 64 * t1); }
            LAS char* kb = lds + (st & 1) * XA_BUF; LAS char* vb = kb + XA_KB;
            f32x16 p0, p1_;
#pragma unroll
            for (int r = 0; r < 16; ++r) { p0[r] = 0.f; p1_[r] = 0.f; }
#pragma unroll
            for (int s_ = 0; s_ < 16; ++s_) {
                const h16x8 a0 = *(LAS h16x8*)(kb + r32 * XA_KROW + s_ * 32 + hi * 16);
                const h16x8 a1 = *(LAS h16x8*)(kb + (32 + r32) * XA_KROW + s_ * 32 + hi * 16);
                p0 = __builtin_amdgcn_mfma_f32_32x32x16_f16(a0, qf[s_], p0, 0, 0, 0);
                p1_ = __builtin_amdgcn_mfma_f32_32x32x16_f16(a1, qf[s_], p1_, 0, 0, 0);
            }
            float mx = fmaxf(p0[0], p1_[0]);
#pragma unroll
            for (int r = 1; r < 16; ++r) mx = fmaxf(mx, fmaxf(p0[r], p1_[r]));
            mx = fmaxf(mx, __shfl_xor(mx, 32));
            const float mn = fmaxf(m, mx), al = __builtin_amdgcn_exp2f(m - mn); m = mn;
            float rs = 0.f;
#pragma unroll
            for (int r = 0; r < 16; ++r) { p0[r] = __builtin_amdgcn_exp2f(p0[r] - mn); p1_[r] = __builtin_amdgcn_exp2f(p1_[r] - mn); rs += p0[r] + p1_[r]; }
            l = l * al + rs;
#pragma unroll
            for (int dt = 0; dt < 4; ++dt)
#pragma unroll
                for (int r = 0; r < 16; ++r) o[dt][r] *= al;
            h16x8 pf[2][2];
#pragma unroll
            for (int j = 0; j < 8; ++j) { pf[0][0][j] = (h16)p0[j]; pf[0][1][j] = (h16)p0[8 + j]; pf[1][0][j] = (h16)p1_[j]; pf[1][1][j] = (h16)p1_[8 + j]; }
#pragma unroll
            for (int kh = 0; kh < 2; ++kh)
#pragma unroll
                for (int s_ = 0; s_ < 2; ++s_)
#pragma unroll
                    for (int dt = 0; dt < 4; ++dt) {
                        LAS char* v0 = vb + (dt * 32 + r32) * XA_VROW + (kh * 32 + 16 * s_ + 4 * hi) * 2;
                        const h16x4 a = *(LAS h16x4*)v0, c = *(LAS h16x4*)(v0 + 16);
                        const h16x8 vf = {a[0], a[1], a[2], a[3], c[0], c[1], c[2], c[3]};
                        o[dt] = __builtin_amdgcn_mfma_f32_32x32x16_f16(vf, pf[kh][s_], o[dt], 0, 0, 0);
                    }
            if (st + 1 < 8) {
                LAS char* nb = lds + ((st + 1) & 1) * XA_BUF;
#pragma unroll
                for (int j = 0; j < 4; ++j) *(LAS h16x8*)(nb + kdst + 16 * j * XA_KROW) = kr[j];
#pragma unroll
                for (int j = 0; j < 2; ++j) { LAS char* vn = nb + vdst + 64 * j * XA_VROW; *(LAS h16x4*)vn = (h16x4){vr[j][0], vr[j][1], vr[j][2], vr[j][3]}; *(LAS h16x4*)(vn + 8) = (h16x4){vr[j][4], vr[j][5], vr[j][6], vr[j][7]}; }
            }
            if (t == 3) {
                const float il = 1.f / (l + __shfl_xor(l, 32));
                h16* op = orow + pass * 128 + 4 * hi;
#pragma unroll
                for (int dt = 0; dt < 4; ++dt)
#pragma unroll
                    for (int g = 0; g < 4; ++g) {
                        *(h16x4*)(op + dt * 32 + 8 * g) = (h16x4){(h16)(o[dt][4 * g] * il), (h16)(o[dt][4 * g + 1] * il), (h16)(o[dt][4 * g + 2] * il), (h16)(o[dt][4 * g + 3] * il)};
                        o[dt][4 * g] = 0.f; o[dt][4 * g + 1] = 0.f; o[dt][4 * g + 2] = 0.f; o[dt][4 * g + 3] = 0.f; }
                m = -1e30f; l = 0.f;
            }
            __syncthreads();
        }
    }
    __syncthreads();
}
__device__ __forceinline__ void phase_route(const Params& p, LAS char* lds, bool dry) {
    const float* X = p.X; const float* g = p.in[27]; const float* wrg = p.in[28]; const float* brg = p.in[29]; const float* wre = p.in[30]; const float* bre = p.in[31];
    float* ssx2 = PF(WS_SSX2); float* tokw = PF(WS_TOKW); int* cnt = PI(WS_CTL); int* list = PI(WS_LIST);
    LAS float* W = (LAS float*)lds;
    const int tid = threadIdx.x, lane = tid & 63, wid = tid >> 6;
    __syncthreads();
    for (int i = tid; i < D * 36; i += NTHR) { const int k = i / 36, j = i - 36 * k; W[i] = g[k] * (j < 4 ? wrg[k * 4 + j] : wre[k * 32 + (j - 4)]); }
    __syncthreads();
    const int b5 = (lane >> 5) & 1, b4 = (lane >> 4) & 1;
    for (int m0 = (blockIdx.x * NWAVE + wid) * 4; m0 < T; m0 += gridDim.x * NWAVE * 4) {
        float acc[4][36]; float ss[4];
#pragma unroll
        for (int t = 0; t < 4; ++t) { ss[t] = 0.f;
#pragma unroll
            for (int j = 0; j < 36; ++j) acc[t][j] = 0.f; }
#pragma unroll 2
        for (int i = 0; i < 16; ++i) {
            const int k = lane + 64 * i;
            float xv[4];
#pragma unroll
            for (int t = 0; t < 4; ++t) { xv[t] = X[(size_t)(m0 + t) * D + k]; ss[t] += xv[t] * xv[t]; }
#pragma unroll
            for (int j4 = 0; j4 < 9; ++j4) { const f32x4 w = *(LAS f32x4*)(W + k * 36 + j4 * 4);
#pragma unroll
                for (int t = 0; t < 4; ++t) { acc[t][j4 * 4] += xv[t] * w[0]; acc[t][j4 * 4 + 1] += xv[t] * w[1]; acc[t][j4 * 4 + 2] += xv[t] * w[2]; acc[t][j4 * 4 + 3] += xv[t] * w[3]; } }
        }
#pragma unroll
        for (int t = 0; t < 4; ++t) {
            const int m = m0 + t;
            const float sst = wave_sum(ss[t]); const float rs = rstd_of(sst, D);
            float a18[18], a9[9];
#pragma unroll
            for (int j = 0; j < 18; ++j) { const float lo = acc[t][j], hi_ = acc[t][j + 18]; const float keep = b5 ? hi_ : lo, send = b5 ? lo : hi_; a18[j] = keep + __shfl_xor(send, 32); }
#pragma unroll
            for (int j = 0; j < 9; ++j) { const float lo = a18[j], hi_ = a18[j + 9]; const float keep = b4 ? hi_ : lo, send = b4 ? lo : hi_; a9[j] = keep + __shfl_xor(send, 16); }
#pragma unroll
            for (int j = 0; j < 9; ++j) { float v = a9[j]; v += __shfl_xor(v, 8); v += __shfl_xor(v, 4); v += __shfl_xor(v, 2); v += __shfl_xor(v, 1); a9[j] = v * rs; }
            float lg[36];
#pragma unroll
            for (int s_ = 0; s_ < 4; ++s_)
#pragma unroll
                for (int j = 0; j < 9; ++j) lg[9 * s_ + j] = __builtin_bit_cast(float, __builtin_amdgcn_readlane(__builtin_bit_cast(int, a9[j]), 16 * s_));
            float gl[4]; int gi = 0; float gm = -1e30f;
#pragma unroll
            for (int j = 0; j < 4; ++j) { gl[j] = lg[j] + brg[j]; if (gl[j] > gm) { gm = gl[j]; gi = j; } }
            float gs = 0.f;
#pragma unroll
            for (int j = 0; j < 4; ++j) gs += expf(gl[j] - gm);
            const float pg = 1.f / gs;
            float e1 = -1e30f, e2 = -1e30f; int i1 = 0, i2 = 0;
#pragma unroll
            for (int g4 = 0; g4 < 4; ++g4) if (g4 == gi) {
#pragma unroll
                for (int j = 0; j < 8; ++j) { const float v = lg[4 + g4 * 8 + j] + bre[g4 * 8 + j];
                    if (v > e1) { e2 = e1; i2 = i1; e1 = v; i1 = j; } else if (v > e2) { e2 = v; i2 = j; } } }
            if (lane == 0) {
                const float p2 = 1.f / (1.f + expf(e1 - e2)), p1 = 1.f - p2;
                const int ea = gi * 8 + i1, eb = gi * 8 + i2;
                ssx2[m] = sst; tokw[m * 2] = pg * p1; tokw[m * 2 + 1] = pg * p2;
                if (!dry) { const int pa = atomicAdd(&cnt[ea], 1), pb = atomicAdd(&cnt[eb], 1); list[ea * T + pa] = m * 2; list[eb * T + pb] = m * 2 + 1; }
            }
        }
    }
    __syncthreads();
}
struct RowGather { const h16* A; const int* lst; int Me; __device__ __forceinline__ const h16* operator()(int m) const { const int pr = m < Me ? lst[m] : lst[0]; return A + (size_t)(pr >> 1) * D; } };
struct RowClamp { const h16* A; int Me; __device__ __forceinline__ const h16* operator()(int m) const { return A + (size_t)(m < Me ? m : 0) * DE; } };
struct EGu { const int* lst; int Me; const float* ssx2; const float* tokw; h16* hb;
    __device__ __forceinline__ void row32(int m, int nb, f32x4 va, f32x4 vb) const {
        if (m >= Me) return;
        const int pr = lst[m]; const float rs = rstd_of(ssx2[pr >> 1], D), w = tokw[pr];
        h16x4 o;
#pragma unroll
        for (int j = 0; j < 4; ++j) { const float a = va[j] * rs, bb = vb[j] * rs; o[j] = (h16)(a / (1.f + __expf(-a)) * bb * w); }
        *(h16x4*)(hb + (size_t)m * DE + (nb >> 5) * 16 + (nb & 31)) = o;
    } };
struct EDn { const int* lst; int Me; h16* yb;
    __device__ __forceinline__ void row32(int m, int nb, f32x4 va, f32x4 vb) const {
        if (m >= Me) return;
        h16* y = yb + (size_t)lst[m] * D + nb;
        *(h16x4*)y = cvt4(va); *(h16x4*)(y + 16) = cvt4(vb);
    } };
template <bool DOWN>
__device__ __forceinline__ void phase_moe(const Params& p, LAS char* lds) {
    const int* cnt = PI(WS_CTL);
    const int G = gridDim.x, bx = blockIdx.x, vid = (G % 8 == 0) ? (bx % 8) * (G / 8) + bx / 8 : bx;
    constexpr int NTN = DOWN ? D / G_BN : 512 / G_BN;
    int tbase = 0, off = 0;
    int tix = vid;
    for (int e = 0; e < NE; ++e) {
        const int Me = cnt[e], nmt = (Me + G_BM - 1) / G_BM, nte = nmt * NTN;
        const int* lst = PI(WS_LIST) + (size_t)e * T;
        for (; tix < tbase + nte; tix += G) {
            const int lt = tix - tbase, mt = lt / NTN, nt_ = lt - mt * NTN;
            if (!DOWN) gemm_tile<true>(lds, RowGather{PH(WS_X2H), lst, Me}, PH(WS_WGU) + (size_t)e * 512 * D, D, D, mt * G_BM, nt_ * G_BN,
                                       EGu{lst, Me, PF(WS_SSX2), PF(WS_TOKW), PH(WS_HB) + (size_t)off * DE});
            else gemm_tile<true>(lds, RowClamp{PH(WS_HB) + (size_t)off * DE, Me}, PH(WS_WDN) + (size_t)e * D * DE, DE, DE, mt * G_BM, nt_ * G_BN,
                                 EDn{lst, Me, PH(WS_YB)});
        }
        tbase += nte; off += Me;
    }
}
__device__ __forceinline__ void phase_final(const Params& p) {
    const float* X = p.X; const h16* yb = PH(WS_YB); const float* g = p.in[35]; float* out = p.X;
    const int lane = threadIdx.x & 63, gw = blockIdx.x * NWAVE + (threadIdx.x >> 6), NGW = gridDim.x * NWAVE;
    for (int m = gw; m < T; m += NGW) {
        f32x4 v[4]; float ss = 0.f;
#pragma unroll
        for (int i = 0; i < 4; ++i) { const int k = (lane + 64 * i) * 4;
            const f32x4 xv = *(const f32x4*)(X + (size_t)m * D + k); const h16x4 y0 = *(const h16x4*)(yb + ((size_t)m * 2) * D + k), y1 = *(const h16x4*)(yb + ((size_t)m * 2 + 1) * D + k);
#pragma unroll
            for (int j = 0; j < 4; ++j) { v[i][j] = xv[j] + (float)y0[j] + (float)y1[j]; ss += v[i][j] * v[i][j]; } }
        ss = wave_sum(ss); const float rs = rstd_of(ss, D);
#pragma unroll
        for (int i = 0; i < 4; ++i) { const int k = (lane + 64 * i) * 4; const f32x4 gv = *(const f32x4*)(g + k); *(f32x4*)(out + (size_t)m * D + k) = v[i] * rs * gv; }
    }
}

#define XB_TMO      128
#define XB_XCNT(j)  (256  + 64 * (j))
#define XB_XSUB(j)  (1280 + 64 * (j))
#define XB_XGEN(j)  (2304 + 64 * (j))
#define XB_TOP      3328
#define XB_TOPGEN   3392
#define XCD_BAR_WORDS 3456
#define XB_SPIN_CAP (1u << 18)
__device__ __forceinline__ unsigned xb_ld(unsigned* p)              { return __hip_atomic_load(p, __ATOMIC_RELAXED, __HIP_MEMORY_SCOPE_AGENT); }
__device__ __forceinline__ unsigned xb_add(unsigned* p, unsigned v) { return __hip_atomic_fetch_add(p, v, __ATOMIC_RELAXED, __HIP_MEMORY_SCOPE_AGENT); }
__device__ __forceinline__ unsigned xb_xcc_id() { return (unsigned)__builtin_amdgcn_s_getreg((3 << 11) | 20) & 0xFu; }
#define XB_SPIN(cond, bar) do { unsigned _sp = 0; while (cond) { __builtin_amdgcn_s_sleep(1); \
    if ((++_sp & 255u) == 0u) { if (xb_ld(&(bar)[XB_TMO])) break; if (_sp > XB_SPIN_CAP) { atomicAdd(&(bar)[XB_TMO], 1u); break; } } } } while (0)
struct XcdBarrier { unsigned* bar; unsigned x; volatile LAS unsigned* st; };
__device__ __forceinline__ XcdBarrier xcd_barrier_post(unsigned* bar, volatile LAS unsigned* st) {
    XcdBarrier b; b.bar = bar; b.x = xb_xcc_id(); b.st = st;
    if (threadIdx.x == 0) (void)xb_add(&bar[XB_XCNT(b.x)], 1u);
    return b;
}
__device__ __forceinline__ void xcd_barrier_complete(unsigned* bar, unsigned x, unsigned& nloc, unsigned& nx) {
    const unsigned G = gridDim.x * gridDim.y * gridDim.z;
    unsigned sum, cnt, mine, sp = 0u;
    for (;;) {
        sum = 0u; cnt = 0u; mine = 0u;
#pragma unroll
        for (unsigned j = 0; j < 16; ++j) { const unsigned c = xb_ld(&bar[XB_XCNT(j)]); sum += c; cnt += (c > 0u) ? 1u : 0u; mine = (j == x) ? c : mine; }
        if (sum == G) break;
        __builtin_amdgcn_s_sleep(1);
        if ((++sp & 255u) == 0u) { if (xb_ld(&bar[XB_TMO])) break; if (sp > XB_SPIN_CAP) { atomicAdd(&bar[XB_TMO], 1u); break; } }
    }
    nloc = mine > 0u ? mine : 1u; nx = cnt > 0u ? cnt : 1u;
}
__device__ __forceinline__ void xcd_barrier(const XcdBarrier& b) {
    asm volatile("s_waitcnt vmcnt(0)" ::: "memory");
    __syncthreads();
    if (threadIdx.x == 0) {
        unsigned* bar = b.bar;
        __builtin_amdgcn_s_waitcnt(0);
        unsigned nloc = b.st[0], nx = b.st[1];
        if (nloc == 0u) { xcd_barrier_complete(bar, b.x, nloc, nx); b.st[0] = nloc; b.st[1] = nx; }
        const unsigned old = xb_add(&bar[XB_XSUB(b.x)], 1u);
        const unsigned gen = old / nloc;
        if (old + 1u == (gen + 1u) * nloc) {
            __builtin_amdgcn_fence(__ATOMIC_RELEASE, "agent");
            asm volatile("s_waitcnt vmcnt(0)" ::: "memory");
            const unsigned og = xb_add(&bar[XB_TOP], 1u);
            const unsigned tg = og / nx;
            if (og + 1u == (tg + 1u) * nx) xb_add(&bar[XB_TOPGEN], 1u);
            else XB_SPIN(xb_ld(&bar[XB_TOPGEN]) == tg, bar);
            __builtin_amdgcn_fence(__ATOMIC_ACQUIRE, "agent");
            xb_add(&bar[XB_XGEN(b.x)], 1u);
            asm volatile("s_waitcnt vmcnt(0)" ::: "memory");
        } else {
            XB_SPIN(xb_ld(&bar[XB_XGEN(b.x)]) == gen, bar);
            __builtin_amdgcn_fence(__ATOMIC_ACQUIRE, "agent");
            asm volatile("s_waitcnt vmcnt(0)" ::: "memory");
        }
    }
    __syncthreads();
}

#ifndef DBG_MODE
#define DBG_MODE 0
#endif
#ifndef REP_PHASE
#define REP_PHASE -1
#endif
__global__ void __launch_bounds__(NTHR) mega(Params p, int ph_lo, int ph_hi) {
    extern __shared__ __attribute__((aligned(16))) char lds_raw[];
    LAS char* lds = (LAS char*)lds_raw;
    cg::grid_group grid = cg::this_grid();
    volatile LAS unsigned* misc = (volatile LAS unsigned*)(lds + LDS_BYTES - 64);
    if (threadIdx.x < 16) misc[threadIdx.x] = 0u;
    __syncthreads();
    const XcdBarrier bar = xcd_barrier_post((unsigned*)(p.ws + WS_BAR), misc);
#define PHASE(k) if (ph_lo <= (k) && (k) < ph_hi) for (int rep_ = 0; rep_ < ((k) == REP_PHASE ? 2 : 1); ++rep_)
#define SEAM(k) if (ph_lo <= (k) && (k) + 1 < ph_hi) { xcd_barrier(bar); }
    if (ph_hi > 1000) grid.sync();
    PHASE(0) { phase_prep(p, lds); }
    PHASE(16) { phase_prep_w(p, lds); }
    PHASE(17) { phase_prep_s(p, lds); }
    SEAM(0);
    PHASE(1) {
        const ELat el{PF(WS_SSX), PH(WS_LAT), rep_ ? nullptr : PF(WS_SSQ), PF(WS_SSKV)};
        pg_gemm<EInProj, false>(lds, PH(WS_XH), PH(WS_WIN), T, 1024, D, EInProj{PF(WS_SSX), PH(WS_HYT), el, 0});
        pg_gemm<EInProj, false>(lds, PH(WS_XH), PH(WS_WIN) + (size_t)1024 * D, T, 1024, D, EInProj{PF(WS_SSX), PH(WS_HYT), el, 4});
    }
    SEAM(1);
    PHASE(2) {
        gemm_job<true>(lds, PH(WS_LAT), LAT, PH(WS_WUQ), 256, T, 768, 256, EQ{PF(WS_SSQ), PF(WS_ROPE), PH(WS_Q)});
        gemm_job<true>(lds, PH(WS_LAT) + 256, LAT, PH(WS_WUKV), 128, T, 512, 128, EK{PF(WS_SSKV), PH(WS_K)}, 128);
        gemm_job<false>(lds, PH(WS_LAT) + 256, LAT, PH(WS_WUKV) + (size_t)512 * 128, 128, T, 512, 128, EV{PF(WS_SSKV), PH(WS_VT)}, 128);
        phase_krot(p);
    }
    PHASE(15) { phase_filt3(p, lds); }
    SEAM(2);
    PHASE(3) { phase_attn(p, lds); }
    PHASE(13) { phase_hyena(p, lds); }
    SEAM(3);
    PHASE(4) { phase_mixprep(p, lds); }
    PHASE(14) {
        gemm_job<true>(lds, PH(WS_MEMH), D, PH(WS_WMKV), D, MROWS, 1024, D, EKc{PF(WS_SSMEM), PH(WS_KC)});
        gemm_job<false>(lds, PH(WS_MEMH), D, PH(WS_WMKV) + (size_t)1024 * D, D, MROWS, 1024, D, EVc{PF(WS_SSMEM), PH(WS_VCT)}, 32);
    }
    SEAM(4);
    PHASE(5) { pg_gemm<PgRow<ERes>, false>(lds, PH(WS_MIX), PH(WS_WOUT), T, D, D, PgRow<ERes>{ERes{p.in[0], p.X, PH(WS_X1H), rep_ ? nullptr : PF(WS_SSX1)}}); }
    SEAM(5);
    PHASE(6) { pg_gemm<PgRow<EMq>, false>(lds, PH(WS_X1H), PH(WS_WMQ), T, D, D, PgRow<EMq>{EMq{PF(WS_SSX1), PH(WS_QC)}}); }
    SEAM(6);
    PHASE(7) { phase_xattn(p, lds); }
    SEAM(7);
    PHASE(8) { pg_gemm<PgRow<ERes>, false>(lds, PH(WS_OC), PH(WS_WMO), T, D, D, PgRow<ERes>{ERes{p.X, p.X, PH(WS_X2H), nullptr}}); }
    SEAM(8);
    PHASE(9) { phase_route(p, lds, rep_ != 0); }
    SEAM(9);
    PHASE(10) { phase_moe<false>(p, lds); }
    SEAM(10);
    PHASE(11) { phase_moe<true>(p, lds); }
    SEAM(11);
    PHASE(12) { phase_final(p); }
}

extern "C" void kernel_launch(void* const* d_in, const int* in_sizes, int n_in, void* d_out, int out_size, void* d_ws, size_t ws_size, hipStream_t st) {
    Params p{};
    for (int i = 0; i < 36; ++i) p.in[i] = (const float*)d_in[i];
    p.X = (float*)d_out; p.ws = (char*)d_ws;
    static int grid = 0;
    if (!grid) {
        (void)hipFuncSetAttribute((const void*)mega, hipFuncAttributeMaxDynamicSharedMemorySize, LDS_BYTES);
        int dev = 0, cus = 0, per_cu = 0;
        (void)hipGetDevice(&dev);
        (void)hipDeviceGetAttribute(&cus, hipDeviceAttributeMultiprocessorCount, dev);
        (void)hipOccupancyMaxActiveBlocksPerMultiprocessor(&per_cu, (const void*)mega, NTHR, LDS_BYTES);
        if (per_cu < 1) { fprintf(stderr, "kernel_launch: occupancy query says %d blocks/CU\n", per_cu); per_cu = 1; }
        grid = cus;
    }
    (void)hipMemsetAsync((char*)d_ws + WS_CTL, 0, 32 * 1024, st);
    int lo = 0, hi = 18;
    void* args[] = {&p, &lo, &hi};
    hipError_t e = hipLaunchCooperativeKernel((const void*)mega, dim3(grid), dim3(NTHR), args, LDS_BYTES, st);
    if (e != hipSuccess) fprintf(stderr, "cooperative launch failed: %s (grid %d)\n", hipGetErrorString(e), grid);
    (void)in_sizes; (void)n_in; (void)out_size; (void)ws_size;
}
```

```cpp
#include <hip/hip_runtime.h>
#include <cstdint>
#include <cstdio>
#include <hip/hip_cooperative_groups.h>
namespace cg = cooperative_groups;
typedef _Float16 h16;

constexpr int NB = 4, S = 4096, D = 1024, T = NB * S, MEMT = 256, MROWS = NB * MEMT;
constexpr int NH = 8, HYW = 512;
constexpr int LAT = 416, INC = 1952;
constexpr int MH = 4, MHD = 256;
constexpr int NE = 32, DE = 256;
constexpr float EPS = 1e-6f;
constexpr float LOG2E = 1.4426950408889634f;
constexpr float QSCALE = 0.10206207261596575f * LOG2E;
constexpr float CSCALE = 0.0625f * LOG2E;

constexpr size_t MiB = 1u << 20;
constexpr size_t WS_CTL = 0;
constexpr size_t WS_SSX = 64 * 1024, WS_SSQ = 128 * 1024, WS_SSKV = 192 * 1024, WS_SSA = 256 * 1024, WS_SSH = 320 * 1024,
                 WS_SSX1 = 384 * 1024, WS_SSX2 = 448 * 1024, WS_SSMEM = 512 * 1024, WS_TOKE = 576 * 1024, WS_TOKW = 704 * 1024,
                 WS_TOKP = 832 * 1024;
constexpr size_t WS_WIN = 2 * MiB, WS_WUQ = 6 * MiB, WS_WUKV = 6 * MiB + 512 * 1024, WS_WOUT = 7 * MiB, WS_WMQ = 9 * MiB,
                 WS_WMKV = 11 * MiB, WS_WMO = 15 * MiB, WS_MEMH = 17 * MiB, WS_KC = 19 * MiB, WS_VCT = 21 * MiB, WS_R = 23 * MiB,
                 WS_WGU = 39 * MiB, WS_WDN = 71 * MiB, WS_LAT = 87 * MiB, WS_HYT = 101 * MiB, WS_XH = 149 * MiB, WS_Q = 149 * MiB,
                 WS_K = 173 * MiB, WS_VT = 197 * MiB, WS_AOUT = 213 * MiB, WS_HT = 229 * MiB, WS_LIST = 245 * MiB, WS_H2 = 247 * MiB;
constexpr size_t WS_OC = 183 * MiB, WS_BAR = 16 * 1024;
constexpr size_t WS_MIX = 87 * MiB, WS_X1H = 119 * MiB, WS_QC = 151 * MiB, WS_X2H = 87 * MiB, WS_HB = 119 * MiB, WS_YB = 135 * MiB;

__device__ __forceinline__ float wave_sum(float v) {
#pragma unroll
    for (int o = 1; o < 64; o <<= 1) v += __shfl_xor(v, o);
    return v;
}
__device__ __forceinline__ float rstd_of(float ss, int n) { return 1.0f / sqrtf(ss / (float)n + EPS); }

#define LAS __attribute__((address_space(3)))
typedef _Float16 h16x8 __attribute__((ext_vector_type(8)));
typedef _Float16 h16x4 __attribute__((ext_vector_type(4)));
typedef _Float16 h16x2 __attribute__((ext_vector_type(2)));
typedef float f32x4 __attribute__((ext_vector_type(4)));
typedef float f32x16 __attribute__((ext_vector_type(16)));
constexpr int NTHR = 512, NWAVE = 8;
constexpr int LDS_BYTES = 150 * 1024;
constexpr size_t WS_ROPE = 248 * MiB;
constexpr float HY_FSCALE = 256.f, HY_FINV = 1.f / 256.f;

struct Params {
    const float* in[36]; float* X; char* ws;
};
#define PF(off) ((float*)(p.ws + (off)))
#define PH(off) ((h16*)(p.ws + (off)))
#define PI(off) ((int*)(p.ws + (off)))

constexpr int G_BM = 256, G_BN = 128, G_BK = 64, G_AB = G_BM * G_BK * 2, G_BB = G_BN * G_BK * 2, G_STAGE = G_AB + G_BB;
static_assert(3 * G_STAGE <= LDS_BYTES, "lds");
__device__ __forceinline__ void glds16(const void* g, LAS char* l) { __builtin_amdgcn_global_load_lds((const unsigned*)g, (LAS unsigned*)l, 16, 0, 0); }

template <bool SWAP, class RowPtr, class Epi, int DBG = 0>
__device__ __forceinline__ void gemm_tile(LAS char* lds, const RowPtr& rowptr, const h16* __restrict__ Wt, int ldw, int K, int m0, int n0, const Epi& epi) {
    const int tid = threadIdx.x, lane = tid & 63, wid = __builtin_amdgcn_readfirstlane(tid >> 6);
    const int wm = wid >> 1, wn = wid & 1, fr = lane & 15, fq = lane >> 4;
    const h16* asrc[4]; const h16* bsrc[2];
#pragma unroll
    for (int i = 0; i < 4; ++i) { const int r = wid * 32 + i * 8 + (lane >> 3); const int ch = (lane & 7) ^ ((r >> 1) & 7); asrc[i] = rowptr(m0 + r) + ch * 8; }
#pragma unroll
    for (int i = 0; i < 2; ++i) { const int r = wid * 16 + i * 8 + (lane >> 3); const int ch = (lane & 7) ^ ((r >> 1) & 7); bsrc[i] = Wt + (size_t)(n0 + r) * ldw + ch * 8; }
    const int sw = fr >> 1;
    const int aoff = (wm * 64 + fr) * 128 + ((fq ^ sw) * 16);
    const int boff = G_AB + (wn * 64 + fr) * 128 + ((fq ^ sw) * 16);
    f32x4 acc[4][4];
#pragma unroll
    for (int i = 0; i < 4; ++i)
#pragma unroll
        for (int j = 0; j < 4; ++j) acc[i][j] = (f32x4){0.f, 0.f, 0.f, 0.f};
    const int nt = K / G_BK;
    asm volatile("s_waitcnt vmcnt(0)" ::: "memory");
#define G_STAGE_ISSUE(buf, kt) do { if (DBG == 2) break; LAS char* sa_ = lds + (buf) * G_STAGE + wid * 4096; \
        _Pragma("unroll") for (int i_ = 0; i_ < 4; ++i_) glds16(asrc[i_] + (kt) * G_BK, sa_ + i_ * 1024); \
        LAS char* sb_ = lds + (buf) * G_STAGE + G_AB + wid * 2048; \
        _Pragma("unroll") for (int i_ = 0; i_ < 2; ++i_) glds16(bsrc[i_] + (kt) * G_BK, sb_ + i_ * 1024); } while (0)
#define G_LDF(FA, FB, base_, kk_) do { _Pragma("unroll") for (int i_ = 0; i_ < 4; ++i_) { FA[i_] = *(LAS h16x8*)((base_) + ((aoff ^ ((kk_) * 64)) + i_ * 2048)); FB[i_] = *(LAS h16x8*)((base_) + ((boff ^ ((kk_) * 64)) + i_ * 2048)); } } while (0)
#define G_MMA(FA, FB) do { if (DBG == 1) { _Pragma("unroll") for (int i_ = 0; i_ < 4; ++i_) asm volatile("" :: "v"(FA[i_]), "v"(FB[i_])); break; } _Pragma("unroll") for (int i_ = 0; i_ < 4; ++i_) _Pragma("unroll") for (int j_ = 0; j_ < 4; ++j_) \
        acc[i_][j_] = SWAP ? __builtin_amdgcn_mfma_f32_16x16x32_f16(FB[j_], FA[i_], acc[i_][j_], 0, 0, 0) : __builtin_amdgcn_mfma_f32_16x16x32_f16(FA[i_], FB[j_], acc[i_][j_], 0, 0, 0); } while (0)
    G_STAGE_ISSUE(0, 0);
    if (nt > 1) G_STAGE_ISSUE(1, 1);
    if (nt > 2) G_STAGE_ISSUE(2, 2);
    if (nt > 2) asm volatile("s_waitcnt vmcnt(12)" ::: "memory"); else if (nt > 1) asm volatile("s_waitcnt vmcnt(6)" ::: "memory"); else asm volatile("s_waitcnt vmcnt(0)" ::: "memory");
    __builtin_amdgcn_s_barrier();
    h16x8 xa[4], xb[4], ya[4], yb[4];
    G_LDF(xa, xb, lds, 0);
    int buf = 0;
    for (int t = 0; t < nt; ++t) {
        LAS char* base = lds + buf * G_STAGE;
        const int nbuf = buf == 2 ? 0 : buf + 1;
        G_LDF(ya, yb, base, 1);
        __builtin_amdgcn_sched_barrier(0);
        G_MMA(xa, xb);
        __builtin_amdgcn_sched_barrier(0);
        asm volatile("s_waitcnt lgkmcnt(0)" ::: "memory");
        if (t + 1 < nt) {
            if (t + 2 < nt) asm volatile("s_waitcnt vmcnt(6)" ::: "memory"); else asm volatile("s_waitcnt vmcnt(0)" ::: "memory");
            __builtin_amdgcn_s_barrier();
            if (t + 3 < nt) G_STAGE_ISSUE(buf, t + 3);
            G_LDF(xa, xb, lds + nbuf * G_STAGE, 0);
        }
        __builtin_amdgcn_sched_barrier(0);
        G_MMA(ya, yb);
        __builtin_amdgcn_sched_barrier(0);
        buf = nbuf;
    }
#undef G_STAGE_ISSUE
#undef G_LDF
#undef G_MMA
    __builtin_amdgcn_s_barrier();
    if constexpr (SWAP) {
#pragma unroll
        for (int i = 0; i < 4; ++i)
#pragma unroll
            for (int jp = 0; jp < 2; ++jp) epi.row32(m0 + wm * 64 + i * 16 + fr, n0 + wn * 64 + jp * 32 + fq * 4, acc[i][2 * jp], acc[i][2 * jp + 1]);
    } else {
#pragma unroll
        for (int i = 0; i < 4; ++i)
#pragma unroll
            for (int j = 0; j < 4; ++j) epi.col4(m0 + wm * 64 + i * 16 + fq * 4, n0 + wn * 64 + j * 16 + fr, acc[i][j]);
    }
}
struct ENull { __device__ __forceinline__ void row32(int, int, f32x4 va, f32x4 vb) const { asm volatile("" :: "v"(va), "v"(vb)); } };
struct RowDense { const h16* A; int lda; __device__ __forceinline__ const h16* operator()(int m) const { return A + (size_t)m * lda; } };

__device__ __forceinline__ h16x4 cvt4(f32x4 v) { return (h16x4){(h16)v[0], (h16)v[1], (h16)v[2], (h16)v[3]}; }
__device__ __forceinline__ float rowgrp_sum(float v) { v += __shfl_xor(v, 16); v += __shfl_xor(v, 32); return v; }

struct EHy {
    const float* ssx; h16* hyT;
    __device__ __forceinline__ void col4(int mr, int n, f32x4 v) const {
        const f32x4 ss = *(const f32x4*)(ssx + mr);
        v[0] *= rstd_of(ss[0], D); v[1] *= rstd_of(ss[1], D); v[2] *= rstd_of(ss[2], D); v[3] *= rstd_of(ss[3], D);
        const int b = mr >> 12, t = mr & 4095;
        *(h16x4*)(hyT + ((size_t)(b * 1536 + n)) * S + t) = cvt4(v);
    } };
struct ELat {
    const float* ssx; h16* lat; float* ssq; float* sskv;
    __device__ __forceinline__ void row32(int m, int nb, f32x4 va, f32x4 vb) const {
        const float r = rstd_of(ssx[m], D); va *= r; vb *= r;
        if (nb < LAT) { *(h16x4*)(lat + (size_t)m * LAT + nb) = cvt4(va); *(h16x4*)(lat + (size_t)m * LAT + nb + 16) = cvt4(vb); }
        float s = va[0] * va[0] + va[1] * va[1] + va[2] * va[2] + va[3] * va[3] + vb[0] * vb[0] + vb[1] * vb[1] + vb[2] * vb[2] + vb[3] * vb[3];
        s = rowgrp_sum(s);
        if (ssq && (threadIdx.x & 63) < 16 && nb < 384) atomicAdd((nb < 256 ? ssq : sskv) + m, s);
    } };
struct EQ {
    const float* ssq; const float* rope; h16* Q;
    __device__ __forceinline__ void row32(int m, int nb, f32x4 va, f32x4 vb) const {
        const float r = rstd_of(ssq[m], 256) * QSCALE; va *= r; vb *= r;
        const int b = m >> 12, t = m & 4095, blk = nb >> 5, h = blk / 3, part = blk - 3 * h, c = nb & 31;
        if (part == 2) {
            const float* rp = rope + ((size_t)t * 16 + c) * 2;
#pragma unroll
            for (int j = 0; j < 4; ++j) { const float cs = rp[2 * j], sn = rp[2 * j + 1]; const float q1 = va[j], q2 = vb[j]; va[j] = q1 * cs - q2 * sn; vb[j] = q1 * sn + q2 * cs; }
        }
        h16* q = Q + ((size_t)((b * NH + h) * S + t)) * 96 + part * 32 + c;
        *(h16x4*)q = cvt4(va); *(h16x4*)(q + 16) = cvt4(vb);
    } };
struct EK {
    const float* sskv; h16* K;
    __device__ __forceinline__ void row32(int m, int nb, f32x4 va, f32x4 vb) const {
        const float r = rstd_of(sskv[m], 128); va *= r; vb *= r;
        const int b = m >> 12, t = m & 4095, h = nb >> 6, j = nb & 63;
        h16* k = K + ((size_t)((b * NH + h) * S + t)) * 96 + j;
        *(h16x4*)k = cvt4(va); *(h16x4*)(k + 16) = cvt4(vb);
    } };
struct EV {
    const float* sskv; h16* Vt;
    __device__ __forceinline__ void col4(int mr, int n, f32x4 v) const {
        const f32x4 ss = *(const f32x4*)(sskv + mr);
        v[0] *= rstd_of(ss[0], 128); v[1] *= rstd_of(ss[1], 128); v[2] *= rstd_of(ss[2], 128); v[3] *= rstd_of(ss[3], 128);
        const int b = mr >> 12, t = mr & 4095;
        *(h16x4*)(Vt + ((size_t)(b * 512 + n)) * S + t) = cvt4(v);
    } };
struct EKc {
    const float* ss; h16* Kc;
    __device__ __forceinline__ void row32(int m, int nb, f32x4 va, f32x4 vb) const {
        const float r = rstd_of(ss[m], D); va *= r; vb *= r;
        *(h16x4*)(Kc + (size_t)m * D + nb) = cvt4(va); *(h16x4*)(Kc + (size_t)m * D + nb + 16) = cvt4(vb);
    } };
struct EVc {
    const float* ss; h16* VcT;
    __device__ __forceinline__ void col4(int mr, int n, f32x4 v) const {
        const f32x4 s4 = *(const f32x4*)(ss + mr);
        v[0] *= rstd_of(s4[0], D); v[1] *= rstd_of(s4[1], D); v[2] *= rstd_of(s4[2], D); v[3] *= rstd_of(s4[3], D);
        const int b = mr >> 8, mm = mr & 255;
        *(h16x4*)(VcT + ((size_t)(b * 1024 + n)) * MEMT + mm) = cvt4(v);
    } };
struct ERes {
    const float* xin; float* X; h16* xh; float* ss;
    __device__ __forceinline__ void row32(int m, int nb, f32x4 va, f32x4 vb) const {
        const size_t i = (size_t)m * D + nb;
        va += *(const f32x4*)(xin + i); vb += *(const f32x4*)(xin + i + 16);
        *(f32x4*)(X + i) = va; *(f32x4*)(X + i + 16) = vb;
        *(h16x4*)(xh + i) = cvt4(va); *(h16x4*)(xh + i + 16) = cvt4(vb);
        float s = va[0] * va[0] + va[1] * va[1] + va[2] * va[2] + va[3] * va[3] + vb[0] * vb[0] + vb[1] * vb[1] + vb[2] * vb[2] + vb[3] * vb[3];
        s = rowgrp_sum(s);
        if (ss && (threadIdx.x & 63) < 16) atomicAdd(ss + m, s);
    } };
struct EMq {
    const float* ss; h16* qc;
    __device__ __forceinline__ void row32(int m, int nb, f32x4 va, f32x4 vb) const {
        const float r = rstd_of(ss[m], D) * CSCALE; va *= r; vb *= r;
        *(h16x4*)(qc + (size_t)m * D + nb) = cvt4(va); *(h16x4*)(qc + (size_t)m * D + nb + 16) = cvt4(vb);
    } };


namespace pg8 {
#define PG8_LAS __attribute__((address_space(3)))
typedef unsigned short bf16_t;
typedef short bf16x8 __attribute__((ext_vector_type(8)));
constexpr int BM = 256, BK = 64, HALF = 128, HTB = HALF * BK * 2  , STAGE_BYTES = 8 * HTB, NXCD = 8, WGM = 8;

__host__ __device__ __forceinline__ int lds_byte(int r, int c) { const int st = (r >> 4) * 2 + (c >> 5), rr = r & 15, cc = c & 31, ob = rr * 64 + cc * 2; return st * 1024 + (ob ^ (((ob >> 9) & 1) << 5)); }
__host__ __device__ __forceinline__ void stage_rc(int b, int& R, int& C) { const int st = b / 1024, sb = b % 1024, swz = sb ^ (((sb >> 9) & 1) << 5); R = (st >> 1) * 16 + swz / 64; C = (st & 1) * 32 + (swz % 64) / 2; }
__host__ __device__ __forceinline__ int perm32(int rho) { const int n = rho >> 4, i = rho & 15; return 8 * (i >> 2) + 4 * n + (i & 3); }

struct Unit { int pm, pn; };
struct Gemm { const bf16_t* A; const bf16_t* Bt; int M, N, K; };

struct StaticOrder {
    int nM, nN, nwg, G, c;
    __host__ __device__ void init(int M, int N, int G_, int c_) { nM = M / BM; nN = N / BM; nwg = nM * nN; G = G_; c = c_; }
    __host__ __device__ bool next(int i, Unit& u) const {
        const long L = (long)i * G + c; if (L >= nwg) return false;
        int wgid = (int)L; { const int q = nwg / NXCD, r = nwg % NXCD, xcd = wgid % NXCD, off = wgid / NXCD; wgid = (xcd < r ? xcd * (q + 1) : r * (q + 1) + (xcd - r) * q) + off; }
        const int nig = WGM * nN, gid = wgid / nig, fm = gid * WGM, gsz = (nM - fm) < WGM ? (nM - fm) : WGM;
        u.pm = fm + ((wgid % nig) % gsz); u.pn = (wgid % nig) / gsz; return true;
    }
    __device__ __forceinline__ void a_ready(const Unit&) const {}
    __device__ __forceinline__ void done(const Unit&) const {}
};

template <class Epi, class Sched, bool ALIGN_EPI = false, bool SP2 = false>
__device__ __forceinline__ void gemm_phase(PG8_LAS unsigned char* lds, const Gemm g, const Sched& S, const Epi& E) {
    const int tid = threadIdx.x, wid = __builtin_amdgcn_readfirstlane(tid >> 6), lane = tid & 63, wr = wid >> 2, wc = wid & 3, fr = lane & 15, fq = lane >> 4;
    const int K = g.K, nt = K / BK;
    unsigned voffA[2], voffB[2];
#pragma unroll
    for (int i = 0; i < 2; ++i) { int R, C; stage_rc(tid * 16 + i * 8192, R, C); const int Rb = Epi::PERM ? ((R & ~31) + perm32(R & 31)) : R;
        voffA[i] = (unsigned)(R * K + C) * 2u; voffB[i] = (unsigned)(Rb * K + C) * 2u; }
    const size_t kstep = (size_t)(BK * 2);
    const size_t hstep = (size_t)HALF * K * 2;
    const size_t tstep = 2 * hstep;
    const unsigned ldsw = (unsigned)wid * 1024u;
    const int aoff = lds_byte(wr * 64 + fr, fq * 8), boff = lds_byte(wc * 32 + fr, fq * 8);
#define PG8_SA(b, h) (((b) * 2 + (h)) * HTB)
#define PG8_SB(b, h) ((4 + (b) * 2 + (h)) * HTB)
#define PG8_STAGE(bufoff, gbase, voff) do { _Pragma("unroll") for (int _i = 0; _i < 2; ++_i) \
        __builtin_amdgcn_global_load_lds((const unsigned*)((const char*)(gbase) + (voff)[_i]), (PG8_LAS unsigned*)(lds + (bufoff) + ldsw + _i * 8192), 16, 0, 0); } while (0)
#define PG8_LDA(dst, b, h) do { _Pragma("unroll") for (int m = 0; m < 4; ++m) _Pragma("unroll") for (int k = 0; k < 2; ++k) dst[m][k] = *(const PG8_LAS bf16x8*)(lds + PG8_SA(b, h) + aoff + m * 2048 + k * 1024); } while (0)
#define PG8_LDB(dst, b, h) do { _Pragma("unroll") for (int n = 0; n < 2; ++n) _Pragma("unroll") for (int k = 0; k < 2; ++k) dst[n][k] = *(const PG8_LAS bf16x8*)(lds + PG8_SB(b, h) + boff + n * 2048 + k * 1024); } while (0)
#define PG8_MMA(ai, bj, At, Bt) do { __builtin_amdgcn_s_setprio(1); _Pragma("unroll") for (int m = 0; m < 4; ++m) _Pragma("unroll") for (int n = 0; n < 2; ++n) _Pragma("unroll") for (int k = 0; k < 2; ++k) \
        acc[ai][bj][m][n] = __builtin_amdgcn_mfma_f32_16x16x32_f16(__builtin_bit_cast(h16x8, Bt[n][k]), __builtin_bit_cast(h16x8, At[m][k]), acc[ai][bj][m][n], 0, 0, 0); __builtin_amdgcn_s_setprio(0); } while (0)
#define PG8_WAIT_V(n) asm volatile("s_waitcnt vmcnt(" #n ")" ::: "memory")
#define PG8_WAIT_L(n) asm volatile("s_waitcnt lgkmcnt(" #n ")" ::: "memory")
#define PG8_BAR __builtin_amdgcn_s_barrier()
#define PG8_SCHED __builtin_amdgcn_sched_barrier(0)
    Unit cur, nxt; int ui = 0;
    if (!S.next(0, cur)) return;
    f32x4 acc[2][2][4][2];
#pragma unroll
    for (int a = 0; a < 2; ++a)
#pragma unroll
        for (int b = 0; b < 2; ++b)
#pragma unroll
            for (int m = 0; m < 4; ++m)
#pragma unroll
                for (int n = 0; n < 2; ++n) acc[a][b][m][n] = (f32x4){0.f, 0.f, 0.f, 0.f};
    bf16x8 At[4][2], B0[2][2], B1[2][2];
    const char* cA = (const char*)g.A + (size_t)cur.pm * tstep; const char* cB = (const char*)g.Bt + (size_t)cur.pn * tstep;
    S.a_ready(cur);
    if constexpr (SP2) {
        PG8_STAGE(PG8_SB(0, 0), cB, voffB); PG8_STAGE(PG8_SB(0, 1), cB + hstep, voffB); PG8_STAGE(PG8_SA(0, 0), cA, voffA); PG8_STAGE(PG8_SA(0, 1), cA + hstep, voffA);
        if (wr == 1) PG8_BAR;
        PG8_WAIT_V(2); PG8_BAR;
        PG8_STAGE(PG8_SB(1, 0), cB + kstep, voffB); PG8_STAGE(PG8_SA(1, 0), cA + kstep, voffA); PG8_STAGE(PG8_SB(1, 1), cB + hstep + kstep, voffB);
        PG8_WAIT_V(6); PG8_BAR;
    } else {
        PG8_STAGE(PG8_SB(0, 0), cB, voffB); PG8_STAGE(PG8_SA(0, 0), cA, voffA); PG8_STAGE(PG8_SB(0, 1), cB + hstep, voffB); PG8_STAGE(PG8_SA(0, 1), cA + hstep, voffA);
        if (wr == 1) PG8_BAR;
        PG8_WAIT_V(4); PG8_BAR;
        PG8_STAGE(PG8_SB(1, 0), cB + kstep, voffB); PG8_STAGE(PG8_SA(1, 0), cA + kstep, voffA); PG8_STAGE(PG8_SB(1, 1), cB + hstep + kstep, voffB);
        PG8_WAIT_V(6); PG8_BAR;
    }
    for (;;) {
        const bool has_next = S.next(ui + 1, nxt);
        const char* nA = has_next ? (const char*)g.A + (size_t)nxt.pm * tstep : cA; const char* nB = has_next ? (const char*)g.Bt + (size_t)nxt.pn * tstep : cB;
        for (int t = 0; t < nt; t += 2) {
            const bool last = (t == nt - 2);
            const char* a1 = cA + (size_t)(t + 1) * kstep;
            const char* a2 = last ? nA : cA + (size_t)(t + 2) * kstep; const char* b2 = last ? nB : cB + (size_t)(t + 2) * kstep;
            const char* a3 = a2 + kstep; const char* b3 = b2 + kstep;
            if (last && has_next) S.a_ready(nxt);
            if constexpr (SP2) {
            PG8_LDB(B0, 0, 0); PG8_LDB(B1, 0, 1); PG8_SCHED; PG8_LDA(At, 0, 0); PG8_STAGE(PG8_SA(1, 1), a1 + hstep, voffA);
            PG8_WAIT_V(8); PG8_WAIT_L(0); PG8_BAR; PG8_MMA(0, 0, At, B0); PG8_MMA(0, 1, At, B1); PG8_BAR; PG8_SCHED;
            PG8_LDA(At, 0, 1); PG8_STAGE(PG8_SB(0, 0), b2, voffB); PG8_STAGE(PG8_SB(0, 1), b2 + hstep, voffB); PG8_STAGE(PG8_SA(0, 0), a2, voffA);
            PG8_WAIT_V(8); PG8_WAIT_L(0); PG8_BAR; PG8_MMA(1, 0, At, B0); PG8_MMA(1, 1, At, B1); PG8_BAR; PG8_SCHED;
            PG8_LDB(B0, 1, 0); PG8_LDB(B1, 1, 1); PG8_SCHED; PG8_LDA(At, 1, 0); PG8_STAGE(PG8_SA(0, 1), a2 + hstep, voffA);
            PG8_WAIT_V(8); PG8_WAIT_L(0); PG8_BAR; PG8_MMA(0, 0, At, B0); PG8_MMA(0, 1, At, B1); PG8_BAR; PG8_SCHED;
            PG8_LDA(At, 1, 1); PG8_STAGE(PG8_SB(1, 0), b3, voffB); PG8_STAGE(PG8_SB(1, 1), b3 + hstep, voffB); PG8_STAGE(PG8_SA(1, 0), a3, voffA);
            PG8_WAIT_V(8); PG8_WAIT_L(0); PG8_BAR; PG8_MMA(1, 0, At, B0); PG8_MMA(1, 1, At, B1); PG8_BAR; PG8_SCHED;
            } else {
            PG8_LDB(B0, 0, 0); PG8_SCHED; PG8_LDA(At, 0, 0); PG8_STAGE(PG8_SA(1, 1), a1 + hstep, voffA);
            PG8_WAIT_L(8); PG8_BAR; PG8_WAIT_L(0); PG8_MMA(0, 0, At, B0); PG8_BAR; PG8_SCHED;
            PG8_LDB(B1, 0, 1); PG8_STAGE(PG8_SB(0, 0), b2, voffB);
            PG8_BAR; PG8_WAIT_L(0); PG8_MMA(0, 1, At, B1); PG8_BAR;
            PG8_LDA(At, 0, 1); PG8_STAGE(PG8_SA(0, 0), a2, voffA);
            PG8_BAR; PG8_WAIT_L(0); PG8_MMA(1, 0, At, B0); PG8_BAR; PG8_SCHED;
            PG8_STAGE(PG8_SB(0, 1), b2 + hstep, voffB);
            PG8_WAIT_V(6); PG8_BAR; PG8_MMA(1, 1, At, B1); PG8_BAR;
            PG8_LDB(B0, 1, 0); PG8_SCHED; PG8_LDA(At, 1, 0); PG8_STAGE(PG8_SA(0, 1), a2 + hstep, voffA);
            PG8_WAIT_L(8); PG8_BAR; PG8_WAIT_L(0); PG8_MMA(0, 0, At, B0); PG8_BAR; PG8_SCHED;
            PG8_LDB(B1, 1, 1); PG8_STAGE(PG8_SB(1, 0), b3, voffB);
            PG8_BAR; PG8_WAIT_L(0); PG8_MMA(0, 1, At, B1); PG8_BAR;
            PG8_LDA(At, 1, 1); PG8_STAGE(PG8_SA(1, 0), a3, voffA);
            PG8_BAR; PG8_WAIT_L(0); PG8_MMA(1, 0, At, B0); PG8_BAR; PG8_SCHED;
            PG8_STAGE(PG8_SB(1, 1), b3 + hstep, voffB);
            PG8_WAIT_V(6); PG8_BAR; PG8_MMA(1, 1, At, B1); PG8_BAR;
            }
        }
        if constexpr (ALIGN_EPI) { if (wr == 0) PG8_BAR; }
        if constexpr (!Epi::AFTER_DRAIN) { E(acc, cur, wr, wc, fr, fq); S.done(cur); }
        if (!has_next) break;
#pragma unroll
        for (int a = 0; a < 2; ++a)
#pragma unroll
            for (int b = 0; b < 2; ++b)
#pragma unroll
                for (int m = 0; m < 4; ++m)
#pragma unroll
                    for (int n = 0; n < 2; ++n) acc[a][b][m][n] = (f32x4){0.f, 0.f, 0.f, 0.f};
        cur = nxt; cA = nA; cB = nB; ++ui;
        if constexpr (ALIGN_EPI) { if (wr == 1) PG8_BAR; }
    }
    PG8_WAIT_V(0);
    if constexpr (!ALIGN_EPI) { if (wr == 0) PG8_BAR; }
    PG8_BAR;
    if constexpr (Epi::AFTER_DRAIN) { E.fused(acc, cur, wr, wc, fr, fq, lds, wid, lane); S.done(cur); }
#undef PG8_SA
#undef PG8_SB
#undef PG8_STAGE
#undef PG8_LDA
#undef PG8_LDB
#undef PG8_MMA
#undef PG8_WAIT_V
#undef PG8_WAIT_L
#undef PG8_BAR
#undef PG8_SCHED
}
}
template <class F> struct PgRow {
    static constexpr bool PERM = false, AFTER_DRAIN = false; F f;
    __device__ __forceinline__ void operator()(const f32x4 (&acc)[2][2][4][2], const pg8::Unit& u, int wr, int wc, int fr, int fq) const {
#pragma unroll
        for (int ai = 0; ai < 2; ++ai)
#pragma unroll
            for (int m = 0; m < 4; ++m) { const int row = u.pm * 256 + ai * 128 + wr * 64 + m * 16 + fr;
#pragma unroll
                for (int bj = 0; bj < 2; ++bj) f.row32(row, u.pn * 256 + bj * 128 + wc * 32 + fq * 4, acc[ai][bj][m][0], acc[ai][bj][m][1]); }
    } };
struct EInProj {
    static constexpr bool PERM = false, AFTER_DRAIN = true;
    const float* ssx; h16* hyT; ELat lat; int pn_off;
    __device__ __forceinline__ void fused(f32x4 (&acc)[2][2][4][2], const pg8::Unit& u0, int wr, int wc, int fr, int fq, PG8_LAS unsigned char* ldsb, int wid, int lane) const {
        pg8::Unit u = u0; u.pn += pn_off;
        if (u.pn >= 6) {
#pragma unroll
            for (int ai = 0; ai < 2; ++ai)
#pragma unroll
                for (int m = 0; m < 4; ++m) { const int row = u.pm * 256 + ai * 128 + wr * 64 + m * 16 + fr;
#pragma unroll
                    for (int bj = 0; bj < 2; ++bj) lat.row32(row, (u.pn - 6) * 256 + bj * 128 + wc * 32 + fq * 4, acc[ai][bj][m][0], acc[ai][bj][m][1]); }
            return;
        }
        constexpr int TP = 264;
        LAS h16* tile = (LAS h16*)ldsb;
#pragma unroll
        for (int ai = 0; ai < 2; ++ai)
#pragma unroll
            for (int m = 0; m < 4; ++m) { const int rl = ai * 128 + wr * 64 + m * 16 + fr; const float rs = rstd_of(ssx[u.pm * 256 + rl], D);
#pragma unroll
                for (int bj = 0; bj < 2; ++bj)
#pragma unroll
                    for (int n = 0; n < 2; ++n)
#pragma unroll
                        for (int j = 0; j < 4; ++j) tile[(bj * 128 + wc * 32 + n * 16 + fq * 4 + j) * TP + rl] = (h16)(acc[ai][bj][m][n][j] * rs); }
        asm volatile("s_waitcnt lgkmcnt(0)" ::: "memory"); __builtin_amdgcn_s_barrier(); asm volatile("" ::: "memory");
        const int row0 = u.pm * 256, b = row0 >> 12, t0 = row0 & 4095, tid = wid * 64 + lane;
#pragma unroll
        for (int i = 0; i < 16; ++i) { const int idx = tid + 512 * i, ch = idx >> 5, c8 = idx & 31;
            *(h16x8*)(hyT + ((size_t)(b * 1536 + u.pn * 256 + ch)) * S + t0 + c8 * 8) = *(LAS h16x8*)(tile + ch * TP + c8 * 8); }
        asm volatile("s_waitcnt lgkmcnt(0)" ::: "memory"); __builtin_amdgcn_s_barrier(); asm volatile("" ::: "memory");
    } };
template <class Epi, bool ALIGN>
__device__ __forceinline__ void pg_gemm(LAS char* lds, const h16* A, const h16* Bt, int M, int N, int K, const Epi& E) {
    asm volatile("s_waitcnt vmcnt(0) lgkmcnt(0)" ::: "memory"); __syncthreads();
    pg8::Gemm g{(const pg8::bf16_t*)A, (const pg8::bf16_t*)Bt, M, N, K};
    pg8::StaticOrder So; So.init(M, N, (int)gridDim.x, (int)blockIdx.x);
    pg8::gemm_phase<Epi, pg8::StaticOrder, ALIGN, true>((PG8_LAS unsigned char*)lds, g, So, E);
    asm volatile("s_waitcnt vmcnt(0) lgkmcnt(0)" ::: "memory"); __syncthreads();
}

template <bool SWAP, class Epi, int DBG = 0>
__device__ __forceinline__ void gemm_job(LAS char* lds, const h16* A, int lda, const h16* Wt, int ldw, int M, int N, int K, const Epi& epi, int first = 0) {
    const int ntn = N / G_BN, ntiles = (M / G_BM) * ntn;
    const RowDense rp{A, lda};
    const int G = gridDim.x, bx = blockIdx.x, vid = (G % 8 == 0) ? (bx % 8) * (G / 8) + bx / 8 : bx;
    for (int tix = (vid + G - first % G) % G; tix < ntiles; tix += G) {
        const int mt = tix / ntn, nt_ = tix - mt * ntn;
        gemm_tile<SWAP, RowDense, Epi, DBG>(lds, rp, Wt, ldw, K, mt * G_BM, nt_ * G_BN, epi);
    }
}

template <class RowMap, class Gain>
__device__ __forceinline__ void wt_item(const float* W, int N, int K, h16* Wt, LAS float* scr, int k0, int n0, int lane, const RowMap& rowmap, const Gain& gain) {
#pragma unroll
    for (int i = 0; i < 32; ++i) { const int kk = 2 * i + (lane >> 5); scr[kk * 33 + (lane & 31)] = W[(size_t)(k0 + kk) * N + n0 + (lane & 31)] * gain(k0 + kk); }
    asm volatile("s_waitcnt lgkmcnt(0)" ::: "memory");
    const int c = lane & 7;
#pragma unroll
    for (int j = 0; j < 4; ++j) { const int n = (lane >> 3) + 8 * j; const LAS float* s = scr + (8 * c) * 33 + n;
        h16x8 o = {(h16)s[0], (h16)s[33], (h16)s[66], (h16)s[99], (h16)s[132], (h16)s[165], (h16)s[198], (h16)s[231]};
        *(h16x8*)(Wt + (size_t)rowmap(n0 + n) * K + k0 + 8 * c) = o; }
    asm volatile("s_waitcnt lgkmcnt(0)" ::: "memory");
}
struct GainNone { __device__ __forceinline__ float operator()(int) const { return 1.f; } };
struct Gain1 { const float* g; __device__ __forceinline__ float operator()(int k) const { return g[k]; } };
struct Gain2 { const float* g; const float* g2; __device__ __forceinline__ float operator()(int k) const { return k < 512 ? g[k] : g2[k - 512]; } };
struct MapId { __device__ __forceinline__ int operator()(int n) const { return n; } };
struct MapIn { __device__ __forceinline__ int operator()(int n) const { return n < LAT ? 1536 + n : n - LAT; } };
struct MapKV { __device__ __forceinline__ int operator()(int n) const { const int h = n >> 7, j = n & 127; return j < 64 ? h * 64 + j : 512 + h * 64 + (j - 64); } };
struct MapG { int up; __device__ __forceinline__ int operator()(int j) const { return 32 * (j >> 4) + (j & 15) + up; } };

__device__ __forceinline__ void phase_prep(const Params& p, LAS char* lds) {
    const int tid = threadIdx.x, lane = tid & 63, wid = tid >> 6;
    const int gw = blockIdx.x * NWAVE + wid, NGW = gridDim.x * NWAVE, gt = blockIdx.x * NTHR + tid, NGT = gridDim.x * NTHR;
    LAS float* scr = (LAS float*)(lds + wid * 16384);
    for (int i = gt; i < 5 * 16384; i += NGT) PF(WS_SSQ)[i] = 0.f;
    for (int row = gw; row < T + MROWS; row += NGW) {
        const bool isx = row < T; const int r = isx ? row : row - T;
        const f32x4* src = (const f32x4*)((isx ? p.in[0] : p.in[1]) + (size_t)r * D) + lane;
        h16* dst = (isx ? PH(WS_XH) : PH(WS_MEMH)) + (size_t)r * D;
        float s = 0.f;
#pragma unroll
        for (int j = 0; j < 4; ++j) { const f32x4 v = src[64 * j]; s += v[0] * v[0] + v[1] * v[1] + v[2] * v[2] + v[3] * v[3]; *(h16x4*)(dst + (lane + 64 * j) * 4) = cvt4(v); }
        s = wave_sum(s);
        if (lane == 0) (isx ? PF(WS_SSX) : PF(WS_SSMEM))[r] = s;
    }
}
__device__ __forceinline__ void phase_prep_w(const Params& p, LAS char* lds) {
    const int tid = threadIdx.x, lane = tid & 63, wid = tid >> 6;
    const int gw = blockIdx.x * NWAVE + wid, NGW = gridDim.x * NWAVE, gt = blockIdx.x * NTHR + tid, NGT = gridDim.x * NTHR;
    LAS float* scr = (LAS float*)(lds + wid * 16384);
    (void)lane; (void)gw; (void)NGW; (void)gt; (void)NGT; (void)scr;
    {
        constexpr int I_IN = 16 * 61, I_UQ = 4 * 24, I_UKV = 2 * 32, I_SQ = 16 * 32, I_MKV = 16 * 64, I_EX = 16 * 8, I_DN = 4 * 32;
        constexpr int NIT = I_IN + I_UQ + I_UKV + 3 * I_SQ + I_MKV + NE * (2 * I_EX + I_DN);
        for (int it = gw; it < NIT; it += NGW) {
            int r = it;
            if (r < I_IN) { wt_item(p.in[3], INC, D, PH(WS_WIN), scr, (r / 61) * 64, (r % 61) * 32, lane, MapIn{}, Gain1{p.in[2]}); continue; } r -= I_IN;
            if (r < I_UQ) { wt_item(p.in[6], 768, 256, PH(WS_WUQ), scr, (r / 24) * 64, (r % 24) * 32, lane, MapId{}, Gain1{p.in[4]}); continue; } r -= I_UQ;
            if (r < I_UKV) { wt_item(p.in[7], 1024, 128, PH(WS_WUKV), scr, (r / 32) * 64, (r % 32) * 32, lane, MapKV{}, Gain1{p.in[5]}); continue; } r -= I_UKV;
            if (r < I_SQ) { wt_item(p.in[21], D, D, PH(WS_WOUT), scr, (r / 32) * 64, (r % 32) * 32, lane, MapId{}, Gain2{p.in[19], p.in[20]}); continue; } r -= I_SQ;
            if (r < I_SQ) { wt_item(p.in[24], D, D, PH(WS_WMQ), scr, (r / 32) * 64, (r % 32) * 32, lane, MapId{}, Gain1{p.in[22]}); continue; } r -= I_SQ;
            if (r < I_SQ) { wt_item(p.in[26], D, D, PH(WS_WMO), scr, (r / 32) * 64, (r % 32) * 32, lane, MapId{}, GainNone{}); continue; } r -= I_SQ;
            if (r < I_MKV) { wt_item(p.in[25], 2048, D, PH(WS_WMKV), scr, (r / 64) * 64, (r % 64) * 32, lane, MapId{}, Gain1{p.in[23]}); continue; } r -= I_MKV;
            const int e = r / (2 * I_EX + I_DN); r -= e * (2 * I_EX + I_DN);
            if (r < I_EX) { wt_item(p.in[32] + (size_t)e * D * DE, DE, D, PH(WS_WGU) + (size_t)e * 512 * D, scr, (r / 8) * 64, (r % 8) * 32, lane, MapG{0}, Gain1{p.in[27]}); continue; } r -= I_EX;
            if (r < I_EX) { wt_item(p.in[33] + (size_t)e * D * DE, DE, D, PH(WS_WGU) + (size_t)e * 512 * D, scr, (r / 8) * 64, (r % 8) * 32, lane, MapG{16}, Gain1{p.in[27]}); continue; } r -= I_EX;
            wt_item(p.in[34] + (size_t)e * DE * D, D, DE, PH(WS_WDN) + (size_t)e * D * DE, scr, (r / 32) * 64, (r % 32) * 32, lane, MapId{}, GainNone{});
        }
        for (int i = gt; i < 96 * D / 8; i += NGT) *(h16x8*)(PH(WS_WIN) + (size_t)INC * D + (size_t)i * 8) = (h16x8){0, 0, 0, 0, 0, 0, 0, 0};
    }
}
__device__ __forceinline__ void phase_prep_s(const Params& p, LAS char* lds) {
    const int tid = threadIdx.x, lane = tid & 63, wid = tid >> 6;
    const int gw = blockIdx.x * NWAVE + wid, NGW = gridDim.x * NWAVE, gt = blockIdx.x * NTHR + tid, NGT = gridDim.x * NTHR;
    LAS float* scr = (LAS float*)(lds + wid * 16384);
    (void)lane; (void)gw; (void)NGW; (void)gt; (void)NGT; (void)scr;
    for (int i = gt; i < S * 16; i += NGT) { const int t = i >> 4, pp = i & 15; const float inv = exp2f(-(float)pp * (13.287712379549449f / 16.0f)); float sn, cs; sincosf((float)t * inv, &sn, &cs);
        PF(WS_ROPE)[2 * i] = cs; PF(WS_ROPE)[2 * i + 1] = sn; }
    {
        LAS float* zf = scr; LAS float* h1 = scr + 64;
        const float* w1 = p.in[10]; const float* b1 = p.in[11]; const float* freq = p.in[12]; const float* w2 = p.in[13]; const float* b2 = p.in[14];
        for (int t = gw; t < S; t += NGW) {
            const int j = lane;
            if (j < 33) { float v;
                if (j == 0) v = (float)t / (float)S;
                else { const int bi = (j - 1) & 15; const float band = 1e-4f + (float)bi * ((15.0f - 1e-4f) / 15.0f);
                    double rev = (double)t * (double)band / (double)S; rev -= floor(rev); const float r2 = (float)(2.0 * rev);
                    v = (j <= 16) ? cospif(r2) : -sinpif(r2); }
                zf[j] = v; }
            asm volatile("s_waitcnt lgkmcnt(0)" ::: "memory");
            float a = b1[j];
            for (int i = 0; i < 33; ++i) a += zf[i] * w1[i * 64 + j];
            h1[j] = sinf(freq[j] * a);
            asm volatile("s_waitcnt lgkmcnt(0)" ::: "memory");
            float c = b2[j];
            for (int i = 0; i < 64; ++i) c += h1[i] * w2[i * 64 + j];
            PF(WS_H2)[t * 64 + j] = sinf(freq[64 + j] * c);
            asm volatile("s_waitcnt lgkmcnt(0)" ::: "memory");
        }
    }
}
__device__ __forceinline__ void phase_filt3(const Params& p, LAS char* lds) {
    const float* H2 = PF(WS_H2); const float* w3 = p.in[15]; const float* b3 = p.in[16]; const float* decay = p.in[17]; h16* R = PH(WS_R);
    LAS h16* tile = (LAS h16*)lds;
    LAS float* wl = (LAS float*)(lds + 65536);
    LAS float* cb = wl + 512;
    const int tid = threadIdx.x;
    for (int it = blockIdx.x; it < 256; it += gridDim.x) {
        const int o = it >> 7, c0 = (it & 127) * 4;
        __syncthreads();
        { const int j = tid >> 3, e = tid & 7, col = o * 1024 + (e >> 2) * 512 + c0 + (e & 3);
          wl[tid] = w3[j * 2048 + col];
          if (tid < 8) { const int cl = o * 1024 + (tid >> 2) * 512 + c0 + (tid & 3); cb[tid] = b3[cl]; cb[8 + tid] = fabsf(decay[cl]) * (1.0f / (float)S); } }
        __syncthreads();
        for (int i = 0; i < 8; ++i) {
            const int tau = tid + 512 * i;
            float acc[8];
#pragma unroll
            for (int e = 0; e < 8; ++e) acc[e] = cb[e];
#pragma unroll
            for (int j4 = 0; j4 < 16; ++j4) {
                const f32x4 hv = *(const f32x4*)(H2 + tau * 64 + j4 * 4);
#pragma unroll
                for (int jj = 0; jj < 4; ++jj) {
                    const f32x4 wa = *(LAS f32x4*)(wl + (j4 * 4 + jj) * 8), wb = *(LAS f32x4*)(wl + (j4 * 4 + jj) * 8 + 4);
                    acc[0] += hv[jj] * wa[0]; acc[1] += hv[jj] * wa[1]; acc[2] += hv[jj] * wa[2]; acc[3] += hv[jj] * wa[3];
                    acc[4] += hv[jj] * wb[0]; acc[5] += hv[jj] * wb[1]; acc[6] += hv[jj] * wb[2]; acc[7] += hv[jj] * wb[3];
                }
            }
#pragma unroll
            for (int e = 0; e < 8; ++e) {
                const float v = acc[e] * HY_FSCALE * __expf(-(float)tau * cb[8 + e]);
                const int ch = e & 3, dir = e >> 2;
                int u; float val = v;
                if (dir == 0) u = 4096 - tau;
                else { u = tau == 0 ? 0 : 4096 + tau; if (tau == 0) val = 0.f; }
                tile[ch * 8192 + u] = (h16)val;
            }
        }
        __syncthreads();
        for (int i = tid; i < 4 * 1024; i += NTHR) { const int ch = i >> 10, k = i & 1023;
            *(h16x8*)(R + ((size_t)(o * 512 + c0 + ch)) * 8192 + k * 8) = *(LAS h16x8*)(tile + ch * 8192 + k * 8); }
    }
    __syncthreads();
}
__device__ __forceinline__ void phase_krot(const Params& p) {
    const int gt = blockIdx.x * NTHR + threadIdx.x, NGT = gridDim.x * NTHR;
    const h16* lat = PH(WS_LAT); h16* K = PH(WS_K); const float* rope = PF(WS_ROPE);
    for (int i = gt; i < T * 4; i += NGT) {
        const int m = i >> 2, p0 = (i & 3) * 4, b = m >> 12, t = m & 4095;
        const h16x4 k1 = *(const h16x4*)(lat + (size_t)m * LAT + 384 + p0), k2 = *(const h16x4*)(lat + (size_t)m * LAT + 400 + p0);
        h16x4 o1, o2;
#pragma unroll
        for (int j = 0; j < 4; ++j) { const float cs = rope[((size_t)t * 16 + p0 + j) * 2], sn = rope[((size_t)t * 16 + p0 + j) * 2 + 1];
            const float a = (float)k1[j], c = (float)k2[j]; o1[j] = (h16)(a * cs - c * sn); o2[j] = (h16)(a * sn + c * cs); }
#pragma unroll
        for (int h = 0; h < NH; ++h) { h16* kp = K + ((size_t)((b * NH + h) * S + t)) * 96 + 64 + p0; *(h16x4*)kp = o1; *(h16x4*)(kp + 16) = o2; }
    }
}


constexpr int AT_KROW = 208, AT_VROW = 136, AT_KB = 64 * AT_KROW, AT_VB = 64 * AT_VROW, AT_BUF = AT_KB + AT_VB;
typedef float f32x2 __attribute__((ext_vector_type(2)));
constexpr float AT_THR = 6.0f;
__device__ __forceinline__ float at_max3(float a, float b, float c) { float r; asm("v_max3_f32 %0, %1, %2, %3" : "=v"(r) : "v"(a), "v"(b), "v"(c)); return r; }
__device__ __forceinline__ void phase_attn(const Params& p, LAS char* lds) {
    const int tid = threadIdx.x, lane = tid & 63, wid = __builtin_amdgcn_readfirstlane(tid >> 6), r32 = lane & 31, hi = lane >> 5;
    const h16* Qg = PH(WS_Q); const h16* Kg = PH(WS_K); const h16* Vtg = PH(WS_VT); h16* aout = PH(WS_AOUT);
    const int k0r = tid / 12, k0c = tid - 12 * k0r, c1 = tid + 512, k1r = c1 / 12, k1c = c1 - 12 * k1r;
    const int vdv = tid >> 3, vc = tid & 7;
    const int G = gridDim.x, bx = blockIdx.x, vid = (G % 8 == 0) ? (bx % 8) * (G / 8) + bx / 8 : bx;
    for (int u = vid; u < NB * NH * 16; u += G) {
        const int bh = u >> 4, q0 = (u & 15) * 256 + wid * 32;
        h16x8 qf[6];
        { const h16* qp = Qg + ((size_t)bh * S + q0 + r32) * 96 + 8 * hi;
#pragma unroll
          for (int s_ = 0; s_ < 6; ++s_) qf[s_] = *(const h16x8*)(qp + 16 * s_); }
        const h16* Kb = Kg + (size_t)bh * S * 96; const h16* Vb = Vtg + (size_t)bh * 64 * S + (size_t)vdv * S + vc * 8;
        h16x8 kr0, kr1, vr;
        kr0 = *(const h16x8*)(Kb + tid * 8); kr1 = kr0; if (tid < 256) kr1 = *(const h16x8*)(Kb + c1 * 8); vr = *(const h16x8*)(Vb);
        __syncthreads();
        { *(LAS h16x8*)(lds + k0r * AT_KROW + k0c * 16) = kr0; if (tid < 256) *(LAS h16x8*)(lds + k1r * AT_KROW + k1c * 16) = kr1;
          LAS char* vn = lds + AT_KB + vdv * AT_VROW + vc * 16; *(LAS h16x4*)vn = (h16x4){vr[0], vr[1], vr[2], vr[3]}; *(LAS h16x4*)(vn + 8) = (h16x4){vr[4], vr[5], vr[6], vr[7]}; }
        __syncthreads();
        f32x16 o0, o1;
#pragma unroll
        for (int r = 0; r < 16; ++r) { o0[r] = 0.f; o1[r] = 0.f; }
        float m = 0.f, l = 0.f;
        f32x16 negm;
#pragma unroll
        for (int r = 0; r < 16; ++r) negm[r] = 0.f;
        for (int t = 0; t < S / 64; ++t) {
            if (t + 1 < S / 64) {
                const h16* kn = Kb + (size_t)(t + 1) * 64 * 96;
                kr0 = *(const h16x8*)(kn + tid * 8); if (tid < 256) kr1 = *(const h16x8*)(kn + c1 * 8); vr = *(const h16x8*)(Vb + (t + 1) * 64);
            }
            LAS char* kb = lds + (t & 1) * AT_BUF; LAS char* vb = kb + AT_KB;
            f32x16 p0, p1;
            h16x8 ka[6], kc[6];
#pragma unroll
            for (int s_ = 0; s_ < 6; ++s_) { ka[s_] = *(LAS h16x8*)(kb + r32 * AT_KROW + s_ * 32 + hi * 16); kc[s_] = *(LAS h16x8*)(kb + (32 + r32) * AT_KROW + s_ * 32 + hi * 16); }
            __builtin_amdgcn_sched_barrier(0);
            p0 = __builtin_amdgcn_mfma_f32_32x32x16_f16(ka[0], qf[0], negm, 0, 0, 0);
            p1 = __builtin_amdgcn_mfma_f32_32x32x16_f16(kc[0], qf[0], negm, 0, 0, 0);
#pragma unroll
            for (int s_ = 1; s_ < 6; ++s_) {
                p0 = __builtin_amdgcn_mfma_f32_32x32x16_f16(ka[s_], qf[s_], p0, 0, 0, 0);
                p1 = __builtin_amdgcn_mfma_f32_32x32x16_f16(kc[s_], qf[s_], p1, 0, 0, 0);
            }
            __builtin_amdgcn_sched_barrier(0);
            h16x8 va[4], vc2[4];
            { LAS char* vb_ = vb + r32 * AT_VROW + 8 * hi;
#pragma unroll
              for (int f_ = 0; f_ < 4; ++f_) {
                  const h16x4 a_ = *(LAS h16x4*)(vb_ + f_ * 32), b_ = *(LAS h16x4*)(vb_ + f_ * 32 + 16), c_ = *(LAS h16x4*)(vb_ + 32 * AT_VROW + f_ * 32), d_ = *(LAS h16x4*)(vb_ + 32 * AT_VROW + f_ * 32 + 16);
                  va[f_] = (h16x8){a_[0], a_[1], a_[2], a_[3], b_[0], b_[1], b_[2], b_[3]}; vc2[f_] = (h16x8){c_[0], c_[1], c_[2], c_[3], d_[0], d_[1], d_[2], d_[3]}; } }
            __builtin_amdgcn_sched_barrier(0);
            asm volatile("s_nop 15\n\ts_nop 7" : "+v"(p0), "+v"(p1));
            float mx = at_max3(p0[0], p0[1], p1[0]);
#pragma unroll
            for (int r = 2; r < 16; r += 2) mx = at_max3(mx, p0[r], p0[r + 1]);
#pragma unroll
            for (int r = 1; r < 15; r += 2) mx = at_max3(mx, p1[r], p1[r + 1]);
            mx = fmaxf(mx, p1[15]);
            mx = fmaxf(mx, __shfl_xor(mx, 32));
            if (__any(mx > AT_THR) || t == 0) {
                const float dl = t == 0 ? mx : fmaxf(mx, 0.f);
                m += dl;
                const float al = __builtin_amdgcn_exp2f(-dl);
                l *= al;
#pragma unroll
                for (int r = 0; r < 16; ++r) { p0[r] -= dl; p1[r] -= dl; o0[r] *= al; o1[r] *= al; negm[r] = -m; }
            }
            f32x2 rs2 = {0.f, 0.f};
#pragma unroll
            for (int r = 0; r < 16; r += 2) { p0[r] = __builtin_amdgcn_exp2f(p0[r]); p0[r + 1] = __builtin_amdgcn_exp2f(p0[r + 1]); p1[r] = __builtin_amdgcn_exp2f(p1[r]); p1[r + 1] = __builtin_amdgcn_exp2f(p1[r + 1]);
                rs2 += (f32x2){p0[r], p0[r + 1]}; rs2 += (f32x2){p1[r], p1[r + 1]}; }
            l += rs2[0] + rs2[1];
            h16x8 pf[4];
#pragma unroll
            for (int j = 0; j < 8; ++j) { pf[0][j] = (h16)p0[j]; pf[1][j] = (h16)p0[8 + j]; pf[2][j] = (h16)p1[j]; pf[3][j] = (h16)p1[8 + j]; }
#pragma unroll
            for (int f_ = 0; f_ < 4; ++f_) {
                o0 = __builtin_amdgcn_mfma_f32_32x32x16_f16(va[f_], pf[f_], o0, 0, 0, 0);
                o1 = __builtin_amdgcn_mfma_f32_32x32x16_f16(vc2[f_], pf[f_], o1, 0, 0, 0);
            }
            if (t + 1 < S / 64) {
                LAS char* kn = lds + ((t + 1) & 1) * AT_BUF;
                *(LAS h16x8*)(kn + k0r * AT_KROW + k0c * 16) = kr0; if (tid < 256) *(LAS h16x8*)(kn + k1r * AT_KROW + k1c * 16) = kr1;
                LAS char* vn = kn + AT_KB + vdv * AT_VROW + vc * 16; *(LAS h16x4*)vn = (h16x4){vr[0], vr[1], vr[2], vr[3]}; *(LAS h16x4*)(vn + 8) = (h16x4){vr[4], vr[5], vr[6], vr[7]};
            }
            __syncthreads();
        }
        const float il = 1.f / (l + __shfl_xor(l, 32));
        const int b = bh >> 3, h = bh & 7;
        h16* ap = aout + ((size_t)(b * S + q0 + r32)) * 512 + h * 64 + 4 * hi;
#pragma unroll
        for (int g = 0; g < 4; ++g) {
            *(h16x4*)(ap + 8 * g) = (h16x4){(h16)(o0[4 * g] * il), (h16)(o0[4 * g + 1] * il), (h16)(o0[4 * g + 2] * il), (h16)(o0[4 * g + 3] * il)};
            *(h16x4*)(ap + 32 + 8 * g) = (h16x4){(h16)(o1[4 * g] * il), (h16)(o1[4 * g + 1] * il), (h16)(o1[4 * g + 2] * il), (h16)(o1[4 * g + 3] * il)};
        }
    }
    __syncthreads();
}
constexpr int HY_CS = 16448, HY_ZOFF = 4 * HY_CS, HY_ZB = 11584, HY_LDS = HY_ZOFF + 4 * HY_ZB;
static_assert(HY_LDS <= LDS_BYTES, "hyena lds");
__device__ __forceinline__ void phase_hyena(const Params& p, LAS char* lds) {
    const int tid = threadIdx.x, lane = tid & 63, wid = __builtin_amdgcn_readfirstlane(tid >> 6), r32 = lane & 31, hi = lane >> 5;
    const h16* hyT = PH(WS_HYT); const h16* Rg = PH(WS_R); const float* convw = p.in[8]; const float* convb = p.in[9]; const float* skip = p.in[18]; h16* hT = PH(WS_HT);
    const int G = gridDim.x, bx = blockIdx.x, vid = (G % 8 == 0) ? (bx % 8) * (G / 8) + bx / 8 : bx;
    __syncthreads();
    for (int i = tid; i < 4 * 16 * 36; i += NTHR) { const int batch = i / 576, rem = i - batch * 576, blk = rem / 36, w = rem - blk * 36, bi = blk < 8 ? blk : 64 + blk;
        *(LAS unsigned*)(lds + HY_ZOFF + batch * HY_ZB + bi * 144 + w * 4) = 0u; }
    const int i0 = wid * 8, q = r32 & 3, ii = r32 >> 2, batch = r32 & 3;
    const int abase = q * HY_CS + 2 * (4096 + 8 * hi - (r32 - q));
    const int bbase = HY_ZOFF + batch * HY_ZB + ((i0 + ii + 8) * 72 + 8 * hi) * 2;
    for (int c = vid; c < HYW; c += G) {
        for (int n = 0; n < 2; ++n) {
            __syncthreads();
            { const unsigned* Rc = (const unsigned*)(Rg + ((size_t)(n * 512 + c)) * 8192);
#pragma unroll
              for (int i = 0; i < 8; ++i) { const int w = tid + NTHR * i; const unsigned cur = Rc[w], prv = w > 0 ? Rc[w - 1] : 0u, odd = (prv >> 16) | (cur << 16);
                  *(LAS unsigned*)(lds + w * 4) = cur; *(LAS unsigned*)(lds + 2 * HY_CS + (w + 1) * 4) = cur;
                  *(LAS unsigned*)(lds + HY_CS + w * 4) = odd; *(LAS unsigned*)(lds + 3 * HY_CS + (w + 1) * 4) = odd; }
              if (tid == 0) { const unsigned last = Rc[4095] >> 16; *(LAS unsigned*)(lds + HY_CS + 4096 * 4) = last; *(LAS unsigned*)(lds + 3 * HY_CS + 4097 * 4) = last; } }
            if (n == 0) {
                const int ch = 1024 + c; const float w0 = convw[ch], w1 = convw[1536 + ch], w2 = convw[3072 + ch], bb = convb[ch];
                for (int i = tid; i < 4 * 512; i += NTHR) { const int bt = i >> 9, t0 = (i & 511) * 8; const h16* raw = hyT + ((size_t)(bt * 1536 + ch)) * S + t0;
                    const h16x8 v = *(const h16x8*)raw; float x[10]; x[0] = t0 > 0 ? (float)raw[-1] : 0.f; x[9] = t0 + 8 < S ? (float)raw[8] : 0.f;
#pragma unroll
                    for (int e = 0; e < 8; ++e) x[e + 1] = (float)v[e];
                    h16x8 o;
#pragma unroll
                    for (int e = 0; e < 8; ++e) o[e] = (h16)(w0 * x[e] + w1 * x[e + 1] + w2 * x[e + 2] + bb);
                    *(LAS h16x8*)(lds + HY_ZOFF + bt * HY_ZB + (((t0 >> 6) + 8) * 72 + (t0 & 63)) * 2) = o; }
            }
            __syncthreads();
            const int gch = n == 0 ? c : 512 + c;
            h16x4 gpre[8]; h16 gpl[8], gpr[8];
            { const h16* graw = hyT + ((size_t)(batch * 1536 + gch)) * S;
#pragma unroll
              for (int rt = 0; rt < 2; ++rt)
#pragma unroll
                  for (int g = 0; g < 4; ++g) { const int t4 = 64 * (i0 + ii) + 32 * rt + 8 * g + 4 * hi;
                      gpre[rt * 4 + g] = *(const h16x4*)(graw + t4); gpl[rt * 4 + g] = t4 > 0 ? graw[t4 - 1] : (h16)0.f; gpr[rt * 4 + g] = t4 + 4 < S ? graw[t4 + 4] : (h16)0.f; } }
            f32x16 acc0, acc1;
#pragma unroll
            for (int r = 0; r < 16; ++r) { acc0[r] = 0.f; acc1[r] = 0.f; }
#define HY_LDA(dst, ptr) do { const h16x4 l_ = *(volatile LAS h16x4*)(ptr), h_ = *(volatile LAS h16x4*)((ptr) + 8); dst = (h16x8){l_[0], l_[1], l_[2], l_[3], h_[0], h_[1], h_[2], h_[3]}; } while (0)
#define HY_LOAD(Sx, d_) do { LAS char* ap_ = lds + abase - 128 * (d_); LAS char* bp_ = lds + bbase - 144 * (d_); \
        HY_LDA(Sx##m32, ap_ - 64); HY_LDA(Sx##m16, ap_ - 32); HY_LDA(Sx##p0, ap_); HY_LDA(Sx##p16, ap_ + 32); \
        Sx##b0 = *(volatile LAS h16x8*)(bp_); Sx##b1 = *(volatile LAS h16x8*)(bp_ + 32); Sx##b2 = *(volatile LAS h16x8*)(bp_ + 64); Sx##b3 = *(volatile LAS h16x8*)(bp_ + 96); } while (0)
#define HY_MMA(Sx) do { \
        acc0 = __builtin_amdgcn_mfma_f32_32x32x16_f16(Sx##p0, Sx##b0, acc0, 0, 0, 0); acc1 = __builtin_amdgcn_mfma_f32_32x32x16_f16(Sx##m32, Sx##b0, acc1, 0, 0, 0); \
        acc0 = __builtin_amdgcn_mfma_f32_32x32x16_f16(Sx##p16, Sx##b1, acc0, 0, 0, 0); acc1 = __builtin_amdgcn_mfma_f32_32x32x16_f16(Sx##m16, Sx##b1, acc1, 0, 0, 0); \
        acc0 = __builtin_amdgcn_mfma_f32_32x32x16_f16(c32, Sx##b2, acc0, 0, 0, 0); acc1 = __builtin_amdgcn_mfma_f32_32x32x16_f16(Sx##p0, Sx##b2, acc1, 0, 0, 0); \
        acc0 = __builtin_amdgcn_mfma_f32_32x32x16_f16(c48, Sx##b3, acc0, 0, 0, 0); acc1 = __builtin_amdgcn_mfma_f32_32x32x16_f16(Sx##p16, Sx##b3, acc1, 0, 0, 0); \
        c32 = Sx##m32; c48 = Sx##m16; } while (0)
            h16x8 c32, c48, Xm32, Xm16, Xp0, Xp16, Xb0, Xb1, Xb2, Xb3, Ym32, Ym16, Yp0, Yp16, Yb0, Yb1, Yb2, Yb3;
            { LAS char* ap = lds + abase - 128 * (i0 - 64); HY_LDA(c32, ap - 64); HY_LDA(c48, ap - 32); }
            HY_LOAD(X, i0 - 63);
            for (int d = i0 - 63; d < i0 + 7; d += 2) {
                HY_LOAD(Y, d + 1);
                HY_MMA(X);
                HY_LOAD(X, d + 2);
                HY_MMA(Y);
            }
            HY_MMA(X);
#undef HY_LDA
#undef HY_LOAD
#undef HY_MMA
            __syncthreads();
            {
                const float w0 = convw[gch], w1 = convw[1536 + gch], w2 = convw[3072 + gch], bb = convb[gch], sk = skip[n * 512 + c];
#pragma unroll
                for (int rt = 0; rt < 2; ++rt)
#pragma unroll
                    for (int g = 0; g < 4; ++g) {
                        const int a4 = 32 * rt + 8 * g + 4 * hi, t4 = 64 * (i0 + ii) + a4;
                        LAS char* zp = lds + HY_ZOFF + batch * HY_ZB + ((i0 + ii + 8) * 72 + a4) * 2;
                        const h16x4 zo = *(LAS h16x4*)zp;
                        const h16x4 gv = gpre[rt * 4 + g];
                        float x[6]; x[0] = (float)gpl[rt * 4 + g]; x[5] = (float)gpr[rt * 4 + g];
#pragma unroll
                        for (int e = 0; e < 4; ++e) x[e + 1] = (float)gv[e];
                        h16x4 zn;
#pragma unroll
                        for (int e = 0; e < 4; ++e) { const float gc = w0 * x[e] + w1 * x[e + 1] + w2 * x[e + 2] + bb; const float y = (rt == 0 ? acc0[4 * g + e] : acc1[4 * g + e]) * HY_FINV;
                            zn[e] = (h16)(gc * (y + sk * (float)zo[e])); }
                        if (n == 0) *(LAS h16x4*)zp = zn; else *(h16x4*)(hT + ((size_t)(batch * 512 + c)) * S + t4) = zn;
                    }
            }
        }
    }
    __syncthreads();
}
__device__ __forceinline__ void phase_mixprep(const Params& p, LAS char* lds) {
    constexpr int LDT = 520;
    LAS h16* tile = (LAS h16*)lds;
    const h16* aout = PH(WS_AOUT); const h16* hT = PH(WS_HT); h16* mix = PH(WS_MIX);
    const int tid = threadIdx.x, lane = tid & 63, wid = tid >> 6;
    for (int u = blockIdx.x; u < T / 64; u += gridDim.x) {
        const int m0 = u * 64, b = m0 >> 12, t0 = m0 & 4095;
        __syncthreads();
        for (int i = tid; i < 512 * 8; i += NTHR) { const int c = i >> 3, j = i & 7;
            const h16x8 v = *(const h16x8*)(hT + ((size_t)(b * 512 + c)) * S + t0 + j * 8);
#pragma unroll
            for (int e = 0; e < 8; ++e) tile[(j * 8 + e) * LDT + c] = v[e]; }
        __syncthreads();
        for (int rr = 0; rr < 8; ++rr) {
            const int r = wid * 8 + rr; const size_t m = (size_t)(m0 + r);
            const h16x8 hv = *(LAS h16x8*)(tile + r * LDT + lane * 8);
            const h16x8 av = *(const h16x8*)(aout + m * 512 + lane * 8);
            float sh = 0.f, sa = 0.f;
#pragma unroll
            for (int e = 0; e < 8; ++e) { const float x = (float)hv[e], y = (float)av[e]; sh += x * x; sa += y * y; }
            sh = wave_sum(sh); sa = wave_sum(sa);
            const float rh = rstd_of(sh, 512), ra = rstd_of(sa, 512);
            h16x8 oh, oa;
#pragma unroll
            for (int e = 0; e < 8; ++e) { oh[e] = (h16)((float)hv[e] * rh); oa[e] = (h16)((float)av[e] * ra); }
            *(h16x8*)(mix + m * D + lane * 8) = oa; *(h16x8*)(mix + m * D + 512 + lane * 8) = oh;
        }
    }
    __syncthreads();
}
constexpr int XA_KROW = 528, XA_VROW = 136, XA_KB = 64 * XA_KROW, XA_VB = 128 * XA_VROW, XA_BUF = XA_KB + XA_VB;
static_assert(2 * XA_BUF <= LDS_BYTES, "xattn lds");
__device__ __forceinline__ void phase_xattn(const Params& p, LAS char* lds) {
    const int tid = threadIdx.x, lane = tid & 63, wid = __builtin_amdgcn_readfirstlane(tid >> 6), r32 = lane & 31, hi = lane >> 5;
    const h16* qc = PH(WS_QC); h16* oc = PH(WS_OC); const h16* Kc = PH(WS_KC); const h16* VcT = PH(WS_VCT);
    const int G = gridDim.x, bx = blockIdx.x, vid = (G % 8 == 0) ? (bx % 8) * (G / 8) + bx / 8 : bx;
    for (int u = vid; u < NB * MH * 16; u += G) {
        const int bh = u >> 4, b = bh >> 2, h = bh & 3, q0 = (u & 15) * 256 + wid * 32;
        const h16* qrow = qc + ((size_t)(b * S + q0 + r32)) * D + h * MHD; h16* orow = oc + ((size_t)(b * S + q0 + r32)) * D + h * MHD;
        h16x8 qf[16];
#pragma unroll
        for (int s_ = 0; s_ < 16; ++s_) qf[s_] = *(const h16x8*)(qrow + 16 * s_ + 8 * hi);
        const h16* Ksrc = Kc + ((size_t)(b * MEMT + (tid >> 5))) * D + h * MHD + (tid & 31) * 8;
        const h16* Vsrc = VcT + ((size_t)(bh * MHD + (tid >> 3))) * MEMT + (tid & 7) * 8;
        const int kdst = (tid >> 5) * XA_KROW + (tid & 31) * 16, vdst = XA_KB + (tid >> 3) * XA_VROW + (tid & 7) * 16;
        h16x8 kr[4], vr[2];
#pragma unroll
        for (int j = 0; j < 4; ++j) kr[j] = *(const h16x8*)(Ksrc + (size_t)(16 * j) * D);
#pragma unroll
        for (int j = 0; j < 2; ++j) vr[j] = *(const h16x8*)(Vsrc + (size_t)(64 * j) * MEMT);
        __syncthreads();
#pragma unroll
        for (int j = 0; j < 4; ++j) *(LAS h16x8*)(lds + kdst + 16 * j * XA_KROW) = kr[j];
#pragma unroll
        for (int j = 0; j < 2; ++j) { LAS char* vn = lds + vdst + 64 * j * XA_VROW; *(LAS h16x4*)vn = (h16x4){vr[j][0], vr[j][1], vr[j][2], vr[j][3]}; *(LAS h16x4*)(vn + 8) = (h16x4){vr[j][4], vr[j][5], vr[j][6], vr[j][7]}; }
        __syncthreads();
        f32x16 o[4]; float m = -1e30f, l = 0.f;
#pragma unroll
        for (int dt = 0; dt < 4; ++dt)
#pragma unroll
            for (int r = 0; r < 16; ++r) o[dt][r] = 0.f;
        for (int st = 0; st < 8; ++st) {
            const int t = st & 3, pass = st >> 2;
            if (st + 1 < 8) { const int t1 = (st + 1) & 3, p1 = (st + 1) >> 2;
#pragma unroll
                for (int j = 0; j < 4; ++j) kr[j] = *(const h16x8*)(Ksrc + (size_t)(64 * t1 + 16 * j) * D);
#pragma unroll
                for (int j = 0; j < 2; ++j) vr[j] = *(const h16x8*)(Vsrc + (size_t)(128 * p1 + 64 * j) * MEMT + 64 * t1); }
            LAS char* kb = lds + (st & 1) * XA_BUF; LAS char* vb = kb + XA_KB;
            f32x16 p0, p1_;
#pragma unroll
            for (int r = 0; r < 16; ++r) { p0[r] = 0.f; p1_[r] = 0.f; }
#pragma unroll
            for (int s_ = 0; s_ < 16; ++s_) {
                const h16x8 a0 = *(LAS h16x8*)(kb + r32 * XA_KROW + s_ * 32 + hi * 16);
                const h16x8 a1 = *(LAS h16x8*)(kb + (32 + r32) * XA_KROW + s_ * 32 + hi * 16);
                p0 = __builtin_amdgcn_mfma_f32_32x32x16_f16(a0, qf[s_], p0, 0, 0, 0);
                p1_ = __builtin_amdgcn_mfma_f32_32x32x16_f16(a1, qf[s_], p1_, 0, 0, 0);
            }
            float mx = fmaxf(p0[0], p1_[0]);
#pragma unroll
            for (int r = 1; r < 16; ++r) mx = fmaxf(mx, fmaxf(p0[r], p1_[r]));
            mx = fmaxf(mx, __shfl_xor(mx, 32));
            const float mn = fmaxf(m, mx), al = __builtin_amdgcn_exp2f(m - mn); m = mn;
            float rs = 0.f;
#pragma unroll
            for (int r = 0; r < 16; ++r) { p0[r] = __builtin_amdgcn_exp2f(p0[r] - mn); p1_[r] = __builtin_amdgcn_exp2f(p1_[r] - mn); rs += p0[r] + p1_[r]; }
            l = l * al + rs;
#pragma unroll
            for (int dt = 0; dt < 4; ++dt)
#pragma unroll
                for (int r = 0; r < 16; ++r) o[dt][r] *= al;
            h16x8 pf[2][2];
#pragma unroll
            for (int j = 0; j < 8; ++j) { pf[0][0][j] = (h16)p0[j]; pf[0][1][j] = (h16)p0[8 + j]; pf[1][0][j] = (h16)p1_[j]; pf[1][1][j] = (h16)p1_[8 + j]; }
#pragma unroll
            for (int kh = 0; kh < 2; ++kh)
#pragma unroll
                for (int s_ = 0; s_ < 2; ++s_)
#pragma unroll
                    for (int dt = 0; dt < 4; ++dt) {
                        LAS char* v0 = vb + (dt * 32 + r32) * XA_VROW + (kh * 32 + 16 * s_ + 4 * hi) * 2;
                        const h16x4 a = *(LAS h16x4*)v0, c = *(LAS h16x4*)(v0 + 16);
                        const h16x8 vf = {a[0], a[1], a[2], a[3], c[0], c[1], c[2], c[3]};
                        o[dt] = __builtin_amdgcn_mfma_f32_32x32x16_f16(vf, pf[kh][s_], o[dt], 0, 0, 0);
                    }
            if (st + 1 < 8) {
                LAS char* nb = lds + ((st + 1) & 1) * XA_BUF;
#pragma unroll
                for (int j = 0; j < 4; ++j) *(LAS h16x8*)(nb + kdst + 16 * j * XA_KROW) = kr[j];
#pragma unroll
                for (int j = 0; j < 2; ++j) { LAS char* vn = nb + vdst + 64 * j * XA_VROW; *(LAS h16x4*)vn = (h16x4){vr[j][0], vr[j][1], vr[j][2], vr[j][3]}; *(LAS h16x4*)(vn + 8) = (h16x4){vr[j][4], vr[j][5], vr[j][6], vr[j][7]}; }
            }
            if (t == 3) {
                const float il = 1.f / (l + __shfl_xor(l, 32));
                h16* op = orow + pass * 128 + 4 * hi;
#pragma unroll
                for (int dt = 0; dt < 4; ++dt)
#pragma unroll
                    for (int g = 0; g < 4; ++g) {
                        *(h16x4*)(op + dt * 32 + 8 * g) = (h16x4){(h16)(o[dt][4 * g] * il), (h16)(o[dt][4 * g + 1] * il), (h16)(o[dt][4 * g + 2] * il), (h16)(o[dt][4 * g + 3] * il)};
                        o[dt][4 * g] = 0.f; o[dt][4 * g + 1] = 0.f; o[dt][4 * g + 2] = 0.f; o[dt][4 * g + 3] = 0.f; }
                m = -1e30f; l = 0.f;
            }
            __syncthreads();
        }
    }
    __syncthreads();
}
__device__ __forceinline__ void phase_route(const Params& p, LAS char* lds, bool dry) {
    const float* X = p.X; const float* g = p.in[27]; const float* wrg = p.in[28]; const float* brg = p.in[29]; const float* wre = p.in[30]; const float* bre = p.in[31];
    float* ssx2 = PF(WS_SSX2); float* tokw = PF(WS_TOKW); int* cnt = PI(WS_CTL); int* list = PI(WS_LIST);
    LAS float* W = (LAS float*)lds;
    const int tid = threadIdx.x, lane = tid & 63, wid = tid >> 6;
    __syncthreads();
    for (int i = tid; i < D * 36; i += NTHR) { const int k = i / 36, j = i - 36 * k; W[i] = g[k] * (j < 4 ? wrg[k * 4 + j] : wre[k * 32 + (j - 4)]); }
    __syncthreads();
    const int b5 = (lane >> 5) & 1, b4 = (lane >> 4) & 1;
    for (int m0 = (blockIdx.x * NWAVE + wid) * 4; m0 < T; m0 += gridDim.x * NWAVE * 4) {
        float acc[4][36]; float ss[4];
#pragma unroll
        for (int t = 0; t < 4; ++t) { ss[t] = 0.f;
#pragma unroll
            for (int j = 0; j < 36; ++j) acc[t][j] = 0.f; }
#pragma unroll 2
        for (int i = 0; i < 16; ++i) {
            const int k = lane + 64 * i;
            float xv[4];
#pragma unroll
            for (int t = 0; t < 4; ++t) { xv[t] = X[(size_t)(m0 + t) * D + k]; ss[t] += xv[t] * xv[t]; }
#pragma unroll
            for (int j4 = 0; j4 < 9; ++j4) { const f32x4 w = *(LAS f32x4*)(W + k * 36 + j4 * 4);
#pragma unroll
                for (int t = 0; t < 4; ++t) { acc[t][j4 * 4] += xv[t] * w[0]; acc[t][j4 * 4 + 1] += xv[t] * w[1]; acc[t][j4 * 4 + 2] += xv[t] * w[2]; acc[t][j4 * 4 + 3] += xv[t] * w[3]; } }
        }
#pragma unroll
        for (int t = 0; t < 4; ++t) {
            const int m = m0 + t;
            const float sst = wave_sum(ss[t]); const float rs = rstd_of(sst, D);
            float a18[18], a9[9];
#pragma unroll
            for (int j = 0; j < 18; ++j) { const float lo = acc[t][j], hi_ = acc[t][j + 18]; const float keep = b5 ? hi_ : lo, send = b5 ? lo : hi_; a18[j] = keep + __shfl_xor(send, 32); }
#pragma unroll
            for (int j = 0; j < 9; ++j) { const float lo = a18[j], hi_ = a18[j + 9]; const float keep = b4 ? hi_ : lo, send = b4 ? lo : hi_; a9[j] = keep + __shfl_xor(send, 16); }
#pragma unroll
            for (int j = 0; j < 9; ++j) { float v = a9[j]; v += __shfl_xor(v, 8); v += __shfl_xor(v, 4); v += __shfl_xor(v, 2); v += __shfl_xor(v, 1); a9[j] = v * rs; }
            float lg[36];
#pragma unroll
            for (int s_ = 0; s_ < 4; ++s_)
#pragma unroll
                for (int j = 0; j < 9; ++j) lg[9 * s_ + j] = __builtin_bit_cast(float, __builtin_amdgcn_readlane(__builtin_bit_cast(int, a9[j]), 16 * s_));
            float gl[4]; int gi = 0; float gm = -1e30f;
#pragma unroll
            for (int j = 0; j < 4; ++j) { gl[j] = lg[j] + brg[j]; if (gl[j] > gm) { gm = gl[j]; gi = j; } }
            float gs = 0.f;
#pragma unroll
            for (int j = 0; j < 4; ++j) gs += expf(gl[j] - gm);
            const float pg = 1.f / gs;
            float e1 = -1e30f, e2 = -1e30f; int i1 = 0, i2 = 0;
#pragma unroll
            for (int g4 = 0; g4 < 4; ++g4) if (g4 == gi) {
#pragma unroll
                for (int j = 0; j < 8; ++j) { const float v = lg[4 + g4 * 8 + j] + bre[g4 * 8 + j];
                    if (v > e1) { e2 = e1; i2 = i1; e1 = v; i1 = j; } else if (v > e2) { e2 = v; i2 = j; } } }
            if (lane == 0) {
                const float p2 = 1.f / (1.f + expf(e1 - e2)), p1 = 1.f - p2;
                const int ea = gi * 8 + i1, eb = gi * 8 + i2;
                ssx2[m] = sst; tokw[m * 2] = pg * p1; tokw[m * 2 + 1] = pg * p2;
                if (!dry) { const int pa = atomicAdd(&cnt[ea], 1), pb = atomicAdd(&cnt[eb], 1); list[ea * T + pa] = m * 2; list[eb * T + pb] = m * 2 + 1; }
            }
        }
    }
    __syncthreads();
}
struct RowGather { const h16* A; const int* lst; int Me; __device__ __forceinline__ const h16* operator()(int m) const { const int pr = m < Me ? lst[m] : lst[0]; return A + (size_t)(pr >> 1) * D; } };
struct RowClamp { const h16* A; int Me; __device__ __forceinline__ const h16* operator()(int m) const { return A + (size_t)(m < Me ? m : 0) * DE; } };
struct EGu { const int* lst; int Me; const float* ssx2; const float* tokw; h16* hb;
    __device__ __forceinline__ void row32(int m, int nb, f32x4 va, f32x4 vb) const {
        if (m >= Me) return;
        const int pr = lst[m]; const float rs = rstd_of(ssx2[pr >> 1], D), w = tokw[pr];
        h16x4 o;
#pragma unroll
        for (int j = 0; j < 4; ++j) { const float a = va[j] * rs, bb = vb[j] * rs; o[j] = (h16)(a / (1.f + __expf(-a)) * bb * w); }
        *(h16x4*)(hb + (size_t)m * DE + (nb >> 5) * 16 + (nb & 31)) = o;
    } };
struct EDn { const int* lst; int Me; h16* yb;
    __device__ __forceinline__ void row32(int m, int nb, f32x4 va, f32x4 vb) const {
        if (m >= Me) return;
        h16* y = yb + (size_t)lst[m] * D + nb;
        *(h16x4*)y = cvt4(va); *(h16x4*)(y + 16) = cvt4(vb);
    } };
template <bool DOWN>
__device__ __forceinline__ void phase_moe(const Params& p, LAS char* lds) {
    const int* cnt = PI(WS_CTL);
    const int G = gridDim.x, bx = blockIdx.x, vid = (G % 8 == 0) ? (bx % 8) * (G / 8) + bx / 8 : bx;
    constexpr int NTN = DOWN ? D / G_BN : 512 / G_BN;
    int tbase = 0, off = 0;
    int tix = vid;
    for (int e = 0; e < NE; ++e) {
        const int Me = cnt[e], nmt = (Me + G_BM - 1) / G_BM, nte = nmt * NTN;
        const int* lst = PI(WS_LIST) + (size_t)e * T;
        for (; tix < tbase + nte; tix += G) {
            const int lt = tix - tbase, mt = lt / NTN, nt_ = lt - mt * NTN;
            if (!DOWN) gemm_tile<true>(lds, RowGather{PH(WS_X2H), lst, Me}, PH(WS_WGU) + (size_t)e * 512 * D, D, D, mt * G_BM, nt_ * G_BN,
                                       EGu{lst, Me, PF(WS_SSX2), PF(WS_TOKW), PH(WS_HB) + (size_t)off * DE});
            else gemm_tile<true>(lds, RowClamp{PH(WS_HB) + (size_t)off * DE, Me}, PH(WS_WDN) + (size_t)e * D * DE, DE, DE, mt * G_BM, nt_ * G_BN,
                                 EDn{lst, Me, PH(WS_YB)});
        }
        tbase += nte; off += Me;
    }
}
__device__ __forceinline__ void phase_final(const Params& p) {
    const float* X = p.X; const h16* yb = PH(WS_YB); const float* g = p.in[35]; float* out = p.X;
    const int lane = threadIdx.x & 63, gw = blockIdx.x * NWAVE + (threadIdx.x >> 6), NGW = gridDim.x * NWAVE;
    for (int m = gw; m < T; m += NGW) {
        f32x4 v[4]; float ss = 0.f;
#pragma unroll
        for (int i = 0; i < 4; ++i) { const int k = (lane + 64 * i) * 4;
            const f32x4 xv = *(const f32x4*)(X + (size_t)m * D + k); const h16x4 y0 = *(const h16x4*)(yb + ((size_t)m * 2) * D + k), y1 = *(const h16x4*)(yb + ((size_t)m * 2 + 1) * D + k);
#pragma unroll
            for (int j = 0; j < 4; ++j) { v[i][j] = xv[j] + (float)y0[j] + (float)y1[j]; ss += v[i][j] * v[i][j]; } }
        ss = wave_sum(ss); const float rs = rstd_of(ss, D);
#pragma unroll
        for (int i = 0; i < 4; ++i) { const int k = (lane + 64 * i) * 4; const f32x4 gv = *(const f32x4*)(g + k); *(f32x4*)(out + (size_t)m * D + k) = v[i] * rs * gv; }
    }
}

#define XB_TMO      128
#define XB_XCNT(j)  (256  + 64 * (j))
#define XB_XSUB(j)  (1280 + 64 * (j))
#define XB_XGEN(j)  (2304 + 64 * (j))
#define XB_TOP      3328
#define XB_TOPGEN   3392
#define XCD_BAR_WORDS 3456
#define XB_SPIN_CAP (1u << 18)
__device__ __forceinline__ unsigned xb_ld(unsigned* p)              { return __hip_atomic_load(p, __ATOMIC_RELAXED, __HIP_MEMORY_SCOPE_AGENT); }
__device__ __forceinline__ unsigned xb_add(unsigned* p, unsigned v) { return __hip_atomic_fetch_add(p, v, __ATOMIC_RELAXED, __HIP_MEMORY_SCOPE_AGENT); }
__device__ __forceinline__ unsigned xb_xcc_id() { return (unsigned)__builtin_amdgcn_s_getreg((3 << 11) | 20) & 0xFu; }
#define XB_SPIN(cond, bar) do { unsigned _sp = 0; while (cond) { __builtin_amdgcn_s_sleep(1); \
    if ((++_sp & 255u) == 0u) { if (xb_ld(&(bar)[XB_TMO])) break; if (_sp > XB_SPIN_CAP) { atomicAdd(&(bar)[XB_TMO], 1u); break; } } } } while (0)
struct XcdBarrier { unsigned* bar; unsigned x; volatile LAS unsigned* st; };
__device__ __forceinline__ XcdBarrier xcd_barrier_post(unsigned* bar, volatile LAS unsigned* st) {
    XcdBarrier b; b.bar = bar; b.x = xb_xcc_id(); b.st = st;
    if (threadIdx.x == 0) (void)xb_add(&bar[XB_XCNT(b.x)], 1u);
    return b;
}
__device__ __forceinline__ void xcd_barrier_complete(unsigned* bar, unsigned x, unsigned& nloc, unsigned& nx) {
    const unsigned G = gridDim.x * gridDim.y * gridDim.z;
    unsigned sum, cnt, mine, sp = 0u;
    for (;;) {
        sum = 0u; cnt = 0u; mine = 0u;
#pragma unroll
        for (unsigned j = 0; j < 16; ++j) { const unsigned c = xb_ld(&bar[XB_XCNT(j)]); sum += c; cnt += (c > 0u) ? 1u : 0u; mine = (j == x) ? c : mine; }
        if (sum == G) break;
        __builtin_amdgcn_s_sleep(1);
        if ((++sp & 255u) == 0u) { if (xb_ld(&bar[XB_TMO])) break; if (sp > XB_SPIN_CAP) { atomicAdd(&bar[XB_TMO], 1u); break; } }
    }
    nloc = mine > 0u ? mine : 1u; nx = cnt > 0u ? cnt : 1u;
}
__device__ __forceinline__ void xcd_barrier(const XcdBarrier& b) {
    asm volatile("s_waitcnt vmcnt(0)" ::: "memory");
    __syncthreads();
    if (threadIdx.x == 0) {
        unsigned* bar = b.bar;
        __builtin_amdgcn_s_waitcnt(0);
        unsigned nloc = b.st[0], nx = b.st[1];
        if (nloc == 0u) { xcd_barrier_complete(bar, b.x, nloc, nx); b.st[0] = nloc; b.st[1] = nx; }
        const unsigned old = xb_add(&bar[XB_XSUB(b.x)], 1u);
        const unsigned gen = old / nloc;
        if (old + 1u == (gen + 1u) * nloc) {
            __builtin_amdgcn_fence(__ATOMIC_RELEASE, "agent");
            asm volatile("s_waitcnt vmcnt(0)" ::: "memory");
            const unsigned og = xb_add(&bar[XB_TOP], 1u);
            const unsigned tg = og / nx;
            if (og + 1u == (tg + 1u) * nx) xb_add(&bar[XB_TOPGEN], 1u);
            else XB_SPIN(xb_ld(&bar[XB_TOPGEN]) == tg, bar);
            __builtin_amdgcn_fence(__ATOMIC_ACQUIRE, "agent");
            xb_add(&bar[XB_XGEN(b.x)], 1u);
            asm volatile("s_waitcnt vmcnt(0)" ::: "memory");
        } else {
            XB_SPIN(xb_ld(&bar[XB_XGEN(b.x)]) == gen, bar);
            __builtin_amdgcn_fence(__ATOMIC_ACQUIRE, "agent");
            asm volatile("s_waitcnt vmcnt(0)" ::: "memory");
        }
    }
    __syncthreads();
}

#ifndef DBG_MODE
#define DBG_MODE 0
#endif
#ifndef REP_PHASE
#define REP_PHASE -1
#endif
__global__ void __launch_bounds__(NTHR) mega(Params p, int ph_lo, int ph_hi) {
    extern __shared__ __attribute__((aligned(16))) char lds_raw[];
    LAS char* lds = (LAS char*)lds_raw;
    cg::grid_group grid = cg::this_grid();
    volatile LAS unsigned* misc = (volatile LAS unsigned*)(lds + LDS_BYTES - 64);
    if (threadIdx.x < 16) misc[threadIdx.x] = 0u;
    __syncthreads();
    const XcdBarrier bar = xcd_barrier_post((unsigned*)(p.ws + WS_BAR), misc);
#define PHASE(k) if (ph_lo <= (k) && (k) < ph_hi) for (int rep_ = 0; rep_ < ((k) == REP_PHASE ? 2 : 1); ++rep_)
#define SEAM(k) if (ph_lo <= (k) && (k) + 1 < ph_hi) { xcd_barrier(bar); }
    if (ph_hi > 1000) grid.sync();
    PHASE(0) { phase_prep(p, lds); }
    PHASE(16) { phase_prep_w(p, lds); }
    PHASE(17) { phase_prep_s(p, lds); }
    SEAM(0);
    PHASE(1) {
        const ELat el{PF(WS_SSX), PH(WS_LAT), rep_ ? nullptr : PF(WS_SSQ), PF(WS_SSKV)};
        pg_gemm<EInProj, false>(lds, PH(WS_XH), PH(WS_WIN), T, 1024, D, EInProj{PF(WS_SSX), PH(WS_HYT), el, 0});
        pg_gemm<EInProj, false>(lds, PH(WS_XH), PH(WS_WIN) + (size_t)1024 * D, T, 1024, D, EInProj{PF(WS_SSX), PH(WS_HYT), el, 4});
    }
    SEAM(1);
    PHASE(2) {
        gemm_job<true>(lds, PH(WS_LAT), LAT, PH(WS_WUQ), 256, T, 768, 256, EQ{PF(WS_SSQ), PF(WS_ROPE), PH(WS_Q)});
        gemm_job<true>(lds, PH(WS_LAT) + 256, LAT, PH(WS_WUKV), 128, T, 512, 128, EK{PF(WS_SSKV), PH(WS_K)}, 128);
        gemm_job<false>(lds, PH(WS_LAT) + 256, LAT, PH(WS_WUKV) + (size_t)512 * 128, 128, T, 512, 128, EV{PF(WS_SSKV), PH(WS_VT)}, 128);
        phase_krot(p);
    }
    PHASE(15) { phase_filt3(p, lds); }
    SEAM(2);
    PHASE(3) { phase_attn(p, lds); }
    PHASE(13) { phase_hyena(p, lds); }
    SEAM(3);
    PHASE(4) { phase_mixprep(p, lds); }
    PHASE(14) {
        gemm_job<true>(lds, PH(WS_MEMH), D, PH(WS_WMKV), D, MROWS, 1024, D, EKc{PF(WS_SSMEM), PH(WS_KC)});
        gemm_job<false>(lds, PH(WS_MEMH), D, PH(WS_WMKV) + (size_t)1024 * D, D, MROWS, 1024, D, EVc{PF(WS_SSMEM), PH(WS_VCT)}, 32);
    }
    SEAM(4);
    PHASE(5) { pg_gemm<PgRow<ERes>, false>(lds, PH(WS_MIX), PH(WS_WOUT), T, D, D, PgRow<ERes>{ERes{p.in[0], p.X, PH(WS_X1H), rep_ ? nullptr : PF(WS_SSX1)}}); }
    SEAM(5);
    PHASE(6) { pg_gemm<PgRow<EMq>, false>(lds, PH(WS_X1H), PH(WS_WMQ), T, D, D, PgRow<EMq>{EMq{PF(WS_SSX1), PH(WS_QC)}}); }
    SEAM(6);
    PHASE(7) { phase_xattn(p, lds); }
    SEAM(7);
    PHASE(8) { pg_gemm<PgRow<ERes>, false>(lds, PH(WS_OC), PH(WS_WMO), T, D, D, PgRow<ERes>{ERes{p.X, p.X, PH(WS_X2H), nullptr}}); }
    SEAM(8);
    PHASE(9) { phase_route(p, lds, rep_ != 0); }
    SEAM(9);
    PHASE(10) { phase_moe<false>(p, lds); }
    SEAM(10);
    PHASE(11) { phase_moe<true>(p, lds); }
    SEAM(11);
    PHASE(12) { phase_final(p); }
}

extern "C" void kernel_launch(void* const* d_in, const int* in_sizes, int n_in, void* d_out, int out_size, void* d_ws, size_t ws_size, hipStream_t st) {
    Params p{};
    for (int i = 0; i < 36; ++i) p.in[i] = (const float*)d_in[i];
    p.X = (float*)d_out; p.ws = (char*)d_ws;
    static int grid = 0;
    if (!grid) {
        (void)hipFuncSetAttribute((const void*)mega, hipFuncAttributeMaxDynamicSharedMemorySize, LDS_BYTES);
        int dev = 0, cus = 0, per_cu = 0;
        (void)hipGetDevice(&dev);
        (void)hipDeviceGetAttribute(&cus, hipDeviceAttributeMultiprocessorCount, dev);
        (void)hipOccupancyMaxActiveBlocksPerMultiprocessor(&per_cu, (const void*)mega, NTHR, LDS_BYTES);
        if (per_cu < 1) { fprintf(stderr, "kernel_launch: occupancy query says %d blocks/CU\n", per_cu); per_cu = 1; }
        grid = cus;
    }
    (void)hipMemsetAsync((char*)d_ws + WS_CTL, 0, 32 * 1024, st);
    int lo = 0, hi = 18;
    void* args[] = {&p, &lo, &hi};
    hipError_t e = hipLaunchCooperativeKernel((const void*)mega, dim3(grid), dim3(NTHR), args, LDS_BYTES, st);
    if (e != hipSuccess) fprintf(stderr, "cooperative launch failed: %s (grid %d)\n", hipGetErrorString(e), grid);
    (void)in_sizes; (void)n_in; (void)out_size; (void)ws_size;
}
```
